# Optimizing an MI355X kernel written in HIP

```python
import jax, jax.numpy as jnp
from jax import lax
import numpy as np

D_MODEL = 1024
BATCH = 8
SEQ = 2048
DEPTH = 1

CHUNK = 64
D_POOL = D_MODEL // 2
POOL_WINDOWS = (2, 4, 8, 16)
POOL_GROUPS = len(POOL_WINDOWS)
POOL_GC = D_POOL // POOL_GROUPS
D_MLSTM = D_MODEL // 2
N_HEADS = 4
HEAD_DIM = D_MLSTM // N_HEADS
CONV_K = 4
N_GROUPS = 4
EXPERTS_PER_GROUP = 8
N_EXPERTS = N_GROUPS * EXPERTS_PER_GROUP
TOP_K = 2
D_EXPERT = D_MODEL // 2
MOE_BLOCK = 128
EPS = 1e-6
SPLIT_SIZES = (D_POOL, D_MLSTM, D_MLSTM, D_MLSTM, D_MLSTM, N_HEADS, N_HEADS, D_MODEL, D_MODEL)
N_IN = sum(SPLIT_SIZES)

kernel_name = "hybrid_pool_mlstm_hmoe_block"


def rmsnorm(x, g):
    xf = x.astype(jnp.float32)
    y = xf * lax.rsqrt(jnp.mean(xf * xf, axis=-1, keepdims=True) + EPS) * g.astype(jnp.float32)
    return y.astype(x.dtype)


def pool_mixer(u, w_pool, pool_scale):
    B, S, _ = u.shape
    uf = u.astype(jnp.float32)
    cs = jnp.pad(jnp.cumsum(uf, axis=1), ((0, 0), (1, 0), (0, 0)))
    t = jnp.arange(S)
    outs = []
    for g, w in enumerate(POOL_WINDOWS):
        sl = slice(g * POOL_GC, (g + 1) * POOL_GC)
        start = jnp.maximum(t + 1 - w, 0)
        win_sum = cs[:, 1:, sl] - cs[:, start, sl]
        cnt = (t + 1 - start).astype(jnp.float32)
        outs.append(win_sum / cnt[None, :, None] - uf[:, :, sl])
    d = jnp.stack(outs, axis=2)
    y = jnp.einsum('bsgc,gcd->bsgd', d, w_pool.astype(jnp.float32)).reshape(B, S, D_POOL)
    return (y * pool_scale.astype(jnp.float32)).astype(u.dtype)


def causal_conv(u, w):
    S = u.shape[1]
    up = jnp.pad(u, ((0, 0), (CONV_K - 1, 0), (0, 0)))
    return sum(up[:, j:j + S, :] * w[j] for j in range(CONV_K))


def mlstm_chunkwise(q, k, v, i_pre, f_pre):
    B, S, H, Dh = q.shape
    NC, L = S // CHUNK, CHUNK

    def to_chunks(a):
        a = a.astype(jnp.float32).reshape((B, NC, L, H) + a.shape[3:])
        return jnp.moveaxis(a, 3, 1)

    q = to_chunks(q)
    k = to_chunks(k) * (Dh ** -0.5)
    v = to_chunks(v)
    ig = to_chunks(i_pre)
    lf = jax.nn.log_sigmoid(to_chunks(f_pre))
    b = jnp.cumsum(lf, axis=-1)
    b_last = b[..., -1]

    a_log = b_last[..., None] - b + ig
    a_max = jnp.max(a_log, axis=-1)
    w_loc = jnp.exp(a_log - a_max[..., None])
    C_loc = jnp.einsum('bhcld,bhcle->bhcde', w_loc[..., None] * k, v)
    n_loc = jnp.einsum('bhcl,bhcld->bhcd', w_loc, k)

    def step(carry, inp):
        C, n, m = carry
        bl, am, Cl, nl = inp
        m_new = jnp.maximum(bl + m, am)
        s_prev = jnp.exp(bl + m - m_new)
        s_loc = jnp.exp(am - m_new)
        C_new = s_prev[..., None, None] * C + s_loc[..., None, None] * Cl
        n_new = s_prev[..., None] * n + s_loc[..., None] * nl
        return (C_new, n_new, m_new), (C, n, m)

    init = (jnp.zeros((B, H, Dh, Dh), jnp.float32), jnp.zeros((B, H, Dh), jnp.float32),
            jnp.zeros((B, H), jnp.float32))
    xs = (jnp.moveaxis(b_last, 2, 0), jnp.moveaxis(a_max, 2, 0),
          jnp.moveaxis(C_loc, 2, 0), jnp.moveaxis(n_loc, 2, 0))
    _, (C_prev, n_prev, m_prev) = lax.scan(step, init, xs)
    C_prev = jnp.moveaxis(C_prev, 0, 2)
    n_prev = jnp.moveaxis(n_prev, 0, 2)
    m_prev = jnp.moveaxis(m_prev, 0, 2)

    inter_log = b + m_prev[..., None]
    causal = jnp.tril(jnp.ones((L, L), dtype=bool))
    D = b[..., :, None] - b[..., None, :] + ig[..., None, :]
    D = jnp.where(causal, D, -jnp.inf)
    m_t = jnp.maximum(inter_log, jnp.max(D, axis=-1))
    w_inter = jnp.exp(inter_log - m_t)
    s = jnp.einsum('bhctd,bhcsd->bhcts', q, k) * jnp.exp(D - m_t[..., None])
    num = (w_inter[..., None] * jnp.einsum('bhctd,bhcde->bhcte', q, C_prev)
           + jnp.einsum('bhcts,bhcse->bhcte', s, v))
    nq = w_inter * jnp.einsum('bhctd,bhcd->bhct', q, n_prev) + jnp.sum(s, axis=-1)
    den = jnp.maximum(jnp.abs(nq), jnp.exp(-m_t))
    h = num / den[..., None]
    return jnp.moveaxis(h, 1, 3).reshape(B, S, H, Dh)


def head_layernorm(h, g):
    B, S, H, Dh = h.shape
    mu = jnp.mean(h, axis=-1, keepdims=True)
    var = jnp.mean(jnp.square(h - mu), axis=-1, keepdims=True)
    hn = (h - mu) * lax.rsqrt(var + EPS)
    return hn * g.astype(jnp.float32).reshape(H, Dh)


def hybrid_mixer(h, w_in, b_if, conv_q, conv_k, g_head, w_pool, pool_scale, w_br_a, w_br_b, w_out):
    B, S, _ = h.shape
    z = h @ w_in
    idx = [int(c) for c in np.cumsum(SPLIT_SIZES)[:-1]]
    u_pool, q, k, v, o, i_pre, f_pre, ga, gb = jnp.split(z, idx, axis=-1)
    y_a = pool_mixer(u_pool, w_pool, pool_scale) @ w_br_a
    q = jax.nn.silu(causal_conv(q, conv_q)).reshape(B, S, N_HEADS, HEAD_DIM)
    k = jax.nn.silu(causal_conv(k, conv_k)).reshape(B, S, N_HEADS, HEAD_DIM)
    v = v.reshape(B, S, N_HEADS, HEAD_DIM)
    i_pre = i_pre.astype(jnp.float32) + b_if[:N_HEADS].astype(jnp.float32)
    f_pre = f_pre.astype(jnp.float32) + b_if[N_HEADS:].astype(jnp.float32)
    hm = mlstm_chunkwise(q, k, v, i_pre, f_pre)
    hm = head_layernorm(hm, g_head).reshape(B, S, D_MLSTM)
    hm = (jax.nn.sigmoid(o.astype(jnp.float32)) * hm).astype(h.dtype)
    y_b = hm @ w_br_b
    merged = jax.nn.sigmoid(ga) * y_a + jax.nn.sigmoid(gb) * y_b
    return merged @ w_out


def hier_moe(h, w_rg, b_rg, w_re, b_re, w_gate, w_up, w_down):
    B, S, D = h.shape
    T = B * S
    xt = h.reshape(T, D)
    g_logits = (xt @ w_rg).astype(jnp.float32) + b_rg.astype(jnp.float32)
    g_prob = jax.nn.softmax(g_logits, axis=-1)
    g_sel = jnp.argmax(g_logits, axis=-1)
    p_g = jnp.take_along_axis(g_prob, g_sel[:, None], axis=-1)
    e_logits = ((xt @ w_re).astype(jnp.float32) + b_re.astype(jnp.float32)).reshape(
        T, N_GROUPS, EXPERTS_PER_GROUP)
    e_sel = jnp.take_along_axis(e_logits, g_sel[:, None, None], axis=1)[:, 0]
    top_p, top_i = lax.top_k(jax.nn.softmax(e_sel, axis=-1), TOP_K)
    gate = p_g * top_p / jnp.sum(top_p, axis=-1, keepdims=True)
    expert_id = g_sel[:, None] * EXPERTS_PER_GROUP + top_i

    A = T * TOP_K
    flat_e = expert_id.reshape(A)
    flat_tok = jnp.repeat(jnp.arange(T), TOP_K)
    flat_w = gate.reshape(A)
    order = jnp.argsort(flat_e)
    e_s, tok_s, w_s = flat_e[order], flat_tok[order], flat_w[order]
    counts = jnp.bincount(flat_e, length=N_EXPERTS)
    padded = (counts + MOE_BLOCK - 1) // MOE_BLOCK * MOE_BLOCK
    off = jnp.cumsum(counts) - counts
    pend = jnp.cumsum(padded)
    poff = pend - padded
    dest = poff[e_s] + jnp.arange(A) - off[e_s]
    n_rows = A + N_EXPERTS * MOE_BLOCK
    n_blocks = n_rows // MOE_BLOCK
    buf = jnp.zeros((n_rows, D), h.dtype).at[dest].set(xt[tok_s])
    block_e = jnp.clip(jnp.searchsorted(pend, jnp.arange(n_blocks) * MOE_BLOCK, side='right'),
                       0, N_EXPERTS - 1)

    def run_block(args):
        xb, e = args
        hid = jax.nn.silu(xb @ w_gate[e]) * (xb @ w_up[e])
        return hid @ w_down[e]

    yb = lax.map(run_block, (buf.reshape(n_blocks, MOE_BLOCK, D), block_e)).reshape(n_rows, D)
    y = jnp.zeros((T, D), jnp.float32).at[tok_s].add(yb[dest].astype(jnp.float32) * w_s[:, None])
    return y.reshape(B, S, D).astype(h.dtype)


def setup_inputs(seed: int = 0) -> dict:
    key = jax.random.key(seed)
    ks = jax.random.split(key, 24)
    nrm = jax.random.normal
    f32 = jnp.float32
    x = nrm(ks[0], (BATCH, SEQ, D_MODEL), f32)
    g_mix = 1.0 + 0.1 * nrm(ks[1], (DEPTH, D_MODEL), f32)
    w_in = nrm(ks[2], (DEPTH, D_MODEL, N_IN), f32) * D_MODEL ** -0.5
    b_i = 0.1 * nrm(ks[3], (DEPTH, N_HEADS), f32)
    b_f = jnp.linspace(3.0, 6.0, N_HEADS, dtype=f32)[None] + 0.1 * nrm(ks[4], (DEPTH, N_HEADS), f32)
    b_if = jnp.concatenate([b_i, b_f], axis=-1)
    conv_q = nrm(ks[5], (DEPTH, CONV_K, D_MLSTM), f32) * CONV_K ** -0.5
    conv_k = nrm(ks[6], (DEPTH, CONV_K, D_MLSTM), f32) * CONV_K ** -0.5
    g_head = 1.0 + 0.1 * nrm(ks[7], (DEPTH, D_MLSTM), f32)
    w_pool = nrm(ks[8], (DEPTH, POOL_GROUPS, POOL_GC, POOL_GC), f32) * POOL_GC ** -0.5
    pool_scale = 1.0 + 0.1 * nrm(ks[9], (DEPTH, D_POOL), f32)
    w_br_a = nrm(ks[10], (DEPTH, D_POOL, D_MODEL), f32) * D_POOL ** -0.5
    w_br_b = nrm(ks[11], (DEPTH, D_MLSTM, D_MODEL), f32) * D_MLSTM ** -0.5
    w_out = nrm(ks[12], (DEPTH, D_MODEL, D_MODEL), f32) * D_MODEL ** -0.5
    g_ffn = 1.0 + 0.1 * nrm(ks[13], (DEPTH, D_MODEL), f32)
    w_rg = nrm(ks[14], (DEPTH, D_MODEL, N_GROUPS), f32) * D_MODEL ** -0.5
    b_rg = 0.01 * nrm(ks[15], (DEPTH, N_GROUPS), f32)
    w_re = nrm(ks[16], (DEPTH, D_MODEL, N_EXPERTS), f32) * D_MODEL ** -0.5
    b_re = 0.01 * nrm(ks[17], (DEPTH, N_EXPERTS), f32)
    w_e_gate = nrm(ks[18], (DEPTH, N_EXPERTS, D_MODEL, D_EXPERT), f32) * D_MODEL ** -0.5
    w_e_up = nrm(ks[19], (DEPTH, N_EXPERTS, D_MODEL, D_EXPERT), f32) * D_MODEL ** -0.5
    w_e_down = nrm(ks[20], (DEPTH, N_EXPERTS, D_EXPERT, D_MODEL), f32) * D_EXPERT ** -0.5
    g_final = 1.0 + 0.1 * nrm(ks[21], (D_MODEL,), f32)
    return {"x": x, "g_mix": g_mix, "w_in": w_in, "b_if": b_if, "conv_q": conv_q,
            "conv_k": conv_k, "g_head": g_head, "w_pool": w_pool, "pool_scale": pool_scale,
            "w_br_a": w_br_a, "w_br_b": w_br_b, "w_out": w_out, "g_ffn": g_ffn,
            "w_rg": w_rg, "b_rg": b_rg, "w_re": w_re, "b_re": b_re, "w_e_gate": w_e_gate,
            "w_e_up": w_e_up, "w_e_down": w_e_down, "g_final": g_final}


def reference(x, g_mix, w_in, b_if, conv_q, conv_k, g_head, w_pool, pool_scale, w_br_a, w_br_b,
              w_out, g_ffn, w_rg, b_rg, w_re, b_re, w_e_gate, w_e_up, w_e_down, g_final):
    for l in range(DEPTH):
        x = x + hybrid_mixer(rmsnorm(x, g_mix[l]), w_in[l], b_if[l], conv_q[l], conv_k[l],
                             g_head[l], w_pool[l], pool_scale[l], w_br_a[l], w_br_b[l], w_out[l])
        x = x + hier_moe(rmsnorm(x, g_ffn[l]), w_rg[l], b_rg[l], w_re[l], b_re[l],
                         w_e_gate[l], w_e_up[l], w_e_down[l])
    return rmsnorm(x, g_final)
```

```cpp
#include <hip/hip_runtime.h>
#include <cstdio>
#include <cstdint>

namespace {
constexpr int D = 1024, BATCH = 8, SEQ = 2048, T = BATCH * SEQ;
constexpr int DP = 512, DM = 512, NH = 4, HD = 128, NIN = 4616, NZ = 4608;
constexpr int NG = 4, EPG = 8, NE = 32, DE = 512;
constexpr float EPS = 1e-6f;
constexpr size_t MiB = 1u << 20;

typedef unsigned short bf16_t;
__device__ __forceinline__ bf16_t f2bf(float f) { unsigned u = __builtin_bit_cast(unsigned, f); return (bf16_t)((u + 0x7fffu + ((u >> 16) & 1u)) >> 16); }
__device__ __forceinline__ float bf2f(bf16_t b) { return __builtin_bit_cast(float, (unsigned)b << 16); }
__device__ __forceinline__ float sigmoidf_(float x) { return 1.f / (1.f + __expf(-x)); }
__device__ __forceinline__ float siluf_(float x) { return x / (1.f + __expf(-x)); }
__device__ __forceinline__ float logsigmoidf_(float x) { return fminf(x, 0.f) - log1pf(__expf(-fabsf(x))); }
__device__ __forceinline__ float wave_sum(float v) {
#pragma unroll
    for (int o = 1; o < 64; o <<= 1) v += __shfl_xor(v, o);
    return v;
}
__device__ __forceinline__ int zcol2orig(int c) { return c < 2560 ? c : c + 8; }

__global__ void __launch_bounds__(256) k_prep(const float* __restrict__ x, const float* __restrict__ g, const float* __restrict__ w_in,
                                               const float* __restrict__ b_if, bf16_t* __restrict__ h, float* __restrict__ gif) {
    const int wave = threadIdx.x >> 6, lane = threadIdx.x & 63;
    const int row = blockIdx.x * 4 + wave;
    if (row >= T) return;
    const float* xr = x + (size_t)row * D;
    float v[16]; float s = 0.f;
#pragma unroll
    for (int j = 0; j < 16; ++j) { v[j] = xr[lane + 64 * j]; s += v[j] * v[j]; }
    s = wave_sum(s);
    const float rstd = rsqrtf(s * (1.f / D) + EPS);
    float acc[8];
#pragma unroll
    for (int o = 0; o < 8; ++o) acc[o] = 0.f;
#pragma unroll
    for (int j = 0; j < 16; ++j) {
        const int k = lane + 64 * j;
        const float hv = v[j] * rstd * g[k];
        h[(size_t)row * D + k] = f2bf(hv);
#pragma unroll
        for (int o = 0; o < 8; ++o) acc[o] += hv * w_in[(size_t)k * NIN + 2560 + o];
    }
#pragma unroll
    for (int o = 0; o < 8; ++o) { acc[o] = wave_sum(acc[o]); }
    if (lane == 0) {
#pragma unroll
        for (int o = 0; o < 8; ++o) gif[(size_t)row * 8 + o] = acc[o] + b_if[o];
    }
}

template <class AL, class BL, class EP>
__global__ void __launch_bounds__(256) k_gemm(int M, int N, int K, AL al, BL bl, EP ep) {
    __shared__ float As[16][68];
    __shared__ float Bs[16][68];
    const int tid = threadIdx.x, tx = tid & 15, ty = tid >> 4;
    const int row0 = blockIdx.y * 64, col0 = blockIdx.x * 64;
    float acc[4][4];
#pragma unroll
    for (int i = 0; i < 4; ++i)
#pragma unroll
        for (int j = 0; j < 4; ++j) acc[i][j] = 0.f;
    for (int k0 = 0; k0 < K; k0 += 16) {
#pragma unroll
        for (int j = 0; j < 4; ++j) {
            const int idx = tid + j * 256;
            const int r = idx >> 4, kk = idx & 15;
            As[kk][r] = (row0 + r < M) ? al(row0 + r, k0 + kk) : 0.f;
            const int k2 = idx >> 6, n = idx & 63;
            Bs[k2][n] = (col0 + n < N) ? bl(k0 + k2, col0 + n) : 0.f;
        }
        __syncthreads();
#pragma unroll
        for (int kk = 0; kk < 16; ++kk) {
            float a[4], b[4];
#pragma unroll
            for (int i = 0; i < 4; ++i) a[i] = As[kk][ty * 4 + i];
#pragma unroll
            for (int j = 0; j < 4; ++j) b[j] = Bs[kk][tx * 4 + j];
#pragma unroll
            for (int i = 0; i < 4; ++i)
#pragma unroll
                for (int j = 0; j < 4; ++j) acc[i][j] += a[i] * b[j];
        }
        __syncthreads();
    }
#pragma unroll
    for (int i = 0; i < 4; ++i)
#pragma unroll
        for (int j = 0; j < 4; ++j) {
            const int r = row0 + ty * 4 + i, c = col0 + tx * 4 + j;
            if (r < M && c < N) ep(r, c, acc[i][j]);
        }
}

struct ALbf { const bf16_t* p; int ld; int pad; __device__ float operator()(int r, int k) const { return bf2f(p[(size_t)r * ld + k]); } };
struct ALf32 { const float* p; int ld; int pad; __device__ float operator()(int r, int k) const { return p[(size_t)r * ld + k]; } };
struct BLwin { const float* w; __device__ float operator()(int k, int n) const { return w[(size_t)k * NIN + zcol2orig(n)]; } };
struct BLplain { const float* w; int ld; int pad; __device__ float operator()(int k, int n) const { return w[(size_t)k * ld + n]; } };
struct EPz { bf16_t* z; __device__ void operator()(int r, int c, float v) const { z[(size_t)r * NZ + c] = f2bf(v); } };
struct EPf32 { float* o; int ld; int pad; __device__ void operator()(int r, int c, float v) const { o[(size_t)r * ld + c] = v; } };
struct EPmerge { const float* ya; const bf16_t* z; bf16_t* m;
    __device__ void operator()(int r, int c, float yb) const {
        const float ga = bf2f(z[(size_t)r * NZ + 2560 + c]), gb = bf2f(z[(size_t)r * NZ + 3584 + c]);
        m[(size_t)r * D + c] = f2bf(sigmoidf_(ga) * ya[(size_t)r * D + c] + sigmoidf_(gb) * yb); } };
struct EPres { const float* x; float* x1; __device__ void operator()(int r, int c, float v) const { x1[(size_t)r * D + c] = x[(size_t)r * D + c] + v; } };

__global__ void __launch_bounds__(256) k_conv(const bf16_t* __restrict__ z, const float* __restrict__ cq, const float* __restrict__ ck, float* __restrict__ qa, float* __restrict__ ka) {
    const size_t idx = (size_t)blockIdx.x * 256 + threadIdx.x;
    const int t = (int)(idx >> 9), c = (int)(idx & 511), s = t % SEQ;
    float aq = 0.f, ak = 0.f;
#pragma unroll
    for (int j = 0; j < 4; ++j) {
        const int ss = s - 3 + j;
        if (ss >= 0) {
            const size_t r = (size_t)(t - 3 + j) * NZ;
            aq += bf2f(z[r + 512 + c]) * cq[j * DM + c];
            ak += bf2f(z[r + 1024 + c]) * ck[j * DM + c];
        }
    }
    qa[idx] = siluf_(aq);
    ka[idx] = siluf_(ak) * 0.08838834764831845f;
}
__global__ void k_bcum(const float* __restrict__ gif, float* __restrict__ bcs) {
    const int bh = blockIdx.x * blockDim.x + threadIdx.x;
    if (bh >= BATCH * NH) return;
    const int b = bh / NH, hh = bh % NH;
    float acc = 0.f;
    for (int s = 0; s < SEQ; ++s) { acc += logsigmoidf_(gif[((size_t)b * SEQ + s) * 8 + 4 + hh]); bcs[(size_t)bh * SEQ + s] = acc; }
}
__global__ void __launch_bounds__(256) k_mlstm_naive(const float* __restrict__ qa, const float* __restrict__ ka, const bf16_t* __restrict__ z, const float* __restrict__ gif,
                                                      const float* __restrict__ bcs, const float* __restrict__ g_head, bf16_t* __restrict__ hm) {
    __shared__ float ks[32][129];
    __shared__ float vs[32][129];
    __shared__ float ws_[32];
    const int bh = blockIdx.x >> 5, qb = blockIdx.x & 31, b = bh / NH, hh = bh % NH;
    const int tid = threadIdx.x, tq = tid >> 2, part = tid & 3;
    const int t = qb * 64 + tq;
    const size_t rowq = (size_t)b * SEQ + t;
    float q[32];
#pragma unroll
    for (int j = 0; j < 32; ++j) q[j] = qa[rowq * DM + hh * HD + part * 32 + j];
    const float bt = bcs[(size_t)bh * SEQ + t];
    float num[32];
#pragma unroll
    for (int j = 0; j < 32; ++j) num[j] = 0.f;
    float nq = 0.f;
    for (int kb = 0; kb <= qb * 2 + 1; ++kb) {
        __syncthreads();
        for (int i = tid; i < 32 * 128; i += 256) {
            const int r = i >> 7, c = i & 127; const size_t row = (size_t)b * SEQ + kb * 32 + r;
            ks[r][c] = ka[row * DM + hh * HD + c];
            vs[r][c] = bf2f(z[row * NZ + 1536 + hh * HD + c]);
        }
        if (tid < 32) { const size_t row = (size_t)b * SEQ + kb * 32 + tid; ws_[tid] = gif[row * 8 + hh] - bcs[(size_t)bh * SEQ + kb * 32 + tid]; }
        __syncthreads();
        for (int s = 0; s < 32; ++s) {
            if (kb * 32 + s > t) break;
            float d = 0.f;
#pragma unroll
            for (int j = 0; j < 32; ++j) d += q[j] * ks[s][part * 32 + j];
            d += __shfl_xor(d, 1); d += __shfl_xor(d, 2);
            const float w = d * __expf(bt + ws_[s]);
            nq += w;
#pragma unroll
            for (int j = 0; j < 32; ++j) num[j] += w * vs[s][part * 32 + j];
        }
    }
    const float den = fmaxf(fabsf(nq), 1.f);
    float s1 = 0.f;
#pragma unroll
    for (int j = 0; j < 32; ++j) { num[j] /= den; s1 += num[j]; }
    s1 += __shfl_xor(s1, 1); s1 += __shfl_xor(s1, 2);
    const float mu = s1 * (1.f / HD);
    float s2 = 0.f;
#pragma unroll
    for (int j = 0; j < 32; ++j) { const float dd = num[j] - mu; s2 += dd * dd; }
    s2 += __shfl_xor(s2, 1); s2 += __shfl_xor(s2, 2);
    const float rstd = rsqrtf(s2 * (1.f / HD) + EPS);
#pragma unroll
    for (int j = 0; j < 32; ++j) {
        const int c = hh * HD + part * 32 + j;
        const float o = bf2f(z[rowq * NZ + 2048 + c]);
        hm[rowq * DM + c] = f2bf((num[j] - mu) * rstd * g_head[c] * sigmoidf_(o));
    }
}
__global__ void __launch_bounds__(256) k_pool(const bf16_t* __restrict__ z, bf16_t* __restrict__ dA) {
    const size_t idx = (size_t)blockIdx.x * 256 + threadIdx.x;
    const int t = (int)(idx >> 9), c = (int)(idx & 511), s = t % SEQ, g = c >> 7;
    const int w = 2 << g;
    const int start = max(s + 1 - w, 0), cnt = s + 1 - start;
    float acc = 0.f;
    for (int j = 0; j < cnt; ++j) acc += bf2f(z[(size_t)(t - j) * NZ + c]);
    dA[idx] = f2bf(acc / (float)cnt - bf2f(z[(size_t)t * NZ + c]));
}
__global__ void __launch_bounds__(256) k_poolmm(const bf16_t* __restrict__ dA, const float* __restrict__ w_pool, const float* __restrict__ scale, float* __restrict__ yp) {
    const size_t idx = (size_t)blockIdx.x * 256 + threadIdx.x;
    const int t = (int)(idx >> 9), j = (int)(idx & 511), g = j >> 7, jj = j & 127;
    float acc = 0.f;
    for (int c = 0; c < 128; ++c) acc += bf2f(dA[(size_t)t * DP + g * 128 + c]) * w_pool[((size_t)g * 128 + c) * 128 + jj];
    yp[idx] = acc * scale[j];
}

__global__ void __launch_bounds__(256) k_route(const float* __restrict__ x1, const float* __restrict__ g_ffn, const float* __restrict__ w_rg, const float* __restrict__ b_rg,
                                                const float* __restrict__ w_re, const float* __restrict__ b_re, float* __restrict__ rstd2, int* __restrict__ sel, float* __restrict__ gw,
                                                int* __restrict__ counts, int* __restrict__ lists) {
    const int wave = threadIdx.x >> 6, lane = threadIdx.x & 63;
    const int tok = blockIdx.x * 4 + wave;
    const float* xr = x1 + (size_t)tok * D;
    float v[16]; float s = 0.f;
#pragma unroll
    for (int j = 0; j < 16; ++j) { v[j] = xr[lane + 64 * j]; s += v[j] * v[j]; }
    s = wave_sum(s);
    const float rstd = rsqrtf(s * (1.f / D) + EPS);
    float lg[4] = {0.f, 0.f, 0.f, 0.f};
#pragma unroll
    for (int j = 0; j < 16; ++j) { const int k = lane + 64 * j; v[j] = v[j] * rstd * g_ffn[k];
#pragma unroll
        for (int o = 0; o < 4; ++o) lg[o] += v[j] * w_rg[k * NG + o]; }
#pragma unroll
    for (int o = 0; o < 4; ++o) lg[o] = wave_sum(lg[o]) + b_rg[o];
    int gs = 0; float gm = lg[0];
#pragma unroll
    for (int o = 1; o < 4; ++o) if (lg[o] > gm) { gm = lg[o]; gs = o; }
    float den = 0.f;
#pragma unroll
    for (int o = 0; o < 4; ++o) den += __expf(lg[o] - gm);
    const float pg = 1.f / den;
    float le[8];
#pragma unroll
    for (int o = 0; o < 8; ++o) le[o] = 0.f;
#pragma unroll
    for (int j = 0; j < 16; ++j) { const int k = lane + 64 * j;
#pragma unroll
        for (int o = 0; o < 8; ++o) le[o] += v[j] * w_re[k * NE + gs * EPG + o]; }
#pragma unroll
    for (int o = 0; o < 8; ++o) le[o] = wave_sum(le[o]) + b_re[gs * EPG + o];
    int i1 = 0; float m1 = le[0];
#pragma unroll
    for (int o = 1; o < 8; ++o) if (le[o] > m1) { m1 = le[o]; i1 = o; }
    int i2 = -1; float m2 = -3.0e38f;
#pragma unroll
    for (int o = 0; o < 8; ++o) if (o != i1 && le[o] > m2) { m2 = le[o]; i2 = o; }
    const float e2 = __expf(m2 - m1);
    const float p1 = 1.f / (1.f + e2), p2 = e2 / (1.f + e2);
    if (lane == 0) {
        rstd2[tok] = rstd;
        const int ea = gs * EPG + i1, eb = gs * EPG + i2;
        sel[tok * 2] = ea; sel[tok * 2 + 1] = eb;
        gw[tok * 2] = pg * p1; gw[tok * 2 + 1] = pg * p2;
        const int pa = atomicAdd(&counts[ea], 1); lists[ea * T + pa] = tok * 2;
        const int pb = atomicAdd(&counts[eb], 1); lists[eb * T + pb] = tok * 2 + 1;
    }
}
__global__ void __launch_bounds__(256) k_moe_up(const float* __restrict__ x1, const float* __restrict__ rstd2, const float* __restrict__ g_ffn, const float* __restrict__ wg, const float* __restrict__ wu,
                                                 const int* __restrict__ counts, const int* __restrict__ lists, float* __restrict__ hid) {
    const int e = blockIdx.z, rt = blockIdx.y, ct = blockIdx.x;
    const int cnt = counts[e];
    if (rt * 64 >= cnt) return;
    __shared__ float As[16][68]; __shared__ float Bg[16][68]; __shared__ float Bu[16][68];
    __shared__ int toks[64]; __shared__ float rs[64];
    const int tid = threadIdx.x, tx = tid & 15, ty = tid >> 4;
    if (tid < 64) { const int r = rt * 64 + tid; const int a = (r < cnt) ? lists[e * T + r] : -1; toks[tid] = a; rs[tid] = (a >= 0) ? rstd2[a >> 1] : 0.f; }
    __syncthreads();
    float ag[4][4], au[4][4];
#pragma unroll
    for (int i = 0; i < 4; ++i)
#pragma unroll
        for (int j = 0; j < 4; ++j) { ag[i][j] = 0.f; au[i][j] = 0.f; }
    const float* wge = wg + (size_t)e * D * DE; const float* wue = wu + (size_t)e * D * DE;
    for (int k0 = 0; k0 < D; k0 += 16) {
#pragma unroll
        for (int j = 0; j < 4; ++j) {
            const int idx = tid + j * 256; const int r = idx >> 4, kk = idx & 15;
            const int a = toks[r];
            As[kk][r] = (a >= 0) ? x1[(size_t)(a >> 1) * D + k0 + kk] * rs[r] * g_ffn[k0 + kk] : 0.f;
            const int k2 = idx >> 6, n = idx & 63;
            Bg[k2][n] = wge[(size_t)(k0 + k2) * DE + ct * 64 + n];
            Bu[k2][n] = wue[(size_t)(k0 + k2) * DE + ct * 64 + n];
        }
        __syncthreads();
#pragma unroll
        for (int kk = 0; kk < 16; ++kk) {
            float a[4], bg[4], bu[4];
#pragma unroll
            for (int i = 0; i < 4; ++i) a[i] = As[kk][ty * 4 + i];
#pragma unroll
            for (int j = 0; j < 4; ++j) { bg[j] = Bg[kk][tx * 4 + j]; bu[j] = Bu[kk][tx * 4 + j]; }
#pragma unroll
            for (int i = 0; i < 4; ++i)
#pragma unroll
                for (int j = 0; j < 4; ++j) { ag[i][j] += a[i] * bg[j]; au[i][j] += a[i] * bu[j]; }
        }
        __syncthreads();
    }
#pragma unroll
    for (int i = 0; i < 4; ++i) { const int a = toks[ty * 4 + i]; if (a < 0) continue;
#pragma unroll
        for (int j = 0; j < 4; ++j) hid[(size_t)a * DE + ct * 64 + tx * 4 + j] = siluf_(ag[i][j]) * au[i][j]; }
}
__global__ void __launch_bounds__(256) k_moe_down(const float* __restrict__ hid, const float* __restrict__ wd, const float* __restrict__ gw, const int* __restrict__ counts, const int* __restrict__ lists, bf16_t* __restrict__ yb) {
    const int e = blockIdx.z, rt = blockIdx.y, ct = blockIdx.x;
    const int cnt = counts[e];
    if (rt * 64 >= cnt) return;
    __shared__ float As[16][68]; __shared__ float Bs[16][68];
    __shared__ int toks[64];
    const int tid = threadIdx.x, tx = tid & 15, ty = tid >> 4;
    if (tid < 64) { const int r = rt * 64 + tid; toks[tid] = (r < cnt) ? lists[e * T + r] : -1; }
    __syncthreads();
    float acc[4][4];
#pragma unroll
    for (int i = 0; i < 4; ++i)
#pragma unroll
        for (int j = 0; j < 4; ++j) acc[i][j] = 0.f;
    const float* wde = wd + (size_t)e * DE * D;
    for (int k0 = 0; k0 < DE; k0 += 16) {
#pragma unroll
        for (int j = 0; j < 4; ++j) {
            const int idx = tid + j * 256; const int r = idx >> 4, kk = idx & 15;
            const int a = toks[r];
            As[kk][r] = (a >= 0) ? hid[(size_t)a * DE + k0 + kk] : 0.f;
            const int k2 = idx >> 6, n = idx & 63;
            Bs[k2][n] = wde[(size_t)(k0 + k2) * D + ct * 64 + n];
        }
        __syncthreads();
#pragma unroll
        for (int kk = 0; kk < 16; ++kk) {
            float a[4], b[4];
#pragma unroll
            for (int i = 0; i < 4; ++i) a[i] = As[kk][ty * 4 + i];
#pragma unroll
            for (int j = 0; j < 4; ++j) b[j] = Bs[kk][tx * 4 + j];
#pragma unroll
            for (int i = 0; i < 4; ++i)
#pragma unroll
                for (int j = 0; j < 4; ++j) acc[i][j] += a[i] * b[j];
        }
        __syncthreads();
    }
#pragma unroll
    for (int i = 0; i < 4; ++i) { const int a = toks[ty * 4 + i]; if (a < 0) continue; const float w = gw[a];
#pragma unroll
        for (int j = 0; j < 4; ++j) yb[(size_t)a * D + ct * 64 + tx * 4 + j] = f2bf(acc[i][j] * w); }
}
__global__ void __launch_bounds__(256) k_final(const float* __restrict__ x1, const bf16_t* __restrict__ yb, const float* __restrict__ g, float* __restrict__ out) {
    const int wave = threadIdx.x >> 6, lane = threadIdx.x & 63;
    const int tok = blockIdx.x * 4 + wave;
    float v[16]; float s = 0.f;
#pragma unroll
    for (int j = 0; j < 16; ++j) { const int k = lane + 64 * j;
        v[j] = x1[(size_t)tok * D + k] + bf2f(yb[(size_t)(tok * 2) * D + k]) + bf2f(yb[(size_t)(tok * 2 + 1) * D + k]); s += v[j] * v[j]; }
    s = wave_sum(s);
    const float rstd = rsqrtf(s * (1.f / D) + EPS);
#pragma unroll
    for (int j = 0; j < 16; ++j) { const int k = lane + 64 * j; out[(size_t)tok * D + k] = v[j] * rstd * g[k]; }
}
}

extern "C" void kernel_launch(void* const* d_in, const int* in_sizes, int n_in, void* d_out, int out_size, void* d_ws, size_t ws_size, hipStream_t stream) {
    const float* x = (const float*)d_in[0]; const float* g_mix = (const float*)d_in[1]; const float* w_in = (const float*)d_in[2]; const float* b_if = (const float*)d_in[3];
    const float* conv_q = (const float*)d_in[4]; const float* conv_k = (const float*)d_in[5]; const float* g_head = (const float*)d_in[6]; const float* w_pool = (const float*)d_in[7];
    const float* pool_scale = (const float*)d_in[8]; const float* w_br_a = (const float*)d_in[9]; const float* w_br_b = (const float*)d_in[10]; const float* w_out = (const float*)d_in[11];
    const float* g_ffn = (const float*)d_in[12]; const float* w_rg = (const float*)d_in[13]; const float* b_rg = (const float*)d_in[14]; const float* w_re = (const float*)d_in[15];
    const float* b_re = (const float*)d_in[16]; const float* w_eg = (const float*)d_in[17]; const float* w_eu = (const float*)d_in[18]; const float* w_ed = (const float*)d_in[19];
    const float* g_final = (const float*)d_in[20];
    if (n_in != 21 || out_size != T * D || ws_size < 282 * MiB) { fprintf(stderr, "kernel_launch: unexpected shapes/ws (%d inputs, out %d, ws %zu)\n", n_in, out_size, ws_size); return; }
    unsigned char* ws = (unsigned char*)d_ws; unsigned char* ob = (unsigned char*)d_out;
    int* counts = (int*)(ws + 0);
    float* gif = (float*)(ws + 1 * MiB);
    float* bcs = (float*)(ws + 2 * MiB);
    float* rstd2 = (float*)(ws + 3 * MiB); int* sel = (int*)(ws + 3 * MiB + 256 * 1024); float* gw = (float*)(ws + 3 * MiB + 512 * 1024);
    int* lists = (int*)(ws + 4 * MiB);
    bf16_t* h = (bf16_t*)(ws + 8 * MiB);
    bf16_t* merged = h;
    bf16_t* z = (bf16_t*)(ws + 40 * MiB);
    float* qa = (float*)(ws + 184 * MiB); float* ka = (float*)(ws + 216 * MiB);
    float* ya = (float*)(ws + 184 * MiB);
    float* x1 = (float*)(ws + 40 * MiB);
    float* hid = (float*)(ws + 104 * MiB);
    bf16_t* yb = (bf16_t*)(ws + 168 * MiB);
    bf16_t* dA = (bf16_t*)(ob); bf16_t* hm = (bf16_t*)(ob + 16 * MiB); float* yp = (float*)(ob + 32 * MiB);

    (void)hipMemsetAsync(counts, 0, 4096, stream);
    k_prep<<<T / 4, 256, 0, stream>>>(x, g_mix, w_in, b_if, h, gif);
    k_gemm<<<dim3(NZ / 64, T / 64), 256, 0, stream>>>(T, NZ, D, ALbf{h, D, 0}, BLwin{w_in}, EPz{z});
    k_conv<<<T * 512 / 256, 256, 0, stream>>>(z, conv_q, conv_k, qa, ka);
    k_bcum<<<1, 64, 0, stream>>>(gif, bcs);
    k_mlstm_naive<<<BATCH * NH * 32, 256, 0, stream>>>(qa, ka, z, gif, bcs, g_head, hm);
    k_pool<<<T * 512 / 256, 256, 0, stream>>>(z, dA);
    k_poolmm<<<T * 512 / 256, 256, 0, stream>>>(dA, w_pool, pool_scale, yp);
    k_gemm<<<dim3(D / 64, T / 64), 256, 0, stream>>>(T, D, DP, ALf32{yp, DP, 0}, BLplain{w_br_a, D, 0}, EPf32{ya, D, 0});
    k_gemm<<<dim3(D / 64, T / 64), 256, 0, stream>>>(T, D, DM, ALbf{hm, DM, 0}, BLplain{w_br_b, D, 0}, EPmerge{ya, z, merged});
    k_gemm<<<dim3(D / 64, T / 64), 256, 0, stream>>>(T, D, D, ALbf{merged, D, 0}, BLplain{w_out, D, 0}, EPres{x, x1});
    k_route<<<T / 4, 256, 0, stream>>>(x1, g_ffn, w_rg, b_rg, w_re, b_re, rstd2, sel, gw, counts, lists);
    k_moe_up<<<dim3(DE / 64, T / 64, NE), 256, 0, stream>>>(x1, rstd2, g_ffn, w_eg, w_eu, counts, lists, hid);
    k_moe_down<<<dim3(D / 64, T / 64, NE), 256, 0, stream>>>(hid, w_ed, gw, counts, lists, yb);
    k_final<<<T / 4, 256, 0, stream>>>(x1, yb, g_final, (float*)d_out);
}
```

```cpp
#include <hip/hip_runtime.h>
#include <cstdio>
#include <cstdint>

namespace {
constexpr int D = 1024, BATCH = 8, SEQ = 2048, T = BATCH * SEQ;
constexpr int DP = 512, DM = 512, NH = 4, HD = 128, NIN = 4616, NZ = 4608;
constexpr int NG = 4, EPG = 8, NE = 32, DE = 512;
constexpr float EPS = 1e-6f;
constexpr size_t MiB = 1u << 20;

typedef unsigned short bf16_t;
__device__ __forceinline__ bf16_t f2bf(float f) { unsigned u = __builtin_bit_cast(unsigned, f); return (bf16_t)((u + 0x7fffu + ((u >> 16) & 1u)) >> 16); }
__device__ __forceinline__ float bf2f(bf16_t b) { return __builtin_bit_cast(float, (unsigned)b << 16); }
__device__ __forceinline__ float sigmoidf_(float x) { return 1.f / (1.f + __expf(-x)); }
__device__ __forceinline__ float siluf_(float x) { return x / (1.f + __expf(-x)); }
__device__ __forceinline__ float logsigmoidf_(float x) { return fminf(x, 0.f) - log1pf(__expf(-fabsf(x))); }
__device__ __forceinline__ float wave_sum(float v) {
#pragma unroll
    for (int o = 1; o < 64; o <<= 1) v += __shfl_xor(v, o);
    return v;
}
__device__ __forceinline__ int zcol2orig(int c) { return c < 2560 ? c : c + 8; }

__global__ void __launch_bounds__(256) k_prep(const float* __restrict__ x, const float* __restrict__ g, const float* __restrict__ w_in,
                                               const float* __restrict__ b_if, bf16_t* __restrict__ h, float* __restrict__ gif) {
    const int wave = threadIdx.x >> 6, lane = threadIdx.x & 63;
    const int row = blockIdx.x * 4 + wave;
    if (row >= T) return;
    const float* xr = x + (size_t)row * D;
    float v[16]; float s = 0.f;
#pragma unroll
    for (int j = 0; j < 16; ++j) { v[j] = xr[lane + 64 * j]; s += v[j] * v[j]; }
    s = wave_sum(s);
    const float rstd = rsqrtf(s * (1.f / D) + EPS);
    float acc[8];
#pragma unroll
    for (int o = 0; o < 8; ++o) acc[o] = 0.f;
#pragma unroll
    for (int j = 0; j < 16; ++j) {
        const int k = lane + 64 * j;
        const float hv = v[j] * rstd * g[k];
        h[(size_t)row * D + k] = f2bf(hv);
#pragma unroll
        for (int o = 0; o < 8; ++o) acc[o] += hv * w_in[(size_t)k * NIN + 2560 + o];
    }
#pragma unroll
    for (int o = 0; o < 8; ++o) { acc[o] = wave_sum(acc[o]); }
    if (lane == 0) {
#pragma unroll
        for (int o = 0; o < 8; ++o) gif[(size_t)row * 8 + o] = acc[o] + b_if[o];
    }
}

template <class AL, class BL, class EP>
__global__ void __launch_bounds__(256) k_gemm(int M, int N, int K, AL al, BL bl, EP ep) {
    __shared__ float As[16][68];
    __shared__ float Bs[16][68];
    const int tid = threadIdx.x, tx = tid & 15, ty = tid >> 4;
    const int row0 = blockIdx.y * 64, col0 = blockIdx.x * 64;
    float acc[4][4];
#pragma unroll
    for (int i = 0; i < 4; ++i)
#pragma unroll
        for (int j = 0; j < 4; ++j) acc[i][j] = 0.f;
    for (int k0 = 0; k0 < K; k0 += 16) {
#pragma unroll
        for (int j = 0; j < 4; ++j) {
            const int idx = tid + j * 256;
            const int r = idx >> 4, kk = idx & 15;
            As[kk][r] = (row0 + r < M) ? al(row0 + r, k0 + kk) : 0.f;
            const int k2 = idx >> 6, n = idx & 63;
            Bs[k2][n] = (col0 + n < N) ? bl(k0 + k2, col0 + n) : 0.f;
        }
        __syncthreads();
#pragma unroll
        for (int kk = 0; kk < 16; ++kk) {
            float a[4], b[4];
#pragma unroll
            for (int i = 0; i < 4; ++i) a[i] = As[kk][ty * 4 + i];
#pragma unroll
            for (int j = 0; j < 4; ++j) b[j] = Bs[kk][tx * 4 + j];
#pragma unroll
            for (int i = 0; i < 4; ++i)
#pragma unroll
                for (int j = 0; j < 4; ++j) acc[i][j] += a[i] * b[j];
        }
        __syncthreads();
    }
#pragma unroll
    for (int i = 0; i < 4; ++i)
#pragma unroll
        for (int j = 0; j < 4; ++j) {
            const int r = row0 + ty * 4 + i, c = col0 + tx * 4 + j;
            if (r < M && c < N) ep(r, c, acc[i][j]);
        }
}

struct ALbf { const bf16_t* p; int ld; int pad; __device__ float operator()(int r, int k) const { return bf2f(p[(size_t)r * ld + k]); } };
struct ALf32 { const float* p; int ld; int pad; __device__ float operator()(int r, int k) const { return p[(size_t)r * ld + k]; } };
struct BLwin { const float* w; __device__ float operator()(int k, int n) const { return w[(size_t)k * NIN + zcol2orig(n)]; } };
struct BLplain { const float* w; int ld; int pad; __device__ float operator()(int k, int n) const { return w[(size_t)k * ld + n]; } };
struct EPz { bf16_t* z; __device__ void operator()(int r, int c, float v) const { z[(size_t)r * NZ + c] = f2bf(v); } };
struct EPf32 { float* o; int ld; int pad; __device__ void operator()(int r, int c, float v) const { o[(size_t)r * ld + c] = v; } };
struct EPmerge { const float* ya; const bf16_t* z; bf16_t* m;
    __device__ void operator()(int r, int c, float yb) const {
        const float ga = bf2f(z[(size_t)r * NZ + 2560 + c]), gb = bf2f(z[(size_t)r * NZ + 3584 + c]);
        m[(size_t)r * D + c] = f2bf(sigmoidf_(ga) * ya[(size_t)r * D + c] + sigmoidf_(gb) * yb); } };
struct EPres { const float* x; float* x1; __device__ void operator()(int r, int c, float v) const { x1[(size_t)r * D + c] = x[(size_t)r * D + c] + v; } };

__global__ void __launch_bounds__(256) k_conv(const bf16_t* __restrict__ z, const float* __restrict__ cq, const float* __restrict__ ck, bf16_t* __restrict__ qa, bf16_t* __restrict__ ka) {
    const size_t idx = (size_t)blockIdx.x * 256 + threadIdx.x;
    const int t = (int)(idx >> 9), c = (int)(idx & 511), s = t % SEQ;
    float aq = 0.f, ak = 0.f;
#pragma unroll
    for (int j = 0; j < 4; ++j) {
        const int ss = s - 3 + j;
        if (ss >= 0) {
            const size_t r = (size_t)(t - 3 + j) * NZ;
            aq += bf2f(z[r + 512 + c]) * cq[j * DM + c];
            ak += bf2f(z[r + 1024 + c]) * ck[j * DM + c];
        }
    }
    qa[idx] = f2bf(siluf_(aq));
    ka[idx] = f2bf(siluf_(ak) * 0.08838834764831845f);
}
__global__ void k_bcum(const float* __restrict__ gif, float* __restrict__ bcs) {
    const int bh = blockIdx.x * blockDim.x + threadIdx.x;
    if (bh >= BATCH * NH) return;
    const int b = bh / NH, hh = bh % NH;
    float acc = 0.f;
    for (int s = 0; s < SEQ; ++s) { acc += logsigmoidf_(gif[((size_t)b * SEQ + s) * 8 + 4 + hh]); bcs[(size_t)bh * SEQ + s] = acc; }
}
__global__ void __launch_bounds__(256) k_mlstm_naive(const bf16_t* __restrict__ qa, const bf16_t* __restrict__ ka, const bf16_t* __restrict__ z, const float* __restrict__ gif,
                                                      const float* __restrict__ bcs, const float* __restrict__ g_head, bf16_t* __restrict__ hm) {
    __shared__ float ks[32][129];
    __shared__ float vs[32][129];
    __shared__ float ws_[32];
    const int bh = blockIdx.x >> 5, qb = blockIdx.x & 31, b = bh / NH, hh = bh % NH;
    const int tid = threadIdx.x, tq = tid >> 2, part = tid & 3;
    const int t = qb * 64 + tq;
    const size_t rowq = (size_t)b * SEQ + t;
    float q[32];
#pragma unroll
    for (int j = 0; j < 32; ++j) q[j] = bf2f(qa[rowq * DM + hh * HD + part * 32 + j]);
    const float bt = bcs[(size_t)bh * SEQ + t];
    float num[32];
#pragma unroll
    for (int j = 0; j < 32; ++j) num[j] = 0.f;
    float nq = 0.f;
    for (int kb = 0; kb <= qb * 2 + 1; ++kb) {
        __syncthreads();
        for (int i = tid; i < 32 * 128; i += 256) {
            const int r = i >> 7, c = i & 127; const size_t row = (size_t)b * SEQ + kb * 32 + r;
            ks[r][c] = bf2f(ka[row * DM + hh * HD + c]);
            vs[r][c] = bf2f(z[row * NZ + 1536 + hh * HD + c]);
        }
        if (tid < 32) { const size_t row = (size_t)b * SEQ + kb * 32 + tid; ws_[tid] = gif[row * 8 + hh] - bcs[(size_t)bh * SEQ + kb * 32 + tid]; }
        __syncthreads();
        for (int s = 0; s < 32; ++s) {
            if (kb * 32 + s > t) break;
            float d = 0.f;
#pragma unroll
            for (int j = 0; j < 32; ++j) d += q[j] * ks[s][part * 32 + j];
            d += __shfl_xor(d, 1); d += __shfl_xor(d, 2);
            const float w = d * __expf(bt + ws_[s]);
            nq += w;
#pragma unroll
            for (int j = 0; j < 32; ++j) num[j] += w * vs[s][part * 32 + j];
        }
    }
    const float den = fmaxf(fabsf(nq), 1.f);
    float s1 = 0.f;
#pragma unroll
    for (int j = 0; j < 32; ++j) { num[j] /= den; s1 += num[j]; }
    s1 += __shfl_xor(s1, 1); s1 += __shfl_xor(s1, 2);
    const float mu = s1 * (1.f / HD);
    float s2 = 0.f;
#pragma unroll
    for (int j = 0; j < 32; ++j) { const float dd = num[j] - mu; s2 += dd * dd; }
    s2 += __shfl_xor(s2, 1); s2 += __shfl_xor(s2, 2);
    const float rstd = rsqrtf(s2 * (1.f / HD) + EPS);
#pragma unroll
    for (int j = 0; j < 32; ++j) {
        const int c = hh * HD + part * 32 + j;
        const float o = bf2f(z[rowq * NZ + 2048 + c]);
        hm[rowq * DM + c] = f2bf((num[j] - mu) * rstd * g_head[c] * sigmoidf_(o));
    }
}
__global__ void __launch_bounds__(256) k_pool(const bf16_t* __restrict__ z, bf16_t* __restrict__ dA) {
    const size_t idx = (size_t)blockIdx.x * 256 + threadIdx.x;
    const int t = (int)(idx >> 9), c = (int)(idx & 511), s = t % SEQ, g = c >> 7;
    const int w = 2 << g;
    const int start = max(s + 1 - w, 0), cnt = s + 1 - start;
    float acc = 0.f;
    for (int j = 0; j < cnt; ++j) acc += bf2f(z[(size_t)(t - j) * NZ + c]);
    dA[idx] = f2bf(acc / (float)cnt - bf2f(z[(size_t)t * NZ + c]));
}
__global__ void __launch_bounds__(256) k_poolmm(const bf16_t* __restrict__ dA, const float* __restrict__ w_pool, const float* __restrict__ scale, float* __restrict__ yp) {
    const size_t idx = (size_t)blockIdx.x * 256 + threadIdx.x;
    const int t = (int)(idx >> 9), j = (int)(idx & 511), g = j >> 7, jj = j & 127;
    float acc = 0.f;
    for (int c = 0; c < 128; ++c) acc += bf2f(dA[(size_t)t * DP + g * 128 + c]) * w_pool[((size_t)g * 128 + c) * 128 + jj];
    yp[idx] = acc * scale[j];
}

__global__ void __launch_bounds__(256) k_route(const float* __restrict__ x1, const float* __restrict__ g_ffn, const float* __restrict__ w_rg, const float* __restrict__ b_rg,
                                                const float* __restrict__ w_re, const float* __restrict__ b_re, float* __restrict__ rstd2, int* __restrict__ sel, float* __restrict__ gw,
                                                int* __restrict__ counts, int* __restrict__ lists) {
    const int wave = threadIdx.x >> 6, lane = threadIdx.x & 63;
    const int tok = blockIdx.x * 4 + wave;
    const float* xr = x1 + (size_t)tok * D;
    float v[16]; float s = 0.f;
#pragma unroll
    for (int j = 0; j < 16; ++j) { v[j] = xr[lane + 64 * j]; s += v[j] * v[j]; }
    s = wave_sum(s);
    const float rstd = rsqrtf(s * (1.f / D) + EPS);
    float lg[4] = {0.f, 0.f, 0.f, 0.f};
#pragma unroll
    for (int j = 0; j < 16; ++j) { const int k = lane + 64 * j; v[j] = v[j] * rstd * g_ffn[k];
#pragma unroll
        for (int o = 0; o < 4; ++o) lg[o] += v[j] * w_rg[k * NG + o]; }
#pragma unroll
    for (int o = 0; o < 4; ++o) lg[o] = wave_sum(lg[o]) + b_rg[o];
    int gs = 0; float gm = lg[0];
#pragma unroll
    for (int o = 1; o < 4; ++o) if (lg[o] > gm) { gm = lg[o]; gs = o; }
    float den = 0.f;
#pragma unroll
    for (int o = 0; o < 4; ++o) den += __expf(lg[o] - gm);
    const float pg = 1.f / den;
    float le[8];
#pragma unroll
    for (int o = 0; o < 8; ++o) le[o] = 0.f;
#pragma unroll
    for (int j = 0; j < 16; ++j) { const int k = lane + 64 * j;
#pragma unroll
        for (int o = 0; o < 8; ++o) le[o] += v[j] * w_re[k * NE + gs * EPG + o]; }
#pragma unroll
    for (int o = 0; o < 8; ++o) le[o] = wave_sum(le[o]) + b_re[gs * EPG + o];
    int i1 = 0; float m1 = le[0];
#pragma unroll
    for (int o = 1; o < 8; ++o) if (le[o] > m1) { m1 = le[o]; i1 = o; }
    int i2 = -1; float m2 = -3.0e38f;
#pragma unroll
    for (int o = 0; o < 8; ++o) if (o != i1 && le[o] > m2) { m2 = le[o]; i2 = o; }
    const float e2 = __expf(m2 - m1);
    const float p1 = 1.f / (1.f + e2), p2 = e2 / (1.f + e2);
    if (lane == 0) {
        rstd2[tok] = rstd;
        const int ea = gs * EPG + i1, eb = gs * EPG + i2;
        sel[tok * 2] = ea; sel[tok * 2 + 1] = eb;
        gw[tok * 2] = pg * p1; gw[tok * 2 + 1] = pg * p2;
        const int pa = atomicAdd(&counts[ea], 1); lists[ea * T + pa] = tok * 2;
        const int pb = atomicAdd(&counts[eb], 1); lists[eb * T + pb] = tok * 2 + 1;
    }
}
__global__ void __launch_bounds__(256) k_moe_up(const float* __restrict__ x1, const float* __restrict__ rstd2, const float* __restrict__ g_ffn, const float* __restrict__ wg, const float* __restrict__ wu,
                                                 const int* __restrict__ counts, const int* __restrict__ lists, float* __restrict__ hid) {
    const int e = blockIdx.z, rt = blockIdx.y, ct = blockIdx.x;
    const int cnt = counts[e];
    if (rt * 64 >= cnt) return;
    __shared__ float As[16][68]; __shared__ float Bg[16][68]; __shared__ float Bu[16][68];
    __shared__ int toks[64]; __shared__ float rs[64];
    const int tid = threadIdx.x, tx = tid & 15, ty = tid >> 4;
    if (tid < 64) { const int r = rt * 64 + tid; const int a = (r < cnt) ? lists[e * T + r] : -1; toks[tid] = a; rs[tid] = (a >= 0) ? rstd2[a >> 1] : 0.f; }
    __syncthreads();
    float ag[4][4], au[4][4];
#pragma unroll
    for (int i = 0; i < 4; ++i)
#pragma unroll
        for (int j = 0; j < 4; ++j) { ag[i][j] = 0.f; au[i][j] = 0.f; }
    const float* wge = wg + (size_t)e * D * DE; const float* wue = wu + (size_t)e * D * DE;
    for (int k0 = 0; k0 < D; k0 += 16) {
#pragma unroll
        for (int j = 0; j < 4; ++j) {
            const int idx = tid + j * 256; const int r = idx >> 4, kk = idx & 15;
            const int a = toks[r];
            As[kk][r] = (a >= 0) ? x1[(size_t)(a >> 1) * D + k0 + kk] * rs[r] * g_ffn[k0 + kk] : 0.f;
            const int k2 = idx >> 6, n = idx & 63;
            Bg[k2][n] = wge[(size_t)(k0 + k2) * DE + ct * 64 + n];
            Bu[k2][n] = wue[(size_t)(k0 + k2) * DE + ct * 64 + n];
        }
        __syncthreads();
#pragma unroll
        for (int kk = 0; kk < 16; ++kk) {
            float a[4], bg[4], bu[4];
#pragma unroll
            for (int i = 0; i < 4; ++i) a[i] = As[kk][ty * 4 + i];
#pragma unroll
            for (int j = 0; j < 4; ++j) { bg[j] = Bg[kk][tx * 4 + j]; bu[j] = Bu[kk][tx * 4 + j]; }
#pragma unroll
            for (int i = 0; i < 4; ++i)
#pragma unroll
                for (int j = 0; j < 4; ++j) { ag[i][j] += a[i] * bg[j]; au[i][j] += a[i] * bu[j]; }
        }
        __syncthreads();
    }
#pragma unroll
    for (int i = 0; i < 4; ++i) { const int a = toks[ty * 4 + i]; if (a < 0) continue;
#pragma unroll
        for (int j = 0; j < 4; ++j) hid[(size_t)a * DE + ct * 64 + tx * 4 + j] = siluf_(ag[i][j]) * au[i][j]; }
}
__global__ void __launch_bounds__(256) k_moe_down(const float* __restrict__ hid, const float* __restrict__ wd, const float* __restrict__ gw, const int* __restrict__ counts, const int* __restrict__ lists, bf16_t* __restrict__ yb) {
    const int e = blockIdx.z, rt = blockIdx.y, ct = blockIdx.x;
    const int cnt = counts[e];
    if (rt * 64 >= cnt) return;
    __shared__ float As[16][68]; __shared__ float Bs[16][68];
    __shared__ int toks[64];
    const int tid = threadIdx.x, tx = tid & 15, ty = tid >> 4;
    if (tid < 64) { const int r = rt * 64 + tid; toks[tid] = (r < cnt) ? lists[e * T + r] : -1; }
    __syncthreads();
    float acc[4][4];
#pragma unroll
    for (int i = 0; i < 4; ++i)
#pragma unroll
        for (int j = 0; j < 4; ++j) acc[i][j] = 0.f;
    const float* wde = wd + (size_t)e * DE * D;
    for (int k0 = 0; k0 < DE; k0 += 16) {
#pragma unroll
        for (int j = 0; j < 4; ++j) {
            const int idx = tid + j * 256; const int r = idx >> 4, kk = idx & 15;
            const int a = toks[r];
            As[kk][r] = (a >= 0) ? hid[(size_t)a * DE + k0 + kk] : 0.f;
            const int k2 = idx >> 6, n = idx & 63;
            Bs[k2][n] = wde[(size_t)(k0 + k2) * D + ct * 64 + n];
        }
        __syncthreads();
#pragma unroll
        for (int kk = 0; kk < 16; ++kk) {
            float a[4], b[4];
#pragma unroll
            for (int i = 0; i < 4; ++i) a[i] = As[kk][ty * 4 + i];
#pragma unroll
            for (int j = 0; j < 4; ++j) b[j] = Bs[kk][tx * 4 + j];
#pragma unroll
            for (int i = 0; i < 4; ++i)
#pragma unroll
                for (int j = 0; j < 4; ++j) acc[i][j] += a[i] * b[j];
        }
        __syncthreads();
    }
#pragma unroll
    for (int i = 0; i < 4; ++i) { const int a = toks[ty * 4 + i]; if (a < 0) continue; const float w = gw[a];
#pragma unroll
        for (int j = 0; j < 4; ++j) yb[(size_t)a * D + ct * 64 + tx * 4 + j] = f2bf(acc[i][j] * w); }
}
__global__ void __launch_bounds__(256) k_final(const float* __restrict__ x1, const bf16_t* __restrict__ yb, const float* __restrict__ g, float* __restrict__ out) {
    const int wave = threadIdx.x >> 6, lane = threadIdx.x & 63;
    const int tok = blockIdx.x * 4 + wave;
    float v[16]; float s = 0.f;
#pragma unroll
    for (int j = 0; j < 16; ++j) { const int k = lane + 64 * j;
        v[j] = x1[(size_t)tok * D + k] + bf2f(yb[(size_t)(tok * 2) * D + k]) + bf2f(yb[(size_t)(tok * 2 + 1) * D + k]); s += v[j] * v[j]; }
    s = wave_sum(s);
    const float rstd = rsqrtf(s * (1.f / D) + EPS);
#pragma unroll
    for (int j = 0; j < 16; ++j) { const int k = lane + 64 * j; out[(size_t)tok * D + k] = v[j] * rstd * g[k]; }
}

#define GAS __attribute__((address_space(1)))
#define LAS __attribute__((address_space(3)))
typedef short bf16x8 __attribute__((ext_vector_type(8)));
typedef float f32x4 __attribute__((ext_vector_type(4)));
typedef float f32x2 __attribute__((ext_vector_type(2)));
typedef unsigned u32x4 __attribute__((ext_vector_type(4)));
typedef unsigned u32x2 __attribute__((ext_vector_type(2)));
#define LDS_WAIT() asm volatile("s_waitcnt lgkmcnt(0)" ::: "memory")
#define VM_WAIT() asm volatile("s_waitcnt vmcnt(0)" ::: "memory")
__device__ __forceinline__ unsigned pk2(float lo, float hi) { return (unsigned)f2bf(lo) | ((unsigned)f2bf(hi) << 16); }
__device__ __forceinline__ unsigned cvt_pk_bf16(float lo, float hi) { unsigned r; asm volatile("v_cvt_pk_bf16_f32 %0, %1, %2" : "=v"(r) : "v"(lo), "v"(hi)); return r; }
__device__ __forceinline__ float bflo(unsigned w) { return __builtin_bit_cast(float, w << 16); }
__device__ __forceinline__ float bfhi(unsigned w) { return __builtin_bit_cast(float, w & 0xffff0000u); }
__device__ __forceinline__ float fast_exp(float x) { return __builtin_amdgcn_exp2f(x * 1.4426950408889634f); }
__device__ __forceinline__ float fast_rcp(float x) { return __builtin_amdgcn_rcpf(x); }
__device__ __forceinline__ float fsigmoid(float x) { return fast_rcp(1.f + fast_exp(-x)); }

#define XB_TMO      128
#define XB_XCNT(j)  (256  + 64 * (j))
#define XB_XSUB(j)  (1280 + 64 * (j))
#define XB_XGEN(j)  (2304 + 64 * (j))
#define XB_TOP      3328
#define XB_TOPGEN   3392
#define XCD_BAR_WORDS 3456
#define XB_SPIN_CAP (1u << 18)
__device__ __forceinline__ unsigned xb_ld(unsigned* p)              { return __hip_atomic_load(p, __ATOMIC_RELAXED, __HIP_MEMORY_SCOPE_AGENT); }
__device__ __forceinline__ unsigned xb_add(unsigned* p, unsigned v) { return __hip_atomic_fetch_add(p, v, __ATOMIC_RELAXED, __HIP_MEMORY_SCOPE_AGENT); }
__device__ __forceinline__ unsigned xb_xcc_id() { return (unsigned)__builtin_amdgcn_s_getreg((3 << 11) | 20) & 0xFu; }
#define XB_SPIN(cond, bar) do { unsigned _sp = 0; while (cond) { __builtin_amdgcn_s_sleep(1); \
    if ((++_sp & 255u) == 0u) { if (xb_ld(&(bar)[XB_TMO])) break; if (_sp > XB_SPIN_CAP) { atomicAdd(&(bar)[XB_TMO], 1u); break; } } } } while (0)
struct XcdBarrier { unsigned* bar; unsigned x; volatile LAS unsigned* st; };
__device__ __forceinline__ XcdBarrier xcd_barrier_post(unsigned* bar, volatile LAS unsigned* st) {
    XcdBarrier b; b.bar = bar; b.x = xb_xcc_id(); b.st = st;
    if (threadIdx.x == 0) (void)xb_add(&bar[XB_XCNT(b.x)], 1u);
    return b;
}
__device__ __forceinline__ void xcd_barrier_complete(unsigned* bar, unsigned x, unsigned& nloc, unsigned& nx) {
    const unsigned G = gridDim.x * gridDim.y * gridDim.z;
    unsigned sum, cnt, mine, sp = 0u;
    for (;;) {
        sum = 0u; cnt = 0u; mine = 0u;
#pragma unroll
        for (unsigned j = 0; j < 16; ++j) { const unsigned c = xb_ld(&bar[XB_XCNT(j)]); sum += c; cnt += (c > 0u) ? 1u : 0u; mine = (j == x) ? c : mine; }
        if (sum == G) break;
        __builtin_amdgcn_s_sleep(1);
        if ((++sp & 255u) == 0u) { if (xb_ld(&bar[XB_TMO])) break; if (sp > XB_SPIN_CAP) { atomicAdd(&bar[XB_TMO], 1u); break; } }
    }
    nloc = mine > 0u ? mine : 1u; nx = cnt > 0u ? cnt : 1u;
}
__device__ __forceinline__ void xcd_barrier(const XcdBarrier& b) {
    asm volatile("s_waitcnt vmcnt(0)" ::: "memory");
    __syncthreads();
    if (threadIdx.x == 0) {
        unsigned* bar = b.bar;
        __builtin_amdgcn_s_waitcnt(0);
        unsigned nloc = b.st[0], nx = b.st[1];
        if (nloc == 0u) { xcd_barrier_complete(bar, b.x, nloc, nx); b.st[0] = nloc; b.st[1] = nx; }
        const unsigned old = xb_add(&bar[XB_XSUB(b.x)], 1u);
        const unsigned gen = old / nloc;
        if (old + 1u == (gen + 1u) * nloc) {
            __builtin_amdgcn_fence(__ATOMIC_RELEASE, "agent");
            asm volatile("s_waitcnt vmcnt(0)" ::: "memory");
            const unsigned og = xb_add(&bar[XB_TOP], 1u);
            const unsigned tg = og / nx;
            if (og + 1u == (tg + 1u) * nx) xb_add(&bar[XB_TOPGEN], 1u);
            else XB_SPIN(xb_ld(&bar[XB_TOPGEN]) == tg, bar);
            __builtin_amdgcn_fence(__ATOMIC_ACQUIRE, "agent");
            xb_add(&bar[XB_XGEN(b.x)], 1u);
            asm volatile("s_waitcnt vmcnt(0)" ::: "memory");
        } else {
            XB_SPIN(xb_ld(&bar[XB_XGEN(b.x)]) == gen, bar);
            __builtin_amdgcn_fence(__ATOMIC_ACQUIRE, "agent");
            asm volatile("s_waitcnt vmcnt(0)" ::: "memory");
        }
    }
    __syncthreads();
}

namespace pg8 {
constexpr int BM = 256, BK = 64, HALF = 128, HTB = HALF * BK * 2, STAGE_BYTES = 8 * HTB, NXCD = 8, WGM = 8;
__host__ __device__ __forceinline__ int lds_byte(int r, int c) { const int st = (r >> 4) * 2 + (c >> 5), rr = r & 15, cc = c & 31, ob = rr * 64 + cc * 2; return st * 1024 + (ob ^ (((ob >> 9) & 1) << 5)); }
__host__ __device__ __forceinline__ void stage_rc(int b, int& R, int& C) { const int st = b / 1024, sb = b % 1024, swz = sb ^ (((sb >> 9) & 1) << 5); R = (st >> 1) * 16 + swz / 64; C = (st & 1) * 32 + (swz % 64) / 2; }
__host__ __device__ __forceinline__ int perm32(int rho) { const int n = rho >> 4, i = rho & 15; return 8 * (i >> 2) + 4 * n + (i & 3); }

struct Unit { const char* A; const char* B; const int* rows; int pm, pn, ex, cnt; };
struct Cfg { int K; unsigned lda, ldb; };
__device__ __forceinline__ void tile_of(int L, int nM, int nN, int& pm, int& pn) {
    const int nwg = nM * nN; int wgid = L; { const int q = nwg / NXCD, r = nwg % NXCD, xcd = wgid % NXCD, off = wgid / NXCD; wgid = (xcd < r ? xcd * (q + 1) : r * (q + 1) + (xcd - r) * q) + off; }
    const int nig = WGM * nN, gid = wgid / nig, fm = gid * WGM, gsz = (nM - fm) < WGM ? (nM - fm) : WGM;
    pm = fm + ((wgid % nig) % gsz); pn = (wgid % nig) / gsz;
}

template <class Epi, class Sched, bool GATHER>
__device__ __forceinline__ void gemm_phase(LAS unsigned char* lds, const Cfg g, const Sched& S, const Epi& E) {
    const int tid = threadIdx.x, wid = __builtin_amdgcn_readfirstlane(tid >> 6), lane = tid & 63, wr = wid >> 2, wc = wid & 3, fr = lane & 15, fq = lane >> 4;
    const int nt = g.K / BK;
    unsigned voffB[2], vA[2][2], vN[2][2]; int Rr[2]; unsigned Cb[2];
#pragma unroll
    for (int i = 0; i < 2; ++i) { int R, C; stage_rc(tid * 16 + i * 8192, R, C); const int Rb = Epi::PERM ? ((R & ~31) + perm32(R & 31)) : R;
        Rr[i] = R; Cb[i] = (unsigned)C * 2u; voffB[i] = (unsigned)Rb * g.ldb + (unsigned)C * 2u;
        vA[0][i] = (unsigned)R * g.lda + (unsigned)C * 2u; vA[1][i] = (unsigned)(R + HALF) * g.lda + (unsigned)C * 2u; vN[0][i] = vA[0][i]; vN[1][i] = vA[1][i]; }
    const size_t kstep = (size_t)(BK * 2);
    const size_t hstepB = (size_t)HALF * g.ldb;
    const unsigned ldsw = (unsigned)wid * 1024u;
    const int aoff = lds_byte(wr * 64 + fr, fq * 8), boff = lds_byte(wc * 32 + fr, fq * 8);
#define PG8_SA(b, h) (((b) * 2 + (h)) * HTB)
#define PG8_SB(b, h) ((4 + (b) * 2 + (h)) * HTB)
#define PG8_STAGE(bufoff, gbase, voff) do { _Pragma("unroll") for (int _i = 0; _i < 2; ++_i) \
        __builtin_amdgcn_global_load_lds((const unsigned*)((const char*)(gbase) + (voff)[_i]), (LAS unsigned*)(lds + (bufoff) + ldsw + _i * 8192), 16, 0, 0); } while (0)
#define PG8_STAGE_AX(bufoff, gbase, h, usenext) do { unsigned _vo[2]; _vo[0] = (usenext) ? vN[h][0] : vA[h][0]; _vo[1] = (usenext) ? vN[h][1] : vA[h][1]; PG8_STAGE(bufoff, gbase, _vo); } while (0)
#define PG8_LDA(dst, b, h) do { _Pragma("unroll") for (int m = 0; m < 4; ++m) _Pragma("unroll") for (int k = 0; k < 2; ++k) dst[m][k] = *(const LAS bf16x8*)(lds + PG8_SA(b, h) + aoff + m * 2048 + k * 1024); } while (0)
#define PG8_LDB(dst, b, h) do { _Pragma("unroll") for (int n = 0; n < 2; ++n) _Pragma("unroll") for (int k = 0; k < 2; ++k) dst[n][k] = *(const LAS bf16x8*)(lds + PG8_SB(b, h) + boff + n * 2048 + k * 1024); } while (0)
#define PG8_MMA(ai, bj, At, Bt) do { __builtin_amdgcn_s_setprio(1); _Pragma("unroll") for (int m = 0; m < 4; ++m) _Pragma("unroll") for (int n = 0; n < 2; ++n) _Pragma("unroll") for (int k = 0; k < 2; ++k) \
        acc[ai][bj][m][n] = __builtin_amdgcn_mfma_f32_16x16x32_bf16(Bt[n][k], At[m][k], acc[ai][bj][m][n], 0, 0, 0); __builtin_amdgcn_s_setprio(0); } while (0)
#define PG8_WAIT_V(n) asm volatile("s_waitcnt vmcnt(" #n ")" ::: "memory")
#define PG8_WAIT_L(n) asm volatile("s_waitcnt lgkmcnt(" #n ")" ::: "memory")
#define PG8_BAR __builtin_amdgcn_s_barrier()
#define PG8_SCHED __builtin_amdgcn_sched_barrier(0)
#define PG8_GATHER_LOAD(dst, u) do { _Pragma("unroll") for (int _h = 0; _h < 2; ++_h) _Pragma("unroll") for (int _i = 0; _i < 2; ++_i) { const int _r = _h * HALF + Rr[_i]; \
        const int _a = (_r < (u).cnt) ? ((u).rows[_r] >> 1) : 0; dst[_h][_i] = (unsigned)_a * g.lda + Cb[_i]; } } while (0)
    Unit cur, nxt; int ui = 0;
    if (!S.next(0, cur)) return;
    f32x4 acc[2][2][4][2];
#pragma unroll
    for (int a = 0; a < 2; ++a)
#pragma unroll
        for (int b = 0; b < 2; ++b)
#pragma unroll
            for (int m = 0; m < 4; ++m)
#pragma unroll
                for (int n = 0; n < 2; ++n) acc[a][b][m][n] = (f32x4){0.f, 0.f, 0.f, 0.f};
    bf16x8 At[4][2], B0[2][2], B1[2][2];
    const char* cA = cur.A; const char* cB = cur.B;
    if constexpr (GATHER) { PG8_GATHER_LOAD(vA, cur); __builtin_amdgcn_s_waitcnt(0x0F70); }
    PG8_STAGE(PG8_SB(0, 0), cB, voffB); PG8_STAGE(PG8_SB(0, 1), cB + hstepB, voffB); PG8_STAGE(PG8_SA(0, 0), cA, vA[0]); PG8_STAGE(PG8_SA(0, 1), cA, vA[1]);
    if (wr == 1) PG8_BAR;
    PG8_WAIT_V(2); PG8_BAR;
    PG8_STAGE(PG8_SB(1, 0), cB + kstep, voffB); PG8_STAGE(PG8_SA(1, 0), cA + kstep, vA[0]); PG8_STAGE(PG8_SB(1, 1), cB + hstepB + kstep, voffB);
    PG8_WAIT_V(6); PG8_BAR;
    for (;;) {
        const bool has_next = S.next(ui + 1, nxt);
        const char* nA = has_next ? nxt.A : cA; const char* nB = has_next ? nxt.B : cB;
        if constexpr (GATHER) {
            if (has_next) { PG8_GATHER_LOAD(vN, nxt); __builtin_amdgcn_s_waitcnt(0x0F70); }
            else {
#pragma unroll
                for (int h = 0; h < 2; ++h)
#pragma unroll
                    for (int i = 0; i < 2; ++i) vN[h][i] = vA[h][i]; }
        }
        for (int t = 0; t < nt; t += 2) {
            const bool last = (t == nt - 2);
            const char* a1 = cA + (size_t)(t + 1) * kstep;
            const char* a2 = last ? nA : cA + (size_t)(t + 2) * kstep; const char* b2 = last ? nB : cB + (size_t)(t + 2) * kstep;
            const char* a3 = a2 + kstep; const char* b3 = b2 + kstep;
            const bool un = GATHER && last;
            PG8_LDB(B0, 0, 0); PG8_LDB(B1, 0, 1); PG8_SCHED; PG8_LDA(At, 0, 0); PG8_STAGE(PG8_SA(1, 1), a1, vA[1]);
            PG8_WAIT_V(8); PG8_WAIT_L(0); PG8_BAR; PG8_MMA(0, 0, At, B0); PG8_MMA(0, 1, At, B1); PG8_BAR; PG8_SCHED;
            PG8_LDA(At, 0, 1); PG8_STAGE(PG8_SB(0, 0), b2, voffB); PG8_STAGE(PG8_SB(0, 1), b2 + hstepB, voffB); PG8_STAGE_AX(PG8_SA(0, 0), a2, 0, un);
            PG8_WAIT_V(8); PG8_WAIT_L(0); PG8_BAR; PG8_MMA(1, 0, At, B0); PG8_MMA(1, 1, At, B1); PG8_BAR; PG8_SCHED;
            PG8_LDB(B0, 1, 0); PG8_LDB(B1, 1, 1); PG8_SCHED; PG8_LDA(At, 1, 0); PG8_STAGE_AX(PG8_SA(0, 1), a2, 1, un);
            PG8_WAIT_V(8); PG8_WAIT_L(0); PG8_BAR; PG8_MMA(0, 0, At, B0); PG8_MMA(0, 1, At, B1); PG8_BAR; PG8_SCHED;
            PG8_LDA(At, 1, 1); PG8_STAGE(PG8_SB(1, 0), b3, voffB); PG8_STAGE(PG8_SB(1, 1), b3 + hstepB, voffB); PG8_STAGE_AX(PG8_SA(1, 0), a3, 0, un);
            PG8_WAIT_V(8); PG8_WAIT_L(0); PG8_BAR; PG8_MMA(1, 0, At, B0); PG8_MMA(1, 1, At, B1); PG8_BAR; PG8_SCHED;
        }
        if (wr == 0) PG8_BAR;
        const bool keep = E(acc, cur, wr, wc, fr, fq);
        if (!has_next) break;
        if (!keep) {
#pragma unroll
        for (int a = 0; a < 2; ++a)
#pragma unroll
            for (int b = 0; b < 2; ++b)
#pragma unroll
                for (int m = 0; m < 4; ++m)
#pragma unroll
                    for (int n = 0; n < 2; ++n) acc[a][b][m][n] = (f32x4){0.f, 0.f, 0.f, 0.f};
        }
        cur = nxt; cA = nA; cB = nB; ++ui;
        if constexpr (GATHER) {
#pragma unroll
            for (int h = 0; h < 2; ++h)
#pragma unroll
                for (int i = 0; i < 2; ++i) vA[h][i] = vN[h][i]; }
        if (wr == 1) PG8_BAR;
    }
    PG8_WAIT_V(0);
    PG8_BAR;
#undef PG8_SA
#undef PG8_SB
#undef PG8_STAGE
#undef PG8_STAGE_AX
#undef PG8_LDA
#undef PG8_LDB
#undef PG8_MMA
#undef PG8_WAIT_V
#undef PG8_WAIT_L
#undef PG8_BAR
#undef PG8_SCHED
#undef PG8_GATHER_LOAD
}
}

constexpr int NWAVES = 8;
constexpr size_t WS_CTL = 0, CTL_ZERO_BYTES = 1 * MiB;
constexpr size_t WS_GIF = 1 * MiB;
constexpr size_t WS_NLOC = 1 * MiB + 512 * 1024;
constexpr size_t WS_SCAL = 2 * MiB;
constexpr size_t WS_GW = 2 * MiB + 256 * 1024;
constexpr size_t WS_ALIST = 4 * MiB;
constexpr size_t WS_RWLIST = 6 * MiB;
constexpr size_t WS_RSTD2 = 3 * MiB, WS_SEL = 3 * MiB + 256 * 1024;
constexpr size_t WS_WZ = 10 * MiB, WS_W2T = 19 * MiB, WS_WBT = 20 * MiB, WS_WOT = 21 * MiB, WS_WUP = 23 * MiB, WS_WDN = 87 * MiB;
constexpr size_t WS_Z = 119 * MiB;
constexpr size_t WS_KACT = 263 * MiB;
constexpr size_t WS_END = 279 * MiB;
constexpr size_t WS_X1 = WS_Z, WS_X1B = WS_Z + 64 * MiB, WS_HID = WS_Z + 96 * MiB;
constexpr size_t OB_H = 0, OB_C = 0, OB_DA = 32 * MiB, OB_HM = 48 * MiB, OB_MERGED = 0;
constexpr int CW_CNT = 64;
constexpr int CW_BAR = 4096;
constexpr int TAB_CNT = 16, TAB_CUM = 48, TAB_HIST = 96, TAB_BASE = 128;
constexpr int RING_OFF = 0, RING_BYTES = 131072, LDSCTL_OFF = RING_BYTES, MISC_OFF = LDSCTL_OFF + 320, LDS_BYTES = 147456;

struct Args { const float* in[21]; float* out; unsigned char* ws; int ph_lo, ph_hi, li, flags; };

struct SchedDense {
    const char* A; const char* B; size_t astep, bstep; int nM, nN, G, c;
    __device__ __forceinline__ bool next(int i, pg8::Unit& u) const {
        const long L = (long)i * G + c; if (L >= (long)nM * nN) return false;
        int pm, pn; pg8::tile_of((int)L, nM, nN, pm, pn);
        u.pm = pm; u.pn = pn; u.ex = 0; u.cnt = 256; u.rows = nullptr; u.A = A + (size_t)pm * astep; u.B = B + (size_t)pn * bstep; return true; }
};
struct EpiZ {
    static constexpr bool PERM = true;
    bf16_t* z;
    __device__ __forceinline__ bool operator()(f32x4 (&acc)[2][2][4][2], const pg8::Unit& u, int wr, int wc, int fr, int fq) const {
        const int row0 = u.pm * 256 + wr * 64 + fr, col0 = u.pn * 256 + wc * 32 + 8 * fq;
#pragma unroll
        for (int ai = 0; ai < 2; ++ai)
#pragma unroll
            for (int m = 0; m < 4; ++m) { bf16_t* rowp = z + (size_t)(row0 + ai * 128 + m * 16) * NZ + col0;
#pragma unroll
                for (int bj = 0; bj < 2; ++bj) { const f32x4 v0 = acc[ai][bj][m][0], v1 = acc[ai][bj][m][1]; u32x4 w;
                    w.x = cvt_pk_bf16(v0[0], v0[1]); w.y = cvt_pk_bf16(v0[2], v0[3]); w.z = cvt_pk_bf16(v1[0], v1[1]); w.w = cvt_pk_bf16(v1[2], v1[3]);
                    *(u32x4*)(rowp + bj * 128) = w; } }
        return false;
    }
};

struct SchedMerge {
    const char* A0; const char* A1; const char* B0; const char* B1; int nM, nN, G, c;
    __device__ __forceinline__ bool next(int i, pg8::Unit& u) const {
        const long L = (long)(i >> 1) * G + c; if (L >= (long)nM * nN) return false;
        int pm, pn; pg8::tile_of((int)L, nM, nN, pm, pn); const int part = i & 1;
        u.pm = pm; u.pn = pn; u.ex = part; u.cnt = 256; u.rows = nullptr;
        u.A = (part ? A1 : A0) + (size_t)pm * 256 * DP * 2; u.B = (part ? B1 : B0) + (size_t)pn * 256 * DP * 2; return true; }
};
struct EpiMerge {
    static constexpr bool PERM = true;
    const bf16_t* z; bf16_t* mg;
    __device__ __forceinline__ bool operator()(f32x4 (&acc)[2][2][4][2], const pg8::Unit& u, int wr, int wc, int fr, int fq) const {
        const int row0 = u.pm * 256 + wr * 64 + fr, col0 = u.pn * 256 + wc * 32 + 8 * fq;
        if (u.ex == 0) {
#pragma unroll
            for (int ai = 0; ai < 2; ++ai)
#pragma unroll
                for (int m = 0; m < 4; ++m) { const bf16_t* zr = z + (size_t)(row0 + ai * 128 + m * 16) * NZ + col0;
#pragma unroll
                    for (int bj = 0; bj < 2; ++bj) { const u32x4 ga = *(const u32x4*)(zr + 2560 + bj * 128), gb = *(const u32x4*)(zr + 3584 + bj * 128);
                        float r[8];
#pragma unroll
                        for (int q = 0; q < 4; ++q) { const unsigned wa = ga[q], wb = gb[q];
                            r[2 * q] = (1.f + fast_exp(-bflo(wb))) * fast_rcp(1.f + fast_exp(-bflo(wa)));
                            r[2 * q + 1] = (1.f + fast_exp(-bfhi(wb))) * fast_rcp(1.f + fast_exp(-bfhi(wa))); }
#pragma unroll
                        for (int q = 0; q < 4; ++q) { acc[ai][bj][m][0][q] *= r[q]; acc[ai][bj][m][1][q] *= r[4 + q]; } } }
            return true;
        }
#pragma unroll
        for (int ai = 0; ai < 2; ++ai)
#pragma unroll
            for (int m = 0; m < 4; ++m) { const size_t row = (size_t)(row0 + ai * 128 + m * 16); const bf16_t* zr = z + row * NZ + col0; bf16_t* mr = mg + row * D + col0;
#pragma unroll
                for (int bj = 0; bj < 2; ++bj) { const u32x4 gb = *(const u32x4*)(zr + 3584 + bj * 128);
                    float sg[8];
#pragma unroll
                    for (int q = 0; q < 4; ++q) { sg[2 * q] = fsigmoid(bflo(gb[q])); sg[2 * q + 1] = fsigmoid(bfhi(gb[q])); }
                    const f32x4 v0 = acc[ai][bj][m][0], v1 = acc[ai][bj][m][1]; u32x4 w;
                    w.x = cvt_pk_bf16(v0[0] * sg[0], v0[1] * sg[1]); w.y = cvt_pk_bf16(v0[2] * sg[2], v0[3] * sg[3]);
                    w.z = cvt_pk_bf16(v1[0] * sg[4], v1[1] * sg[5]); w.w = cvt_pk_bf16(v1[2] * sg[6], v1[3] * sg[7]);
                    *(u32x4*)(mr + bj * 128) = w; } }
        return false;
    }
};
struct EpiX1 {
    static constexpr bool PERM = false;
    const float* x; float* x1;
    __device__ __forceinline__ bool operator()(f32x4 (&acc)[2][2][4][2], const pg8::Unit& u, int wr, int wc, int fr, int fq) const {
        const int row0 = u.pm * 256 + wr * 64 + fr, col0 = u.pn * 256 + wc * 32 + 4 * fq;
#pragma unroll
        for (int ai = 0; ai < 2; ++ai)
#pragma unroll
            for (int m = 0; m < 4; ++m) { const size_t off = (size_t)(row0 + ai * 128 + m * 16) * D + col0;
#pragma unroll
                for (int bj = 0; bj < 2; ++bj)
#pragma unroll
                    for (int n = 0; n < 2; ++n) { const f32x4 xv = *(const f32x4*)(x + off + bj * 128 + n * 16); *(f32x4*)(x1 + off + bj * 128 + n * 16) = xv + acc[ai][bj][m][n]; } }
        return false;
    }
};

struct SchedMoE {
    volatile LAS unsigned* M; const char* A; const char* Bw; const int* alist; size_t bstepE, bstepN, astepBlk; int G, c, gather;
    __device__ __forceinline__ bool next(int i, pg8::Unit& u) const {
        const int L = i * G + c; const int tot = (int)M[TAB_CUM + 32];
        if (L >= 4 * tot) return false;
        int e = 0;
        while (e < 31 && L >= 4 * (int)M[TAB_CUM + e + 1]) ++e;
        const int cb = (int)M[TAB_CUM + e], nb = (int)M[TAB_CUM + e + 1] - cb, r = L - 4 * cb;
        int pn = r / nb, rb = r - pn * nb; int cnt = (int)M[TAB_CNT + e] - rb * 256; cnt = cnt > 256 ? 256 : cnt;
        e = __builtin_amdgcn_readfirstlane(e); pn = __builtin_amdgcn_readfirstlane(pn); rb = __builtin_amdgcn_readfirstlane(rb); cnt = __builtin_amdgcn_readfirstlane(cnt);
        const int blk = __builtin_amdgcn_readfirstlane(cb) + rb;
        u.pm = blk; u.pn = pn; u.ex = e; u.cnt = cnt; u.rows = alist + (size_t)e * T + rb * 256;
        u.A = gather ? A : A + (size_t)blk * astepBlk; u.B = Bw + (size_t)e * bstepE + (size_t)pn * bstepN; return true; }
};
struct EpiUp {
    static constexpr bool PERM = true;
    const int* alist; const f32x2* rwlist; bf16_t* hid;
    __device__ __forceinline__ bool operator()(f32x4 (&acc)[2][2][4][2], const pg8::Unit& u, int wr, int wc, int fr, int fq) const {
        const f32x2* rw = rwlist + (u.rows - alist);
        const int col0 = u.pn * 128 + wc * 32 + 8 * fq;
#pragma unroll
        for (int ai = 0; ai < 2; ++ai)
#pragma unroll
            for (int m = 0; m < 4; ++m) { const int r = ai * 128 + wr * 64 + m * 16 + fr; const float rs = (r < u.cnt) ? rw[r].x : 0.f;
                const f32x4 g0 = acc[ai][0][m][0] * rs, g1 = acc[ai][0][m][1] * rs, u0 = acc[ai][1][m][0] * rs, u1 = acc[ai][1][m][1] * rs;
                float o[8];
#pragma unroll
                for (int q = 0; q < 4; ++q) { o[q] = g0[q] * fsigmoid(g0[q]) * u0[q]; o[4 + q] = g1[q] * fsigmoid(g1[q]) * u1[q]; }
                u32x4 w; w.x = cvt_pk_bf16(o[0], o[1]); w.y = cvt_pk_bf16(o[2], o[3]); w.z = cvt_pk_bf16(o[4], o[5]); w.w = cvt_pk_bf16(o[6], o[7]);
                *(u32x4*)(hid + (size_t)(u.pm * 256 + r) * DE + col0) = w; }
        return false;
    }
};
struct EpiDown {
    static constexpr bool PERM = true;
    const int* alist; const f32x2* rwlist; bf16_t* yb;
    __device__ __forceinline__ bool operator()(f32x4 (&acc)[2][2][4][2], const pg8::Unit& u, int wr, int wc, int fr, int fq) const {
        const f32x2* rw = rwlist + (u.rows - alist);
        const int col0 = u.pn * 256 + wc * 32 + 8 * fq;
#pragma unroll
        for (int ai = 0; ai < 2; ++ai)
#pragma unroll
            for (int m = 0; m < 4; ++m) { const int r = ai * 128 + wr * 64 + m * 16 + fr;
                if (r < u.cnt) { const int a = u.rows[r]; const float w8 = rw[r].y; bf16_t* yr = yb + (size_t)a * D + col0;
#pragma unroll
                    for (int bj = 0; bj < 2; ++bj) { const f32x4 v0 = acc[ai][bj][m][0] * w8, v1 = acc[ai][bj][m][1] * w8; u32x4 w;
                        w.x = cvt_pk_bf16(v0[0], v0[1]); w.y = cvt_pk_bf16(v0[2], v0[3]); w.z = cvt_pk_bf16(v1[0], v1[1]); w.w = cvt_pk_bf16(v1[2], v1[3]);
                        *(u32x4*)(yr + bj * 128) = w; } } }
        return false;
    }
};

__device__ __forceinline__ void p7_route(const Args& a, LAS unsigned char* lds, volatile LAS unsigned* MISC, int tid, int lane, int wave, int vcu, int G) {
    const float* g_ffn = a.in[12]; const float* w_rg = a.in[13]; const float* b_rg = a.in[14]; const float* w_re = a.in[15]; const float* b_re = a.in[16];
    unsigned char* ws = a.ws;
    const float* x1 = (const float*)(ws + WS_X1); bf16_t* x1b = (bf16_t*)(ws + WS_X1B);
    int* alist = (int*)(ws + WS_ALIST); f32x2* rwlist = (f32x2*)(ws + WS_RWLIST); unsigned* counts = (unsigned*)(ws + WS_CTL) + CW_CNT;
    float* rstd2 = (float*)(ws + WS_RSTD2); float* gwd = (float*)(ws + WS_GW);
    LAS unsigned short* Wr = (LAS unsigned short*)lds;
    for (int idx = tid; idx < 1024 * 32; idx += NWAVES * 64) { const int k = idx >> 5, c = idx & 31, col = 4 + c;
        Wr[col * 1024 + ((((k >> 3) ^ (col & 15)) << 3) | (k & 7))] = f2bf(w_re[idx] * g_ffn[k]); }
    for (int idx = tid; idx < 1024 * 4; idx += NWAVES * 64) { const int k = idx >> 2, col = idx & 3;
        Wr[col * 1024 + ((((k >> 3) ^ (col & 15)) << 3) | (k & 7))] = f2bf(w_rg[idx] * g_ffn[k]); }
    for (int idx = tid; idx < 12 * 1024; idx += NWAVES * 64) Wr[36 * 1024 + idx] = 0;
    if (tid < 32) MISC[TAB_HIST + tid] = 0u;
    __syncthreads();
    LAS float* lgs = (LAS float*)(lds + 98304 + wave * 4096);
    for (int tile = vcu; tile < T / 64; tile += G) {
        int e1 = 0, e2 = 0, lp1 = 0, lp2 = 0; float gw1 = 0.f, gw2 = 0.f, rstd_t = 0.f;
        const int tok0 = tile * 64 + wave * 16;
        if (wave < 4) {
            const int row = lane & 15, kg = lane >> 4;
            const float* xp = x1 + (size_t)(tok0 + row) * D + 8 * kg; bf16_t* xbp = x1b + (size_t)(tok0 + row) * D + 8 * kg;
            f32x4 acc[3]; acc[0] = (f32x4){0.f, 0.f, 0.f, 0.f}; acc[1] = acc[0]; acc[2] = acc[0];
            float ss = 0.f;
#pragma unroll 4
            for (int s = 0; s < 32; ++s) {
                const f32x4 v0 = *(const f32x4*)(xp + 32 * s), v1 = *(const f32x4*)(xp + 32 * s + 4);
                ss += (v0.x * v0.x + v0.y * v0.y) + (v0.z * v0.z + v0.w * v0.w) + (v1.x * v1.x + v1.y * v1.y) + (v1.z * v1.z + v1.w * v1.w);
                u32x4 w; w.x = pk2(v0.x, v0.y); w.y = pk2(v0.z, v0.w); w.z = pk2(v1.x, v1.y); w.w = pk2(v1.z, v1.w);
                *(u32x4*)(xbp + 32 * s) = w;
                const bf16x8 af = __builtin_bit_cast(bf16x8, w);
#pragma unroll
                for (int j = 0; j < 3; ++j) { const bf16x8 bfr = *(const LAS bf16x8*)(lds + (16 * j + row) * 2048 + (((4 * s + kg) ^ row) << 4));
                    acc[j] = __builtin_amdgcn_mfma_f32_16x16x32_bf16(af, bfr, acc[j], 0, 0, 0); }
            }
            ss += __shfl_xor(ss, 16); ss += __shfl_xor(ss, 32);
            const float rstd = rsqrtf(ss * (1.f / D) + EPS);
#pragma unroll
            for (int j = 0; j < 3; ++j)
#pragma unroll
                for (int q = 0; q < 4; ++q) lgs[(4 * kg + q) * 48 + 16 * j + row] = acc[j][q];
            if (lane < 16) lgs[768 + lane] = rstd;
            LDS_WAIT(); asm volatile("" ::: "memory");
            if (lane < 16) {
                rstd_t = lgs[768 + lane];
                const LAS float* lr = lgs + lane * 48;
                float lg[4];
#pragma unroll
                for (int o = 0; o < 4; ++o) lg[o] = lr[o] * rstd_t + b_rg[o];
                int gs = 0; float gm = lg[0];
#pragma unroll
                for (int o = 1; o < 4; ++o) if (lg[o] > gm) { gm = lg[o]; gs = o; }
                float den = 0.f;
#pragma unroll
                for (int o = 0; o < 4; ++o) den += __expf(lg[o] - gm);
                const float pg = 1.f / den;
                float le[8];
#pragma unroll
                for (int o = 0; o < 8; ++o) le[o] = lr[4 + gs * 8 + o] * rstd_t + b_re[gs * 8 + o];
                int i1 = 0; float m1 = le[0];
#pragma unroll
                for (int o = 1; o < 8; ++o) if (le[o] > m1) { m1 = le[o]; i1 = o; }
                int i2 = 0; float m2 = -3.0e38f;
#pragma unroll
                for (int o = 0; o < 8; ++o) if (o != i1 && le[o] > m2) { m2 = le[o]; i2 = o; }
                const float ex2 = __expf(m2 - m1), inv = 1.f / (1.f + ex2);
                e1 = gs * 8 + i1; e2 = gs * 8 + i2; gw1 = pg * inv; gw2 = pg * ex2 * inv;
                lp1 = (int)__hip_atomic_fetch_add((LAS unsigned*)&MISC[TAB_HIST + e1], 1u, __ATOMIC_RELAXED, __HIP_MEMORY_SCOPE_WORKGROUP);
                lp2 = (int)__hip_atomic_fetch_add((LAS unsigned*)&MISC[TAB_HIST + e2], 1u, __ATOMIC_RELAXED, __HIP_MEMORY_SCOPE_WORKGROUP);
            }
        }
        __syncthreads();
        if (tid < 32) { const unsigned hc = MISC[TAB_HIST + tid]; MISC[TAB_BASE + tid] = hc ? __hip_atomic_fetch_add(counts + tid, hc, __ATOMIC_RELAXED, __HIP_MEMORY_SCOPE_AGENT) : 0u; MISC[TAB_HIST + tid] = 0u; }
        __syncthreads();
        if (wave < 4 && lane < 16) {
            const int tok = tok0 + lane;
            const int p1 = (int)MISC[TAB_BASE + e1] + lp1, p2 = (int)MISC[TAB_BASE + e2] + lp2;
            alist[(size_t)e1 * T + p1] = tok * 2; rwlist[(size_t)e1 * T + p1] = (f32x2){rstd_t, gw1};
            alist[(size_t)e2 * T + p2] = tok * 2 + 1; rwlist[(size_t)e2 * T + p2] = (f32x2){rstd_t, gw2};
            rstd2[tok] = rstd_t; gwd[tok * 2] = gw1; gwd[tok * 2 + 1] = gw2;
        }
        __syncthreads();
    }
}
__device__ __forceinline__ void moe_tables(unsigned* counts, volatile LAS unsigned* MISC, int tid) {
    if (tid == 0) { unsigned cum = 0;
        for (int e = 0; e < 32; ++e) { const unsigned c = __hip_atomic_load(counts + e, __ATOMIC_RELAXED, __HIP_MEMORY_SCOPE_AGENT); MISC[TAB_CNT + e] = c; MISC[TAB_CUM + e] = cum; cum += (c + 255u) >> 8; }
        MISC[TAB_CUM + 32] = cum; }
    __syncthreads();
}
__device__ __forceinline__ void p10_final(const Args& a, int lane, int wave, int vcu, int G) {
    const float* x1 = (const float*)(a.ws + WS_X1); const float* gf = a.in[20];
    const int gw = vcu * NWAVES + wave, NGW = G * NWAVES;
    f32x4 gv[4];
#pragma unroll
    for (int j = 0; j < 4; ++j) gv[j] = *(const f32x4*)(gf + 4 * lane + 256 * j);
    for (int t = gw; t < T; t += NGW) {
        const f32x4* xr = (const f32x4*)(x1 + (size_t)t * D) + lane; float* orow = a.out + (size_t)t * D;
        const u32x2* y0 = (const u32x2*)orow + lane; const u32x2* y1 = (const u32x2*)(orow + 512) + lane;
        f32x4 v[4]; float s = 0.f;
#pragma unroll
        for (int j = 0; j < 4; ++j) { const f32x4 xv = xr[64 * j]; const u32x2 p = y0[64 * j], q = y1[64 * j];
            v[j].x = xv.x + bflo(p.x) + bflo(q.x); v[j].y = xv.y + bfhi(p.x) + bfhi(q.x); v[j].z = xv.z + bflo(p.y) + bflo(q.y); v[j].w = xv.w + bfhi(p.y) + bfhi(q.y);
            s += (v[j].x * v[j].x + v[j].y * v[j].y) + (v[j].z * v[j].z + v[j].w * v[j].w); }
        s = wave_sum(s);
        const float rstd = rsqrtf(s * (1.f / D) + EPS);
#pragma unroll
        for (int j = 0; j < 4; ++j) ((f32x4*)orow)[lane + 64 * j] = v[j] * rstd * gv[j];
    }
}

typedef short v4i16_t __attribute__((ext_vector_type(4)));
__device__ __forceinline__ int img_off(int row, int ch) { return 2048 * (row >> 3) + 512 * (ch >> 2) + 64 * (row & 7) + 16 * ((ch & 3) ^ ((row >> 2) & 3)); }
__device__ __forceinline__ v4i16_t tr_read(LAS unsigned char* p) { return __builtin_amdgcn_ds_read_tr16_b64_v4i16((LAS v4i16_t*)p); }
__device__ __forceinline__ bf16x8 tr_frag(LAS unsigned char* img, int r0, int r1, int c0, int lane) {
    const int li = lane & 15, q = li >> 2, p = li & 3;
    const v4i16_t lo = tr_read(img + img_off(r0 + q, c0 + (p >> 1)) + 8 * (p & 1)), hi = tr_read(img + img_off(r1 + q, c0 + (p >> 1)) + 8 * (p & 1));
    return (bf16x8){lo[0], lo[1], lo[2], lo[3], hi[0], hi[1], hi[2], hi[3]};
}
__device__ __forceinline__ float wave_prefix_sum(float v, int lane) {
#pragma unroll
    for (int d = 1; d < 64; d <<= 1) { const float o = __shfl_up(v, d); if (lane >= d) v += o; }
    return v;
}
__device__ __forceinline__ float wave_prefix_max(float v, int lane) {
#pragma unroll
    for (int d = 1; d < 64; d <<= 1) { const float o = __shfl_up(v, d); if (lane >= d) v = fmaxf(v, o); }
    return v;
}
__device__ __forceinline__ float wave_max(float v) {
#pragma unroll
    for (int o = 1; o < 64; o <<= 1) v = fmaxf(v, __shfl_xor(v, o));
    return v;
}
constexpr int HALF_LDS = 50176;
__device__ __forceinline__ void conv4_silu(const u32x4 (&raw)[7], const float (&cw)[4][8], float scale, float (&out)[4][8]) {
#pragma unroll
    for (int i = 0; i < 4; ++i)
#pragma unroll
        for (int q = 0; q < 4; ++q) { float a0 = 0.f, a1 = 0.f;
#pragma unroll
            for (int j = 0; j < 4; ++j) { const unsigned w = raw[i + j][q]; a0 += bflo(w) * cw[j][2 * q]; a1 += bfhi(w) * cw[j][2 * q + 1]; }
            out[i][2 * q] = a0 * fsigmoid(a0) * scale; out[i][2 * q + 1] = a1 * fsigmoid(a1) * scale; }
}
__device__ __forceinline__ void b1_item(const Args& a, LAS unsigned char* hl, int item, int tl, int wv, int lane) {
    unsigned char* ws = a.ws; const bf16_t* z = (const bf16_t*)(ws + WS_Z); const float* gif = (const float*)(ws + WS_GIF); const float* conv_k = a.in[5];
    bf16_t* kact = (bf16_t*)(ws + WS_KACT); float* nloc = (float*)(ws + WS_NLOC); float* scal = (float*)(ws + WS_SCAL);
    unsigned char* Cb = (unsigned char*)a.out + OB_C + (size_t)item * 32768;
    const int bh = item >> 5, c = item & 31, b = bh >> 2, hh = bh & 3;
    const size_t tok_base = (size_t)b * SEQ + c * 64;
    const int cc = tl & 15, tg = tl >> 4, t0 = 4 * tg;
    u32x4 kr[7], vr[4];
#pragma unroll
    for (int j = 0; j < 7; ++j) { const int t = t0 - 3 + j; kr[j] = (c * 64 + t >= 0) ? *(const u32x4*)(z + (tok_base + t) * NZ + 1024 + hh * 128 + cc * 8) : (u32x4){0u, 0u, 0u, 0u}; }
#pragma unroll
    for (int i = 0; i < 4; ++i) vr[i] = *(const u32x4*)(z + (tok_base + t0 + i) * NZ + 1536 + hh * 128 + cc * 8);
    float cw[4][8];
#pragma unroll
    for (int j = 0; j < 4; ++j) { const f32x4 w0 = *(const f32x4*)(conv_k + j * DM + hh * 128 + cc * 8), w1 = *(const f32x4*)(conv_k + j * DM + hh * 128 + cc * 8 + 4);
        cw[j][0] = w0.x; cw[j][1] = w0.y; cw[j][2] = w0.z; cw[j][3] = w0.w; cw[j][4] = w1.x; cw[j][5] = w1.y; cw[j][6] = w1.z; cw[j][7] = w1.w; }
    LAS float* sc = (LAS float*)(hl + 49152);
    if (wv == 0) {
        const size_t tok = tok_base + lane;
        const float ig = gif[tok * 8 + hh], fp = gif[tok * 8 + 4 + hh];
        const float bb = wave_prefix_sum(logsigmoidf_(fp), lane);
        const float blast = __shfl(bb, 63);
        const float alog = blast - bb + ig;
        const float amax = wave_max(alog);
        sc[lane] = __expf(alog - amax);
        if (lane == 0) { scal[item] = amax; scal[1024 + item] = blast; }
    }
#pragma unroll
    for (int i = 0; i < 4; ++i) *(LAS u32x4*)(hl + 16384 + img_off(t0 + i, cc)) = vr[i];
    __syncthreads();
    {
        float ka[4][8]; conv4_silu(kr, cw, 0.08838834764831845f, ka);
#pragma unroll
        for (int i = 0; i < 4; ++i) { const float wl = sc[t0 + i];
            u32x4 w; w.x = pk2(ka[i][0], ka[i][1]); w.y = pk2(ka[i][2], ka[i][3]); w.z = pk2(ka[i][4], ka[i][5]); w.w = pk2(ka[i][6], ka[i][7]);
            *(u32x4*)(kact + (tok_base + t0 + i) * DM + hh * 128 + cc * 8) = w;
            u32x4 x; x.x = pk2(ka[i][0] * wl, ka[i][1] * wl); x.y = pk2(ka[i][2] * wl, ka[i][3] * wl); x.z = pk2(ka[i][4] * wl, ka[i][5] * wl); x.w = pk2(ka[i][6] * wl, ka[i][7] * wl);
            *(LAS u32x4*)(hl + img_off(t0 + i, cc)) = x; }
    }
    __syncthreads();
    {
        const int g = lane >> 4;
        bf16x8 af[2][2];
#pragma unroll
        for (int ii = 0; ii < 2; ++ii)
#pragma unroll
            for (int ks = 0; ks < 2; ++ks) af[ii][ks] = tr_frag(hl, 32 * ks + 8 * g, 32 * ks + 8 * g + 4, 2 * (2 * wv + ii), lane);
        const bf16x8 ones = (bf16x8){0x3F80, 0x3F80, 0x3F80, 0x3F80, 0x3F80, 0x3F80, 0x3F80, 0x3F80};
        f32x4 accn[2];
#pragma unroll
        for (int ii = 0; ii < 2; ++ii) { accn[ii] = (f32x4){0.f, 0.f, 0.f, 0.f};
#pragma unroll
            for (int ks = 0; ks < 2; ++ks) accn[ii] = __builtin_amdgcn_mfma_f32_16x16x32_bf16(af[ii][ks], ones, accn[ii], 0, 0, 0); }
#pragma unroll
        for (int j = 0; j < 8; ++j) {
            f32x4 acc0 = (f32x4){0.f, 0.f, 0.f, 0.f}, acc1 = acc0;
#pragma unroll
            for (int ks = 0; ks < 2; ++ks) { const bf16x8 bfv = tr_frag(hl + 16384, 32 * ks + 8 * g, 32 * ks + 8 * g + 4, 2 * j, lane);
                acc0 = __builtin_amdgcn_mfma_f32_16x16x32_bf16(af[0][ks], bfv, acc0, 0, 0, 0); acc1 = __builtin_amdgcn_mfma_f32_16x16x32_bf16(af[1][ks], bfv, acc1, 0, 0, 0); }
            u32x4 w; w.x = pk2(acc0[0], acc0[1]); w.y = pk2(acc0[2], acc0[3]); w.z = pk2(acc1[0], acc1[1]); w.w = pk2(acc1[2], acc1[3]);
            *(u32x4*)(Cb + ((size_t)((wv * 8 + j) * 64 + lane) << 4)) = w;
        }
        if ((lane & 15) == 0) {
#pragma unroll
            for (int ii = 0; ii < 2; ++ii) *(f32x4*)(nloc + (size_t)item * 128 + 16 * (2 * wv + ii) + 4 * g) = accn[ii]; }
    }
    __syncthreads();
}
__device__ __forceinline__ void pool_pass(const Args& a, int tid, int vcu, int G) {
    const bf16_t* z = (const bf16_t*)(a.ws + WS_Z); bf16_t* dA = (bf16_t*)((unsigned char*)a.out + OB_DA);
    for (int w = vcu * (NWAVES * 64) + tid; w < (T / 8) * 64; w += G * NWAVES * 64) {
        const int cc = w & 63, run = w >> 6, tokA = run * 8, s0 = tokA % SEQ, grp = cc >> 4, win = 2 << grp;
        const bf16_t* zp = z + (size_t)tokA * NZ + cc * 8;
        float S[8];
#pragma unroll
        for (int q = 0; q < 8; ++q) S[q] = 0.f;
        for (int j = 1; j <= win; ++j) if (s0 - j >= 0) { const u32x4 r = *(const u32x4*)(zp - (size_t)j * NZ);
#pragma unroll
            for (int q = 0; q < 4; ++q) { S[2 * q] += bflo(r[q]); S[2 * q + 1] += bfhi(r[q]); } }
#pragma unroll
        for (int i = 0; i < 8; ++i) {
            const int s = s0 + i; const u32x4 r = *(const u32x4*)(zp + (size_t)i * NZ);
            float cur[8];
#pragma unroll
            for (int q = 0; q < 4; ++q) { cur[2 * q] = bflo(r[q]); cur[2 * q + 1] = bfhi(r[q]); S[2 * q] += cur[2 * q]; S[2 * q + 1] += cur[2 * q + 1]; }
            if (s - win >= 0) { const u32x4 o = *(const u32x4*)(zp + (size_t)(i - win) * NZ);
#pragma unroll
                for (int q = 0; q < 4; ++q) { S[2 * q] -= bflo(o[q]); S[2 * q + 1] -= bfhi(o[q]); } }
            const float inv = 1.f / (float)(s + 1 < win ? s + 1 : win);
            u32x4 w4;
#pragma unroll
            for (int q = 0; q < 4; ++q) w4[q] = pk2(S[2 * q] * inv - cur[2 * q], S[2 * q + 1] * inv - cur[2 * q + 1]);
            *(u32x4*)(dA + (size_t)(tokA + i) * DP + cc * 8) = w4;
        }
    }
}
__device__ __forceinline__ void p3_scan(const Args& a, int tid, int vcu, int G) {
    float* scal = (float*)(a.ws + WS_SCAL); float* nloc = (float*)(a.ws + WS_NLOC);
    for (int w = vcu; w < 256; w += G) {
        const int bh = w >> 3, part = w & 7;
        unsigned char* Cp = (unsigned char*)a.out + OB_C + (size_t)bh * 32 * 32768 + (size_t)(part * 512 + tid) * 8;
        float st[4] = {0.f, 0.f, 0.f, 0.f}; float m = 0.f, nst = 0.f;
        const bool do_n = (part == 0 && tid < 128);
#pragma unroll 4
        for (int c = 0; c < 32; ++c) {
            const float am = scal[bh * 32 + c], bl = scal[1024 + bh * 32 + c];
            const float mn = fmaxf(bl + m, am), sp = __expf(bl + m - mn), sl = __expf(am - mn);
            u32x2* p = (u32x2*)(Cp + (size_t)c * 32768);
            const u32x2 ld = *p;
            u32x2 o; o.x = pk2(st[0], st[1]); o.y = pk2(st[2], st[3]); *p = o;
            st[0] = sp * st[0] + sl * bflo(ld.x); st[1] = sp * st[1] + sl * bfhi(ld.x); st[2] = sp * st[2] + sl * bflo(ld.y); st[3] = sp * st[3] + sl * bfhi(ld.y);
            if (do_n) { float* np = nloc + (size_t)(bh * 32 + c) * 128 + tid; const float nl = *np; *np = nst; nst = sp * nst + sl * nl; }
            if (part == 0 && tid == 0) scal[2048 + bh * 32 + c] = m;
            m = mn;
        }
    }
}
__device__ __forceinline__ void b3_item(const Args& a, LAS unsigned char* hl, int item, int tl, int wv, int lane) {
    unsigned char* ws = a.ws; const bf16_t* z = (const bf16_t*)(ws + WS_Z); const float* gif = (const float*)(ws + WS_GIF); const float* conv_q = a.in[4]; const float* g_head = a.in[6];
    const bf16_t* kact = (const bf16_t*)(ws + WS_KACT); const float* nprev = (const float*)(ws + WS_NLOC) + (size_t)item * 128; const float* scal = (const float*)(ws + WS_SCAL);
    const unsigned char* Cb = (const unsigned char*)a.out + OB_C + (size_t)item * 32768; bf16_t* hm = (bf16_t*)((unsigned char*)a.out + OB_HM);
    const int bh = item >> 5, c = item & 31, b = bh >> 2, hh = bh & 3;
    const size_t tok_base = (size_t)b * SEQ + c * 64;
    const int cc = tl & 15, tg = tl >> 4, t0 = 4 * tg;
    LAS unsigned char* qi = hl; LAS unsigned char* ki = hl + 16384; LAS unsigned char* vi = hl + 32768; LAS float* sc = (LAS float*)(hl + 49152);
    const float mprev = scal[2048 + item];
    {
        u32x4 qr[7], kv[4], vr[4];
#pragma unroll
        for (int j = 0; j < 7; ++j) { const int t = t0 - 3 + j; qr[j] = (c * 64 + t >= 0) ? *(const u32x4*)(z + (tok_base + t) * NZ + 512 + hh * 128 + cc * 8) : (u32x4){0u, 0u, 0u, 0u}; }
#pragma unroll
        for (int i = 0; i < 4; ++i) { kv[i] = *(const u32x4*)(kact + (tok_base + t0 + i) * DM + hh * 128 + cc * 8); vr[i] = *(const u32x4*)(z + (tok_base + t0 + i) * NZ + 1536 + hh * 128 + cc * 8); }
        float cw[4][8];
#pragma unroll
        for (int j = 0; j < 4; ++j) { const f32x4 w0 = *(const f32x4*)(conv_q + j * DM + hh * 128 + cc * 8), w1 = *(const f32x4*)(conv_q + j * DM + hh * 128 + cc * 8 + 4);
            cw[j][0] = w0.x; cw[j][1] = w0.y; cw[j][2] = w0.z; cw[j][3] = w0.w; cw[j][4] = w1.x; cw[j][5] = w1.y; cw[j][6] = w1.z; cw[j][7] = w1.w; }
        if (wv == 0) {
            const size_t tok = tok_base + lane;
            const float ig = gif[tok * 8 + hh], fp = gif[tok * 8 + 4 + hh];
            const float bb = wave_prefix_sum(logsigmoidf_(fp), lane);
            const float gg = ig - bb;
            const float M = fmaxf(mprev, wave_prefix_max(gg, lane));
            sc[lane] = gg; sc[64 + lane] = M; sc[128 + lane] = bb;
        }
        float qa[4][8]; conv4_silu(qr, cw, 1.f, qa);
#pragma unroll
        for (int i = 0; i < 4; ++i) { u32x4 w; w.x = pk2(qa[i][0], qa[i][1]); w.y = pk2(qa[i][2], qa[i][3]); w.z = pk2(qa[i][4], qa[i][5]); w.w = pk2(qa[i][6], qa[i][7]);
            *(LAS u32x4*)(qi + img_off(t0 + i, cc)) = w; *(LAS u32x4*)(ki + img_off(t0 + i, cc)) = kv[i]; *(LAS u32x4*)(vi + img_off(t0 + i, cc)) = vr[i]; }
    }
    __syncthreads();
    {
        const int jt = wv, li = lane & 15, g = lane >> 4, trow = 16 * jt + li;
        bf16x8 qn[4];
#pragma unroll
        for (int ks = 0; ks < 4; ++ks) qn[ks] = *(const LAS bf16x8*)(qi + img_off(trow, 4 * ks + g));
        f32x4 accs[4];
#pragma unroll
        for (int i = 0; i < 4; ++i) { accs[i] = (f32x4){0.f, 0.f, 0.f, 0.f};
            if (i <= jt) {
#pragma unroll
                for (int ks = 0; ks < 4; ++ks) { const bf16x8 kf = *(const LAS bf16x8*)(ki + img_off(16 * i + li, 4 * ks + g)); accs[i] = __builtin_amdgcn_mfma_f32_16x16x32_bf16(kf, qn[ks], accs[i], 0, 0, 0); } } }
        const float Mt = sc[64 + trow], bt = sc[128 + trow];
        float rsum = 0.f;
#pragma unroll
        for (int i = 0; i < 4; ++i) { if (i <= jt) { const f32x4 gsv = *(const LAS f32x4*)(sc + 16 * i + 4 * g);
#pragma unroll
                for (int q = 0; q < 4; ++q) { float p = accs[i][q] * __expf(gsv[q] - Mt); if (i == jt && 4 * g + q > li) p = 0.f; accs[i][q] = p; rsum += p; } } }
        rsum += __shfl_xor(rsum, 16); rsum += __shfl_xor(rsum, 32);
        bf16x8 pf[2];
#pragma unroll
        for (int u = 0; u < 2; ++u) { u32x4 w; w.x = pk2(accs[2 * u][0], accs[2 * u][1]); w.y = pk2(accs[2 * u][2], accs[2 * u][3]); w.z = pk2(accs[2 * u + 1][0], accs[2 * u + 1][1]); w.w = pk2(accs[2 * u + 1][2], accs[2 * u + 1][3]); pf[u] = __builtin_bit_cast(bf16x8, w); }
        bf16x8 qp[4];
#pragma unroll
        for (int s4 = 0; s4 < 4; ++s4) { const u32x2 lo = *(const LAS u32x2*)(qi + img_off(trow, 4 * s4 + (g >> 1)) + 8 * (g & 1)), hi = *(const LAS u32x2*)(qi + img_off(trow, 4 * s4 + 2 + (g >> 1)) + 8 * (g & 1));
            qp[s4] = __builtin_bit_cast(bf16x8, (u32x4){lo.x, lo.y, hi.x, hi.y}); }
        f32x4 acco[8]; f32x4 accn = (f32x4){0.f, 0.f, 0.f, 0.f};
#pragma unroll
        for (int s4 = 0; s4 < 4; ++s4) { const f32x4 n0 = *(const f32x4*)(nprev + 32 * s4 + 4 * g), n1 = *(const f32x4*)(nprev + 32 * s4 + 16 + 4 * g);
            u32x4 w; w.x = pk2(n0.x, n0.y); w.y = pk2(n0.z, n0.w); w.z = pk2(n1.x, n1.y); w.w = pk2(n1.z, n1.w);
            accn = __builtin_amdgcn_mfma_f32_16x16x32_bf16(__builtin_bit_cast(bf16x8, w), qp[s4], accn, 0, 0, 0); }
#pragma unroll
        for (int jd = 0; jd < 8; ++jd) { acco[jd] = (f32x4){0.f, 0.f, 0.f, 0.f};
#pragma unroll
            for (int s4 = 0; s4 < 4; ++s4) { const bf16x8 cf = *(const bf16x8*)(Cb + ((size_t)((s4 * 8 + jd) * 64 + lane) << 4)); acco[jd] = __builtin_amdgcn_mfma_f32_16x16x32_bf16(cf, qp[s4], acco[jd], 0, 0, 0); } }
        const float winter = __expf(mprev - Mt);
#pragma unroll
        for (int jd = 0; jd < 8; ++jd) acco[jd] = acco[jd] * winter;
#pragma unroll
        for (int u = 0; u < 2; ++u) { if (2 * u <= jt) {
#pragma unroll
                for (int jd = 0; jd < 8; ++jd) { const bf16x8 vf = tr_frag(vi, 32 * u + 4 * g, 32 * u + 16 + 4 * g, 2 * jd, lane); acco[jd] = __builtin_amdgcn_mfma_f32_16x16x32_bf16(vf, pf[u], acco[jd], 0, 0, 0); } } }
        const float nq = winter * accn[0] + rsum;
        const float inv = 1.f / fmaxf(fabsf(nq), __expf(-bt - Mt));
        float s1 = 0.f;
#pragma unroll
        for (int jd = 0; jd < 8; ++jd) { acco[jd] = acco[jd] * inv; s1 += (acco[jd][0] + acco[jd][1]) + (acco[jd][2] + acco[jd][3]); }
        s1 += __shfl_xor(s1, 16); s1 += __shfl_xor(s1, 32);
        const float mu = s1 * (1.f / HD);
        float s2 = 0.f;
#pragma unroll
        for (int jd = 0; jd < 8; ++jd) { const f32x4 d = acco[jd] - mu; s2 += (d[0] * d[0] + d[1] * d[1]) + (d[2] * d[2] + d[3] * d[3]); }
        s2 += __shfl_xor(s2, 16); s2 += __shfl_xor(s2, 32);
        const float rstd = rsqrtf(s2 * (1.f / HD) + EPS);
        const size_t tok = tok_base + trow;
#pragma unroll
        for (int jd = 0; jd < 8; ++jd) { const int dv0 = hh * 128 + 16 * jd + 4 * g;
            const f32x4 gh = *(const f32x4*)(g_head + dv0); const u32x2 ov = *(const u32x2*)(z + tok * NZ + 2048 + dv0);
            const f32x4 hn = (acco[jd] - mu) * rstd * gh;
            u32x2 w; w.x = pk2(hn[0] * fsigmoid(bflo(ov.x)), hn[1] * fsigmoid(bfhi(ov.x))); w.y = pk2(hn[2] * fsigmoid(bflo(ov.y)), hn[3] * fsigmoid(bfhi(ov.y)));
            *(u32x2*)(hm + tok * DM + dv0) = w; }
    }
    __syncthreads();
}

__device__ __forceinline__ void tr_item(const float* __restrict__ src, int ld, int k0, int n0s, bf16_t* dst, int dstK, const float* __restrict__ kscale, LAS float* scr, int lane) {
#pragma unroll 8
    for (int i = 0; i < 32; ++i) { const int kk = 2 * i + (lane >> 5); float v = src[(size_t)(k0 + kk) * ld + n0s + (lane & 31)]; if (kscale) v *= kscale[k0 + kk]; scr[kk * 33 + (lane & 31)] = v; }
    LDS_WAIT(); asm volatile("" ::: "memory");
    const int c = lane & 7;
#pragma unroll
    for (int j = 0; j < 4; ++j) { const int n = (lane >> 3) + 8 * j; const LAS float* s = scr + (8 * c) * 33 + n;
        u32x4 o; o.x = pk2(s[0 * 33], s[1 * 33]); o.y = pk2(s[2 * 33], s[3 * 33]); o.z = pk2(s[4 * 33], s[5 * 33]); o.w = pk2(s[6 * 33], s[7 * 33]);
        *(u32x4*)(dst + (size_t)n * dstK + k0 + 8 * c) = o; }
    LDS_WAIT(); asm volatile("" ::: "memory");
}

__device__ __forceinline__ void p0_prologue(const Args& a, LAS unsigned char* lds, int tid, int lane, int wave, int vcu, int G) {
    const float* x = a.in[0]; const float* g_mix = a.in[1]; const float* w_in = a.in[2]; const float* b_if = a.in[3];
    const float* w_pool = a.in[7]; const float* pool_scale = a.in[8]; const float* w_br_a = a.in[9]; const float* w_br_b = a.in[10]; const float* w_out = a.in[11];
    const float* g_ffn = a.in[12]; const float* w_eg = a.in[17]; const float* w_eu = a.in[18]; const float* w_ed = a.in[19];
    unsigned char* ws = a.ws;
    bf16_t* h = (bf16_t*)((unsigned char*)a.out + OB_H); float* gif = (float*)(ws + WS_GIF);
    const int gw = vcu * NWAVES + wave, NGW = G * NWAVES;
    LAS float* gwl = (LAS float*)(lds + 81920);
    for (int idx = tid; idx < 8192; idx += NWAVES * 64) { const int k = idx >> 3, o = idx & 7; gwl[o * 1024 + k] = w_in[(size_t)k * NIN + 2560 + o] * g_mix[k]; }
    __syncthreads();
    {
        f32x4 gm[4];
#pragma unroll
        for (int j = 0; j < 4; ++j) gm[j] = *(const f32x4*)(g_mix + 4 * lane + 256 * j);
        for (int m = gw; m < T; m += NGW) {
            const f32x4* xr = (const f32x4*)(x + (size_t)m * D) + lane;
            f32x4 v[4]; float s = 0.f;
#pragma unroll
            for (int j = 0; j < 4; ++j) { v[j] = xr[64 * j]; s += (v[j].x * v[j].x + v[j].y * v[j].y) + (v[j].z * v[j].z + v[j].w * v[j].w); }
            s = wave_sum(s);
            const float rstd = rsqrtf(s * (1.f / D) + EPS);
            float acc[8];
#pragma unroll
            for (int o = 0; o < 8; ++o) { float t = 0.f;
#pragma unroll
                for (int j = 0; j < 4; ++j) { const f32x4 w = *(const LAS f32x4*)(gwl + o * 1024 + 4 * lane + 256 * j); t += (v[j].x * w.x + v[j].y * w.y) + (v[j].z * w.z + v[j].w * w.w); }
                acc[o] = wave_sum(t); }
            u32x2* o8 = (u32x2*)(h + (size_t)m * D) + lane;
#pragma unroll
            for (int j = 0; j < 4; ++j) { const f32x4 hv = v[j] * rstd * gm[j]; u32x2 w; w.x = pk2(hv.x, hv.y); w.y = pk2(hv.z, hv.w); o8[64 * j] = w; }
            if (lane < 8) { float r = acc[0];
#pragma unroll
                for (int o = 1; o < 8; ++o) r = (lane == o) ? acc[o] : r;
                gif[(size_t)m * 8 + lane] = r * rstd + b_if[lane]; }
        }
    }
    LAS float* scr = (LAS float*)(lds + wave * 8448);
    constexpr int I_WZ = 16 * 144, I_WB = 8 * 32, I_WO = 16 * 32, I_EG = 32 * 16 * 16, I_ED = 32 * 8 * 32;
    constexpr int NITEMS = I_WZ + I_WB + I_WO + 2 * I_EG + I_ED;
    const bool do_experts = (a.flags & 1) == 0;
    for (int it = gw; it < NITEMS; it += NGW) {
        int r = it;
        if (r < I_WZ) { const int kb = r / 144, nb = r % 144, n0 = nb * 32; tr_item(w_in, NIN, kb * 64, zcol2orig(n0), (bf16_t*)(ws + WS_WZ) + (size_t)n0 * D, D, nullptr, scr, lane); continue; } r -= I_WZ;
        if (r < I_WB) { const int kb = r / 32, nb = r % 32; tr_item(w_br_b, D, kb * 64, nb * 32, (bf16_t*)(ws + WS_WBT) + (size_t)(nb * 32) * DM, DM, nullptr, scr, lane); continue; } r -= I_WB;
        if (r < I_WO) { const int kb = r / 32, nb = r % 32; tr_item(w_out, D, kb * 64, nb * 32, (bf16_t*)(ws + WS_WOT) + (size_t)(nb * 32) * D, D, nullptr, scr, lane); continue; } r -= I_WO;
        if (!do_experts) break;
        if (r < 2 * I_EG) { const int up = r >= I_EG; if (up) r -= I_EG; const int e = r >> 8, kb = (r >> 4) & 15, nb = r & 15, j0 = nb * 32;
            const int drow = (j0 >> 7) * 256 + up * 128 + (j0 & 127);
            tr_item((up ? w_eu : w_eg) + (size_t)e * D * DE, DE, kb * 64, j0, (bf16_t*)(ws + WS_WUP) + ((size_t)e * 1024 + drow) * D, D, g_ffn, scr, lane); continue; } r -= 2 * I_EG;
        { const int e = r >> 8, kb = (r >> 5) & 7, nb = r & 31; tr_item(w_ed + (size_t)e * DE * D, D, kb * 64, nb * 32, (bf16_t*)(ws + WS_WDN) + ((size_t)e * 1024 + nb * 32) * DE, DE, nullptr, scr, lane); }
    }
    {
        bf16_t* W2T = (bf16_t*)(ws + WS_W2T);
        const int gt = gw * 64 + lane, NT_ = NGW * 64;
        for (int o = gt; o < DP * D; o += NT_) {
            const int n = o >> 9, k = o & 511, gq = k >> 7;
            const float* wp = w_pool + (size_t)k * 128; const float* sc = pool_scale + gq * 128; const float* wa = w_br_a + (size_t)(gq * 128) * D + n;
            float acc = 0.f;
#pragma unroll 8
            for (int d = 0; d < 128; ++d) acc += wp[d] * sc[d] * wa[(size_t)d * D];
            W2T[(size_t)n * DP + k] = f2bf(acc);
        }
    }
}

__global__ void __launch_bounds__(NWAVES * 64, 2) mk_fwd(Args args) {
    extern __shared__ __attribute__((aligned(16))) unsigned char lds_raw[];
    LAS unsigned char* lds = (LAS unsigned char*)lds_raw;
    volatile LAS unsigned* MISC = (volatile LAS unsigned*)(lds + MISC_OFF);
    const int tid = threadIdx.x, lane = tid & 63, wave = __builtin_amdgcn_readfirstlane(tid >> 6);
    const int G = gridDim.x; const int bx = blockIdx.x; const int vcu = (G % 8 == 0) ? (bx % 8) * (G / 8) + bx / 8 : bx;
    unsigned char* ws = args.ws; unsigned* ctl = (unsigned*)(ws + WS_CTL);
    for (int u = tid; u < (LDS_BYTES - LDSCTL_OFF) / 4; u += NWAVES * 64) ((LAS unsigned*)(lds + LDSCTL_OFF))[u] = 0u;
    __syncthreads();
    XcdBarrier bar = xcd_barrier_post(ctl + CW_BAR + args.li * XCD_BAR_WORDS, MISC + 8);
    const int lo = args.ph_lo, hi = args.ph_hi;
#define IN(k) (lo <= (k) && (k) < hi)
#define BOTH(k) (IN(k) && IN((k) + 1))
#define GRID_BAR() xcd_barrier(bar)
    if (IN(0)) { p0_prologue(args, lds, tid, lane, wave, vcu, G); if (BOTH(0)) GRID_BAR(); }
    if (IN(1)) {
        SchedDense S{(const char*)args.out + OB_H, (const char*)(ws + WS_WZ), (size_t)256 * D * 2, (size_t)256 * D * 2, T / 256, NZ / 256, G, bx};
        EpiZ E{(bf16_t*)(ws + WS_Z)};
        pg8::gemm_phase<EpiZ, SchedDense, false>(lds + RING_OFF, pg8::Cfg{D, D * 2, D * 2}, S, E);
        if (BOTH(1)) GRID_BAR();
    }
    if (IN(2)) {
        for (int pr = vcu; pr < 512; pr += G) b1_item(args, lds + (wave >> 2) * HALF_LDS, 2 * pr + (wave >> 2), tid & 255, wave & 3, lane);
        pool_pass(args, tid, vcu, G);
        if (BOTH(2)) GRID_BAR();
    }
    if (IN(3)) { p3_scan(args, tid, vcu, G); if (BOTH(3)) GRID_BAR(); }
    if (IN(4)) {
        for (int pr = vcu; pr < 512; pr += G) b3_item(args, lds + (wave >> 2) * HALF_LDS, 2 * pr + (wave >> 2), tid & 255, wave & 3, lane);
        if (BOTH(4)) GRID_BAR();
    }
    if (IN(5)) {
        SchedMerge S{(const char*)args.out + OB_DA, (const char*)args.out + OB_HM, (const char*)(ws + WS_W2T), (const char*)(ws + WS_WBT), T / 256, D / 256, G, bx};
        EpiMerge E{(const bf16_t*)(ws + WS_Z), (bf16_t*)((unsigned char*)args.out + OB_MERGED)};
        pg8::gemm_phase<EpiMerge, SchedMerge, false>(lds + RING_OFF, pg8::Cfg{DP, DP * 2, DP * 2}, S, E);
        if (BOTH(5)) GRID_BAR();
    }
    if (IN(6)) {
        SchedDense S{(const char*)args.out + OB_MERGED, (const char*)(ws + WS_WOT), (size_t)256 * D * 2, (size_t)256 * D * 2, T / 256, D / 256, G, bx};
        EpiX1 E{args.in[0], (float*)(ws + WS_X1)};
        pg8::gemm_phase<EpiX1, SchedDense, false>(lds + RING_OFF, pg8::Cfg{D, D * 2, D * 2}, S, E);
        if (BOTH(6)) GRID_BAR();
    }
    if (IN(7)) { p7_route(args, lds, MISC, tid, lane, wave, vcu, G); if (BOTH(7)) GRID_BAR(); }
    if (IN(8)) {
        moe_tables(ctl + CW_CNT, MISC, tid);
        SchedMoE S{MISC, (const char*)(ws + WS_X1B), (const char*)(ws + WS_WUP), (const int*)(ws + WS_ALIST), (size_t)1024 * D * 2, (size_t)256 * D * 2, 0, G, bx, 1};
        EpiUp E{(const int*)(ws + WS_ALIST), (const f32x2*)(ws + WS_RWLIST), (bf16_t*)(ws + WS_HID)};
        pg8::gemm_phase<EpiUp, SchedMoE, true>(lds + RING_OFF, pg8::Cfg{D, D * 2, D * 2}, S, E);
        if (BOTH(8)) GRID_BAR();
    }
    if (IN(9)) {
        moe_tables(ctl + CW_CNT, MISC, tid);
        SchedMoE S{MISC, (const char*)(ws + WS_HID), (const char*)(ws + WS_WDN), (const int*)(ws + WS_ALIST), (size_t)1024 * DE * 2, (size_t)256 * DE * 2, (size_t)256 * DE * 2, G, bx, 0};
        EpiDown E{(const int*)(ws + WS_ALIST), (const f32x2*)(ws + WS_RWLIST), (bf16_t*)args.out};
        pg8::gemm_phase<EpiDown, SchedMoE, false>(lds + RING_OFF, pg8::Cfg{DE, DE * 2, DE * 2}, S, E);
        if (BOTH(9)) GRID_BAR();
    }
    if (IN(10)) p10_final(args, lane, wave, vcu, G);
#undef IN
#undef BOTH
#undef GRID_BAR
}

}

extern "C" void kernel_launch(void* const* d_in, const int* in_sizes, int n_in, void* d_out, int out_size, void* d_ws, size_t ws_size, hipStream_t stream) {
    const float* x = (const float*)d_in[0];
    const float* conv_q = (const float*)d_in[4]; const float* conv_k = (const float*)d_in[5]; const float* g_head = (const float*)d_in[6]; const float* w_pool = (const float*)d_in[7];
    const float* pool_scale = (const float*)d_in[8]; const float* w_br_a = (const float*)d_in[9]; const float* w_br_b = (const float*)d_in[10]; const float* w_out = (const float*)d_in[11];
    const float* g_ffn = (const float*)d_in[12]; const float* w_rg = (const float*)d_in[13]; const float* b_rg = (const float*)d_in[14]; const float* w_re = (const float*)d_in[15];
    const float* b_re = (const float*)d_in[16]; const float* w_eg = (const float*)d_in[17]; const float* w_eu = (const float*)d_in[18]; const float* w_ed = (const float*)d_in[19];
    const float* g_final = (const float*)d_in[20];
    static int grid = 0;
    if (grid == 0) {
        if (n_in != 21 || out_size != T * D || ws_size < WS_END) { fprintf(stderr, "kernel_launch: unexpected shapes/ws (%d inputs, out %d, ws %zu)\n", n_in, out_size, ws_size); grid = -1; return; }
        int dev = 0, cus = 0, per_cu = 0;
        if (hipGetDevice(&dev) != hipSuccess || hipDeviceGetAttribute(&cus, hipDeviceAttributeMultiprocessorCount, dev) != hipSuccess) { grid = -1; return; }
        if (hipFuncSetAttribute((const void*)mk_fwd, hipFuncAttributeMaxDynamicSharedMemorySize, LDS_BYTES) != hipSuccess) { fprintf(stderr, "kernel_launch: hipFuncSetAttribute failed\n"); grid = -1; return; }
        if (hipOccupancyMaxActiveBlocksPerMultiprocessor(&per_cu, (const void*)mk_fwd, NWAVES * 64, LDS_BYTES) != hipSuccess || per_cu < 1) { fprintf(stderr, "kernel_launch: occupancy query says %d blocks per CU\n", per_cu); grid = -1; return; }
        (void)hipGetLastError();
        grid = cus;
    }
    if (grid < 0) return;
    unsigned char* ws = (unsigned char*)d_ws; unsigned char* ob = (unsigned char*)d_out;
    (void)hipMemsetAsync(ws + WS_CTL, 0, CTL_ZERO_BYTES, stream);
    Args a{};
    for (int i = 0; i < 21; ++i) a.in[i] = (const float*)d_in[i];
    a.out = (float*)d_out; a.ws = ws; a.flags = 0;
    a.ph_lo = 0; a.ph_hi = 11; a.li = 0;
    hipLaunchKernelGGL(mk_fwd, dim3(grid), dim3(NWAVES * 64), LDS_BYTES, stream, a);
}
```

```cpp
#include <hip/hip_runtime.h>
#include <cstdio>
#include <cstdint>

namespace {
constexpr int D = 1024, BATCH = 8, SEQ = 2048, T = BATCH * SEQ;
constexpr int DP = 512, DM = 512, NH = 4, HD = 128, NIN = 4616, NZ = 4608;
constexpr int NG = 4, EPG = 8, NE = 32, DE = 512;
constexpr float EPS = 1e-6f;
constexpr size_t MiB = 1u << 20;

typedef unsigned short bf16_t;
__device__ __forceinline__ bf16_t f2bf(float f) { unsigned u = __builtin_bit_cast(unsigned, f); return (bf16_t)((u + 0x7fffu + ((u >> 16) & 1u)) >> 16); }
__device__ __forceinline__ float bf2f(bf16_t b) { return __builtin_bit_cast(float, (unsigned)b << 16); }
__device__ __forceinline__ float sigmoidf_(float x) { return 1.f / (1.f + __expf(-x)); }
__device__ __forceinline__ float siluf_(float x) { return x / (1.f + __expf(-x)); }
__device__ __forceinline__ float logsigmoidf_(float x) { return fminf(x, 0.f) - log1pf(__expf(-fabsf(x))); }
__device__ __forceinline__ float wave_sum(float v) {
#pragma unroll
    for (int o = 1; o < 64; o <<= 1) v += __shfl_xor(v, o);
    return v;
}
__device__ __forceinline__ int zcol2orig(int c) { return c < 2560 ? c : c + 8; }

__global__ void __launch_bounds__(256) k_prep(const float* __restrict__ x, const float* __restrict__ g, const float* __restrict__ w_in,
                                               const float* __restrict__ b_if, bf16_t* __restrict__ h, float* __restrict__ gif) {
    const int wave = threadIdx.x >> 6, lane = threadIdx.x & 63;
    const int row = blockIdx.x * 4 + wave;
    if (row >= T) return;
    const float* xr = x + (size_t)row * D;
    float v[16]; float s = 0.f;
#pragma unroll
    for (int j = 0; j < 16; ++j) { v[j] = xr[lane + 64 * j]; s += v[j] * v[j]; }
    s = wave_sum(s);
    const float rstd = rsqrtf(s * (1.f / D) + EPS);
    float acc[8];
#pragma unroll
    for (int o = 0; o < 8; ++o) acc[o] = 0.f;
#pragma unroll
    for (int j = 0; j < 16; ++j) {
        const int k = lane + 64 * j;
        const float hv = v[j] * rstd * g[k];
        h[(size_t)row * D + k] = f2bf(hv);
#pragma unroll
        for (int o = 0; o < 8; ++o) acc[o] += hv * w_in[(size_t)k * NIN + 2560 + o];
    }
#pragma unroll
    for (int o = 0; o < 8; ++o) { acc[o] = wave_sum(acc[o]); }
    if (lane == 0) {
#pragma unroll
        for (int o = 0; o < 8; ++o) gif[(size_t)row * 8 + o] = acc[o] + b_if[o];
    }
}

template <class AL, class BL, class EP>
__global__ void __launch_bounds__(256) k_gemm(int M, int N, int K, AL al, BL bl, EP ep) {
    __shared__ float As[16][68];
    __shared__ float Bs[16][68];
    const int tid = threadIdx.x, tx = tid & 15, ty = tid >> 4;
    const int row0 = blockIdx.y * 64, col0 = blockIdx.x * 64;
    float acc[4][4];
#pragma unroll
    for (int i = 0; i < 4; ++i)
#pragma unroll
        for (int j = 0; j < 4; ++j) acc[i][j] = 0.f;
    for (int k0 = 0; k0 < K; k0 += 16) {
#pragma unroll
        for (int j = 0; j < 4; ++j) {
            const int idx = tid + j * 256;
            const int r = idx >> 4, kk = idx & 15;
            As[kk][r] = (row0 + r < M) ? al(row0 + r, k0 + kk) : 0.f;
            const int k2 = idx >> 6, n = idx & 63;
            Bs[k2][n] = (col0 + n < N) ? bl(k0 + k2, col0 + n) : 0.f;
        }
        __syncthreads();
#pragma unroll
        for (int kk = 0; kk < 16; ++kk) {
            float a[4], b[4];
#pragma unroll
            for (int i = 0; i < 4; ++i) a[i] = As[kk][ty * 4 + i];
#pragma unroll
            for (int j = 0; j < 4; ++j) b[j] = Bs[kk][tx * 4 + j];
#pragma unroll
            for (int i = 0; i < 4; ++i)
#pragma unroll
                for (int j = 0; j < 4; ++j) acc[i][j] += a[i] * b[j];
        }
        __syncthreads();
    }
#pragma unroll
    for (int i = 0; i < 4; ++i)
#pragma unroll
        for (int j = 0; j < 4; ++j) {
            const int r = row0 + ty * 4 + i, c = col0 + tx * 4 + j;
            if (r < M && c < N) ep(r, c, acc[i][j]);
        }
}

struct ALbf { const bf16_t* p; int ld; int pad; __device__ float operator()(int r, int k) const { return bf2f(p[(size_t)r * ld + k]); } };
struct ALf32 { const float* p; int ld; int pad; __device__ float operator()(int r, int k) const { return p[(size_t)r * ld + k]; } };
struct BLwin { const float* w; __device__ float operator()(int k, int n) const { return w[(size_t)k * NIN + zcol2orig(n)]; } };
struct BLplain { const float* w; int ld; int pad; __device__ float operator()(int k, int n) const { return w[(size_t)k * ld + n]; } };
struct EPz { bf16_t* z; __device__ void operator()(int r, int c, float v) const { z[(size_t)r * NZ + c] = f2bf(v); } };
struct EPf32 { float* o; int ld; int pad; __device__ void operator()(int r, int c, float v) const { o[(size_t)r * ld + c] = v; } };
struct EPmerge { const float* ya; const bf16_t* z; bf16_t* m;
    __device__ void operator()(int r, int c, float yb) const {
        const float ga = bf2f(z[(size_t)r * NZ + 2560 + c]), gb = bf2f(z[(size_t)r * NZ + 3584 + c]);
        m[(size_t)r * D + c] = f2bf(sigmoidf_(ga) * ya[(size_t)r * D + c] + sigmoidf_(gb) * yb); } };
struct EPres { const float* x; float* x1; __device__ void operator()(int r, int c, float v) const { x1[(size_t)r * D + c] = x[(size_t)r * D + c] + v; } };

__global__ void __launch_bounds__(256) k_conv(const bf16_t* __restrict__ z, const float* __restrict__ cq, const float* __restrict__ ck, bf16_t* __restrict__ qa, bf16_t* __restrict__ ka) {
    const size_t idx = (size_t)blockIdx.x * 256 + threadIdx.x;
    const int t = (int)(idx >> 9), c = (int)(idx & 511), s = t % SEQ;
    float aq = 0.f, ak = 0.f;
#pragma unroll
    for (int j = 0; j < 4; ++j) {
        const int ss = s - 3 + j;
        if (ss >= 0) {
            const size_t r = (size_t)(t - 3 + j) * NZ;
            aq += bf2f(z[r + 512 + c]) * cq[j * DM + c];
            ak += bf2f(z[r + 1024 + c]) * ck[j * DM + c];
        }
    }
    qa[idx] = f2bf(siluf_(aq));
    ka[idx] = f2bf(siluf_(ak) * 0.08838834764831845f);
}
__global__ void k_bcum(const float* __restrict__ gif, float* __restrict__ bcs) {
    const int bh = blockIdx.x * blockDim.x + threadIdx.x;
    if (bh >= BATCH * NH) return;
    const int b = bh / NH, hh = bh % NH;
    float acc = 0.f;
    for (int s = 0; s < SEQ; ++s) { acc += logsigmoidf_(gif[((size_t)b * SEQ + s) * 8 + 4 + hh]); bcs[(size_t)bh * SEQ + s] = acc; }
}
__global__ void __launch_bounds__(256) k_mlstm_naive(const bf16_t* __restrict__ qa, const bf16_t* __restrict__ ka, const bf16_t* __restrict__ z, const float* __restrict__ gif,
                                                      const float* __restrict__ bcs, const float* __restrict__ g_head, bf16_t* __restrict__ hm) {
    __shared__ float ks[32][129];
    __shared__ float vs[32][129];
    __shared__ float ws_[32];
    const int bh = blockIdx.x >> 5, qb = blockIdx.x & 31, b = bh / NH, hh = bh % NH;
    const int tid = threadIdx.x, tq = tid >> 2, part = tid & 3;
    const int t = qb * 64 + tq;
    const size_t rowq = (size_t)b * SEQ + t;
    float q[32];
#pragma unroll
    for (int j = 0; j < 32; ++j) q[j] = bf2f(qa[rowq * DM + hh * HD + part * 32 + j]);
    const float bt = bcs[(size_t)bh * SEQ + t];
    float num[32];
#pragma unroll
    for (int j = 0; j < 32; ++j) num[j] = 0.f;
    float nq = 0.f;
    for (int kb = 0; kb <= qb * 2 + 1; ++kb) {
        __syncthreads();
        for (int i = tid; i < 32 * 128; i += 256) {
            const int r = i >> 7, c = i & 127; const size_t row = (size_t)b * SEQ + kb * 32 + r;
            ks[r][c] = bf2f(ka[row * DM + hh * HD + c]);
            vs[r][c] = bf2f(z[row * NZ + 1536 + hh * HD + c]);
        }
        if (tid < 32) { const size_t row = (size_t)b * SEQ + kb * 32 + tid; ws_[tid] = gif[row * 8 + hh] - bcs[(size_t)bh * SEQ + kb * 32 + tid]; }
        __syncthreads();
        for (int s = 0; s < 32; ++s) {
            if (kb * 32 + s > t) break;
            float d = 0.f;
#pragma unroll
            for (int j = 0; j < 32; ++j) d += q[j] * ks[s][part * 32 + j];
            d += __shfl_xor(d, 1); d += __shfl_xor(d, 2);
            const float w = d * __expf(bt + ws_[s]);
            nq += w;
#pragma unroll
            for (int j = 0; j < 32; ++j) num[j] += w * vs[s][part * 32 + j];
        }
    }
    const float den = fmaxf(fabsf(nq), 1.f);
    float s1 = 0.f;
#pragma unroll
    for (int j = 0; j < 32; ++j) { num[j] /= den; s1 += num[j]; }
    s1 += __shfl_xor(s1, 1); s1 += __shfl_xor(s1, 2);
    const float mu = s1 * (1.f / HD);
    float s2 = 0.f;
#pragma unroll
    for (int j = 0; j < 32; ++j) { const float dd = num[j] - mu; s2 += dd * dd; }
    s2 += __shfl_xor(s2, 1); s2 += __shfl_xor(s2, 2);
    const float rstd = rsqrtf(s2 * (1.f / HD) + EPS);
#pragma unroll
    for (int j = 0; j < 32; ++j) {
        const int c = hh * HD + part * 32 + j;
        const float o = bf2f(z[rowq * NZ + 2048 + c]);
        hm[rowq * DM + c] = f2bf((num[j] - mu) * rstd * g_head[c] * sigmoidf_(o));
    }
}
__global__ void __launch_bounds__(256) k_pool(const bf16_t* __restrict__ z, bf16_t* __restrict__ dA) {
    const size_t idx = (size_t)blockIdx.x * 256 + threadIdx.x;
    const int t = (int)(idx >> 9), c = (int)(idx & 511), s = t % SEQ, g = c >> 7;
    const int w = 2 << g;
    const int start = max(s + 1 - w, 0), cnt = s + 1 - start;
    float acc = 0.f;
    for (int j = 0; j < cnt; ++j) acc += bf2f(z[(size_t)(t - j) * NZ + c]);
    dA[idx] = f2bf(acc / (float)cnt - bf2f(z[(size_t)t * NZ + c]));
}
__global__ void __launch_bounds__(256) k_poolmm(const bf16_t* __restrict__ dA, const float* __restrict__ w_pool, const float* __restrict__ scale, float* __restrict__ yp) {
    const size_t idx = (size_t)blockIdx.x * 256 + threadIdx.x;
    const int t = (int)(idx >> 9), j = (int)(idx & 511), g = j >> 7, jj = j & 127;
    float acc = 0.f;
    for (int c = 0; c < 128; ++c) acc += bf2f(dA[(size_t)t * DP + g * 128 + c]) * w_pool[((size_t)g * 128 + c) * 128 + jj];
    yp[idx] = acc * scale[j];
}

__global__ void __launch_bounds__(256) k_route(const float* __restrict__ x1, const float* __restrict__ g_ffn, const float* __restrict__ w_rg, const float* __restrict__ b_rg,
                                                const float* __restrict__ w_re, const float* __restrict__ b_re, float* __restrict__ rstd2, int* __restrict__ sel, float* __restrict__ gw,
                                                int* __restrict__ counts, int* __restrict__ lists) {
    const int wave = threadIdx.x >> 6, lane = threadIdx.x & 63;
    const int tok = blockIdx.x * 4 + wave;
    const float* xr = x1 + (size_t)tok * D;
    float v[16]; float s = 0.f;
#pragma unroll
    for (int j = 0; j < 16; ++j) { v[j] = xr[lane + 64 * j]; s += v[j] * v[j]; }
    s = wave_sum(s);
    const float rstd = rsqrtf(s * (1.f / D) + EPS);
    float lg[4] = {0.f, 0.f, 0.f, 0.f};
#pragma unroll
    for (int j = 0; j < 16; ++j) { const int k = lane + 64 * j; v[j] = v[j] * rstd * g_ffn[k];
#pragma unroll
        for (int o = 0; o < 4; ++o) lg[o] += v[j] * w_rg[k * NG + o]; }
#pragma unroll
    for (int o = 0; o < 4; ++o) lg[o] = wave_sum(lg[o]) + b_rg[o];
    int gs = 0; float gm = lg[0];
#pragma unroll
    for (int o = 1; o < 4; ++o) if (lg[o] > gm) { gm = lg[o]; gs = o; }
    float den = 0.f;
#pragma unroll
    for (int o = 0; o < 4; ++o) den += __expf(lg[o] - gm);
    const float pg = 1.f / den;
    float le[8];
#pragma unroll
    for (int o = 0; o < 8; ++o) le[o] = 0.f;
#pragma unroll
    for (int j = 0; j < 16; ++j) { const int k = lane + 64 * j;
#pragma unroll
        for (int o = 0; o < 8; ++o) le[o] += v[j] * w_re[k * NE + gs * EPG + o]; }
#pragma unroll
    for (int o = 0; o < 8; ++o) le[o] = wave_sum(le[o]) + b_re[gs * EPG + o];
    int i1 = 0; float m1 = le[0];
#pragma unroll
    for (int o = 1; o < 8; ++o) if (le[o] > m1) { m1 = le[o]; i1 = o; }
    int i2 = -1; float m2 = -3.0e38f;
#pragma unroll
    for (int o = 0; o < 8; ++o) if (o != i1 && le[o] > m2) { m2 = le[o]; i2 = o; }
    const float e2 = __expf(m2 - m1);
    const float p1 = 1.f / (1.f + e2), p2 = e2 / (1.f + e2);
    if (lane == 0) {
        rstd2[tok] = rstd;
        const int ea = gs * EPG + i1, eb = gs * EPG + i2;
        sel[tok * 2] = ea; sel[tok * 2 + 1] = eb;
        gw[tok * 2] = pg * p1; gw[tok * 2 + 1] = pg * p2;
        const int pa = atomicAdd(&counts[ea], 1); lists[ea * T + pa] = tok * 2;
        const int pb = atomicAdd(&counts[eb], 1); lists[eb * T + pb] = tok * 2 + 1;
    }
}
__global__ void __launch_bounds__(256) k_moe_up(const float* __restrict__ x1, const float* __restrict__ rstd2, const float* __restrict__ g_ffn, const float* __restrict__ wg, const float* __restrict__ wu,
                                                 const int* __restrict__ counts, const int* __restrict__ lists, float* __restrict__ hid) {
    const int e = blockIdx.z, rt = blockIdx.y, ct = blockIdx.x;
    const int cnt = counts[e];
    if (rt * 64 >= cnt) return;
    __shared__ float As[16][68]; __shared__ float Bg[16][68]; __shared__ float Bu[16][68];
    __shared__ int toks[64]; __shared__ float rs[64];
    const int tid = threadIdx.x, tx = tid & 15, ty = tid >> 4;
    if (tid < 64) { const int r = rt * 64 + tid; const int a = (r < cnt) ? lists[e * T + r] : -1; toks[tid] = a; rs[tid] = (a >= 0) ? rstd2[a >> 1] : 0.f; }
    __syncthreads();
    float ag[4][4], au[4][4];
#pragma unroll
    for (int i = 0; i < 4; ++i)
#pragma unroll
        for (int j = 0; j < 4; ++j) { ag[i][j] = 0.f; au[i][j] = 0.f; }
    const float* wge = wg + (size_t)e * D * DE; const float* wue = wu + (size_t)e * D * DE;
    for (int k0 = 0; k0 < D; k0 += 16) {
#pragma unroll
        for (int j = 0; j < 4; ++j) {
            const int idx = tid + j * 256; const int r = idx >> 4, kk = idx & 15;
            const int a = toks[r];
            As[kk][r] = (a >= 0) ? x1[(size_t)(a >> 1) * D + k0 + kk] * rs[r] * g_ffn[k0 + kk] : 0.f;
            const int k2 = idx >> 6, n = idx & 63;
            Bg[k2][n] = wge[(size_t)(k0 + k2) * DE + ct * 64 + n];
            Bu[k2][n] = wue[(size_t)(k0 + k2) * DE + ct * 64 + n];
        }
        __syncthreads();
#pragma unroll
        for (int kk = 0; kk < 16; ++kk) {
            float a[4], bg[4], bu[4];
#pragma unroll
            for (int i = 0; i < 4; ++i) a[i] = As[kk][ty * 4 + i];
#pragma unroll
            for (int j = 0; j < 4; ++j) { bg[j] = Bg[kk][tx * 4 + j]; bu[j] = Bu[kk][tx * 4 + j]; }
#pragma unroll
            for (int i = 0; i < 4; ++i)
#pragma unroll
                for (int j = 0; j < 4; ++j) { ag[i][j] += a[i] * bg[j]; au[i][j] += a[i] * bu[j]; }
        }
        __syncthreads();
    }
#pragma unroll
    for (int i = 0; i < 4; ++i) { const int a = toks[ty * 4 + i]; if (a < 0) continue;
#pragma unroll
        for (int j = 0; j < 4; ++j) hid[(size_t)a * DE + ct * 64 + tx * 4 + j] = siluf_(ag[i][j]) * au[i][j]; }
}
__global__ void __launch_bounds__(256) k_moe_down(const float* __restrict__ hid, const float* __restrict__ wd, const float* __restrict__ gw, const int* __restrict__ counts, const int* __restrict__ lists, bf16_t* __restrict__ yb) {
    const int e = blockIdx.z, rt = blockIdx.y, ct = blockIdx.x;
    const int cnt = counts[e];
    if (rt * 64 >= cnt) return;
    __shared__ float As[16][68]; __shared__ float Bs[16][68];
    __shared__ int toks[64];
    const int tid = threadIdx.x, tx = tid & 15, ty = tid >> 4;
    if (tid < 64) { const int r = rt * 64 + tid; toks[tid] = (r < cnt) ? lists[e * T + r] : -1; }
    __syncthreads();
    float acc[4][4];
#pragma unroll
    for (int i = 0; i < 4; ++i)
#pragma unroll
        for (int j = 0; j < 4; ++j) acc[i][j] = 0.f;
    const float* wde = wd + (size_t)e * DE * D;
    for (int k0 = 0; k0 < DE; k0 += 16) {
#pragma unroll
        for (int j = 0; j < 4; ++j) {
            const int idx = tid + j * 256; const int r = idx >> 4, kk = idx & 15;
            const int a = toks[r];
            As[kk][r] = (a >= 0) ? hid[(size_t)a * DE + k0 + kk] : 0.f;
            const int k2 = idx >> 6, n = idx & 63;
            Bs[k2][n] = wde[(size_t)(k0 + k2) * D + ct * 64 + n];
        }
        __syncthreads();
#pragma unroll
        for (int kk = 0; kk < 16; ++kk) {
            float a[4], b[4];
#pragma unroll
            for (int i = 0; i < 4; ++i) a[i] = As[kk][ty * 4 + i];
#pragma unroll
            for (int j = 0; j < 4; ++j) b[j] = Bs[kk][tx * 4 + j];
#pragma unroll
            for (int i = 0; i < 4; ++i)
#pragma unroll
                for (int j = 0; j < 4; ++j) acc[i][j] += a[i] * b[j];
        }
        __syncthreads();
    }
#pragma unroll
    for (int i = 0; i < 4; ++i) { const int a = toks[ty * 4 + i]; if (a < 0) continue; const float w = gw[a];
#pragma unroll
        for (int j = 0; j < 4; ++j) yb[(size_t)a * D + ct * 64 + tx * 4 + j] = f2bf(acc[i][j] * w); }
}
__global__ void __launch_bounds__(256) k_final(const float* __restrict__ x1, const bf16_t* __restrict__ yb, const float* __restrict__ g, float* __restrict__ out) {
    const int wave = threadIdx.x >> 6, lane = threadIdx.x & 63;
    const int tok = blockIdx.x * 4 + wave;
    float v[16]; float s = 0.f;
#pragma unroll
    for (int j = 0; j < 16; ++j) { const int k = lane + 64 * j;
        v[j] = x1[(size_t)tok * D + k] + bf2f(yb[(size_t)(tok * 2) * D + k]) + bf2f(yb[(size_t)(tok * 2 + 1) * D + k]); s += v[j] * v[j]; }
    s = wave_sum(s);
    const float rstd = rsqrtf(s * (1.f / D) + EPS);
#pragma unroll
    for (int j = 0; j < 16; ++j) { const int k = lane + 64 * j; out[(size_t)tok * D + k] = v[j] * rstd * g[k]; }
}

#define GAS __attribute__((address_space(1)))
#define LAS __attribute__((address_space(3)))
typedef short bf16x8 __attribute__((ext_vector_type(8)));
typedef float f32x4 __attribute__((ext_vector_type(4)));
typedef float f32x2 __attribute__((ext_vector_type(2)));
typedef unsigned u32x4 __attribute__((ext_vector_type(4)));
typedef unsigned u32x2 __attribute__((ext_vector_type(2)));
#define LDS_WAIT() asm volatile("s_waitcnt lgkmcnt(0)" ::: "memory")
#define VM_WAIT() asm volatile("s_waitcnt vmcnt(0)" ::: "memory")
__device__ __forceinline__ unsigned pk2(float lo, float hi) { return (unsigned)f2bf(lo) | ((unsigned)f2bf(hi) << 16); }
__device__ __forceinline__ unsigned cvt_pk_bf16(float lo, float hi) { unsigned r; asm volatile("v_cvt_pk_bf16_f32 %0, %1, %2" : "=v"(r) : "v"(lo), "v"(hi)); return r; }
__device__ __forceinline__ float bflo(unsigned w) { return __builtin_bit_cast(float, w << 16); }
__device__ __forceinline__ float bfhi(unsigned w) { return __builtin_bit_cast(float, w & 0xffff0000u); }
__device__ __forceinline__ float fast_exp(float x) { return __builtin_amdgcn_exp2f(x * 1.4426950408889634f); }
__device__ __forceinline__ float fast_rcp(float x) { return __builtin_amdgcn_rcpf(x); }
__device__ __forceinline__ float fsigmoid(float x) { return fast_rcp(1.f + fast_exp(-x)); }

#define XB_TMO      128
#define XB_XCNT(j)  (256  + 64 * (j))
#define XB_XSUB(j)  (1280 + 64 * (j))
#define XB_XGEN(j)  (2304 + 64 * (j))
#define XB_TOP      3328
#define XB_TOPGEN   3392
#define XCD_BAR_WORDS 3456
#define XB_SPIN_CAP (1u << 18)
__device__ __forceinline__ unsigned xb_ld(unsigned* p)              { return __hip_atomic_load(p, __ATOMIC_RELAXED, __HIP_MEMORY_SCOPE_AGENT); }
__device__ __forceinline__ unsigned xb_add(unsigned* p, unsigned v) { return __hip_atomic_fetch_add(p, v, __ATOMIC_RELAXED, __HIP_MEMORY_SCOPE_AGENT); }
__device__ __forceinline__ unsigned xb_xcc_id() { return (unsigned)__builtin_amdgcn_s_getreg((3 << 11) | 20) & 0xFu; }
#define XB_SPIN(cond, bar) do { unsigned _sp = 0; while (cond) { __builtin_amdgcn_s_sleep(1); \
    if ((++_sp & 255u) == 0u) { if (xb_ld(&(bar)[XB_TMO])) break; if (_sp > XB_SPIN_CAP) { atomicAdd(&(bar)[XB_TMO], 1u); break; } } } } while (0)
struct XcdBarrier { unsigned* bar; unsigned x; volatile LAS unsigned* st; };
__device__ __forceinline__ XcdBarrier xcd_barrier_post(unsigned* bar, volatile LAS unsigned* st) {
    XcdBarrier b; b.bar = bar; b.x = xb_xcc_id(); b.st = st;
    if (threadIdx.x == 0) (void)xb_add(&bar[XB_XCNT(b.x)], 1u);
    return b;
}
__device__ __forceinline__ void xcd_barrier_complete(unsigned* bar, unsigned x, unsigned& nloc, unsigned& nx) {
    const unsigned G = gridDim.x * gridDim.y * gridDim.z;
    unsigned sum, cnt, mine, sp = 0u;
    for (;;) {
        sum = 0u; cnt = 0u; mine = 0u;
#pragma unroll
        for (unsigned j = 0; j < 16; ++j) { const unsigned c = xb_ld(&bar[XB_XCNT(j)]); sum += c; cnt += (c > 0u) ? 1u : 0u; mine = (j == x) ? c : mine; }
        if (sum == G) break;
        __builtin_amdgcn_s_sleep(1);
        if ((++sp & 255u) == 0u) { if (xb_ld(&bar[XB_TMO])) break; if (sp > XB_SPIN_CAP) { atomicAdd(&bar[XB_TMO], 1u); break; } }
    }
    nloc = mine > 0u ? mine : 1u; nx = cnt > 0u ? cnt : 1u;
}
__device__ __forceinline__ void xcd_barrier(const XcdBarrier& b) {
    asm volatile("s_waitcnt vmcnt(0)" ::: "memory");
    __syncthreads();
    if (threadIdx.x == 0) {
        unsigned* bar = b.bar;
        __builtin_amdgcn_s_waitcnt(0);
        unsigned nloc = b.st[0], nx = b.st[1];
        if (nloc == 0u) { xcd_barrier_complete(bar, b.x, nloc, nx); b.st[0] = nloc; b.st[1] = nx; }
        const unsigned old = xb_add(&bar[XB_XSUB(b.x)], 1u);
        const unsigned gen = old / nloc;
        if (old + 1u == (gen + 1u) * nloc) {
            __builtin_amdgcn_fence(__ATOMIC_RELEASE, "agent");
            asm volatile("s_waitcnt vmcnt(0)" ::: "memory");
            const unsigned og = xb_add(&bar[XB_TOP], 1u);
            const unsigned tg = og / nx;
            if (og + 1u == (tg + 1u) * nx) xb_add(&bar[XB_TOPGEN], 1u);
            else XB_SPIN(xb_ld(&bar[XB_TOPGEN]) == tg, bar);
            __builtin_amdgcn_fence(__ATOMIC_ACQUIRE, "agent");
            xb_add(&bar[XB_XGEN(b.x)], 1u);
            asm volatile("s_waitcnt vmcnt(0)" ::: "memory");
        } else {
            XB_SPIN(xb_ld(&bar[XB_XGEN(b.x)]) == gen, bar);
            __builtin_amdgcn_fence(__ATOMIC_ACQUIRE, "agent");
            asm volatile("s_waitcnt vmcnt(0)" ::: "memory");
        }
    }
    __syncthreads();
}

namespace pg8 {
constexpr int BM = 256, BK = 64, HALF = 128, HTB = HALF * BK * 2, STAGE_BYTES = 8 * HTB, NXCD = 8, WGM = 8;
__host__ __device__ __forceinline__ int lds_byte(int r, int c) { const int st = (r >> 4) * 2 + (c >> 5), rr = r & 15, cc = c & 31, ob = rr * 64 + cc * 2; return st * 1024 + (ob ^ (((ob >> 9) & 1) << 5)); }
__host__ __device__ __forceinline__ void stage_rc(int b, int& R, int& C) { const int st = b / 1024, sb = b % 1024, swz = sb ^ (((sb >> 9) & 1) << 5); R = (st >> 1) * 16 + swz / 64; C = (st & 1) * 32 + (swz % 64) / 2; }
__host__ __device__ __forceinline__ int perm32(int rho) { const int n = rho >> 4, i = rho & 15; return 8 * (i >> 2) + 4 * n + (i & 3); }

struct Unit { const char* A; const char* B; const int* rows; int pm, pn, ex, cnt; };
struct Cfg { int K; unsigned lda, ldb; };
__device__ __forceinline__ void tile_of(int L, int nM, int nN, int& pm, int& pn) {
    const int nwg = nM * nN; int wgid = L; { const int q = nwg / NXCD, r = nwg % NXCD, xcd = wgid % NXCD, off = wgid / NXCD; wgid = (xcd < r ? xcd * (q + 1) : r * (q + 1) + (xcd - r) * q) + off; }
    const int nig = WGM * nN, gid = wgid / nig, fm = gid * WGM, gsz = (nM - fm) < WGM ? (nM - fm) : WGM;
    pm = fm + ((wgid % nig) % gsz); pn = (wgid % nig) / gsz;
}

template <class Epi, class Sched, bool GATHER>
__device__ __forceinline__ void gemm_phase(LAS unsigned char* lds, const Cfg g, const Sched& S, const Epi& E) {
    const int tid = threadIdx.x, wid = __builtin_amdgcn_readfirstlane(tid >> 6), lane = tid & 63, wr = wid >> 2, wc = wid & 3, fr = lane & 15, fq = lane >> 4;
    const int nt = g.K / BK;
    unsigned voffB[2], vA[2][2], vN[2][2]; int Rr[2]; unsigned Cb[2];
#pragma unroll
    for (int i = 0; i < 2; ++i) { int R, C; stage_rc(tid * 16 + i * 8192, R, C); const int Rb = Epi::PERM ? ((R & ~31) + perm32(R & 31)) : R;
        Rr[i] = R; Cb[i] = (unsigned)C * 2u; voffB[i] = (unsigned)Rb * g.ldb + (unsigned)C * 2u;
        vA[0][i] = (unsigned)R * g.lda + (unsigned)C * 2u; vA[1][i] = (unsigned)(R + HALF) * g.lda + (unsigned)C * 2u; vN[0][i] = vA[0][i]; vN[1][i] = vA[1][i]; }
    const size_t kstep = (size_t)(BK * 2);
    const size_t hstepB = (size_t)HALF * g.ldb;
    const unsigned ldsw = (unsigned)wid * 1024u;
    const int aoff = lds_byte(wr * 64 + fr, fq * 8), boff = lds_byte(wc * 32 + fr, fq * 8);
#define PG8_SA(b, h) (((b) * 2 + (h)) * HTB)
#define PG8_SB(b, h) ((4 + (b) * 2 + (h)) * HTB)
#define PG8_STAGE(bufoff, gbase, voff) do { _Pragma("unroll") for (int _i = 0; _i < 2; ++_i) \
        __builtin_amdgcn_global_load_lds((const unsigned*)((const char*)(gbase) + (voff)[_i]), (LAS unsigned*)(lds + (bufoff) + ldsw + _i * 8192), 16, 0, 0); } while (0)
#define PG8_STAGE_AX(bufoff, gbase, h, usenext) do { unsigned _vo[2]; _vo[0] = (usenext) ? vN[h][0] : vA[h][0]; _vo[1] = (usenext) ? vN[h][1] : vA[h][1]; PG8_STAGE(bufoff, gbase, _vo); } while (0)
#define PG8_LDA(dst, b, h) do { _Pragma("unroll") for (int m = 0; m < 4; ++m) _Pragma("unroll") for (int k = 0; k < 2; ++k) dst[m][k] = *(const LAS bf16x8*)(lds + PG8_SA(b, h) + aoff + m * 2048 + k * 1024); } while (0)
#define PG8_LDB(dst, b, h) do { _Pragma("unroll") for (int n = 0; n < 2; ++n) _Pragma("unroll") for (int k = 0; k < 2; ++k) dst[n][k] = *(const LAS bf16x8*)(lds + PG8_SB(b, h) + boff + n * 2048 + k * 1024); } while (0)
#define PG8_MMA(ai, bj, At, Bt) do { __builtin_amdgcn_s_setprio(1); _Pragma("unroll") for (int m = 0; m < 4; ++m) _Pragma("unroll") for (int n = 0; n < 2; ++n) _Pragma("unroll") for (int k = 0; k < 2; ++k) \
        acc[ai][bj][m][n] = __builtin_amdgcn_mfma_f32_16x16x32_bf16(Bt[n][k], At[m][k], acc[ai][bj][m][n], 0, 0, 0); __builtin_amdgcn_s_setprio(0); } while (0)
#define PG8_WAIT_V(n) asm volatile("s_waitcnt vmcnt(" #n ")" ::: "memory")
#define PG8_WAIT_L(n) asm volatile("s_waitcnt lgkmcnt(" #n ")" ::: "memory")
#define PG8_BAR __builtin_amdgcn_s_barrier()
#define PG8_SCHED __builtin_amdgcn_sched_barrier(0)
#define PG8_GATHER_LOAD(dst, u) do { _Pragma("unroll") for (int _h = 0; _h < 2; ++_h) _Pragma("unroll") for (int _i = 0; _i < 2; ++_i) { const int _r = _h * HALF + Rr[_i]; \
        const int _a = (_r < (u).cnt) ? ((u).rows[_r] >> 1) : 0; dst[_h][_i] = (unsigned)_a * g.lda + Cb[_i]; } } while (0)
    Unit cur, nxt; int ui = 0;
    if (!S.next(0, cur)) return;
    f32x4 acc[2][2][4][2];
#pragma unroll
    for (int a = 0; a < 2; ++a)
#pragma unroll
        for (int b = 0; b < 2; ++b)
#pragma unroll
            for (int m = 0; m < 4; ++m)
#pragma unroll
                for (int n = 0; n < 2; ++n) acc[a][b][m][n] = (f32x4){0.f, 0.f, 0.f, 0.f};
    bf16x8 At[4][2], B0[2][2], B1[2][2];
    const char* cA = cur.A; const char* cB = cur.B;
    if constexpr (GATHER) { PG8_GATHER_LOAD(vA, cur); __builtin_amdgcn_s_waitcnt(0x0F70); }
    PG8_STAGE(PG8_SB(0, 0), cB, voffB); PG8_STAGE(PG8_SB(0, 1), cB + hstepB, voffB); PG8_STAGE(PG8_SA(0, 0), cA, vA[0]); PG8_STAGE(PG8_SA(0, 1), cA, vA[1]);
    if (wr == 1) PG8_BAR;
    PG8_WAIT_V(2); PG8_BAR;
    PG8_STAGE(PG8_SB(1, 0), cB + kstep, voffB); PG8_STAGE(PG8_SA(1, 0), cA + kstep, vA[0]); PG8_STAGE(PG8_SB(1, 1), cB + hstepB + kstep, voffB);
    PG8_WAIT_V(6); PG8_BAR;
    for (;;) {
        const bool has_next = S.next(ui + 1, nxt);
        const char* nA = has_next ? nxt.A : cA; const char* nB = has_next ? nxt.B : cB;
        if constexpr (GATHER) {
            if (has_next) { PG8_GATHER_LOAD(vN, nxt); __builtin_amdgcn_s_waitcnt(0x0F70); }
            else {
#pragma unroll
                for (int h = 0; h < 2; ++h)
#pragma unroll
                    for (int i = 0; i < 2; ++i) vN[h][i] = vA[h][i]; }
        }
        for (int t = 0; t < nt; t += 2) {
            const bool last = (t == nt - 2);
            const char* a1 = cA + (size_t)(t + 1) * kstep;
            const char* a2 = last ? nA : cA + (size_t)(t + 2) * kstep; const char* b2 = last ? nB : cB + (size_t)(t + 2) * kstep;
            const char* a3 = a2 + kstep; const char* b3 = b2 + kstep;
            const bool un = GATHER && last;
            PG8_LDB(B0, 0, 0); PG8_LDB(B1, 0, 1); PG8_SCHED; PG8_LDA(At, 0, 0); PG8_STAGE(PG8_SA(1, 1), a1, vA[1]);
            PG8_WAIT_V(8); PG8_WAIT_L(0); PG8_BAR; PG8_MMA(0, 0, At, B0); PG8_MMA(0, 1, At, B1); PG8_BAR; PG8_SCHED;
            PG8_LDA(At, 0, 1); PG8_STAGE(PG8_SB(0, 0), b2, voffB); PG8_STAGE(PG8_SB(0, 1), b2 + hstepB, voffB); PG8_STAGE_AX(PG8_SA(0, 0), a2, 0, un);
            PG8_WAIT_V(8); PG8_WAIT_L(0); PG8_BAR; PG8_MMA(1, 0, At, B0); PG8_MMA(1, 1, At, B1); PG8_BAR; PG8_SCHED;
            PG8_LDB(B0, 1, 0); PG8_LDB(B1, 1, 1); PG8_SCHED; PG8_LDA(At, 1, 0); PG8_STAGE_AX(PG8_SA(0, 1), a2, 1, un);
            PG8_WAIT_V(8); PG8_WAIT_L(0); PG8_BAR; PG8_MMA(0, 0, At, B0); PG8_MMA(0, 1, At, B1); PG8_BAR; PG8_SCHED;
            PG8_LDA(At, 1, 1); PG8_STAGE(PG8_SB(1, 0), b3, voffB); PG8_STAGE(PG8_SB(1, 1), b3 + hstepB, voffB); PG8_STAGE_AX(PG8_SA(1, 0), a3, 0, un);
            PG8_WAIT_V(8); PG8_WAIT_L(0); PG8_BAR; PG8_MMA(1, 0, At, B0); PG8_MMA(1, 1, At, B1); PG8_BAR; PG8_SCHED;
        }
        if (wr == 0) PG8_BAR;
        const bool keep = E(acc, cur, wr, wc, fr, fq);
        if (!has_next) break;
        if (!keep) {
#pragma unroll
        for (int a = 0; a < 2; ++a)
#pragma unroll
            for (int b = 0; b < 2; ++b)
#pragma unroll
                for (int m = 0; m < 4; ++m)
#pragma unroll
                    for (int n = 0; n < 2; ++n) acc[a][b][m][n] = (f32x4){0.f, 0.f, 0.f, 0.f};
        }
        cur = nxt; cA = nA; cB = nB; ++ui;
        if constexpr (GATHER) {
#pragma unroll
            for (int h = 0; h < 2; ++h)
#pragma unroll
                for (int i = 0; i < 2; ++i) vA[h][i] = vN[h][i]; }
        if (wr == 1) PG8_BAR;
    }
    PG8_WAIT_V(0);
    PG8_BAR;
#undef PG8_SA
#undef PG8_SB
#undef PG8_STAGE
#undef PG8_STAGE_AX
#undef PG8_LDA
#undef PG8_LDB
#undef PG8_MMA
#undef PG8_WAIT_V
#undef PG8_WAIT_L
#undef PG8_BAR
#undef PG8_SCHED
#undef PG8_GATHER_LOAD
}
}

#ifndef PROBE_PHASE
#define PROBE_PHASE -1
#endif
#define REP(k) _Pragma("nounroll") for (int _r = 0; _r < ((PROBE_PHASE == (k)) ? 2 : 1); ++_r)
constexpr int NWAVES = 8;
constexpr size_t WS_CTL = 0, CTL_ZERO_BYTES = 1 * MiB;
constexpr size_t WS_GIF = 1 * MiB;
constexpr size_t WS_NLOC = 1 * MiB + 512 * 1024;
constexpr size_t WS_SCAL = 2 * MiB;
constexpr size_t WS_GW = 2 * MiB + 256 * 1024;
constexpr size_t WS_ALIST = 4 * MiB;
constexpr size_t WS_RWLIST = 6 * MiB;
constexpr size_t WS_WR = 3 * MiB + 512 * 1024;
constexpr size_t WS_RSTD2 = 3 * MiB, WS_SEL = 3 * MiB + 256 * 1024;
constexpr size_t WS_WZ = 10 * MiB, WS_W2T = 19 * MiB, WS_WBT = 20 * MiB, WS_WOT = 21 * MiB, WS_WUP = 23 * MiB, WS_WDN = 87 * MiB;
constexpr size_t WS_Z = 119 * MiB;
constexpr size_t WS_KACT = 263 * MiB;
constexpr size_t WS_END = 279 * MiB;
constexpr size_t WS_X1 = WS_Z, WS_X1B = WS_Z + 64 * MiB, WS_HID = WS_Z + 96 * MiB;
constexpr size_t OB_H = 0, OB_C = 0, OB_DA = 32 * MiB, OB_HM = 48 * MiB, OB_MERGED = 0;
constexpr int CW_CNT = 64;
constexpr int CW_BAR = 4096;
constexpr int TAB_CNT = 16, TAB_CUM = 48, TAB_HIST = 96, TAB_BASE = 128;
constexpr int RING_OFF = 0, RING_BYTES = 131072, LDSCTL_OFF = RING_BYTES, MISC_OFF = LDSCTL_OFF + 320, LDS_BYTES = 147456;

struct Args { const float* in[21]; float* out; unsigned char* ws; int ph_lo, ph_hi, li, flags; };

struct SchedDense {
    const char* A; const char* B; size_t astep, bstep; int nM, nN, G, c, rep;
    __device__ __forceinline__ bool next(int i, pg8::Unit& u) const {
        long L = (long)i * G + c; if (L >= (long)nM * nN * rep) return false; L %= (long)nM * nN;
        int pm, pn; pg8::tile_of((int)L, nM, nN, pm, pn);
        u.pm = pm; u.pn = pn; u.ex = 0; u.cnt = 256; u.rows = nullptr; u.A = A + (size_t)pm * astep; u.B = B + (size_t)pn * bstep; return true; }
};
struct EpiZ {
    static constexpr bool PERM = true;
    bf16_t* z;
    __device__ __forceinline__ bool operator()(f32x4 (&acc)[2][2][4][2], const pg8::Unit& u, int wr, int wc, int fr, int fq) const {
        const int row0 = u.pm * 256 + wr * 64 + fr, col0 = u.pn * 256 + wc * 32 + 8 * fq;
#pragma unroll
        for (int ai = 0; ai < 2; ++ai)
#pragma unroll
            for (int m = 0; m < 4; ++m) { bf16_t* rowp = z + (size_t)(row0 + ai * 128 + m * 16) * NZ + col0;
#pragma unroll
                for (int bj = 0; bj < 2; ++bj) { const f32x4 v0 = acc[ai][bj][m][0], v1 = acc[ai][bj][m][1]; u32x4 w;
                    w.x = cvt_pk_bf16(v0[0], v0[1]); w.y = cvt_pk_bf16(v0[2], v0[3]); w.z = cvt_pk_bf16(v1[0], v1[1]); w.w = cvt_pk_bf16(v1[2], v1[3]);
                    *(u32x4*)(rowp + bj * 128) = w; } }
        return false;
    }
};

struct SchedMerge {
    const char* A0; const char* A1; const char* B0; const char* B1; int nM, nN, G, c;
    __device__ __forceinline__ bool next(int i, pg8::Unit& u) const {
        const long L = (long)(i >> 1) * G + c; if (L >= (long)nM * nN) return false;
        int pm, pn; pg8::tile_of((int)L, nM, nN, pm, pn); const int part = i & 1;
        u.pm = pm; u.pn = pn; u.ex = part; u.cnt = 256; u.rows = nullptr;
        u.A = (part ? A1 : A0) + (size_t)pm * 256 * DP * 2; u.B = (part ? B1 : B0) + (size_t)pn * 256 * DP * 2; return true; }
};
struct EpiMerge {
    static constexpr bool PERM = true;
    const bf16_t* z; bf16_t* mg;
    __device__ __forceinline__ bool operator()(f32x4 (&acc)[2][2][4][2], const pg8::Unit& u, int wr, int wc, int fr, int fq) const {
        const int row0 = u.pm * 256 + wr * 64 + fr, col0 = u.pn * 256 + wc * 32 + 8 * fq;
        if (u.ex == 0) {
#pragma unroll
            for (int ai = 0; ai < 2; ++ai)
#pragma unroll
                for (int m = 0; m < 4; ++m) { const bf16_t* zr = z + (size_t)(row0 + ai * 128 + m * 16) * NZ + col0;
#pragma unroll
                    for (int bj = 0; bj < 2; ++bj) { const u32x4 ga = *(const u32x4*)(zr + 2560 + bj * 128), gb = *(const u32x4*)(zr + 3584 + bj * 128);
                        float r[8];
#pragma unroll
                        for (int q = 0; q < 4; ++q) { const unsigned wa = ga[q], wb = gb[q];
                            r[2 * q] = (1.f + fast_exp(-bflo(wb))) * fast_rcp(1.f + fast_exp(-bflo(wa)));
                            r[2 * q + 1] = (1.f + fast_exp(-bfhi(wb))) * fast_rcp(1.f + fast_exp(-bfhi(wa))); }
#pragma unroll
                        for (int q = 0; q < 4; ++q) { acc[ai][bj][m][0][q] *= r[q]; acc[ai][bj][m][1][q] *= r[4 + q]; } } }
            return true;
        }
#pragma unroll
        for (int ai = 0; ai < 2; ++ai)
#pragma unroll
            for (int m = 0; m < 4; ++m) { const size_t row = (size_t)(row0 + ai * 128 + m * 16); const bf16_t* zr = z + row * NZ + col0; bf16_t* mr = mg + row * D + col0;
#pragma unroll
                for (int bj = 0; bj < 2; ++bj) { const u32x4 gb = *(const u32x4*)(zr + 3584 + bj * 128);
                    float sg[8];
#pragma unroll
                    for (int q = 0; q < 4; ++q) { sg[2 * q] = fsigmoid(bflo(gb[q])); sg[2 * q + 1] = fsigmoid(bfhi(gb[q])); }
                    const f32x4 v0 = acc[ai][bj][m][0], v1 = acc[ai][bj][m][1]; u32x4 w;
                    w.x = cvt_pk_bf16(v0[0] * sg[0], v0[1] * sg[1]); w.y = cvt_pk_bf16(v0[2] * sg[2], v0[3] * sg[3]);
                    w.z = cvt_pk_bf16(v1[0] * sg[4], v1[1] * sg[5]); w.w = cvt_pk_bf16(v1[2] * sg[6], v1[3] * sg[7]);
                    *(u32x4*)(mr + bj * 128) = w; } }
        return false;
    }
};
struct EpiX1 {
    static constexpr bool PERM = true;
    const float* x; bf16_t* x1b;
    __device__ __forceinline__ bool operator()(f32x4 (&acc)[2][2][4][2], const pg8::Unit& u, int wr, int wc, int fr, int fq) const {
        const int row0 = u.pm * 256 + wr * 64 + fr, col0 = u.pn * 256 + wc * 32 + 8 * fq;
#pragma unroll
        for (int ai = 0; ai < 2; ++ai)
#pragma unroll
            for (int m = 0; m < 4; ++m) { const size_t off = (size_t)(row0 + ai * 128 + m * 16) * D + col0;
#pragma unroll
                for (int bj = 0; bj < 2; ++bj) { const f32x4 x0 = *(const f32x4*)(x + off + bj * 128), x1v = *(const f32x4*)(x + off + bj * 128 + 4);
                    const f32x4 v0 = acc[ai][bj][m][0] + x0, v1 = acc[ai][bj][m][1] + x1v; u32x4 w;
                    w.x = cvt_pk_bf16(v0[0], v0[1]); w.y = cvt_pk_bf16(v0[2], v0[3]); w.z = cvt_pk_bf16(v1[0], v1[1]); w.w = cvt_pk_bf16(v1[2], v1[3]);
                    *(u32x4*)(x1b + off + bj * 128) = w; } }
        return false;
    }
};

struct SchedMoE {
    volatile LAS unsigned* M; const char* A; const char* Bw; const int* alist; size_t bstepE, bstepN, astepBlk; int G, c, gather, rep;
    __device__ __forceinline__ bool next(int i, pg8::Unit& u) const {
        int L = i * G + c; const int tot = (int)M[TAB_CUM + 32];
        if (L >= 4 * tot * rep) return false; L %= 4 * tot;
        int e = 0;
        while (e < 31 && L >= 4 * (int)M[TAB_CUM + e + 1]) ++e;
        const int cb = (int)M[TAB_CUM + e], nb = (int)M[TAB_CUM + e + 1] - cb, r = L - 4 * cb;
        int pn = r / nb, rb = r - pn * nb; int cnt = (int)M[TAB_CNT + e] - rb * 256; cnt = cnt > 256 ? 256 : cnt;
        e = __builtin_amdgcn_readfirstlane(e); pn = __builtin_amdgcn_readfirstlane(pn); rb = __builtin_amdgcn_readfirstlane(rb); cnt = __builtin_amdgcn_readfirstlane(cnt);
        const int blk = __builtin_amdgcn_readfirstlane(cb) + rb;
        u.pm = blk; u.pn = pn; u.ex = e; u.cnt = cnt; u.rows = alist + (size_t)e * T + rb * 256;
        u.A = gather ? A : A + (size_t)blk * astepBlk; u.B = Bw + (size_t)e * bstepE + (size_t)pn * bstepN; return true; }
};
struct EpiUp {
    static constexpr bool PERM = true;
    const int* alist; const f32x2* rwlist; bf16_t* hid;
    __device__ __forceinline__ bool operator()(f32x4 (&acc)[2][2][4][2], const pg8::Unit& u, int wr, int wc, int fr, int fq) const {
        const f32x2* rw = rwlist + (u.rows - alist);
        const int col0 = u.pn * 128 + wc * 32 + 8 * fq;
#pragma unroll
        for (int ai = 0; ai < 2; ++ai)
#pragma unroll
            for (int m = 0; m < 4; ++m) { const int r = ai * 128 + wr * 64 + m * 16 + fr; const float rs = (r < u.cnt) ? rw[r].x : 0.f;
                const f32x4 g0 = acc[ai][0][m][0] * rs, g1 = acc[ai][0][m][1] * rs, u0 = acc[ai][1][m][0] * rs, u1 = acc[ai][1][m][1] * rs;
                float o[8];
#pragma unroll
                for (int q = 0; q < 4; ++q) { o[q] = g0[q] * fsigmoid(g0[q]) * u0[q]; o[4 + q] = g1[q] * fsigmoid(g1[q]) * u1[q]; }
                u32x4 w; w.x = cvt_pk_bf16(o[0], o[1]); w.y = cvt_pk_bf16(o[2], o[3]); w.z = cvt_pk_bf16(o[4], o[5]); w.w = cvt_pk_bf16(o[6], o[7]);
                *(u32x4*)(hid + (size_t)(u.pm * 256 + r) * DE + col0) = w; }
        return false;
    }
};
struct EpiDown {
    static constexpr bool PERM = true;
    const int* alist; const f32x2* rwlist; bf16_t* yb;
    __device__ __forceinline__ bool operator()(f32x4 (&acc)[2][2][4][2], const pg8::Unit& u, int wr, int wc, int fr, int fq) const {
        const f32x2* rw = rwlist + (u.rows - alist);
        const int col0 = u.pn * 256 + wc * 32 + 8 * fq;
#pragma unroll
        for (int ai = 0; ai < 2; ++ai)
#pragma unroll
            for (int m = 0; m < 4; ++m) { const int r = ai * 128 + wr * 64 + m * 16 + fr;
                if (r < u.cnt) { const int a = u.rows[r]; const float w8 = rw[r].y; bf16_t* yr = yb + (size_t)a * D + col0;
#pragma unroll
                    for (int bj = 0; bj < 2; ++bj) { const f32x4 v0 = acc[ai][bj][m][0] * w8, v1 = acc[ai][bj][m][1] * w8; u32x4 w;
                        w.x = cvt_pk_bf16(v0[0], v0[1]); w.y = cvt_pk_bf16(v0[2], v0[3]); w.z = cvt_pk_bf16(v1[0], v1[1]); w.w = cvt_pk_bf16(v1[2], v1[3]);
                        *(u32x4*)(yr + bj * 128) = w; } } }
        return false;
    }
};

__device__ __forceinline__ void p7_route(const Args& a, LAS unsigned char* lds, volatile LAS unsigned* MISC, int tid, int lane, int wave, int vcu, int G) {
    const float* b_rg = a.in[14]; const float* b_re = a.in[16];
    unsigned char* ws = a.ws;
    const bf16_t* x1b = (const bf16_t*)(ws + WS_X1B);
    int* alist = (int*)(ws + WS_ALIST); f32x2* rwlist = (f32x2*)(ws + WS_RWLIST); unsigned* counts = (unsigned*)(ws + WS_CTL) + CW_CNT;
    float* rstd2 = (float*)(ws + WS_RSTD2); float* gwd = (float*)(ws + WS_GW);
    { u32x4 t[12];
#pragma unroll
      for (int i = 0; i < 12; ++i) t[i] = *(const u32x4*)(ws + WS_WR + (size_t)(tid + i * 512) * 16);
#pragma unroll
      for (int i = 0; i < 12; ++i) *(LAS u32x4*)(lds + (tid + i * 512) * 16) = t[i]; }
    if (tid < 32) MISC[TAB_HIST + tid] = 0u;
    __syncthreads();
    LAS float* lgs = (LAS float*)(lds + 98304 + wave * 4096);
    for (int tile = vcu; tile < T / 64; tile += G) {
        int e1 = 0, e2 = 0, lp1 = 0, lp2 = 0; float gw1 = 0.f, gw2 = 0.f, rstd_t = 0.f;
        const int tok0 = tile * 64 + wave * 16;
        if (wave < 4) {
            const int row = lane & 15, kg = lane >> 4;
            const bf16_t* xbp = x1b + (size_t)(tok0 + row) * D + 8 * kg;
            f32x4 acc[3]; acc[0] = (f32x4){0.f, 0.f, 0.f, 0.f}; acc[1] = acc[0]; acc[2] = acc[0];
            float ss = 0.f;
#pragma unroll 8
            for (int s = 0; s < 32; ++s) {
                const u32x4 w = *(const u32x4*)(xbp + 32 * s);
#pragma unroll
                for (int q = 0; q < 4; ++q) { const float lo = bflo(w[q]), hi = bfhi(w[q]); ss += lo * lo + hi * hi; }
                const bf16x8 af = __builtin_bit_cast(bf16x8, w);
#pragma unroll
                for (int j = 0; j < 3; ++j) { const bf16x8 bfr = *(const LAS bf16x8*)(lds + (16 * j + row) * 2048 + (((4 * s + kg) ^ row) << 4));
                    acc[j] = __builtin_amdgcn_mfma_f32_16x16x32_bf16(af, bfr, acc[j], 0, 0, 0); }
            }
            ss += __shfl_xor(ss, 16); ss += __shfl_xor(ss, 32);
            const float rstd = rsqrtf(ss * (1.f / D) + EPS);
#pragma unroll
            for (int j = 0; j < 3; ++j)
#pragma unroll
                for (int q = 0; q < 4; ++q) lgs[(4 * kg + q) * 48 + 16 * j + row] = acc[j][q];
            if (lane < 16) lgs[768 + lane] = rstd;
            LDS_WAIT(); asm volatile("" ::: "memory");
            if (lane < 16) {
                rstd_t = lgs[768 + lane];
                const LAS float* lr = lgs + lane * 48;
                float lg[4];
#pragma unroll
                for (int o = 0; o < 4; ++o) lg[o] = lr[o] * rstd_t + b_rg[o];
                int gs = 0; float gm = lg[0];
#pragma unroll
                for (int o = 1; o < 4; ++o) if (lg[o] > gm) { gm = lg[o]; gs = o; }
                float den = 0.f;
#pragma unroll
                for (int o = 0; o < 4; ++o) den += __expf(lg[o] - gm);
                const float pg = 1.f / den;
                float le[8];
#pragma unroll
                for (int o = 0; o < 8; ++o) le[o] = lr[4 + gs * 8 + o] * rstd_t + b_re[gs * 8 + o];
                int i1 = 0; float m1 = le[0];
#pragma unroll
                for (int o = 1; o < 8; ++o) if (le[o] > m1) { m1 = le[o]; i1 = o; }
                int i2 = 0; float m2 = -3.0e38f;
#pragma unroll
                for (int o = 0; o < 8; ++o) if (o != i1 && le[o] > m2) { m2 = le[o]; i2 = o; }
                const float ex2 = __expf(m2 - m1), inv = 1.f / (1.f + ex2);
                e1 = gs * 8 + i1; e2 = gs * 8 + i2; gw1 = pg * inv; gw2 = pg * ex2 * inv;
                lp1 = (int)__hip_atomic_fetch_add((LAS unsigned*)&MISC[TAB_HIST + e1], 1u, __ATOMIC_RELAXED, __HIP_MEMORY_SCOPE_WORKGROUP);
                lp2 = (int)__hip_atomic_fetch_add((LAS unsigned*)&MISC[TAB_HIST + e2], 1u, __ATOMIC_RELAXED, __HIP_MEMORY_SCOPE_WORKGROUP);
            }
        }
        __syncthreads();
        if (tid < 32) { const unsigned hc = MISC[TAB_HIST + tid]; MISC[TAB_BASE + tid] = hc ? __hip_atomic_fetch_add(counts + tid, hc, __ATOMIC_RELAXED, __HIP_MEMORY_SCOPE_AGENT) : 0u; MISC[TAB_HIST + tid] = 0u; }
        __syncthreads();
        if (wave < 4 && lane < 16) {
            const int tok = tok0 + lane;
            const int p1 = (int)MISC[TAB_BASE + e1] + lp1, p2 = (int)MISC[TAB_BASE + e2] + lp2;
            alist[(size_t)e1 * T + p1] = tok * 2; rwlist[(size_t)e1 * T + p1] = (f32x2){rstd_t, gw1};
            alist[(size_t)e2 * T + p2] = tok * 2 + 1; rwlist[(size_t)e2 * T + p2] = (f32x2){rstd_t, gw2};
            rstd2[tok] = rstd_t; gwd[tok * 2] = gw1; gwd[tok * 2 + 1] = gw2;
        }
        __syncthreads();
    }
}
__device__ __forceinline__ void moe_tables(unsigned* counts, volatile LAS unsigned* MISC, int tid) {
    if (tid == 0) { unsigned cum = 0;
        for (int e = 0; e < 32; ++e) { const unsigned c = __hip_atomic_load(counts + e, __ATOMIC_RELAXED, __HIP_MEMORY_SCOPE_AGENT); MISC[TAB_CNT + e] = c; MISC[TAB_CUM + e] = cum; cum += (c + 255u) >> 8; }
        MISC[TAB_CUM + 32] = cum; }
    __syncthreads();
}
__device__ __forceinline__ void p10_final(const Args& a, int lane, int wave, int vcu, int G) {
    const bf16_t* x1b = (const bf16_t*)(a.ws + WS_X1B); const float* gf = a.in[20];
    const int gw = vcu * NWAVES + wave, NGW = G * NWAVES;
    f32x4 gv[4];
#pragma unroll
    for (int j = 0; j < 4; ++j) gv[j] = *(const f32x4*)(gf + 4 * lane + 256 * j);
    u32x2 xn[4], pn[4], qn[4];
    if (gw < T) {
#pragma unroll
        for (int j = 0; j < 4; ++j) { xn[j] = ((const u32x2*)(x1b + (size_t)gw * D) + lane)[64 * j]; pn[j] = ((const u32x2*)(a.out + (size_t)gw * D) + lane)[64 * j]; qn[j] = ((const u32x2*)(a.out + (size_t)gw * D + 512) + lane)[64 * j]; } }
    for (int t = gw; t < T; t += NGW) {
        float* orow = a.out + (size_t)t * D;
        f32x4 v[4]; float s = 0.f;
#pragma unroll
        for (int j = 0; j < 4; ++j) { const u32x2 xv = xn[j], p = pn[j], q = qn[j];
            v[j].x = bflo(xv.x) + bflo(p.x) + bflo(q.x); v[j].y = bfhi(xv.x) + bfhi(p.x) + bfhi(q.x); v[j].z = bflo(xv.y) + bflo(p.y) + bflo(q.y); v[j].w = bfhi(xv.y) + bfhi(p.y) + bfhi(q.y);
            s += (v[j].x * v[j].x + v[j].y * v[j].y) + (v[j].z * v[j].z + v[j].w * v[j].w); }
        if (t + NGW < T) { const size_t tn = (size_t)(t + NGW);
#pragma unroll
            for (int j = 0; j < 4; ++j) { xn[j] = ((const u32x2*)(x1b + tn * D) + lane)[64 * j]; pn[j] = ((const u32x2*)(a.out + tn * D) + lane)[64 * j]; qn[j] = ((const u32x2*)(a.out + tn * D + 512) + lane)[64 * j]; } }
        s = wave_sum(s);
        const float rstd = rsqrtf(s * (1.f / D) + EPS);
#pragma unroll
        for (int j = 0; j < 4; ++j) ((f32x4*)orow)[lane + 64 * j] = v[j] * rstd * gv[j];
    }
}

typedef short v4i16_t __attribute__((ext_vector_type(4)));
__device__ __forceinline__ int img_off(int row, int ch) { return 2048 * (row >> 3) + 512 * (ch >> 2) + 64 * (row & 7) + 16 * ((ch & 3) ^ ((row >> 2) & 3)); }
__device__ __forceinline__ v4i16_t tr_read(LAS unsigned char* p) { return __builtin_amdgcn_ds_read_tr16_b64_v4i16((LAS v4i16_t*)p); }
__device__ __forceinline__ bf16x8 tr_frag(LAS unsigned char* img, int r0, int r1, int c0, int lane) {
    const int li = lane & 15, q = li >> 2, p = li & 3;
    const v4i16_t lo = tr_read(img + img_off(r0 + q, c0 + (p >> 1)) + 8 * (p & 1)), hi = tr_read(img + img_off(r1 + q, c0 + (p >> 1)) + 8 * (p & 1));
    return (bf16x8){lo[0], lo[1], lo[2], lo[3], hi[0], hi[1], hi[2], hi[3]};
}
__device__ __forceinline__ float wave_prefix_sum(float v, int lane) {
#pragma unroll
    for (int d = 1; d < 64; d <<= 1) { const float o = __shfl_up(v, d); if (lane >= d) v += o; }
    return v;
}
__device__ __forceinline__ float wave_prefix_max(float v, int lane) {
#pragma unroll
    for (int d = 1; d < 64; d <<= 1) { const float o = __shfl_up(v, d); if (lane >= d) v = fmaxf(v, o); }
    return v;
}
__device__ __forceinline__ float wave_max(float v) {
#pragma unroll
    for (int o = 1; o < 64; o <<= 1) v = fmaxf(v, __shfl_xor(v, o));
    return v;
}
constexpr int HALF_LDS = 50176;
__device__ __forceinline__ void conv4_silu(const u32x4 (&raw)[7], const float (&cw)[4][8], float scale, float (&out)[4][8]) {
#pragma unroll
    for (int i = 0; i < 4; ++i)
#pragma unroll
        for (int q = 0; q < 4; ++q) { float a0 = 0.f, a1 = 0.f;
#pragma unroll
            for (int j = 0; j < 4; ++j) { const unsigned w = raw[i + j][q]; a0 += bflo(w) * cw[j][2 * q]; a1 += bfhi(w) * cw[j][2 * q + 1]; }
            out[i][2 * q] = a0 * fsigmoid(a0) * scale; out[i][2 * q + 1] = a1 * fsigmoid(a1) * scale; }
}
__device__ __forceinline__ void b1_item(const Args& a, LAS unsigned char* hl, int item, int tl, int wv, int lane) {
    unsigned char* ws = a.ws; const bf16_t* z = (const bf16_t*)(ws + WS_Z); const float* gif = (const float*)(ws + WS_GIF); const float* conv_k = a.in[5];
    bf16_t* kact = (bf16_t*)(ws + WS_KACT); float* nloc = (float*)(ws + WS_NLOC); float* scal = (float*)(ws + WS_SCAL);
    unsigned char* Cb = (unsigned char*)a.out + OB_C + (size_t)item * 32768;
    const int bh = item >> 5, c = item & 31, b = bh >> 2, hh = bh & 3;
    const size_t tok_base = (size_t)b * SEQ + c * 64;
    const int cc = tl & 15, tg = tl >> 4, t0 = 4 * tg;
    u32x4 kr[7], vr[4];
#pragma unroll
    for (int j = 0; j < 7; ++j) { const int t = t0 - 3 + j; kr[j] = (c * 64 + t >= 0) ? *(const u32x4*)(z + (tok_base + t) * NZ + 1024 + hh * 128 + cc * 8) : (u32x4){0u, 0u, 0u, 0u}; }
#pragma unroll
    for (int i = 0; i < 4; ++i) vr[i] = *(const u32x4*)(z + (tok_base + t0 + i) * NZ + 1536 + hh * 128 + cc * 8);
    float cw[4][8];
#pragma unroll
    for (int j = 0; j < 4; ++j) { const f32x4 w0 = *(const f32x4*)(conv_k + j * DM + hh * 128 + cc * 8), w1 = *(const f32x4*)(conv_k + j * DM + hh * 128 + cc * 8 + 4);
        cw[j][0] = w0.x; cw[j][1] = w0.y; cw[j][2] = w0.z; cw[j][3] = w0.w; cw[j][4] = w1.x; cw[j][5] = w1.y; cw[j][6] = w1.z; cw[j][7] = w1.w; }
    LAS float* sc = (LAS float*)(hl + 49152);
    if (wv == 0) {
        const size_t tok = tok_base + lane;
        const float ig = gif[tok * 8 + hh], fp = gif[tok * 8 + 4 + hh];
        const float bb = wave_prefix_sum(logsigmoidf_(fp), lane);
        const float blast = __shfl(bb, 63);
        const float alog = blast - bb + ig;
        const float amax = wave_max(alog);
        sc[lane] = __expf(alog - amax);
        if (lane == 0) { scal[item] = amax; scal[1024 + item] = blast; }
    }
#pragma unroll
    for (int i = 0; i < 4; ++i) *(LAS u32x4*)(hl + 16384 + img_off(t0 + i, cc)) = vr[i];
    __syncthreads();
    {
        float ka[4][8]; conv4_silu(kr, cw, 0.08838834764831845f, ka);
#pragma unroll
        for (int i = 0; i < 4; ++i) { const float wl = sc[t0 + i];
            u32x4 w; w.x = pk2(ka[i][0], ka[i][1]); w.y = pk2(ka[i][2], ka[i][3]); w.z = pk2(ka[i][4], ka[i][5]); w.w = pk2(ka[i][6], ka[i][7]);
            *(u32x4*)(kact + (tok_base + t0 + i) * DM + hh * 128 + cc * 8) = w;
            u32x4 x; x.x = pk2(ka[i][0] * wl, ka[i][1] * wl); x.y = pk2(ka[i][2] * wl, ka[i][3] * wl); x.z = pk2(ka[i][4] * wl, ka[i][5] * wl); x.w = pk2(ka[i][6] * wl, ka[i][7] * wl);
            *(LAS u32x4*)(hl + img_off(t0 + i, cc)) = x; }
    }
    __syncthreads();
    {
        const int g = lane >> 4;
        bf16x8 af[2][2];
#pragma unroll
        for (int ii = 0; ii < 2; ++ii)
#pragma unroll
            for (int ks = 0; ks < 2; ++ks) af[ii][ks] = tr_frag(hl, 32 * ks + 8 * g, 32 * ks + 8 * g + 4, 2 * (2 * wv + ii), lane);
        const bf16x8 ones = (bf16x8){0x3F80, 0x3F80, 0x3F80, 0x3F80, 0x3F80, 0x3F80, 0x3F80, 0x3F80};
        f32x4 accn[2];
#pragma unroll
        for (int ii = 0; ii < 2; ++ii) { accn[ii] = (f32x4){0.f, 0.f, 0.f, 0.f};
#pragma unroll
            for (int ks = 0; ks < 2; ++ks) accn[ii] = __builtin_amdgcn_mfma_f32_16x16x32_bf16(af[ii][ks], ones, accn[ii], 0, 0, 0); }
#pragma unroll
        for (int j = 0; j < 8; ++j) {
            f32x4 acc0 = (f32x4){0.f, 0.f, 0.f, 0.f}, acc1 = acc0;
#pragma unroll
            for (int ks = 0; ks < 2; ++ks) { const bf16x8 bfv = tr_frag(hl + 16384, 32 * ks + 8 * g, 32 * ks + 8 * g + 4, 2 * j, lane);
                acc0 = __builtin_amdgcn_mfma_f32_16x16x32_bf16(af[0][ks], bfv, acc0, 0, 0, 0); acc1 = __builtin_amdgcn_mfma_f32_16x16x32_bf16(af[1][ks], bfv, acc1, 0, 0, 0); }
            u32x4 w; w.x = pk2(acc0[0], acc0[1]); w.y = pk2(acc0[2], acc0[3]); w.z = pk2(acc1[0], acc1[1]); w.w = pk2(acc1[2], acc1[3]);
            *(u32x4*)(Cb + ((size_t)((wv * 8 + j) * 64 + lane) << 4)) = w;
        }
        if ((lane & 15) == 0) {
#pragma unroll
            for (int ii = 0; ii < 2; ++ii) *(f32x4*)(nloc + (size_t)item * 128 + 16 * (2 * wv + ii) + 4 * g) = accn[ii]; }
    }
    __syncthreads();
}
__device__ __forceinline__ void pool_pass(const Args& a, int tid, int vcu, int G) {
    const bf16_t* z = (const bf16_t*)(a.ws + WS_Z); bf16_t* dA = (bf16_t*)((unsigned char*)a.out + OB_DA);
    for (int w = vcu * (NWAVES * 64) + tid; w < (T / 8) * 64; w += G * NWAVES * 64) {
        const int cc = w & 63, run = w >> 6, tokA = run * 8, s0 = tokA % SEQ, grp = cc >> 4, win = 2 << grp;
        const bf16_t* zp = z + (size_t)tokA * NZ + cc * 8;
        float S[8];
#pragma unroll
        for (int q = 0; q < 8; ++q) S[q] = 0.f;
        for (int j = 1; j <= win; ++j) if (s0 - j >= 0) { const u32x4 r = *(const u32x4*)(zp - (size_t)j * NZ);
#pragma unroll
            for (int q = 0; q < 4; ++q) { S[2 * q] += bflo(r[q]); S[2 * q + 1] += bfhi(r[q]); } }
#pragma unroll
        for (int i = 0; i < 8; ++i) {
            const int s = s0 + i; const u32x4 r = *(const u32x4*)(zp + (size_t)i * NZ);
            float cur[8];
#pragma unroll
            for (int q = 0; q < 4; ++q) { cur[2 * q] = bflo(r[q]); cur[2 * q + 1] = bfhi(r[q]); S[2 * q] += cur[2 * q]; S[2 * q + 1] += cur[2 * q + 1]; }
            if (s - win >= 0) { const u32x4 o = *(const u32x4*)(zp + (size_t)(i - win) * NZ);
#pragma unroll
                for (int q = 0; q < 4; ++q) { S[2 * q] -= bflo(o[q]); S[2 * q + 1] -= bfhi(o[q]); } }
            const float inv = 1.f / (float)(s + 1 < win ? s + 1 : win);
            u32x4 w4;
#pragma unroll
            for (int q = 0; q < 4; ++q) w4[q] = pk2(S[2 * q] * inv - cur[2 * q], S[2 * q + 1] * inv - cur[2 * q + 1]);
            *(u32x4*)(dA + (size_t)(tokA + i) * DP + cc * 8) = w4;
        }
    }
}
__device__ __forceinline__ void p3_scan(const Args& a, int tid, int vcu, int G) {
    float* scal = (float*)(a.ws + WS_SCAL); float* nloc = (float*)(a.ws + WS_NLOC);
    for (int w = vcu; w < 256; w += G) {
        const int bh = w >> 3, part = w & 7;
        unsigned char* Cp = (unsigned char*)a.out + OB_C + (size_t)bh * 32 * 32768 + (size_t)(part * 512 + tid) * 8;
        u32x2 ld[32];
#pragma unroll
        for (int c = 0; c < 32; ++c) ld[c] = *(const u32x2*)(Cp + (size_t)c * 32768);
        const bool do_n = (part == 0 && tid < 128);
        float nl[32];
        if (do_n) {
#pragma unroll
            for (int c = 0; c < 32; ++c) nl[c] = nloc[(size_t)(bh * 32 + c) * 128 + tid]; }
        float st[4] = {0.f, 0.f, 0.f, 0.f}; float m = 0.f, nst = 0.f;
#pragma unroll
        for (int c = 0; c < 32; ++c) {
            const float am = scal[bh * 32 + c], bl = scal[1024 + bh * 32 + c];
            const float mn = fmaxf(bl + m, am), sp = __expf(bl + m - mn), sl = __expf(am - mn);
            u32x2 o; o.x = pk2(st[0], st[1]); o.y = pk2(st[2], st[3]); *(u32x2*)(Cp + (size_t)c * 32768) = o;
            st[0] = sp * st[0] + sl * bflo(ld[c].x); st[1] = sp * st[1] + sl * bfhi(ld[c].x); st[2] = sp * st[2] + sl * bflo(ld[c].y); st[3] = sp * st[3] + sl * bfhi(ld[c].y);
            if (do_n) { nloc[(size_t)(bh * 32 + c) * 128 + tid] = nst; nst = sp * nst + sl * nl[c]; }
            if (part == 0 && tid == 0) scal[2048 + bh * 32 + c] = m;
            m = mn;
        }
    }
}
__device__ __forceinline__ void b3_item(const Args& a, LAS unsigned char* hl, int item, int tl, int wv, int lane) {
    unsigned char* ws = a.ws; const bf16_t* z = (const bf16_t*)(ws + WS_Z); const float* gif = (const float*)(ws + WS_GIF); const float* conv_q = a.in[4]; const float* g_head = a.in[6];
    const bf16_t* kact = (const bf16_t*)(ws + WS_KACT); const float* nprev = (const float*)(ws + WS_NLOC) + (size_t)item * 128; const float* scal = (const float*)(ws + WS_SCAL);
    const unsigned char* Cb = (const unsigned char*)a.out + OB_C + (size_t)item * 32768; bf16_t* hm = (bf16_t*)((unsigned char*)a.out + OB_HM);
    const int bh = item >> 5, c = item & 31, b = bh >> 2, hh = bh & 3;
    const size_t tok_base = (size_t)b * SEQ + c * 64;
    const int cc = tl & 15, tg = tl >> 4, t0 = 4 * tg;
    LAS unsigned char* qi = hl; LAS unsigned char* ki = hl + 16384; LAS unsigned char* vi = hl + 32768; LAS float* sc = (LAS float*)(hl + 49152);
    const float mprev = scal[2048 + item];
    {
        u32x4 qr[7], kv[4], vr[4];
#pragma unroll
        for (int j = 0; j < 7; ++j) { const int t = t0 - 3 + j; qr[j] = (c * 64 + t >= 0) ? *(const u32x4*)(z + (tok_base + t) * NZ + 512 + hh * 128 + cc * 8) : (u32x4){0u, 0u, 0u, 0u}; }
#pragma unroll
        for (int i = 0; i < 4; ++i) { kv[i] = *(const u32x4*)(kact + (tok_base + t0 + i) * DM + hh * 128 + cc * 8); vr[i] = *(const u32x4*)(z + (tok_base + t0 + i) * NZ + 1536 + hh * 128 + cc * 8); }
        float cw[4][8];
#pragma unroll
        for (int j = 0; j < 4; ++j) { const f32x4 w0 = *(const f32x4*)(conv_q + j * DM + hh * 128 + cc * 8), w1 = *(const f32x4*)(conv_q + j * DM + hh * 128 + cc * 8 + 4);
            cw[j][0] = w0.x; cw[j][1] = w0.y; cw[j][2] = w0.z; cw[j][3] = w0.w; cw[j][4] = w1.x; cw[j][5] = w1.y; cw[j][6] = w1.z; cw[j][7] = w1.w; }
        if (wv == 0) {
            const size_t tok = tok_base + lane;
            const float ig = gif[tok * 8 + hh], fp = gif[tok * 8 + 4 + hh];
            const float bb = wave_prefix_sum(logsigmoidf_(fp), lane);
            const float gg = ig - bb;
            const float M = fmaxf(mprev, wave_prefix_max(gg, lane));
            sc[lane] = gg; sc[64 + lane] = M; sc[128 + lane] = bb;
        }
        float qa[4][8]; conv4_silu(qr, cw, 1.f, qa);
#pragma unroll
        for (int i = 0; i < 4; ++i) { u32x4 w; w.x = pk2(qa[i][0], qa[i][1]); w.y = pk2(qa[i][2], qa[i][3]); w.z = pk2(qa[i][4], qa[i][5]); w.w = pk2(qa[i][6], qa[i][7]);
            *(LAS u32x4*)(qi + img_off(t0 + i, cc)) = w; *(LAS u32x4*)(ki + img_off(t0 + i, cc)) = kv[i]; *(LAS u32x4*)(vi + img_off(t0 + i, cc)) = vr[i]; }
    }
    __syncthreads();
    {
        const int jt = wv, li = lane & 15, g = lane >> 4, trow = 16 * jt + li;
        bf16x8 qn[4];
#pragma unroll
        for (int ks = 0; ks < 4; ++ks) qn[ks] = *(const LAS bf16x8*)(qi + img_off(trow, 4 * ks + g));
        f32x4 accs[4];
#pragma unroll
        for (int i = 0; i < 4; ++i) { accs[i] = (f32x4){0.f, 0.f, 0.f, 0.f};
            if (i <= jt) {
#pragma unroll
                for (int ks = 0; ks < 4; ++ks) { const bf16x8 kf = *(const LAS bf16x8*)(ki + img_off(16 * i + li, 4 * ks + g)); accs[i] = __builtin_amdgcn_mfma_f32_16x16x32_bf16(kf, qn[ks], accs[i], 0, 0, 0); } } }
        const float Mt = sc[64 + trow], bt = sc[128 + trow];
        float rsum = 0.f;
#pragma unroll
        for (int i = 0; i < 4; ++i) { if (i <= jt) { const f32x4 gsv = *(const LAS f32x4*)(sc + 16 * i + 4 * g);
#pragma unroll
                for (int q = 0; q < 4; ++q) { float p = accs[i][q] * __expf(gsv[q] - Mt); if (i == jt && 4 * g + q > li) p = 0.f; accs[i][q] = p; rsum += p; } } }
        rsum += __shfl_xor(rsum, 16); rsum += __shfl_xor(rsum, 32);
        bf16x8 pf[2];
#pragma unroll
        for (int u = 0; u < 2; ++u) { u32x4 w; w.x = pk2(accs[2 * u][0], accs[2 * u][1]); w.y = pk2(accs[2 * u][2], accs[2 * u][3]); w.z = pk2(accs[2 * u + 1][0], accs[2 * u + 1][1]); w.w = pk2(accs[2 * u + 1][2], accs[2 * u + 1][3]); pf[u] = __builtin_bit_cast(bf16x8, w); }
        bf16x8 qp[4];
#pragma unroll
        for (int s4 = 0; s4 < 4; ++s4) { const u32x2 lo = *(const LAS u32x2*)(qi + img_off(trow, 4 * s4 + (g >> 1)) + 8 * (g & 1)), hi = *(const LAS u32x2*)(qi + img_off(trow, 4 * s4 + 2 + (g >> 1)) + 8 * (g & 1));
            qp[s4] = __builtin_bit_cast(bf16x8, (u32x4){lo.x, lo.y, hi.x, hi.y}); }
        f32x4 acco[8]; f32x4 accn = (f32x4){0.f, 0.f, 0.f, 0.f};
#pragma unroll
        for (int s4 = 0; s4 < 4; ++s4) { const f32x4 n0 = *(const f32x4*)(nprev + 32 * s4 + 4 * g), n1 = *(const f32x4*)(nprev + 32 * s4 + 16 + 4 * g);
            u32x4 w; w.x = pk2(n0.x, n0.y); w.y = pk2(n0.z, n0.w); w.z = pk2(n1.x, n1.y); w.w = pk2(n1.z, n1.w);
            accn = __builtin_amdgcn_mfma_f32_16x16x32_bf16(__builtin_bit_cast(bf16x8, w), qp[s4], accn, 0, 0, 0); }
#pragma unroll
        for (int jd = 0; jd < 8; ++jd) { acco[jd] = (f32x4){0.f, 0.f, 0.f, 0.f};
#pragma unroll
            for (int s4 = 0; s4 < 4; ++s4) { const bf16x8 cf = *(const bf16x8*)(Cb + ((size_t)((s4 * 8 + jd) * 64 + lane) << 4)); acco[jd] = __builtin_amdgcn_mfma_f32_16x16x32_bf16(cf, qp[s4], acco[jd], 0, 0, 0); } }
        const float winter = __expf(mprev - Mt);
#pragma unroll
        for (int jd = 0; jd < 8; ++jd) acco[jd] = acco[jd] * winter;
#pragma unroll
        for (int u = 0; u < 2; ++u) { if (2 * u <= jt) {
#pragma unroll
                for (int jd = 0; jd < 8; ++jd) { const bf16x8 vf = tr_frag(vi, 32 * u + 4 * g, 32 * u + 16 + 4 * g, 2 * jd, lane); acco[jd] = __builtin_amdgcn_mfma_f32_16x16x32_bf16(vf, pf[u], acco[jd], 0, 0, 0); } } }
        const float nq = winter * accn[0] + rsum;
        const float inv = 1.f / fmaxf(fabsf(nq), __expf(-bt - Mt));
        float s1 = 0.f;
#pragma unroll
        for (int jd = 0; jd < 8; ++jd) { acco[jd] = acco[jd] * inv; s1 += (acco[jd][0] + acco[jd][1]) + (acco[jd][2] + acco[jd][3]); }
        s1 += __shfl_xor(s1, 16); s1 += __shfl_xor(s1, 32);
        const float mu = s1 * (1.f / HD);
        float s2 = 0.f;
#pragma unroll
        for (int jd = 0; jd < 8; ++jd) { const f32x4 d = acco[jd] - mu; s2 += (d[0] * d[0] + d[1] * d[1]) + (d[2] * d[2] + d[3] * d[3]); }
        s2 += __shfl_xor(s2, 16); s2 += __shfl_xor(s2, 32);
        const float rstd = rsqrtf(s2 * (1.f / HD) + EPS);
        const size_t tok = tok_base + trow;
#pragma unroll
        for (int jd = 0; jd < 8; ++jd) { const int dv0 = hh * 128 + 16 * jd + 4 * g;
            const f32x4 gh = *(const f32x4*)(g_head + dv0); const u32x2 ov = *(const u32x2*)(z + tok * NZ + 2048 + dv0);
            const f32x4 hn = (acco[jd] - mu) * rstd * gh;
            u32x2 w; w.x = pk2(hn[0] * fsigmoid(bflo(ov.x)), hn[1] * fsigmoid(bfhi(ov.x))); w.y = pk2(hn[2] * fsigmoid(bflo(ov.y)), hn[3] * fsigmoid(bfhi(ov.y)));
            *(u32x2*)(hm + tok * DM + dv0) = w; }
    }
    __syncthreads();
}

constexpr int TR_PITCH = 144, TR_SCR = 64 * TR_PITCH;
__device__ __forceinline__ void tr64_item(const float* __restrict__ src, int ld, int k0, int n0s, bf16_t* dst, int dstK, const float* __restrict__ kscale, LAS unsigned char* scr, int lane) {
    const int lr = lane >> 4, lc = (lane & 15) * 4;
    f32x4 v[16];
#pragma unroll
    for (int i = 0; i < 16; ++i) v[i] = *(const f32x4*)(src + (size_t)(k0 + 4 * i + lr) * ld + n0s + lc);
#pragma unroll
    for (int i = 0; i < 16; ++i) { f32x4 x = v[i]; if (kscale) x = x * kscale[k0 + 4 * i + lr];
        u32x2 w; w.x = pk2(x.x, x.y); w.y = pk2(x.z, x.w); *(LAS u32x2*)(scr + (4 * i + lr) * TR_PITCH + lc * 2) = w; }
    LDS_WAIT(); asm volatile("" ::: "memory");
    const int li = lane & 15, g = lane >> 4, q = li >> 2, p = li & 3;
#pragma unroll
    for (int nb = 0; nb < 4; ++nb)
#pragma unroll
        for (int kh = 0; kh < 2; ++kh) { const int kc = 4 * kh + g;
            LAS unsigned char* ap = scr + (8 * kc + q) * TR_PITCH + (nb * 16 + 4 * p) * 2;
            const v4i16_t lo = tr_read(ap), hi = tr_read(ap + 4 * TR_PITCH);
            const bf16x8 o = (bf16x8){lo[0], lo[1], lo[2], lo[3], hi[0], hi[1], hi[2], hi[3]};
            *(bf16x8*)(dst + (size_t)(nb * 16 + li) * dstK + k0 + 8 * kc) = o; }
    LDS_WAIT(); asm volatile("" ::: "memory");
}

__device__ __forceinline__ void p0_prologue(const Args& a, LAS unsigned char* lds, int tid, int lane, int wave, int vcu, int G) {
    const float* x = a.in[0]; const float* g_mix = a.in[1]; const float* w_in = a.in[2]; const float* b_if = a.in[3];
    const float* w_pool = a.in[7]; const float* pool_scale = a.in[8]; const float* w_br_a = a.in[9]; const float* w_br_b = a.in[10]; const float* w_out = a.in[11];
    const float* g_ffn = a.in[12]; const float* w_eg = a.in[17]; const float* w_eu = a.in[18]; const float* w_ed = a.in[19];
    unsigned char* ws = a.ws;
    bf16_t* h = (bf16_t*)((unsigned char*)a.out + OB_H); float* gif = (float*)(ws + WS_GIF);
    const int gw = vcu * NWAVES + wave, NGW = G * NWAVES;
    LAS float* gwl = (LAS float*)(lds + 81920);
    for (int idx = tid; idx < 8192; idx += NWAVES * 64) { const int k = idx >> 3, o = idx & 7; gwl[o * 1024 + k] = w_in[(size_t)k * NIN + 2560 + o] * g_mix[k]; }
    __syncthreads();
    REP(20) {
        f32x4 gm[4];
#pragma unroll
        for (int j = 0; j < 4; ++j) gm[j] = *(const f32x4*)(g_mix + 4 * lane + 256 * j);
        f32x4 vn[4];
        if (gw < T) {
#pragma unroll
            for (int j = 0; j < 4; ++j) vn[j] = ((const f32x4*)(x + (size_t)gw * D) + lane)[64 * j]; }
        for (int m = gw; m < T; m += NGW) {
            f32x4 v[4];
#pragma unroll
            for (int j = 0; j < 4; ++j) v[j] = vn[j];
            if (m + NGW < T) {
#pragma unroll
                for (int j = 0; j < 4; ++j) vn[j] = ((const f32x4*)(x + (size_t)(m + NGW) * D) + lane)[64 * j]; }
            float s = 0.f;
#pragma unroll
            for (int j = 0; j < 4; ++j) s += (v[j].x * v[j].x + v[j].y * v[j].y) + (v[j].z * v[j].z + v[j].w * v[j].w);
            float acc[8];
#pragma unroll
            for (int o = 0; o < 8; ++o) { float t = 0.f;
#pragma unroll
                for (int j = 0; j < 4; ++j) { const f32x4 w = *(const LAS f32x4*)(gwl + o * 1024 + 4 * lane + 256 * j); t += (v[j].x * w.x + v[j].y * w.y) + (v[j].z * w.z + v[j].w * w.w); }
                acc[o] = t; }
            s = wave_sum(s);
#pragma unroll
            for (int o = 0; o < 8; ++o) acc[o] = wave_sum(acc[o]);
            const float rstd = rsqrtf(s * (1.f / D) + EPS);
            u32x2* o8 = (u32x2*)(h + (size_t)m * D) + lane;
#pragma unroll
            for (int j = 0; j < 4; ++j) { const f32x4 hv = v[j] * rstd * gm[j]; u32x2 w; w.x = pk2(hv.x, hv.y); w.y = pk2(hv.z, hv.w); o8[64 * j] = w; }
            if (lane < 8) { float r = acc[0];
#pragma unroll
                for (int o = 1; o < 8; ++o) r = (lane == o) ? acc[o] : r;
                gif[(size_t)m * 8 + lane] = r * rstd + b_if[lane]; }
        }
    }
    REP(21) {
        bf16_t* W2T = (bf16_t*)(ws + WS_W2T);
        const int gt = gw * 64 + lane, NT_ = NGW * 64;
        for (int o = gt; o < DP * D; o += NT_) {
            const int k = o >> 10, n = o & 1023, gq = k >> 7;
            const float* wp = w_pool + (size_t)k * 128; const float* sc = pool_scale + gq * 128; const float* wa = w_br_a + (size_t)(gq * 128) * D + n;
            float acc = 0.f;
#pragma unroll 16
            for (int d = 0; d < 128; ++d) acc += (wp[d] * sc[d]) * wa[(size_t)d * D];
            W2T[(size_t)n * DP + k] = f2bf(acc);
        }
    }
    LAS unsigned char* scr = lds + wave * TR_SCR;
    constexpr int I_WZ = 16 * 72, I_WB = 8 * 16, I_WO = 16 * 16, I_EG = 32 * 16 * 8, I_ED = 32 * 8 * 16;
    constexpr int NITEMS = I_WZ + I_WB + I_WO + 2 * I_EG + I_ED;
    REP(22) for (int it = gw; it < NITEMS; it += NGW) {
        int r = it;
        if (r < I_WZ) { const int kb = r / 72, nb = r % 72, n0 = nb * 64; tr64_item(w_in, NIN, kb * 64, zcol2orig(n0), (bf16_t*)(ws + WS_WZ) + (size_t)n0 * D, D, nullptr, scr, lane); continue; } r -= I_WZ;
        if (r < I_WB) { const int kb = r >> 4, nb = r & 15; tr64_item(w_br_b, D, kb * 64, nb * 64, (bf16_t*)(ws + WS_WBT) + (size_t)(nb * 64) * DM, DM, nullptr, scr, lane); continue; } r -= I_WB;
        if (r < I_WO) { const int kb = r >> 4, nb = r & 15; tr64_item(w_out, D, kb * 64, nb * 64, (bf16_t*)(ws + WS_WOT) + (size_t)(nb * 64) * D, D, nullptr, scr, lane); continue; } r -= I_WO;
        if (r < 2 * I_EG) { const int up = r >= I_EG; if (up) r -= I_EG; const int e = r >> 7, kb = (r >> 3) & 15, nb = r & 7, j0 = nb * 64;
            const int drow = (j0 >> 7) * 256 + up * 128 + (j0 & 127);
            tr64_item((up ? w_eu : w_eg) + (size_t)e * D * DE, DE, kb * 64, j0, (bf16_t*)(ws + WS_WUP) + ((size_t)e * 1024 + drow) * D, D, g_ffn, scr, lane); continue; } r -= 2 * I_EG;
        { const int e = r >> 7, kb = (r >> 4) & 7, nb = r & 15; tr64_item(w_ed + (size_t)e * DE * D, D, kb * 64, nb * 64, (bf16_t*)(ws + WS_WDN) + ((size_t)e * 1024 + nb * 64) * DE, DE, nullptr, scr, lane); }
    }
    {
        const float* w_rg = a.in[13]; const float* w_re = a.in[15];
        const int gt = gw * 64 + lane;
        if (gt < 48 * 128) { const int col = gt >> 7, ch = gt & 127; float v[8];
#pragma unroll
            for (int q = 0; q < 8; ++q) { const int k = 8 * ch + q; v[q] = (col < 4 ? w_rg[k * NG + col] : col < 36 ? w_re[k * NE + col - 4] : 0.f) * g_ffn[k]; }
            u32x4 w; w.x = pk2(v[0], v[1]); w.y = pk2(v[2], v[3]); w.z = pk2(v[4], v[5]); w.w = pk2(v[6], v[7]);
            *(u32x4*)(ws + WS_WR + col * 2048 + ((ch ^ (col & 15)) << 4)) = w; }
    }
}

__global__ void __launch_bounds__(NWAVES * 64, 2) mk_fwd(Args args) {
    extern __shared__ __attribute__((aligned(16))) unsigned char lds_raw[];
    LAS unsigned char* lds = (LAS unsigned char*)lds_raw;
    volatile LAS unsigned* MISC = (volatile LAS unsigned*)(lds + MISC_OFF);
    const int tid = threadIdx.x, lane = tid & 63, wave = __builtin_amdgcn_readfirstlane(tid >> 6);
    const int G = gridDim.x; const int bx = blockIdx.x; const int vcu = (G % 8 == 0) ? (bx % 8) * (G / 8) + bx / 8 : bx;
    unsigned char* ws = args.ws; unsigned* ctl = (unsigned*)(ws + WS_CTL);
    for (int u = tid; u < (LDS_BYTES - LDSCTL_OFF) / 4; u += NWAVES * 64) ((LAS unsigned*)(lds + LDSCTL_OFF))[u] = 0u;
    __syncthreads();
    XcdBarrier bar = xcd_barrier_post(ctl + CW_BAR + args.li * XCD_BAR_WORDS, MISC + 8);
    const int lo = args.ph_lo, hi = args.ph_hi;
#define IN(k) (lo <= (k) && (k) < hi)
#define BOTH(k) (IN(k) && IN((k) + 1))
#define GRID_BAR() xcd_barrier(bar)
#define STAMP(k) do { if (PROBE_PHASE >= 100 && bx == 0 && tid == 0) { const unsigned long long _t = __builtin_amdgcn_s_memrealtime(); if ((k) == PROBE_PHASE - 100) tstart = _t; if ((k) == PROBE_PHASE - 99) tend = _t; } } while (0)
    unsigned long long tstart = 0, tend = 0;
    STAMP(0);
    if (IN(0)) { REP(0) { p0_prologue(args, lds, tid, lane, wave, vcu, G); __syncthreads(); } if (BOTH(0)) GRID_BAR(); STAMP(1); }
    if (IN(1)) {
        SchedDense S{(const char*)args.out + OB_H, (const char*)(ws + WS_WZ), (size_t)256 * D * 2, (size_t)256 * D * 2, T / 256, NZ / 256, G, bx, (PROBE_PHASE == 1) ? 2 : 1};
        EpiZ E{(bf16_t*)(ws + WS_Z)};
        pg8::gemm_phase<EpiZ, SchedDense, false>(lds + RING_OFF, pg8::Cfg{D, D * 2, D * 2}, S, E);
        if (BOTH(1)) GRID_BAR(); STAMP(2);
    }
    if (IN(2)) {
        REP(2) for (int pr = vcu; pr < 512; pr += G) b1_item(args, lds + (wave >> 2) * HALF_LDS, 2 * pr + (wave >> 2), tid & 255, wave & 3, lane);
        pool_pass(args, tid, vcu, G);
        if (BOTH(2)) GRID_BAR(); STAMP(3);
    }
    if (IN(3)) { p3_scan(args, tid, vcu, G); if (BOTH(3)) GRID_BAR(); STAMP(4); }
    if (IN(4)) {
        REP(4) for (int pr = vcu; pr < 512; pr += G) b3_item(args, lds + (wave >> 2) * HALF_LDS, 2 * pr + (wave >> 2), tid & 255, wave & 3, lane);
        if (BOTH(4)) GRID_BAR(); STAMP(5);
    }
    if (IN(5)) {
        SchedMerge S{(const char*)args.out + OB_DA, (const char*)args.out + OB_HM, (const char*)(ws + WS_W2T), (const char*)(ws + WS_WBT), T / 256, D / 256, G, bx};
        EpiMerge E{(const bf16_t*)(ws + WS_Z), (bf16_t*)((unsigned char*)args.out + OB_MERGED)};
        pg8::gemm_phase<EpiMerge, SchedMerge, false>(lds + RING_OFF, pg8::Cfg{DP, DP * 2, DP * 2}, S, E);
        if (BOTH(5)) GRID_BAR(); STAMP(6);
    }
    if (IN(6)) {
        SchedDense S{(const char*)args.out + OB_MERGED, (const char*)(ws + WS_WOT), (size_t)256 * D * 2, (size_t)256 * D * 2, T / 256, D / 256, G, bx, (PROBE_PHASE == 6) ? 2 : 1};
        EpiX1 E{args.in[0], (bf16_t*)(ws + WS_X1B)};
        pg8::gemm_phase<EpiX1, SchedDense, false>(lds + RING_OFF, pg8::Cfg{D, D * 2, D * 2}, S, E);
        if (BOTH(6)) GRID_BAR(); STAMP(7);
    }
    if (IN(7)) { p7_route(args, lds, MISC, tid, lane, wave, vcu, G); if (BOTH(7)) GRID_BAR(); STAMP(8); }
    if (IN(8)) {
        moe_tables(ctl + CW_CNT, MISC, tid);
        SchedMoE S{MISC, (const char*)(ws + WS_X1B), (const char*)(ws + WS_WUP), (const int*)(ws + WS_ALIST), (size_t)1024 * D * 2, (size_t)256 * D * 2, 0, G, vcu, 1, (PROBE_PHASE == 8) ? 2 : 1};
        EpiUp E{(const int*)(ws + WS_ALIST), (const f32x2*)(ws + WS_RWLIST), (bf16_t*)(ws + WS_HID)};
        pg8::gemm_phase<EpiUp, SchedMoE, true>(lds + RING_OFF, pg8::Cfg{D, D * 2, D * 2}, S, E);
        if (BOTH(8)) GRID_BAR(); STAMP(9);
    }
    if (IN(9)) {
        moe_tables(ctl + CW_CNT, MISC, tid);
        SchedMoE S{MISC, (const char*)(ws + WS_HID), (const char*)(ws + WS_WDN), (const int*)(ws + WS_ALIST), (size_t)1024 * DE * 2, (size_t)256 * DE * 2, (size_t)256 * DE * 2, G, vcu, 0, (PROBE_PHASE == 9) ? 2 : 1};
        EpiDown E{(const int*)(ws + WS_ALIST), (const f32x2*)(ws + WS_RWLIST), (bf16_t*)args.out};
        pg8::gemm_phase<EpiDown, SchedMoE, false>(lds + RING_OFF, pg8::Cfg{DE, DE * 2, DE * 2}, S, E);
        if (BOTH(9)) GRID_BAR(); STAMP(10);
    }
    if (IN(10)) p10_final(args, lane, wave, vcu, G);
    STAMP(11);
    if (PROBE_PHASE >= 100 && bx == 0 && tid == 0) { const unsigned long long d = (tend - tstart) * 8ull, t0 = __builtin_amdgcn_s_memrealtime(); while (__builtin_amdgcn_s_memrealtime() - t0 < d) __builtin_amdgcn_s_sleep(16); }
#undef IN
#undef BOTH
#undef GRID_BAR
}

}

extern "C" void kernel_launch(void* const* d_in, const int* in_sizes, int n_in, void* d_out, int out_size, void* d_ws, size_t ws_size, hipStream_t stream) {
    const float* x = (const float*)d_in[0];
    const float* conv_q = (const float*)d_in[4]; const float* conv_k = (const float*)d_in[5]; const float* g_head = (const float*)d_in[6]; const float* w_pool = (const float*)d_in[7];
    const float* pool_scale = (const float*)d_in[8]; const float* w_br_a = (const float*)d_in[9]; const float* w_br_b = (const float*)d_in[10]; const float* w_out = (const float*)d_in[11];
    const float* g_ffn = (const float*)d_in[12]; const float* w_rg = (const float*)d_in[13]; const float* b_rg = (const float*)d_in[14]; const float* w_re = (const float*)d_in[15];
    const float* b_re = (const float*)d_in[16]; const float* w_eg = (const float*)d_in[17]; const float* w_eu = (const float*)d_in[18]; const float* w_ed = (const float*)d_in[19];
    const float* g_final = (const float*)d_in[20];
    static int grid = 0;
    if (grid == 0) {
        if (n_in != 21 || out_size != T * D || ws_size < WS_END) { fprintf(stderr, "kernel_launch: unexpected shapes/ws (%d inputs, out %d, ws %zu)\n", n_in, out_size, ws_size); grid = -1; return; }
        int dev = 0, cus = 0, per_cu = 0;
        if (hipGetDevice(&dev) != hipSuccess || hipDeviceGetAttribute(&cus, hipDeviceAttributeMultiprocessorCount, dev) != hipSuccess) { grid = -1; return; }
        if (hipFuncSetAttribute((const void*)mk_fwd, hipFuncAttributeMaxDynamicSharedMemorySize, LDS_BYTES) != hipSuccess) { fprintf(stderr, "kernel_launch: hipFuncSetAttribute failed\n"); grid = -1; return; }
        if (hipOccupancyMaxActiveBlocksPerMultiprocessor(&per_cu, (const void*)mk_fwd, NWAVES * 64, LDS_BYTES) != hipSuccess || per_cu < 1) { fprintf(stderr, "kernel_launch: occupancy query says %d blocks per CU\n", per_cu); grid = -1; return; }
        (void)hipGetLastError();
        grid = cus;
    }
    if (grid < 0) return;
    unsigned char* ws = (unsigned char*)d_ws; unsigned char* ob = (unsigned char*)d_out;
    (void)hipMemsetAsync(ws + WS_CTL, 0, CTL_ZERO_BYTES, stream);
    Args a{};
    for (int i = 0; i < 21; ++i) a.in[i] = (const float*)d_in[i];
    a.out = (float*)d_out; a.ws = ws; a.flags = 0;
    a.ph_lo = 0; a.ph_hi = 11; a.li = 0;
    hipLaunchKernelGGL(mk_fwd, dim3(grid), dim3(NWAVES * 64), LDS_BYTES, stream, a);
}
```

```cpp
#include <hip/hip_runtime.h>
#include <cstdio>
#include <cstdint>

namespace {
constexpr int D = 1024, BATCH = 8, SEQ = 2048, T = BATCH * SEQ;
constexpr int DP = 512, DM = 512, NH = 4, HD = 128, NIN = 4616, NZ = 4608;
constexpr int NG = 4, EPG = 8, NE = 32, DE = 512;
constexpr float EPS = 1e-6f;
constexpr size_t MiB = 1u << 20;

typedef unsigned short bf16_t;
__device__ __forceinline__ bf16_t f2bf(float f) { unsigned u = __builtin_bit_cast(unsigned, f); return (bf16_t)((u + 0x7fffu + ((u >> 16) & 1u)) >> 16); }
__device__ __forceinline__ float bf2f(bf16_t b) { return __builtin_bit_cast(float, (unsigned)b << 16); }
__device__ __forceinline__ float sigmoidf_(float x) { return 1.f / (1.f + __expf(-x)); }
__device__ __forceinline__ float siluf_(float x) { return x / (1.f + __expf(-x)); }
__device__ __forceinline__ float logsigmoidf_(float x) { return fminf(x, 0.f) - log1pf(__expf(-fabsf(x))); }
__device__ __forceinline__ float wave_sum(float v) {
#pragma unroll
    for (int o = 1; o < 64; o <<= 1) v += __shfl_xor(v, o);
    return v;
}
__device__ __forceinline__ int zcol2orig(int c) { return c < 2560 ? c : c + 8; }

__global__ void __launch_bounds__(256) k_prep(const float* __restrict__ x, const float* __restrict__ g, const float* __restrict__ w_in,
                                               const float* __restrict__ b_if, bf16_t* __restrict__ h, float* __restrict__ gif) {
    const int wave = threadIdx.x >> 6, lane = threadIdx.x & 63;
    const int row = blockIdx.x * 4 + wave;
    if (row >= T) return;
    const float* xr = x + (size_t)row * D;
    float v[16]; float s = 0.f;
#pragma unroll
    for (int j = 0; j < 16; ++j) { v[j] = xr[lane + 64 * j]; s += v[j] * v[j]; }
    s = wave_sum(s);
    const float rstd = rsqrtf(s * (1.f / D) + EPS);
    float acc[8];
#pragma unroll
    for (int o = 0; o < 8; ++o) acc[o] = 0.f;
#pragma unroll
    for (int j = 0; j < 16; ++j) {
        const int k = lane + 64 * j;
        const float hv = v[j] * rstd * g[k];
        h[(size_t)row * D + k] = f2bf(hv);
#pragma unroll
        for (int o = 0; o < 8; ++o) acc[o] += hv * w_in[(size_t)k * NIN + 2560 + o];
    }
#pragma unroll
    for (int o = 0; o < 8; ++o) { acc[o] = wave_sum(acc[o]); }
    if (lane == 0) {
#pragma unroll
        for (int o = 0; o < 8; ++o) gif[(size_t)row * 8 + o] = acc[o] + b_if[o];
    }
}

template <class AL, class BL, class EP>
__global__ void __launch_bounds__(256) k_gemm(int M, int N, int K, AL al, BL bl, EP ep) {
    __shared__ float As[16][68];
    __shared__ float Bs[16][68];
    const int tid = threadIdx.x, tx = tid & 15, ty = tid >> 4;
    const int row0 = blockIdx.y * 64, col0 = blockIdx.x * 64;
    float acc[4][4];
#pragma unroll
    for (int i = 0; i < 4; ++i)
#pragma unroll
        for (int j = 0; j < 4; ++j) acc[i][j] = 0.f;
    for (int k0 = 0; k0 < K; k0 += 16) {
#pragma unroll
        for (int j = 0; j < 4; ++j) {
            const int idx = tid + j * 256;
            const int r = idx >> 4, kk = idx & 15;
            As[kk][r] = (row0 + r < M) ? al(row0 + r, k0 + kk) : 0.f;
            const int k2 = idx >> 6, n = idx & 63;
            Bs[k2][n] = (col0 + n < N) ? bl(k0 + k2, col0 + n) : 0.f;
        }
        __syncthreads();
#pragma unroll
        for (int kk = 0; kk < 16; ++kk) {
            float a[4], b[4];
#pragma unroll
            for (int i = 0; i < 4; ++i) a[i] = As[kk][ty * 4 + i];
#pragma unroll
            for (int j = 0; j < 4; ++j) b[j] = Bs[kk][tx * 4 + j];
#pragma unroll
            for (int i = 0; i < 4; ++i)
#pragma unroll
                for (int j = 0; j < 4; ++j) acc[i][j] += a[i] * b[j];
        }
        __syncthreads();
    }
#pragma unroll
    for (int i = 0; i < 4; ++i)
#pragma unroll
        for (int j = 0; j < 4; ++j) {
            const int r = row0 + ty * 4 + i, c = col0 + tx * 4 + j;
            if (r < M && c < N) ep(r, c, acc[i][j]);
        }
}

struct ALbf { const bf16_t* p; int ld; int pad; __device__ float operator()(int r, int k) const { return bf2f(p[(size_t)r * ld + k]); } };
struct ALf32 { const float* p; int ld; int pad; __device__ float operator()(int r, int k) const { return p[(size_t)r * ld + k]; } };
struct BLwin { const float* w; __device__ float operator()(int k, int n) const { return w[(size_t)k * NIN + zcol2orig(n)]; } };
struct BLplain { const float* w; int ld; int pad; __device__ float operator()(int k, int n) const { return w[(size_t)k * ld + n]; } };
struct EPz { bf16_t* z; __device__ void operator()(int r, int c, float v) const { z[(size_t)r * NZ + c] = f2bf(v); } };
struct EPf32 { float* o; int ld; int pad; __device__ void operator()(int r, int c, float v) const { o[(size_t)r * ld + c] = v; } };
struct EPmerge { const float* ya; const bf16_t* z; bf16_t* m;
    __device__ void operator()(int r, int c, float yb) const {
        const float ga = bf2f(z[(size_t)r * NZ + 2560 + c]), gb = bf2f(z[(size_t)r * NZ + 3584 + c]);
        m[(size_t)r * D + c] = f2bf(sigmoidf_(ga) * ya[(size_t)r * D + c] + sigmoidf_(gb) * yb); } };
struct EPres { const float* x; float* x1; __device__ void operator()(int r, int c, float v) const { x1[(size_t)r * D + c] = x[(size_t)r * D + c] + v; } };

__global__ void __launch_bounds__(256) k_conv(const bf16_t* __restrict__ z, const float* __restrict__ cq, const float* __restrict__ ck, bf16_t* __restrict__ qa, bf16_t* __restrict__ ka) {
    const size_t idx = (size_t)blockIdx.x * 256 + threadIdx.x;
    const int t = (int)(idx >> 9), c = (int)(idx & 511), s = t % SEQ;
    float aq = 0.f, ak = 0.f;
#pragma unroll
    for (int j = 0; j < 4; ++j) {
        const int ss = s - 3 + j;
        if (ss >= 0) {
            const size_t r = (size_t)(t - 3 + j) * NZ;
            aq += bf2f(z[r + 512 + c]) * cq[j * DM + c];
            ak += bf2f(z[r + 1024 + c]) * ck[j * DM + c];
        }
    }
    qa[idx] = f2bf(siluf_(aq));
    ka[idx] = f2bf(siluf_(ak) * 0.08838834764831845f);
}
__global__ void k_bcum(const float* __restrict__ gif, float* __restrict__ bcs) {
    const int bh = blockIdx.x * blockDim.x + threadIdx.x;
    if (bh >= BATCH * NH) return;
    const int b = bh / NH, hh = bh % NH;
    float acc = 0.f;
    for (int s = 0; s < SEQ; ++s) { acc += logsigmoidf_(gif[((size_t)b * SEQ + s) * 8 + 4 + hh]); bcs[(size_t)bh * SEQ + s] = acc; }
}
__global__ void __launch_bounds__(256) k_mlstm_naive(const bf16_t* __restrict__ qa, const bf16_t* __restrict__ ka, const bf16_t* __restrict__ z, const float* __restrict__ gif,
                                                      const float* __restrict__ bcs, const float* __restrict__ g_head, bf16_t* __restrict__ hm) {
    __shared__ float ks[32][129];
    __shared__ float vs[32][129];
    __shared__ float ws_[32];
    const int bh = blockIdx.x >> 5, qb = blockIdx.x & 31, b = bh / NH, hh = bh % NH;
    const int tid = threadIdx.x, tq = tid >> 2, part = tid & 3;
    const int t = qb * 64 + tq;
    const size_t rowq = (size_t)b * SEQ + t;
    float q[32];
#pragma unroll
    for (int j = 0; j < 32; ++j) q[j] = bf2f(qa[rowq * DM + hh * HD + part * 32 + j]);
    const float bt = bcs[(size_t)bh * SEQ + t];
    float num[32];
#pragma unroll
    for (int j = 0; j < 32; ++j) num[j] = 0.f;
    float nq = 0.f;
    for (int kb = 0; kb <= qb * 2 + 1; ++kb) {
        __syncthreads();
        for (int i = tid; i < 32 * 128; i += 256) {
            const int r = i >> 7, c = i & 127; const size_t row = (size_t)b * SEQ + kb * 32 + r;
            ks[r][c] = bf2f(ka[row * DM + hh * HD + c]);
            vs[r][c] = bf2f(z[row * NZ + 1536 + hh * HD + c]);
        }
        if (tid < 32) { const size_t row = (size_t)b * SEQ + kb * 32 + tid; ws_[tid] = gif[row * 8 + hh] - bcs[(size_t)bh * SEQ + kb * 32 + tid]; }
        __syncthreads();
        for (int s = 0; s < 32; ++s) {
            if (kb * 32 + s > t) break;
            float d = 0.f;
#pragma unroll
            for (int j = 0; j < 32; ++j) d += q[j] * ks[s][part * 32 + j];
            d += __shfl_xor(d, 1); d += __shfl_xor(d, 2);
            const float w = d * __expf(bt + ws_[s]);
            nq += w;
#pragma unroll
            for (int j = 0; j < 32; ++j) num[j] += w * vs[s][part * 32 + j];
        }
    }
    const float den = fmaxf(fabsf(nq), 1.f);
    float s1 = 0.f;
#pragma unroll
    for (int j = 0; j < 32; ++j) { num[j] /= den; s1 += num[j]; }
    s1 += __shfl_xor(s1, 1); s1 += __shfl_xor(s1, 2);
    const float mu = s1 * (1.f / HD);
    float s2 = 0.f;
#pragma unroll
    for (int j = 0; j < 32; ++j) { const float dd = num[j] - mu; s2 += dd * dd; }
    s2 += __shfl_xor(s2, 1); s2 += __shfl_xor(s2, 2);
    const float rstd = rsqrtf(s2 * (1.f / HD) + EPS);
#pragma unroll
    for (int j = 0; j < 32; ++j) {
        const int c = hh * HD + part * 32 + j;
        const float o = bf2f(z[rowq * NZ + 2048 + c]);
        hm[rowq * DM + c] = f2bf((num[j] - mu) * rstd * g_head[c] * sigmoidf_(o));
    }
}
__global__ void __launch_bounds__(256) k_pool(const bf16_t* __restrict__ z, bf16_t* __restrict__ dA) {
    const size_t idx = (size_t)blockIdx.x * 256 + threadIdx.x;
    const int t = (int)(idx >> 9), c = (int)(idx & 511), s = t % SEQ, g = c >> 7;
    const int w = 2 << g;
    const int start = max(s + 1 - w, 0), cnt = s + 1 - start;
    float acc = 0.f;
    for (int j = 0; j < cnt; ++j) acc += bf2f(z[(size_t)(t - j) * NZ + c]);
    dA[idx] = f2bf(acc / (float)cnt - bf2f(z[(size_t)t * NZ + c]));
}
__global__ void __launch_bounds__(256) k_poolmm(const bf16_t* __restrict__ dA, const float* __restrict__ w_pool, const float* __restrict__ scale, float* __restrict__ yp) {
    const size_t idx = (size_t)blockIdx.x * 256 + threadIdx.x;
    const int t = (int)(idx >> 9), j = (int)(idx & 511), g = j >> 7, jj = j & 127;
    float acc = 0.f;
    for (int c = 0; c < 128; ++c) acc += bf2f(dA[(size_t)t * DP + g * 128 + c]) * w_pool[((size_t)g * 128 + c) * 128 + jj];
    yp[idx] = acc * scale[j];
}

__global__ void __launch_bounds__(256) k_route(const float* __restrict__ x1, const float* __restrict__ g_ffn, const float* __restrict__ w_rg, const float* __restrict__ b_rg,
                                                const float* __restrict__ w_re, const float* __restrict__ b_re, float* __restrict__ rstd2, int* __restrict__ sel, float* __restrict__ gw,
                                                int* __restrict__ counts, int* __restrict__ lists) {
    const int wave = threadIdx.x >> 6, lane = threadIdx.x & 63;
    const int tok = blockIdx.x * 4 + wave;
    const float* xr = x1 + (size_t)tok * D;
    float v[16]; float s = 0.f;
#pragma unroll
    for (int j = 0; j < 16; ++j) { v[j] = xr[lane + 64 * j]; s += v[j] * v[j]; }
    s = wave_sum(s);
    const float rstd = rsqrtf(s * (1.f / D) + EPS);
    float lg[4] = {0.f, 0.f, 0.f, 0.f};
#pragma unroll
    for (int j = 0; j < 16; ++j) { const int k = lane + 64 * j; v[j] = v[j] * rstd * g_ffn[k];
#pragma unroll
        for (int o = 0; o < 4; ++o) lg[o] += v[j] * w_rg[k * NG + o]; }
#pragma unroll
    for (int o = 0; o < 4; ++o) lg[o] = wave_sum(lg[o]) + b_rg[o];
    int gs = 0; float gm = lg[0];
#pragma unroll
    for (int o = 1; o < 4; ++o) if (lg[o] > gm) { gm = lg[o]; gs = o; }
    float den = 0.f;
#pragma unroll
    for (int o = 0; o < 4; ++o) den += __expf(lg[o] - gm);
    const float pg = 1.f / den;
    float le[8];
#pragma unroll
    for (int o = 0; o < 8; ++o) le[o] = 0.f;
#pragma unroll
    for (int j = 0; j < 16; ++j) { const int k = lane + 64 * j;
#pragma unroll
        for (int o = 0; o < 8; ++o) le[o] += v[j] * w_re[k * NE + gs * EPG + o]; }
#pragma unroll
    for (int o = 0; o < 8; ++o) le[o] = wave_sum(le[o]) + b_re[gs * EPG + o];
    int i1 = 0; float m1 = le[0];
#pragma unroll
    for (int o = 1; o < 8; ++o) if (le[o] > m1) { m1 = le[o]; i1 = o; }
    int i2 = -1; float m2 = -3.0e38f;
#pragma unroll
    for (int o = 0; o < 8; ++o) if (o != i1 && le[o] > m2) { m2 = le[o]; i2 = o; }
    const float e2 = __expf(m2 - m1);
    const float p1 = 1.f / (1.f + e2), p2 = e2 / (1.f + e2);
    if (lane == 0) {
        rstd2[tok] = rstd;
        const int ea = gs * EPG + i1, eb = gs * EPG + i2;
        sel[tok * 2] = ea; sel[tok * 2 + 1] = eb;
        gw[tok * 2] = pg * p1; gw[tok * 2 + 1] = pg * p2;
        const int pa = atomicAdd(&counts[ea], 1); lists[ea * T + pa] = tok * 2;
        const int pb = atomicAdd(&counts[eb], 1); lists[eb * T + pb] = tok * 2 + 1;
    }
}
__global__ void __launch_bounds__(256) k_moe_up(const float* __restrict__ x1, const float* __restrict__ rstd2, const float* __restrict__ g_ffn, const float* __restrict__ wg, const float* __restrict__ wu,
                                                 const int* __restrict__ counts, const int* __restrict__ lists, float* __restrict__ hid) {
    const int e = blockIdx.z, rt = blockIdx.y, ct = blockIdx.x;
    const int cnt = counts[e];
    if (rt * 64 >= cnt) return;
    __shared__ float As[16][68]; __shared__ float Bg[16][68]; __shared__ float Bu[16][68];
    __shared__ int toks[64]; __shared__ float rs[64];
    const int tid = threadIdx.x, tx = tid & 15, ty = tid >> 4;
    if (tid < 64) { const int r = rt * 64 + tid; const int a = (r < cnt) ? lists[e * T + r] : -1; toks[tid] = a; rs[tid] = (a >= 0) ? rstd2[a >> 1] : 0.f; }
    __syncthreads();
    float ag[4][4], au[4][4];
#pragma unroll
    for (int i = 0; i < 4; ++i)
#pragma unroll
        for (int j = 0; j < 4; ++j) { ag[i][j] = 0.f; au[i][j] = 0.f; }
    const float* wge = wg + (size_t)e * D * DE; const float* wue = wu + (size_t)e * D * DE;
    for (int k0 = 0; k0 < D; k0 += 16) {
#pragma unroll
        for (int j = 0; j < 4; ++j) {
            const int idx = tid + j * 256; const int r = idx >> 4, kk = idx & 15;
            const int a = toks[r];
            As[kk][r] = (a >= 0) ? x1[(size_t)(a >> 1) * D + k0 + kk] * rs[r] * g_ffn[k0 + kk] : 0.f;
            const int k2 = idx >> 6, n = idx & 63;
            Bg[k2][n] = wge[(size_t)(k0 + k2) * DE + ct * 64 + n];
            Bu[k2][n] = wue[(size_t)(k0 + k2) * DE + ct * 64 + n];
        }
        __syncthreads();
#pragma unroll
        for (int kk = 0; kk < 16; ++kk) {
            float a[4], bg[4], bu[4];
#pragma unroll
            for (int i = 0; i < 4; ++i) a[i] = As[kk][ty * 4 + i];
#pragma unroll
            for (int j = 0; j < 4; ++j) { bg[j] = Bg[kk][tx * 4 + j]; bu[j] = Bu[kk][tx * 4 + j]; }
#pragma unroll
            for (int i = 0; i < 4; ++i)
#pragma unroll
                for (int j = 0; j < 4; ++j) { ag[i][j] += a[i] * bg[j]; au[i][j] += a[i] * bu[j]; }
        }
        __syncthreads();
    }
#pragma unroll
    for (int i = 0; i < 4; ++i) { const int a = toks[ty * 4 + i]; if (a < 0) continue;
#pragma unroll
        for (int j = 0; j < 4; ++j) hid[(size_t)a * DE + ct * 64 + tx * 4 + j] = siluf_(ag[i][j]) * au[i][j]; }
}
__global__ void __launch_bounds__(256) k_moe_down(const float* __restrict__ hid, const float* __restrict__ wd, const float* __restrict__ gw, const int* __restrict__ counts, const int* __restrict__ lists, bf16_t* __restrict__ yb) {
    const int e = blockIdx.z, rt = blockIdx.y, ct = blockIdx.x;
    const int cnt = counts[e];
    if (rt * 64 >= cnt) return;
    __shared__ float As[16][68]; __shared__ float Bs[16][68];
    __shared__ int toks[64];
    const int tid = threadIdx.x, tx = tid & 15, ty = tid >> 4;
    if (tid < 64) { const int r = rt * 64 + tid; toks[tid] = (r < cnt) ? lists[e * T + r] : -1; }
    __syncthreads();
    float acc[4][4];
#pragma unroll
    for (int i = 0; i < 4; ++i)
#pragma unroll
        for (int j = 0; j < 4; ++j) acc[i][j] = 0.f;
    const float* wde = wd + (size_t)e * DE * D;
    for (int k0 = 0; k0 < DE; k0 += 16) {
#pragma unroll
        for (int j = 0; j < 4; ++j) {
            const int idx = tid + j * 256; const int r = idx >> 4, kk = idx & 15;
            const int a = toks[r];
            As[kk][r] = (a >= 0) ? hid[(size_t)a * DE + k0 + kk] : 0.f;
            const int k2 = idx >> 6, n = idx & 63;
            Bs[k2][n] = wde[(size_t)(k0 + k2) * D + ct * 64 + n];
        }
        __syncthreads();
#pragma unroll
        for (int kk = 0; kk < 16; ++kk) {
            float a[4], b[4];
#pragma unroll
            for (int i = 0; i < 4; ++i) a[i] = As[kk][ty * 4 + i];
#pragma unroll
            for (int j = 0; j < 4; ++j) b[j] = Bs[kk][tx * 4 + j];
#pragma unroll
            for (int i = 0; i < 4; ++i)
#pragma unroll
                for (int j = 0; j < 4; ++j) acc[i][j] += a[i] * b[j];
        }
        __syncthreads();
    }
#pragma unroll
    for (int i = 0; i < 4; ++i) { const int a = toks[ty * 4 + i]; if (a < 0) continue; const float w = gw[a];
#pragma unroll
        for (int j = 0; j < 4; ++j) yb[(size_t)a * D + ct * 64 + tx * 4 + j] = f2bf(acc[i][j] * w); }
}
__global__ void __launch_bounds__(256) k_final(const float* __restrict__ x1, const bf16_t* __restrict__ yb, const float* __restrict__ g, float* __restrict__ out) {
    const int wave = threadIdx.x >> 6, lane = threadIdx.x & 63;
    const int tok = blockIdx.x * 4 + wave;
    float v[16]; float s = 0.f;
#pragma unroll
    for (int j = 0; j < 16; ++j) { const int k = lane + 64 * j;
        v[j] = x1[(size_t)tok * D + k] + bf2f(yb[(size_t)(tok * 2) * D + k]) + bf2f(yb[(size_t)(tok * 2 + 1) * D + k]); s += v[j] * v[j]; }
    s = wave_sum(s);
    const float rstd = rsqrtf(s * (1.f / D) + EPS);
#pragma unroll
    for (int j = 0; j < 16; ++j) { const int k = lane + 64 * j; out[(size_t)tok * D + k] = v[j] * rstd * g[k]; }
}

#define GAS __attribute__((address_space(1)))
#define LAS __attribute__((address_space(3)))
typedef short bf16x8 __attribute__((ext_vector_type(8)));
typedef float f32x4 __attribute__((ext_vector_type(4)));
typedef float f32x2 __attribute__((ext_vector_type(2)));
typedef unsigned u32x4 __attribute__((ext_vector_type(4)));
typedef unsigned u32x2 __attribute__((ext_vector_type(2)));
#define LDS_WAIT() asm volatile("s_waitcnt lgkmcnt(0)" ::: "memory")
#define VM_WAIT() asm volatile("s_waitcnt vmcnt(0)" ::: "memory")
__device__ __forceinline__ unsigned pk2(float lo, float hi) { return (unsigned)f2bf(lo) | ((unsigned)f2bf(hi) << 16); }
__device__ __forceinline__ unsigned cvt_pk_bf16(float lo, float hi) { unsigned r; asm volatile("v_cvt_pk_bf16_f32 %0, %1, %2" : "=v"(r) : "v"(lo), "v"(hi)); return r; }
__device__ __forceinline__ float u2f(unsigned u) { return __builtin_bit_cast(float, u); }
__device__ __forceinline__ float bflo(unsigned w) { return __builtin_bit_cast(float, w << 16); }
__device__ __forceinline__ float bfhi(unsigned w) { return __builtin_bit_cast(float, w & 0xffff0000u); }
__device__ __forceinline__ float fast_exp(float x) { return __builtin_amdgcn_exp2f(x * 1.4426950408889634f); }
__device__ __forceinline__ float fast_rcp(float x) { return __builtin_amdgcn_rcpf(x); }
__device__ __forceinline__ float fsigmoid(float x) { return fast_rcp(1.f + fast_exp(-x)); }

#define XB_TMO      128
#define XB_XCNT(j)  (256  + 64 * (j))
#define XB_XSUB(j)  (1280 + 64 * (j))
#define XB_XGEN(j)  (2304 + 64 * (j))
#define XB_TOP      3328
#define XB_TOPGEN   3392
#define XCD_BAR_WORDS 3456
#define XB_SPIN_CAP (1u << 18)
__device__ __forceinline__ unsigned xb_ld(unsigned* p)              { return __hip_atomic_load(p, __ATOMIC_RELAXED, __HIP_MEMORY_SCOPE_AGENT); }
__device__ __forceinline__ unsigned xb_add(unsigned* p, unsigned v) { return __hip_atomic_fetch_add(p, v, __ATOMIC_RELAXED, __HIP_MEMORY_SCOPE_AGENT); }
__device__ __forceinline__ unsigned xb_xcc_id() { return (unsigned)__builtin_amdgcn_s_getreg((3 << 11) | 20) & 0xFu; }
#define XB_SPIN(cond, bar) do { unsigned _sp = 0; while (cond) { __builtin_amdgcn_s_sleep(1); \
    if ((++_sp & 255u) == 0u) { if (xb_ld(&(bar)[XB_TMO])) break; if (_sp > XB_SPIN_CAP) { atomicAdd(&(bar)[XB_TMO], 1u); break; } } } } while (0)
struct XcdBarrier { unsigned* bar; unsigned x; volatile LAS unsigned* st; };
__device__ __forceinline__ XcdBarrier xcd_barrier_post(unsigned* bar, volatile LAS unsigned* st) {
    XcdBarrier b; b.bar = bar; b.x = xb_xcc_id(); b.st = st;
    if (threadIdx.x == 0) (void)xb_add(&bar[XB_XCNT(b.x)], 1u);
    return b;
}
__device__ __forceinline__ void xcd_barrier_complete(unsigned* bar, unsigned x, unsigned& nloc, unsigned& nx) {
    const unsigned G = gridDim.x * gridDim.y * gridDim.z;
    unsigned sum, cnt, mine, sp = 0u;
    for (;;) {
        sum = 0u; cnt = 0u; mine = 0u;
#pragma unroll
        for (unsigned j = 0; j < 16; ++j) { const unsigned c = xb_ld(&bar[XB_XCNT(j)]); sum += c; cnt += (c > 0u) ? 1u : 0u; mine = (j == x) ? c : mine; }
        if (sum == G) break;
        __builtin_amdgcn_s_sleep(1);
        if ((++sp & 255u) == 0u) { if (xb_ld(&bar[XB_TMO])) break; if (sp > XB_SPIN_CAP) { atomicAdd(&bar[XB_TMO], 1u); break; } }
    }
    nloc = mine > 0u ? mine : 1u; nx = cnt > 0u ? cnt : 1u;
}
__device__ __forceinline__ void xcd_barrier(const XcdBarrier& b) {
    asm volatile("s_waitcnt vmcnt(0)" ::: "memory");
    __syncthreads();
    if (threadIdx.x == 0) {
        unsigned* bar = b.bar;
        __builtin_amdgcn_s_waitcnt(0);
        unsigned nloc = b.st[0], nx = b.st[1];
        if (nloc == 0u) { xcd_barrier_complete(bar, b.x, nloc, nx); b.st[0] = nloc; b.st[1] = nx; }
        const unsigned old = xb_add(&bar[XB_XSUB(b.x)], 1u);
        const unsigned gen = old / nloc;
        if (old + 1u == (gen + 1u) * nloc) {
            __builtin_amdgcn_fence(__ATOMIC_RELEASE, "agent");
            asm volatile("s_waitcnt vmcnt(0)" ::: "memory");
            const unsigned og = xb_add(&bar[XB_TOP], 1u);
            const unsigned tg = og / nx;
            if (og + 1u == (tg + 1u) * nx) xb_add(&bar[XB_TOPGEN], 1u);
            else XB_SPIN(xb_ld(&bar[XB_TOPGEN]) == tg, bar);
            __builtin_amdgcn_fence(__ATOMIC_ACQUIRE, "agent");
            xb_add(&bar[XB_XGEN(b.x)], 1u);
            asm volatile("s_waitcnt vmcnt(0)" ::: "memory");
        } else {
            XB_SPIN(xb_ld(&bar[XB_XGEN(b.x)]) == gen, bar);
            __builtin_amdgcn_fence(__ATOMIC_ACQUIRE, "agent");
            asm volatile("s_waitcnt vmcnt(0)" ::: "memory");
        }
    }
    __syncthreads();
}

namespace pg8 {
constexpr int BM = 256, BK = 64, HALF = 128, HTB = HALF * BK * 2, STAGE_BYTES = 8 * HTB, NXCD = 8, WGM = 8;
__host__ __device__ __forceinline__ int lds_byte(int r, int c) { const int st = (r >> 4) * 2 + (c >> 5), rr = r & 15, cc = c & 31, ob = rr * 64 + cc * 2; return st * 1024 + (ob ^ (((ob >> 9) & 1) << 5)); }
__host__ __device__ __forceinline__ void stage_rc(int b, int& R, int& C) { const int st = b / 1024, sb = b % 1024, swz = sb ^ (((sb >> 9) & 1) << 5); R = (st >> 1) * 16 + swz / 64; C = (st & 1) * 32 + (swz % 64) / 2; }
__host__ __device__ __forceinline__ int perm32(int rho) { const int n = rho >> 4, i = rho & 15; return 8 * (i >> 2) + 4 * n + (i & 3); }

struct Unit { const char* A; const char* B; const int* rows; int pm, pn, ex, cnt; };
struct Cfg { int K; unsigned lda, ldb; };
__device__ __forceinline__ void tile_of(int L, int nM, int nN, int& pm, int& pn) {
    const int nwg = nM * nN; int wgid = L; { const int q = nwg / NXCD, r = nwg % NXCD, xcd = wgid % NXCD, off = wgid / NXCD; wgid = (xcd < r ? xcd * (q + 1) : r * (q + 1) + (xcd - r) * q) + off; }
    const int nig = WGM * nN, gid = wgid / nig, fm = gid * WGM, gsz = (nM - fm) < WGM ? (nM - fm) : WGM;
    pm = fm + ((wgid % nig) % gsz); pn = (wgid % nig) / gsz;
}

template <class Epi, class Sched, bool GATHER>
__device__ __forceinline__ void gemm_phase(LAS unsigned char* lds, const Cfg g, const Sched& S, const Epi& E) {
    const int tid = threadIdx.x, wid = __builtin_amdgcn_readfirstlane(tid >> 6), lane = tid & 63, wr = wid >> 2, wc = wid & 3, fr = lane & 15, fq = lane >> 4;
    const int nt = g.K / BK;
    unsigned voffB[2], vA[2][2], vN[2][2]; int Rr[2]; unsigned Cb[2];
#pragma unroll
    for (int i = 0; i < 2; ++i) { int R, C; stage_rc(tid * 16 + i * 8192, R, C); const int Rb = Epi::PERM ? ((R & ~31) + perm32(R & 31)) : R;
        Rr[i] = R; Cb[i] = (unsigned)C * 2u; voffB[i] = (unsigned)Rb * g.ldb + (unsigned)C * 2u;
        vA[0][i] = (unsigned)R * g.lda + (unsigned)C * 2u; vA[1][i] = (unsigned)(R + HALF) * g.lda + (unsigned)C * 2u; vN[0][i] = vA[0][i]; vN[1][i] = vA[1][i]; }
    const size_t kstep = (size_t)(BK * 2);
    const size_t hstepB = (size_t)HALF * g.ldb;
    const unsigned ldsw = (unsigned)wid * 1024u;
    const int aoff = lds_byte(wr * 64 + fr, fq * 8), boff = lds_byte(wc * 32 + fr, fq * 8);
#define PG8_SA(b, h) (((b) * 2 + (h)) * HTB)
#define PG8_SB(b, h) ((4 + (b) * 2 + (h)) * HTB)
#define PG8_STAGE(bufoff, gbase, voff) do { _Pragma("unroll") for (int _i = 0; _i < 2; ++_i) \
        __builtin_amdgcn_global_load_lds((const unsigned*)((const char*)(gbase) + (voff)[_i]), (LAS unsigned*)(lds + (bufoff) + ldsw + _i * 8192), 16, 0, 0); } while (0)
#define PG8_STAGE_AX(bufoff, gbase, h, usenext) do { unsigned _vo[2]; _vo[0] = (usenext) ? vN[h][0] : vA[h][0]; _vo[1] = (usenext) ? vN[h][1] : vA[h][1]; PG8_STAGE(bufoff, gbase, _vo); } while (0)
#define PG8_LDA(dst, b, h) do { _Pragma("unroll") for (int m = 0; m < 4; ++m) _Pragma("unroll") for (int k = 0; k < 2; ++k) dst[m][k] = *(const LAS bf16x8*)(lds + PG8_SA(b, h) + aoff + m * 2048 + k * 1024); } while (0)
#define PG8_LDB(dst, b, h) do { _Pragma("unroll") for (int n = 0; n < 2; ++n) _Pragma("unroll") for (int k = 0; k < 2; ++k) dst[n][k] = *(const LAS bf16x8*)(lds + PG8_SB(b, h) + boff + n * 2048 + k * 1024); } while (0)
#define PG8_MMA(ai, bj, At, Bt) do { __builtin_amdgcn_s_setprio(1); _Pragma("unroll") for (int m = 0; m < 4; ++m) _Pragma("unroll") for (int n = 0; n < 2; ++n) _Pragma("unroll") for (int k = 0; k < 2; ++k) \
        acc[ai][bj][m][n] = __builtin_amdgcn_mfma_f32_16x16x32_bf16(Bt[n][k], At[m][k], acc[ai][bj][m][n], 0, 0, 0); __builtin_amdgcn_s_setprio(0); } while (0)
#define PG8_WAIT_V(n) asm volatile("s_waitcnt vmcnt(" #n ")" ::: "memory")
#define PG8_WAIT_L(n) asm volatile("s_waitcnt lgkmcnt(" #n ")" ::: "memory")
#define PG8_BAR __builtin_amdgcn_s_barrier()
#define PG8_SCHED __builtin_amdgcn_sched_barrier(0)
#define PG8_GATHER_LOAD(dst, u) do { _Pragma("unroll") for (int _h = 0; _h < 2; ++_h) _Pragma("unroll") for (int _i = 0; _i < 2; ++_i) { const int _r = _h * HALF + Rr[_i]; \
        const int _a = (_r < (u).cnt) ? ((u).rows[_r] >> 1) : 0; dst[_h][_i] = (unsigned)_a * g.lda + Cb[_i]; } } while (0)
    Unit cur, nxt; int ui = 0;
    if (!S.next(0, cur)) return;
    f32x4 acc[2][2][4][2];
#pragma unroll
    for (int a = 0; a < 2; ++a)
#pragma unroll
        for (int b = 0; b < 2; ++b)
#pragma unroll
            for (int m = 0; m < 4; ++m)
#pragma unroll
                for (int n = 0; n < 2; ++n) acc[a][b][m][n] = (f32x4){0.f, 0.f, 0.f, 0.f};
    bf16x8 At[4][2], B0[2][2], B1[2][2];
    const char* cA = cur.A; const char* cB = cur.B;
    if constexpr (GATHER) { PG8_GATHER_LOAD(vA, cur); __builtin_amdgcn_s_waitcnt(0x0F70); }
    PG8_STAGE(PG8_SB(0, 0), cB, voffB); PG8_STAGE(PG8_SB(0, 1), cB + hstepB, voffB); PG8_STAGE(PG8_SA(0, 0), cA, vA[0]); PG8_STAGE(PG8_SA(0, 1), cA, vA[1]);
    if (wr == 1) PG8_BAR;
    PG8_WAIT_V(2); PG8_BAR;
    PG8_STAGE(PG8_SB(1, 0), cB + kstep, voffB); PG8_STAGE(PG8_SA(1, 0), cA + kstep, vA[0]); PG8_STAGE(PG8_SB(1, 1), cB + hstepB + kstep, voffB);
    PG8_WAIT_V(6); PG8_BAR;
    for (;;) {
        const bool has_next = S.next(ui + 1, nxt);
        const char* nA = has_next ? nxt.A : cA; const char* nB = has_next ? nxt.B : cB;
        if constexpr (GATHER) {
            if (has_next) { PG8_GATHER_LOAD(vN, nxt); __builtin_amdgcn_s_waitcnt(0x0F70); }
            else {
#pragma unroll
                for (int h = 0; h < 2; ++h)
#pragma unroll
                    for (int i = 0; i < 2; ++i) vN[h][i] = vA[h][i]; }
        }
        for (int t = 0; t < nt; t += 2) {
            const bool last = (t == nt - 2);
            const char* a1 = cA + (size_t)(t + 1) * kstep;
            const char* a2 = last ? nA : cA + (size_t)(t + 2) * kstep; const char* b2 = last ? nB : cB + (size_t)(t + 2) * kstep;
            const char* a3 = a2 + kstep; const char* b3 = b2 + kstep;
            const bool un = GATHER && last;
            PG8_LDB(B0, 0, 0); PG8_LDB(B1, 0, 1); PG8_SCHED; PG8_LDA(At, 0, 0); PG8_STAGE(PG8_SA(1, 1), a1, vA[1]);
            PG8_WAIT_V(8); PG8_WAIT_L(0); PG8_BAR; PG8_MMA(0, 0, At, B0); PG8_MMA(0, 1, At, B1); PG8_BAR; PG8_SCHED;
            PG8_LDA(At, 0, 1); PG8_STAGE(PG8_SB(0, 0), b2, voffB); PG8_STAGE(PG8_SB(0, 1), b2 + hstepB, voffB); PG8_STAGE_AX(PG8_SA(0, 0), a2, 0, un);
            PG8_WAIT_V(8); PG8_WAIT_L(0); PG8_BAR; PG8_MMA(1, 0, At, B0); PG8_MMA(1, 1, At, B1); PG8_BAR; PG8_SCHED;
            PG8_LDB(B0, 1, 0); PG8_LDB(B1, 1, 1); PG8_SCHED; PG8_LDA(At, 1, 0); PG8_STAGE_AX(PG8_SA(0, 1), a2, 1, un);
            PG8_WAIT_V(8); PG8_WAIT_L(0); PG8_BAR; PG8_MMA(0, 0, At, B0); PG8_MMA(0, 1, At, B1); PG8_BAR; PG8_SCHED;
            PG8_LDA(At, 1, 1); PG8_STAGE(PG8_SB(1, 0), b3, voffB); PG8_STAGE(PG8_SB(1, 1), b3 + hstepB, voffB); PG8_STAGE_AX(PG8_SA(1, 0), a3, 0, un);
            PG8_WAIT_V(8); PG8_WAIT_L(0); PG8_BAR; PG8_MMA(1, 0, At, B0); PG8_MMA(1, 1, At, B1); PG8_BAR; PG8_SCHED;
        }
        if (wr == 0) PG8_BAR;
        const bool keep = E(acc, cur, wr, wc, fr, fq);
        if (!has_next) break;
        if (!keep) {
#pragma unroll
        for (int a = 0; a < 2; ++a)
#pragma unroll
            for (int b = 0; b < 2; ++b)
#pragma unroll
                for (int m = 0; m < 4; ++m)
#pragma unroll
                    for (int n = 0; n < 2; ++n) acc[a][b][m][n] = (f32x4){0.f, 0.f, 0.f, 0.f};
        }
        cur = nxt; cA = nA; cB = nB; ++ui;
        if constexpr (GATHER) {
#pragma unroll
            for (int h = 0; h < 2; ++h)
#pragma unroll
                for (int i = 0; i < 2; ++i) vA[h][i] = vN[h][i]; }
        if (wr == 1) PG8_BAR;
    }
    PG8_WAIT_V(0);
    PG8_BAR;
#undef PG8_SA
#undef PG8_SB
#undef PG8_STAGE
#undef PG8_STAGE_AX
#undef PG8_LDA
#undef PG8_LDB
#undef PG8_MMA
#undef PG8_WAIT_V
#undef PG8_WAIT_L
#undef PG8_BAR
#undef PG8_SCHED
#undef PG8_GATHER_LOAD
}
}


namespace pg8 {
struct UnitM { const char* A; const char* B; const int* rows; int blk, pn, ex, cnt, type; };
template <class Sched, class Epi0, class Epi1>
__device__ __forceinline__ void gemm_phase_moe(LAS unsigned char* lds, LAS unsigned char* meta, const Sched& S, const Epi0& E0, const Epi1& E1) {
    const int tid = threadIdx.x, wid = __builtin_amdgcn_readfirstlane(tid >> 6), lane = tid & 63, wr = wid >> 2, wc = wid & 3, fr = lane & 15, fq = lane >> 4;
    unsigned vA[2][2], vN[2][2], vB[2];
    const size_t kstep = (size_t)(BK * 2);
    const unsigned ldsw = (unsigned)wid * 1024u;
    const int aoff = lds_byte(wr * 64 + fr, fq * 8), boff = lds_byte(wc * 32 + fr, fq * 8);
#define PG8_SA(b, h) (((b) * 2 + (h)) * HTB)
#define PG8_SB(b, h) ((4 + (b) * 2 + (h)) * HTB)
#define PG8_STAGE_A(bufoff, gbase, voff) do { _Pragma("unroll") for (int _i = 0; _i < 2; ++_i) \
        __builtin_amdgcn_global_load_lds((const unsigned*)((const char*)(gbase) + (voff)[_i]), (LAS unsigned*)(lds + (bufoff) + ldsw + _i * 8192), 16, 0, 16); } while (0)
#define PG8_STAGE_B(bufoff, gbase, voff) do { _Pragma("unroll") for (int _i = 0; _i < 2; ++_i) \
        __builtin_amdgcn_global_load_lds((const unsigned*)((const char*)(gbase) + (voff)[_i]), (LAS unsigned*)(lds + (bufoff) + ldsw + _i * 8192), 16, 0, 0); } while (0)
#define PG8_STAGE_AX(bufoff, gbase, h, usenext) do { unsigned _vo[2]; _vo[0] = (usenext) ? vN[h][0] : vA[h][0]; _vo[1] = (usenext) ? vN[h][1] : vA[h][1]; PG8_STAGE_A(bufoff, gbase, _vo); } while (0)
#define PG8_STAGE_BX(bufoff, gbase, usenext) do { unsigned _vo[2]; _vo[0] = (usenext) ? vBn[0] : vB[0]; _vo[1] = (usenext) ? vBn[1] : vB[1]; PG8_STAGE_B(bufoff, gbase, _vo); } while (0)
#define PG8_LDA(dst, b, h) do { _Pragma("unroll") for (int m = 0; m < 4; ++m) _Pragma("unroll") for (int k = 0; k < 2; ++k) dst[m][k] = *(const LAS bf16x8*)(lds + PG8_SA(b, h) + aoff + m * 2048 + k * 1024); } while (0)
#define PG8_LDB(dst, b, h) do { _Pragma("unroll") for (int n = 0; n < 2; ++n) _Pragma("unroll") for (int k = 0; k < 2; ++k) dst[n][k] = *(const LAS bf16x8*)(lds + PG8_SB(b, h) + boff + n * 2048 + k * 1024); } while (0)
#define PG8_MMA(ai, bj, At, Bt) do { __builtin_amdgcn_s_setprio(1); _Pragma("unroll") for (int m = 0; m < 4; ++m) _Pragma("unroll") for (int n = 0; n < 2; ++n) _Pragma("unroll") for (int k = 0; k < 2; ++k) \
        acc[ai][bj][m][n] = __builtin_amdgcn_mfma_f32_16x16x32_bf16(Bt[n][k], At[m][k], acc[ai][bj][m][n], 0, 0, 0); __builtin_amdgcn_s_setprio(0); } while (0)
#define PG8_WAIT_V(n) asm volatile("s_waitcnt vmcnt(" #n ")" ::: "memory")
#define PG8_WAIT_L(n) asm volatile("s_waitcnt lgkmcnt(" #n ")" ::: "memory")
#define PG8_BAR __builtin_amdgcn_s_barrier()
#define PG8_SCHED __builtin_amdgcn_sched_barrier(0)
#define PG8_SETUP(u, vAx, vBx) do { const unsigned _ld = (u).type ? 1024u : 2048u; \
        _Pragma("unroll") for (int _i = 0; _i < 2; ++_i) { int _R, _C; stage_rc(tid * 16 + _i * 8192, _R, _C); asm volatile("" : "+v"(_R), "+v"(_C)); const unsigned _cb = (unsigned)_C * 2u; \
            _Pragma("unroll") for (int _h = 0; _h < 2; ++_h) { const int _r = _h * HALF + _R; \
                const int _a = (u).type ? _r : ((_r < (u).cnt) ? ((u).rows[_r] >> 1) : 0); vAx[_h][_i] = (unsigned)_a * _ld + _cb; } \
            vBx[_i] = (unsigned)((_R & ~31) + perm32(_R & 31)) * _ld + _cb; } } while (0)
#define PG8_META(u, n) do { if (tid < 256) { u32x4 _mv = (u32x4){0xFFFFFFFFu, 0u, 0u, 0u}; \
        if (tid < (u).cnt) { const u32x2 _w2 = ((const u32x2*)S.rwlist)[((u).rows - S.alist) + tid]; _mv.x = (unsigned)(u).rows[tid]; _mv.y = _w2.x; _mv.z = _w2.y; } \
        *(LAS u32x4*)(meta + (((n) & 1) * 256 + tid) * 16) = _mv; } } while (0)
#define PG8_PUBLISH() do { if (pend >= 0) { if (lane == 0) __hip_atomic_fetch_add(S.ready + pend, 1u, __ATOMIC_RELAXED, __HIP_MEMORY_SCOPE_AGENT); pend = -1; } } while (0)
    int pend = -1;
    UnitM cur, nxt; int ui = 0;
    bool have = S.next(0, cur);
    f32x4 acc[2][2][4][2];
    bf16x8 At[4][2], B0[2][2], B1[2][2];
    while (have) {
#pragma unroll
        for (int a = 0; a < 2; ++a)
#pragma unroll
            for (int b = 0; b < 2; ++b)
#pragma unroll
                for (int m = 0; m < 4; ++m)
#pragma unroll
                    for (int n = 0; n < 2; ++n) acc[a][b][m][n] = (f32x4){0.f, 0.f, 0.f, 0.f};
        const char* cA = cur.A; const char* cB = cur.B; size_t hB = cur.type ? (size_t)HALF * 1024 : (size_t)HALF * 2048;
        PG8_SETUP(cur, vA, vB); PG8_META(cur, ui); __builtin_amdgcn_s_waitcnt(0x0F70); asm volatile("s_waitcnt vmcnt(0)" ::: "memory"); PG8_PUBLISH();
        if (cur.type) S.wait_ready(cur);
        PG8_STAGE_B(PG8_SB(0, 0), cB, vB); PG8_STAGE_B(PG8_SB(0, 1), cB + hB, vB); PG8_STAGE_A(PG8_SA(0, 0), cA, vA[0]); PG8_STAGE_A(PG8_SA(0, 1), cA, vA[1]);
        if (wr == 1) PG8_BAR;
        PG8_WAIT_V(2); PG8_BAR;
        PG8_STAGE_B(PG8_SB(1, 0), cB + kstep, vB); PG8_STAGE_A(PG8_SA(1, 0), cA + kstep, vA[0]); PG8_STAGE_B(PG8_SB(1, 1), cB + hB + kstep, vB);
        PG8_WAIT_V(6); PG8_BAR;
        bool has_next;
        for (;;) {
            has_next = S.next(ui + 1, nxt);
            const bool chain = has_next && nxt.type == cur.type;
            const char* nA = chain ? nxt.A : cA; const char* nB = chain ? nxt.B : cB;
            if (chain) { unsigned vBn[2]; PG8_SETUP(nxt, vN, vBn); PG8_META(nxt, ui + 1); __builtin_amdgcn_s_waitcnt(0x0F70); asm volatile("s_waitcnt vmcnt(0)" ::: "memory"); PG8_PUBLISH(); }
            else {
                if (pend >= 0) { asm volatile("s_waitcnt vmcnt(0)" ::: "memory"); PG8_PUBLISH(); }
#pragma unroll
                for (int h = 0; h < 2; ++h)
#pragma unroll
                    for (int i = 0; i < 2; ++i) vN[h][i] = vA[h][i]; }
            const int nt = cur.type ? 8 : 16;
            for (int t = 0; t < nt; t += 2) {
                const bool last = (t == nt - 2);
                if (last && chain && nxt.type) S.wait_ready(nxt);
                const char* a1 = cA + (size_t)(t + 1) * kstep;
                const char* a2 = last ? nA : cA + (size_t)(t + 2) * kstep; const char* b2 = last ? nB : cB + (size_t)(t + 2) * kstep; const size_t hB2 = hB;
                const char* a3 = a2 + kstep; const char* b3 = b2 + kstep;
                PG8_LDB(B0, 0, 0); PG8_LDB(B1, 0, 1); PG8_SCHED; PG8_LDA(At, 0, 0); PG8_STAGE_A(PG8_SA(1, 1), a1, vA[1]);
                PG8_WAIT_V(8); PG8_WAIT_L(0); PG8_BAR; PG8_MMA(0, 0, At, B0); PG8_MMA(0, 1, At, B1); PG8_BAR; PG8_SCHED;
                PG8_LDA(At, 0, 1); PG8_STAGE_B(PG8_SB(0, 0), b2, vB); PG8_STAGE_B(PG8_SB(0, 1), b2 + hB2, vB); PG8_STAGE_AX(PG8_SA(0, 0), a2, 0, last);
                PG8_WAIT_V(8); PG8_WAIT_L(0); PG8_BAR; PG8_MMA(1, 0, At, B0); PG8_MMA(1, 1, At, B1); PG8_BAR; PG8_SCHED;
                PG8_LDB(B0, 1, 0); PG8_LDB(B1, 1, 1); PG8_SCHED; PG8_LDA(At, 1, 0); PG8_STAGE_AX(PG8_SA(0, 1), a2, 1, last);
                PG8_WAIT_V(8); PG8_WAIT_L(0); PG8_BAR; PG8_MMA(0, 0, At, B0); PG8_MMA(0, 1, At, B1); PG8_BAR; PG8_SCHED;
                PG8_LDA(At, 1, 1); PG8_STAGE_B(PG8_SB(1, 0), b3, vB); PG8_STAGE_B(PG8_SB(1, 1), b3 + hB2, vB); PG8_STAGE_AX(PG8_SA(1, 0), a3, 0, last);
                PG8_WAIT_V(8); PG8_WAIT_L(0); PG8_BAR; PG8_MMA(1, 0, At, B0); PG8_MMA(1, 1, At, B1); PG8_BAR; PG8_SCHED;
            }
            if (wr == 0) PG8_BAR;
            if (cur.type == 0) { E0(acc, cur, wr, wc, fr, fq, meta + (ui & 1) * 4096); pend = cur.blk; } else E1(acc, cur, wr, wc, fr, fq, meta + (ui & 1) * 4096);
            if (!chain) break;
#pragma unroll
            for (int a = 0; a < 2; ++a)
#pragma unroll
                for (int b = 0; b < 2; ++b)
#pragma unroll
                    for (int m = 0; m < 4; ++m)
#pragma unroll
                        for (int n = 0; n < 2; ++n) acc[a][b][m][n] = (f32x4){0.f, 0.f, 0.f, 0.f};
            cur = nxt; cA = nA; cB = nB; ++ui;
#pragma unroll
            for (int h = 0; h < 2; ++h)
#pragma unroll
                for (int i = 0; i < 2; ++i) vA[h][i] = vN[h][i];
            if (wr == 1) PG8_BAR;
        }
        PG8_WAIT_V(0); PG8_PUBLISH();
        PG8_BAR;
        have = has_next; cur = nxt; ++ui;
    }
#undef PG8_SA
#undef PG8_SB
#undef PG8_STAGE_A
#undef PG8_STAGE_B
#undef PG8_STAGE_AX
#undef PG8_STAGE_BX
#undef PG8_LDA
#undef PG8_LDB
#undef PG8_MMA
#undef PG8_WAIT_V
#undef PG8_WAIT_L
#undef PG8_BAR
#undef PG8_SCHED
#undef PG8_SETUP
#undef PG8_PUBLISH
}
}

#ifndef MOE_DYN
#define MOE_DYN 1
#endif
#ifndef PROBE_PHASE
#define PROBE_PHASE -1
#endif
#define REP(k) _Pragma("nounroll") for (int _r = 0; _r < ((PROBE_PHASE == (k)) ? 2 : 1); ++_r)
constexpr int NWAVES = 8;
constexpr size_t WS_CTL = 0, CTL_ZERO_BYTES = 1 * MiB;
constexpr size_t WS_GIF = 1 * MiB;
constexpr size_t WS_NLOC = 1 * MiB + 512 * 1024;
constexpr size_t WS_SCAL = 2 * MiB;
constexpr size_t WS_GW = 2 * MiB + 256 * 1024;
constexpr size_t WS_ALIST = 4 * MiB;
constexpr size_t WS_RWLIST = 6 * MiB;
constexpr size_t WS_WR = 3 * MiB + 512 * 1024;
constexpr size_t WS_RSTD2 = 3 * MiB, WS_SEL = 3 * MiB + 256 * 1024;
constexpr size_t WS_WZ = 10 * MiB, WS_W2T = 19 * MiB, WS_WBT = 20 * MiB, WS_WOT = 21 * MiB, WS_WUP = 23 * MiB, WS_WDN = 87 * MiB;
constexpr size_t WS_Z = 119 * MiB;
constexpr size_t WS_KACT = 263 * MiB;
constexpr size_t WS_END = 279 * MiB;
constexpr size_t WS_X1 = WS_Z, WS_X1B = WS_Z + 64 * MiB, WS_HID = WS_Z + 96 * MiB;
constexpr size_t OB_H = 0, OB_C = 0, OB_DA = 32 * MiB, OB_HM = 48 * MiB, OB_MERGED = 0;
constexpr int CW_CNT = 64;
constexpr int CW_Q = 1024;
constexpr int CW_READY = 2048;
constexpr int CW_TMO = 8;
constexpr int CW_BAR = 4096;
constexpr int META_OFF = 131072 + 320 + 2048;
constexpr int TAB_CNT = 16, TAB_CUM = 48, TAB_HIST = 96, TAB_BASE = 128, TAB_Q = 160, TAB_XS = 164, TAB_BLK = 176;
constexpr int RING_OFF = 0, RING_BYTES = 131072, LDSCTL_OFF = RING_BYTES, MISC_OFF = LDSCTL_OFF + 320, LDS_BYTES = 147456;

struct Args { const float* in[21]; float* out; unsigned char* ws; int ph_lo, ph_hi, li, flags; };

struct SchedDense {
    const char* A; const char* B; size_t astep, bstep; int nM, nN, G, c, rep;
    __device__ __forceinline__ bool next(int i, pg8::Unit& u) const {
        long L = (long)i * G + c; if (L >= (long)nM * nN * rep) return false; L %= (long)nM * nN;
        int pm, pn; pg8::tile_of((int)L, nM, nN, pm, pn);
        u.pm = pm; u.pn = pn; u.ex = 0; u.cnt = 256; u.rows = nullptr; u.A = A + (size_t)pm * astep; u.B = B + (size_t)pn * bstep; return true; }
};
struct EpiZ {
    static constexpr bool PERM = true;
    bf16_t* z;
    __device__ __forceinline__ bool operator()(f32x4 (&acc)[2][2][4][2], const pg8::Unit& u, int wr, int wc, int fr, int fq) const {
        const int row0 = u.pm * 256 + wr * 64 + fr, col0 = u.pn * 256 + wc * 32 + 8 * fq;
#pragma unroll
        for (int ai = 0; ai < 2; ++ai)
#pragma unroll
            for (int m = 0; m < 4; ++m) { bf16_t* rowp = z + (size_t)(row0 + ai * 128 + m * 16) * NZ + col0;
#pragma unroll
                for (int bj = 0; bj < 2; ++bj) { const f32x4 v0 = acc[ai][bj][m][0], v1 = acc[ai][bj][m][1]; u32x4 w;
                    w.x = cvt_pk_bf16(v0[0], v0[1]); w.y = cvt_pk_bf16(v0[2], v0[3]); w.z = cvt_pk_bf16(v1[0], v1[1]); w.w = cvt_pk_bf16(v1[2], v1[3]);
                    *(u32x4*)(rowp + bj * 128) = w; } }
        return false;
    }
};

struct SchedMerge {
    const char* A0; const char* A1; const char* B0; const char* B1; int nM, nN, G, c;
    __device__ __forceinline__ bool next(int i, pg8::Unit& u) const {
        const long L = (long)(i >> 1) * G + c; if (L >= (long)nM * nN) return false;
        int pm, pn; pg8::tile_of((int)L, nM, nN, pm, pn); const int part = i & 1;
        u.pm = pm; u.pn = pn; u.ex = part; u.cnt = 256; u.rows = nullptr;
        u.A = (part ? A1 : A0) + (size_t)pm * 256 * DP * 2; u.B = (part ? B1 : B0) + (size_t)pn * 256 * DP * 2; return true; }
};
struct EpiMerge {
    static constexpr bool PERM = true;
    const bf16_t* z; bf16_t* mg;
    __device__ __forceinline__ bool operator()(f32x4 (&acc)[2][2][4][2], const pg8::Unit& u, int wr, int wc, int fr, int fq) const {
        const int row0 = u.pm * 256 + wr * 64 + fr, col0 = u.pn * 256 + wc * 32 + 8 * fq;
        if (u.ex == 0) {
#pragma unroll
            for (int ai = 0; ai < 2; ++ai)
#pragma unroll
                for (int m = 0; m < 4; ++m) { const bf16_t* zr = z + (size_t)(row0 + ai * 128 + m * 16) * NZ + col0;
#pragma unroll
                    for (int bj = 0; bj < 2; ++bj) { const u32x4 ga = *(const u32x4*)(zr + 2560 + bj * 128), gb = *(const u32x4*)(zr + 3584 + bj * 128);
                        float r[8];
#pragma unroll
                        for (int q = 0; q < 4; ++q) { const unsigned wa = ga[q], wb = gb[q];
                            r[2 * q] = (1.f + fast_exp(-bflo(wb))) * fast_rcp(1.f + fast_exp(-bflo(wa)));
                            r[2 * q + 1] = (1.f + fast_exp(-bfhi(wb))) * fast_rcp(1.f + fast_exp(-bfhi(wa))); }
#pragma unroll
                        for (int q = 0; q < 4; ++q) { acc[ai][bj][m][0][q] *= r[q]; acc[ai][bj][m][1][q] *= r[4 + q]; } } }
            return true;
        }
#pragma unroll
        for (int ai = 0; ai < 2; ++ai)
#pragma unroll
            for (int m = 0; m < 4; ++m) { const size_t row = (size_t)(row0 + ai * 128 + m * 16); const bf16_t* zr = z + row * NZ + col0; bf16_t* mr = mg + row * D + col0;
#pragma unroll
                for (int bj = 0; bj < 2; ++bj) { const u32x4 gb = *(const u32x4*)(zr + 3584 + bj * 128);
                    float sg[8];
#pragma unroll
                    for (int q = 0; q < 4; ++q) { sg[2 * q] = fsigmoid(bflo(gb[q])); sg[2 * q + 1] = fsigmoid(bfhi(gb[q])); }
                    const f32x4 v0 = acc[ai][bj][m][0], v1 = acc[ai][bj][m][1]; u32x4 w;
                    w.x = cvt_pk_bf16(v0[0] * sg[0], v0[1] * sg[1]); w.y = cvt_pk_bf16(v0[2] * sg[2], v0[3] * sg[3]);
                    w.z = cvt_pk_bf16(v1[0] * sg[4], v1[1] * sg[5]); w.w = cvt_pk_bf16(v1[2] * sg[6], v1[3] * sg[7]);
                    *(u32x4*)(mr + bj * 128) = w; } }
        return false;
    }
};
struct EpiX1 {
    static constexpr bool PERM = true;
    const float* x; bf16_t* x1b;
    __device__ __forceinline__ bool operator()(f32x4 (&acc)[2][2][4][2], const pg8::Unit& u, int wr, int wc, int fr, int fq) const {
        const int row0 = u.pm * 256 + wr * 64 + fr, col0 = u.pn * 256 + wc * 32 + 8 * fq;
#pragma unroll
        for (int ai = 0; ai < 2; ++ai)
#pragma unroll
            for (int m = 0; m < 4; ++m) { const size_t off = (size_t)(row0 + ai * 128 + m * 16) * D + col0;
#pragma unroll
                for (int bj = 0; bj < 2; ++bj) { const f32x4 x0 = *(const f32x4*)(x + off + bj * 128), x1v = *(const f32x4*)(x + off + bj * 128 + 4);
                    const f32x4 v0 = acc[ai][bj][m][0] + x0, v1 = acc[ai][bj][m][1] + x1v; u32x4 w;
                    w.x = cvt_pk_bf16(v0[0], v0[1]); w.y = cvt_pk_bf16(v0[2], v0[3]); w.z = cvt_pk_bf16(v1[0], v1[1]); w.w = cvt_pk_bf16(v1[2], v1[3]);
                    *(u32x4*)(x1b + off + bj * 128) = w; } }
        return false;
    }
};

struct SchedMoE {
    volatile LAS unsigned* M; const char* A; const char* Bw; const int* alist; size_t bstepE, bstepN, astepBlk; int G, c, gather, rep;
    __device__ __forceinline__ bool next(int i, pg8::Unit& u) const {
        int L = i * G + c; const int tot = (int)M[TAB_CUM + 32];
        if (L >= 4 * tot * rep) return false; L %= 4 * tot;
        int e = 0;
        while (e < 31 && L >= 4 * (int)M[TAB_CUM + e + 1]) ++e;
        const int cb = (int)M[TAB_CUM + e], nb = (int)M[TAB_CUM + e + 1] - cb, r = L - 4 * cb;
        int pn = r / nb, rb = r - pn * nb; int cnt = (int)M[TAB_CNT + e] - rb * 256; cnt = cnt > 256 ? 256 : cnt;
        e = __builtin_amdgcn_readfirstlane(e); pn = __builtin_amdgcn_readfirstlane(pn); rb = __builtin_amdgcn_readfirstlane(rb); cnt = __builtin_amdgcn_readfirstlane(cnt);
        const int blk = __builtin_amdgcn_readfirstlane(cb) + rb;
        u.pm = blk; u.pn = pn; u.ex = e; u.cnt = cnt; u.rows = alist + (size_t)e * T + rb * 256;
        u.A = gather ? A : A + (size_t)blk * astepBlk; u.B = Bw + (size_t)e * bstepE + (size_t)pn * bstepN; return true; }
};
struct EpiUp {
    static constexpr bool PERM = true;
    const int* alist; const f32x2* rwlist; bf16_t* hid;
    __device__ __forceinline__ bool operator()(f32x4 (&acc)[2][2][4][2], const pg8::Unit& u, int wr, int wc, int fr, int fq) const {
        const f32x2* rw = rwlist + (u.rows - alist);
        const int col0 = u.pn * 128 + wc * 32 + 8 * fq;
#pragma unroll
        for (int ai = 0; ai < 2; ++ai)
#pragma unroll
            for (int m = 0; m < 4; ++m) { const int r = ai * 128 + wr * 64 + m * 16 + fr; const float rs = (r < u.cnt) ? rw[r].x : 0.f;
                const f32x4 g0 = acc[ai][0][m][0] * rs, g1 = acc[ai][0][m][1] * rs, u0 = acc[ai][1][m][0] * rs, u1 = acc[ai][1][m][1] * rs;
                float o[8];
#pragma unroll
                for (int q = 0; q < 4; ++q) { o[q] = g0[q] * fsigmoid(g0[q]) * u0[q]; o[4 + q] = g1[q] * fsigmoid(g1[q]) * u1[q]; }
                u32x4 w; w.x = cvt_pk_bf16(o[0], o[1]); w.y = cvt_pk_bf16(o[2], o[3]); w.z = cvt_pk_bf16(o[4], o[5]); w.w = cvt_pk_bf16(o[6], o[7]);
                *(u32x4*)(hid + (size_t)(u.pm * 256 + r) * DE + col0) = w; }
        return false;
    }
};
struct EpiDown {
    static constexpr bool PERM = true;
    const int* alist; const f32x2* rwlist; bf16_t* yb;
    __device__ __forceinline__ bool operator()(f32x4 (&acc)[2][2][4][2], const pg8::Unit& u, int wr, int wc, int fr, int fq) const {
        const f32x2* rw = rwlist + (u.rows - alist);
        const int col0 = u.pn * 256 + wc * 32 + 8 * fq;
#pragma unroll
        for (int ai = 0; ai < 2; ++ai)
#pragma unroll
            for (int m = 0; m < 4; ++m) { const int r = ai * 128 + wr * 64 + m * 16 + fr;
                if (r < u.cnt) { const int a = u.rows[r]; const float w8 = rw[r].y; bf16_t* yr = yb + (size_t)a * D + col0;
#pragma unroll
                    for (int bj = 0; bj < 2; ++bj) { const f32x4 v0 = acc[ai][bj][m][0] * w8, v1 = acc[ai][bj][m][1] * w8; u32x4 w;
                        w.x = cvt_pk_bf16(v0[0], v0[1]); w.y = cvt_pk_bf16(v0[2], v0[3]); w.z = cvt_pk_bf16(v1[0], v1[1]); w.w = cvt_pk_bf16(v1[2], v1[3]);
                        *(u32x4*)(yr + bj * 128) = w; } } }
        return false;
    }
};

struct SchedMoEQ {
    volatile LAS unsigned* M; unsigned* ctl; const char* x1b; const char* hid; const char* wup; const char* wdn; const int* alist; const f32x2* rwlist; unsigned* ready; int xcc, wave, lane;
    __device__ __forceinline__ bool next(int i, pg8::UnitM& u) const {
        if (wave == 0) {
            if (lane == 0) {
                unsigned code = 0xFFFFFFFFu; int sft = (int)M[TAB_XS]; const int tot = (int)M[TAB_CUM + 32];
                while (sft < 8) { const int x = (xcc + sft) & 7; const int b0 = x * tot / 8, b1 = (x + 1) * tot / 8; const unsigned nq = (unsigned)(b1 - b0) * 4u;
                    const unsigned p = nq ? __hip_atomic_fetch_add(ctl + CW_Q + 64 * x, 1u, __ATOMIC_RELAXED, __HIP_MEMORY_SCOPE_AGENT) : 0xFFFFFFFFu;
                    if (p < 2u * nq) { code = (p < nq) ? ((unsigned)b0 * 4u + p) : (0x80000000u | ((unsigned)b0 * 4u + (p - nq))); break; }
                    ++sft; }
                M[TAB_XS] = (unsigned)sft; M[TAB_Q + (i & 1)] = code;
            }
            asm volatile("s_waitcnt lgkmcnt(0)" ::: "memory");
        }
        asm volatile("" ::: "memory"); __builtin_amdgcn_s_barrier(); asm volatile("" ::: "memory");
        const unsigned code = (unsigned)__builtin_amdgcn_readfirstlane((int)M[TAB_Q + (i & 1)]);
        if (code == 0xFFFFFFFFu) return false;
        const int type = (int)(code >> 31), L = (int)(code & 0x7FFFFFFFu), blk = L >> 2, pn = L & 3;
        const int e = __builtin_amdgcn_readfirstlane((int)M[TAB_BLK + blk]);
        const int rb = blk - __builtin_amdgcn_readfirstlane((int)M[TAB_CUM + e]); int cnt = __builtin_amdgcn_readfirstlane((int)M[TAB_CNT + e]) - rb * 256; cnt = cnt > 256 ? 256 : cnt;
        u.blk = blk; u.pn = pn; u.ex = e; u.cnt = cnt; u.type = type; u.rows = alist + (size_t)e * T + rb * 256;
        if (type == 0) { u.A = x1b; u.B = wup + ((size_t)e * 1024 + pn * 256) * (D * 2); }
        else { u.A = hid + (size_t)blk * 256 * (DE * 2); u.B = wdn + ((size_t)e * 1024 + pn * 256) * (DE * 2); }
        return true;
    }
    __device__ __forceinline__ void wait_ready(const pg8::UnitM& u) const {
        unsigned spins = 0;
        while ((unsigned)__builtin_amdgcn_readfirstlane((int)__hip_atomic_load(ctl + CW_READY + u.blk, __ATOMIC_RELAXED, __HIP_MEMORY_SCOPE_AGENT)) < 32u) {
            __builtin_amdgcn_s_sleep(2);
            if (++spins > (1u << 22)) { if (lane == 0) __hip_atomic_store(ctl + CW_TMO, 1u, __ATOMIC_RELAXED, __HIP_MEMORY_SCOPE_AGENT); break; } }
    }
};
struct EpiUpQ {
    bf16_t* hid;
    __device__ __forceinline__ void operator()(f32x4 (&acc)[2][2][4][2], const pg8::UnitM& u, int wr, int wc, int fr, int fq, const LAS unsigned char* meta) const {
        const __amdgpu_buffer_rsrc_t rs = __builtin_amdgcn_make_buffer_rsrc(hid, 0, 40960 * DE * 2, 0x00020000);
        const int col0 = u.pn * 128 + wc * 32 + 8 * fq;
#pragma unroll
        for (int ai = 0; ai < 2; ++ai)
#pragma unroll
            for (int m = 0; m < 4; ++m) { const int r = ai * 128 + wr * 64 + m * 16 + fr; const unsigned rbits = ((const LAS unsigned*)meta)[4 * r + 1]; const float rsd = u2f(rbits);
                const f32x4 g0 = acc[ai][0][m][0] * rsd, g1 = acc[ai][0][m][1] * rsd, u0 = acc[ai][1][m][0] * rsd, u1 = acc[ai][1][m][1] * rsd;
                float o[8];
#pragma unroll
                for (int q = 0; q < 4; ++q) { o[q] = g0[q] * fsigmoid(g0[q]) * u0[q]; o[4 + q] = g1[q] * fsigmoid(g1[q]) * u1[q]; }
                u32x4 w; w.x = cvt_pk_bf16(o[0], o[1]); w.y = cvt_pk_bf16(o[2], o[3]); w.z = cvt_pk_bf16(o[4], o[5]); w.w = cvt_pk_bf16(o[6], o[7]);
                __builtin_amdgcn_raw_buffer_store_b128(w, rs, (int)(((unsigned)(u.blk * 256 + r) * DE + col0) * 2u), 0, 16);
                if (m & 1) asm volatile("" ::: "memory"); }
    }
};
struct EpiDownQ {
    bf16_t* yb;
    __device__ __forceinline__ void operator()(f32x4 (&acc)[2][2][4][2], const pg8::UnitM& u, int wr, int wc, int fr, int fq, const LAS unsigned char* meta) const {
        const int col0 = u.pn * 256 + wc * 32 + 8 * fq;
#pragma unroll
        for (int ai = 0; ai < 2; ++ai)
#pragma unroll
            for (int m = 0; m < 4; ++m) { const int r = ai * 128 + wr * 64 + m * 16 + fr; const unsigned abits = ((const LAS unsigned*)meta)[4 * r], wbits = ((const LAS unsigned*)meta)[4 * r + 2];
                if ((int)abits >= 0) { const float w8 = u2f(wbits); bf16_t* yr = yb + (size_t)abits * D + col0;
#pragma unroll
                    for (int bj = 0; bj < 2; ++bj) { const f32x4 v0 = acc[ai][bj][m][0] * w8, v1 = acc[ai][bj][m][1] * w8; u32x4 w;
                        w.x = cvt_pk_bf16(v0[0], v0[1]); w.y = cvt_pk_bf16(v0[2], v0[3]); w.z = cvt_pk_bf16(v1[0], v1[1]); w.w = cvt_pk_bf16(v1[2], v1[3]);
                        *(u32x4*)(yr + bj * 128) = w; } } }
    }
};

__device__ __forceinline__ void p7_route(const Args& a, LAS unsigned char* lds, volatile LAS unsigned* MISC, int tid, int lane, int wave, int vcu, int G) {
    const float* b_rg = a.in[14]; const float* b_re = a.in[16];
    unsigned char* ws = a.ws;
    const bf16_t* x1b = (const bf16_t*)(ws + WS_X1B);
    int* alist = (int*)(ws + WS_ALIST); f32x2* rwlist = (f32x2*)(ws + WS_RWLIST); unsigned* counts = (unsigned*)(ws + WS_CTL) + CW_CNT;
    float* rstd2 = (float*)(ws + WS_RSTD2); float* gwd = (float*)(ws + WS_GW);
    { u32x4 t[12];
#pragma unroll
      for (int i = 0; i < 12; ++i) t[i] = *(const u32x4*)(ws + WS_WR + (size_t)(tid + i * 512) * 16);
#pragma unroll
      for (int i = 0; i < 12; ++i) *(LAS u32x4*)(lds + (tid + i * 512) * 16) = t[i]; }
    if (tid < 32) MISC[TAB_HIST + tid] = 0u;
    __syncthreads();
    LAS float* lgs = (LAS float*)(lds + 98304 + wave * 4096);
    for (int tile = vcu; tile < T / 64; tile += G) {
        int e1 = 0, e2 = 0, lp1 = 0, lp2 = 0; float gw1 = 0.f, gw2 = 0.f, rstd_t = 0.f;
        const int tok0 = tile * 64 + wave * 16;
        if (wave < 4) {
            const int row = lane & 15, kg = lane >> 4;
            const bf16_t* xbp = x1b + (size_t)(tok0 + row) * D + 8 * kg;
            f32x4 acc[3]; acc[0] = (f32x4){0.f, 0.f, 0.f, 0.f}; acc[1] = acc[0]; acc[2] = acc[0];
            float ss = 0.f;
#pragma unroll 8
            for (int s = 0; s < 32; ++s) {
                const u32x4 w = *(const u32x4*)(xbp + 32 * s);
#pragma unroll
                for (int q = 0; q < 4; ++q) { const float lo = bflo(w[q]), hi = bfhi(w[q]); ss += lo * lo + hi * hi; }
                const bf16x8 af = __builtin_bit_cast(bf16x8, w);
#pragma unroll
                for (int j = 0; j < 3; ++j) { const bf16x8 bfr = *(const LAS bf16x8*)(lds + (16 * j + row) * 2048 + (((4 * s + kg) ^ row) << 4));
                    acc[j] = __builtin_amdgcn_mfma_f32_16x16x32_bf16(af, bfr, acc[j], 0, 0, 0); }
            }
            ss += __shfl_xor(ss, 16); ss += __shfl_xor(ss, 32);
            const float rstd = rsqrtf(ss * (1.f / D) + EPS);
#pragma unroll
            for (int j = 0; j < 3; ++j)
#pragma unroll
                for (int q = 0; q < 4; ++q) lgs[(4 * kg + q) * 48 + 16 * j + row] = acc[j][q];
            if (lane < 16) lgs[768 + lane] = rstd;
            LDS_WAIT(); asm volatile("" ::: "memory");
            if (lane < 16) {
                rstd_t = lgs[768 + lane];
                const LAS float* lr = lgs + lane * 48;
                float lg[4];
#pragma unroll
                for (int o = 0; o < 4; ++o) lg[o] = lr[o] * rstd_t + b_rg[o];
                int gs = 0; float gm = lg[0];
#pragma unroll
                for (int o = 1; o < 4; ++o) if (lg[o] > gm) { gm = lg[o]; gs = o; }
                float den = 0.f;
#pragma unroll
                for (int o = 0; o < 4; ++o) den += __expf(lg[o] - gm);
                const float pg = 1.f / den;
                float le[8];
#pragma unroll
                for (int o = 0; o < 8; ++o) le[o] = lr[4 + gs * 8 + o] * rstd_t + b_re[gs * 8 + o];
                int i1 = 0; float m1 = le[0];
#pragma unroll
                for (int o = 1; o < 8; ++o) if (le[o] > m1) { m1 = le[o]; i1 = o; }
                int i2 = 0; float m2 = -3.0e38f;
#pragma unroll
                for (int o = 0; o < 8; ++o) if (o != i1 && le[o] > m2) { m2 = le[o]; i2 = o; }
                const float ex2 = __expf(m2 - m1), inv = 1.f / (1.f + ex2);
                e1 = gs * 8 + i1; e2 = gs * 8 + i2; gw1 = pg * inv; gw2 = pg * ex2 * inv;
                lp1 = (int)__hip_atomic_fetch_add((LAS unsigned*)&MISC[TAB_HIST + e1], 1u, __ATOMIC_RELAXED, __HIP_MEMORY_SCOPE_WORKGROUP);
                lp2 = (int)__hip_atomic_fetch_add((LAS unsigned*)&MISC[TAB_HIST + e2], 1u, __ATOMIC_RELAXED, __HIP_MEMORY_SCOPE_WORKGROUP);
            }
        }
        __syncthreads();
        if (tid < 32) { const unsigned hc = MISC[TAB_HIST + tid]; MISC[TAB_BASE + tid] = hc ? __hip_atomic_fetch_add(counts + tid, hc, __ATOMIC_RELAXED, __HIP_MEMORY_SCOPE_AGENT) : 0u; MISC[TAB_HIST + tid] = 0u; }
        __syncthreads();
        if (wave < 4 && lane < 16) {
            const int tok = tok0 + lane;
            const int p1 = (int)MISC[TAB_BASE + e1] + lp1, p2 = (int)MISC[TAB_BASE + e2] + lp2;
            alist[(size_t)e1 * T + p1] = tok * 2; rwlist[(size_t)e1 * T + p1] = (f32x2){rstd_t, gw1};
            alist[(size_t)e2 * T + p2] = tok * 2 + 1; rwlist[(size_t)e2 * T + p2] = (f32x2){rstd_t, gw2};
            rstd2[tok] = rstd_t; gwd[tok * 2] = gw1; gwd[tok * 2 + 1] = gw2;
        }
        __syncthreads();
    }
}
__device__ __forceinline__ void moe_tables(unsigned* counts, volatile LAS unsigned* MISC, int tid) {
    if (tid == 0) { unsigned cum = 0;
        for (int e = 0; e < 32; ++e) { const unsigned c = __hip_atomic_load(counts + e, __ATOMIC_RELAXED, __HIP_MEMORY_SCOPE_AGENT); MISC[TAB_CNT + e] = c; MISC[TAB_CUM + e] = cum; const unsigned nb = (c + 255u) >> 8;
            for (unsigned b = 0; b < nb; ++b) MISC[TAB_BLK + cum + b] = (unsigned)e; cum += nb; }
        MISC[TAB_CUM + 32] = cum; MISC[TAB_XS] = 0u; }
    __syncthreads();
}
__device__ __forceinline__ void p10_final(const Args& a, int lane, int wave, int vcu, int G) {
    const bf16_t* x1b = (const bf16_t*)(a.ws + WS_X1B); const float* gf = a.in[20];
    const int gw = vcu * NWAVES + wave, NGW = G * NWAVES;
    f32x4 gv[4];
#pragma unroll
    for (int j = 0; j < 4; ++j) gv[j] = *(const f32x4*)(gf + 4 * lane + 256 * j);
    u32x2 xn[4], pn[4], qn[4];
    if (gw < T) {
#pragma unroll
        for (int j = 0; j < 4; ++j) { xn[j] = ((const u32x2*)(x1b + (size_t)gw * D) + lane)[64 * j]; pn[j] = ((const u32x2*)(a.out + (size_t)gw * D) + lane)[64 * j]; qn[j] = ((const u32x2*)(a.out + (size_t)gw * D + 512) + lane)[64 * j]; } }
    for (int t = gw; t < T; t += NGW) {
        float* orow = a.out + (size_t)t * D;
        f32x4 v[4]; float s = 0.f;
#pragma unroll
        for (int j = 0; j < 4; ++j) { const u32x2 xv = xn[j], p = pn[j], q = qn[j];
            v[j].x = bflo(xv.x) + bflo(p.x) + bflo(q.x); v[j].y = bfhi(xv.x) + bfhi(p.x) + bfhi(q.x); v[j].z = bflo(xv.y) + bflo(p.y) + bflo(q.y); v[j].w = bfhi(xv.y) + bfhi(p.y) + bfhi(q.y);
            s += (v[j].x * v[j].x + v[j].y * v[j].y) + (v[j].z * v[j].z + v[j].w * v[j].w); }
        if (t + NGW < T) { const size_t tn = (size_t)(t + NGW);
#pragma unroll
            for (int j = 0; j < 4; ++j) { xn[j] = ((const u32x2*)(x1b + tn * D) + lane)[64 * j]; pn[j] = ((const u32x2*)(a.out + tn * D) + lane)[64 * j]; qn[j] = ((const u32x2*)(a.out + tn * D + 512) + lane)[64 * j]; } }
        s = wave_sum(s);
        const float rstd = rsqrtf(s * (1.f / D) + EPS);
#pragma unroll
        for (int j = 0; j < 4; ++j) ((f32x4*)orow)[lane + 64 * j] = v[j] * rstd * gv[j];
    }
}

typedef short v4i16_t __attribute__((ext_vector_type(4)));
__device__ __forceinline__ int img_off(int row, int ch) { return 2048 * (row >> 3) + 512 * (ch >> 2) + 64 * (row & 7) + 16 * ((ch & 3) ^ ((row >> 2) & 3)); }
__device__ __forceinline__ v4i16_t tr_read(LAS unsigned char* p) { return __builtin_amdgcn_ds_read_tr16_b64_v4i16((LAS v4i16_t*)p); }
__device__ __forceinline__ bf16x8 tr_frag(LAS unsigned char* img, int r0, int r1, int c0, int lane) {
    const int li = lane & 15, q = li >> 2, p = li & 3;
    const v4i16_t lo = tr_read(img + img_off(r0 + q, c0 + (p >> 1)) + 8 * (p & 1)), hi = tr_read(img + img_off(r1 + q, c0 + (p >> 1)) + 8 * (p & 1));
    return (bf16x8){lo[0], lo[1], lo[2], lo[3], hi[0], hi[1], hi[2], hi[3]};
}
__device__ __forceinline__ float wave_prefix_sum(float v, int lane) {
#pragma unroll
    for (int d = 1; d < 64; d <<= 1) { const float o = __shfl_up(v, d); if (lane >= d) v += o; }
    return v;
}
__device__ __forceinline__ float wave_prefix_max(float v, int lane) {
#pragma unroll
    for (int d = 1; d < 64; d <<= 1) { const float o = __shfl_up(v, d); if (lane >= d) v = fmaxf(v, o); }
    return v;
}
__device__ __forceinline__ float wave_max(float v) {
#pragma unroll
    for (int o = 1; o < 64; o <<= 1) v = fmaxf(v, __shfl_xor(v, o));
    return v;
}
constexpr int HALF_LDS = 50176;
__device__ __forceinline__ void conv4_silu(const u32x4 (&raw)[7], const float (&cw)[4][8], float scale, float (&out)[4][8]) {
#pragma unroll
    for (int i = 0; i < 4; ++i)
#pragma unroll
        for (int q = 0; q < 4; ++q) { float a0 = 0.f, a1 = 0.f;
#pragma unroll
            for (int j = 0; j < 4; ++j) { const unsigned w = raw[i + j][q]; a0 += bflo(w) * cw[j][2 * q]; a1 += bfhi(w) * cw[j][2 * q + 1]; }
            out[i][2 * q] = a0 * fsigmoid(a0) * scale; out[i][2 * q + 1] = a1 * fsigmoid(a1) * scale; }
}
__device__ __forceinline__ void b1_item(const Args& a, LAS unsigned char* hl, int item, int tl, int wv, int lane) {
    unsigned char* ws = a.ws; const bf16_t* z = (const bf16_t*)(ws + WS_Z); const float* gif = (const float*)(ws + WS_GIF); const float* conv_k = a.in[5];
    bf16_t* kact = (bf16_t*)(ws + WS_KACT); float* nloc = (float*)(ws + WS_NLOC); float* scal = (float*)(ws + WS_SCAL);
    unsigned char* Cb = (unsigned char*)a.out + OB_C + (size_t)item * 32768;
    const int bh = item >> 5, c = item & 31, b = bh >> 2, hh = bh & 3;
    const size_t tok_base = (size_t)b * SEQ + c * 64;
    const int cc = tl & 15, tg = tl >> 4, t0 = 4 * tg;
    u32x4 kr[7], vr[4];
#pragma unroll
    for (int j = 0; j < 7; ++j) { const int t = t0 - 3 + j; kr[j] = (c * 64 + t >= 0) ? *(const u32x4*)(z + (tok_base + t) * NZ + 1024 + hh * 128 + cc * 8) : (u32x4){0u, 0u, 0u, 0u}; }
#pragma unroll
    for (int i = 0; i < 4; ++i) vr[i] = *(const u32x4*)(z + (tok_base + t0 + i) * NZ + 1536 + hh * 128 + cc * 8);
    float cw[4][8];
#pragma unroll
    for (int j = 0; j < 4; ++j) { const f32x4 w0 = *(const f32x4*)(conv_k + j * DM + hh * 128 + cc * 8), w1 = *(const f32x4*)(conv_k + j * DM + hh * 128 + cc * 8 + 4);
        cw[j][0] = w0.x; cw[j][1] = w0.y; cw[j][2] = w0.z; cw[j][3] = w0.w; cw[j][4] = w1.x; cw[j][5] = w1.y; cw[j][6] = w1.z; cw[j][7] = w1.w; }
    LAS float* sc = (LAS float*)(hl + 49152);
    if (wv == 0) {
        const size_t tok = tok_base + lane;
        const float ig = gif[tok * 8 + hh], fp = gif[tok * 8 + 4 + hh];
        const float bb = wave_prefix_sum(logsigmoidf_(fp), lane);
        const float blast = __shfl(bb, 63);
        const float alog = blast - bb + ig;
        const float amax = wave_max(alog);
        sc[lane] = __expf(alog - amax);
        if (lane == 0) { scal[item] = amax; scal[1024 + item] = blast; }
    }
#pragma unroll
    for (int i = 0; i < 4; ++i) *(LAS u32x4*)(hl + 16384 + img_off(t0 + i, cc)) = vr[i];
    __syncthreads();
    {
        float ka[4][8]; conv4_silu(kr, cw, 0.08838834764831845f, ka);
#pragma unroll
        for (int i = 0; i < 4; ++i) { const float wl = sc[t0 + i];
            u32x4 w; w.x = pk2(ka[i][0], ka[i][1]); w.y = pk2(ka[i][2], ka[i][3]); w.z = pk2(ka[i][4], ka[i][5]); w.w = pk2(ka[i][6], ka[i][7]);
            *(u32x4*)(kact + (tok_base + t0 + i) * DM + hh * 128 + cc * 8) = w;
            u32x4 x; x.x = pk2(ka[i][0] * wl, ka[i][1] * wl); x.y = pk2(ka[i][2] * wl, ka[i][3] * wl); x.z = pk2(ka[i][4] * wl, ka[i][5] * wl); x.w = pk2(ka[i][6] * wl, ka[i][7] * wl);
            *(LAS u32x4*)(hl + img_off(t0 + i, cc)) = x; }
    }
    __syncthreads();
    {
        const int g = lane >> 4;
        bf16x8 af[2][2];
#pragma unroll
        for (int ii = 0; ii < 2; ++ii)
#pragma unroll
            for (int ks = 0; ks < 2; ++ks) af[ii][ks] = tr_frag(hl, 32 * ks + 8 * g, 32 * ks + 8 * g + 4, 2 * (2 * wv + ii), lane);
        const bf16x8 ones = (bf16x8){0x3F80, 0x3F80, 0x3F80, 0x3F80, 0x3F80, 0x3F80, 0x3F80, 0x3F80};
        f32x4 accn[2];
#pragma unroll
        for (int ii = 0; ii < 2; ++ii) { accn[ii] = (f32x4){0.f, 0.f, 0.f, 0.f};
#pragma unroll
            for (int ks = 0; ks < 2; ++ks) accn[ii] = __builtin_amdgcn_mfma_f32_16x16x32_bf16(af[ii][ks], ones, accn[ii], 0, 0, 0); }
#pragma unroll
        for (int j = 0; j < 8; ++j) {
            f32x4 acc0 = (f32x4){0.f, 0.f, 0.f, 0.f}, acc1 = acc0;
#pragma unroll
            for (int ks = 0; ks < 2; ++ks) { const bf16x8 bfv = tr_frag(hl + 16384, 32 * ks + 8 * g, 32 * ks + 8 * g + 4, 2 * j, lane);
                acc0 = __builtin_amdgcn_mfma_f32_16x16x32_bf16(af[0][ks], bfv, acc0, 0, 0, 0); acc1 = __builtin_amdgcn_mfma_f32_16x16x32_bf16(af[1][ks], bfv, acc1, 0, 0, 0); }
            u32x4 w; w.x = pk2(acc0[0], acc0[1]); w.y = pk2(acc0[2], acc0[3]); w.z = pk2(acc1[0], acc1[1]); w.w = pk2(acc1[2], acc1[3]);
            *(u32x4*)(Cb + ((size_t)((wv * 8 + j) * 64 + lane) << 4)) = w;
        }
        if ((lane & 15) == 0) {
#pragma unroll
            for (int ii = 0; ii < 2; ++ii) *(f32x4*)(nloc + (size_t)item * 128 + 16 * (2 * wv + ii) + 4 * g) = accn[ii]; }
    }
    __syncthreads();
}
__device__ __forceinline__ void pool_pass(const Args& a, int tid, int vcu, int G) {
    const bf16_t* z = (const bf16_t*)(a.ws + WS_Z); bf16_t* dA = (bf16_t*)((unsigned char*)a.out + OB_DA);
    for (int w = vcu * (NWAVES * 64) + tid; w < (T / 8) * 64; w += G * NWAVES * 64) {
        const int cc = w & 63, run = w >> 6, tokA = run * 8, s0 = tokA % SEQ, grp = cc >> 4, win = 2 << grp;
        const bf16_t* zp = z + (size_t)tokA * NZ + cc * 8;
        float S[8];
#pragma unroll
        for (int q = 0; q < 8; ++q) S[q] = 0.f;
        for (int j = 1; j <= win; ++j) if (s0 - j >= 0) { const u32x4 r = *(const u32x4*)(zp - (size_t)j * NZ);
#pragma unroll
            for (int q = 0; q < 4; ++q) { S[2 * q] += bflo(r[q]); S[2 * q + 1] += bfhi(r[q]); } }
#pragma unroll
        for (int i = 0; i < 8; ++i) {
            const int s = s0 + i; const u32x4 r = *(const u32x4*)(zp + (size_t)i * NZ);
            float cur[8];
#pragma unroll
            for (int q = 0; q < 4; ++q) { cur[2 * q] = bflo(r[q]); cur[2 * q + 1] = bfhi(r[q]); S[2 * q] += cur[2 * q]; S[2 * q + 1] += cur[2 * q + 1]; }
            if (s - win >= 0) { const u32x4 o = *(const u32x4*)(zp + (size_t)(i - win) * NZ);
#pragma unroll
                for (int q = 0; q < 4; ++q) { S[2 * q] -= bflo(o[q]); S[2 * q + 1] -= bfhi(o[q]); } }
            const float inv = 1.f / (float)(s + 1 < win ? s + 1 : win);
            u32x4 w4;
#pragma unroll
            for (int q = 0; q < 4; ++q) w4[q] = pk2(S[2 * q] * inv - cur[2 * q], S[2 * q + 1] * inv - cur[2 * q + 1]);
            *(u32x4*)(dA + (size_t)(tokA + i) * DP + cc * 8) = w4;
        }
    }
}
__device__ __forceinline__ void p3_scan(const Args& a, int tid, int vcu, int G) {
    float* scal = (float*)(a.ws + WS_SCAL); float* nloc = (float*)(a.ws + WS_NLOC);
    for (int w = vcu; w < 256; w += G) {
        const int bh = w >> 3, part = w & 7;
        unsigned char* Cp = (unsigned char*)a.out + OB_C + (size_t)bh * 32 * 32768 + (size_t)(part * 512 + tid) * 8;
        u32x2 ld[32];
#pragma unroll
        for (int c = 0; c < 32; ++c) ld[c] = *(const u32x2*)(Cp + (size_t)c * 32768);
        const bool do_n = (part == 0 && tid < 128);
        float nl[32];
        if (do_n) {
#pragma unroll
            for (int c = 0; c < 32; ++c) nl[c] = nloc[(size_t)(bh * 32 + c) * 128 + tid]; }
        float st[4] = {0.f, 0.f, 0.f, 0.f}; float m = 0.f, nst = 0.f;
#pragma unroll
        for (int c = 0; c < 32; ++c) {
            const float am = scal[bh * 32 + c], bl = scal[1024 + bh * 32 + c];
            const float mn = fmaxf(bl + m, am), sp = __expf(bl + m - mn), sl = __expf(am - mn);
            u32x2 o; o.x = pk2(st[0], st[1]); o.y = pk2(st[2], st[3]); *(u32x2*)(Cp + (size_t)c * 32768) = o;
            st[0] = sp * st[0] + sl * bflo(ld[c].x); st[1] = sp * st[1] + sl * bfhi(ld[c].x); st[2] = sp * st[2] + sl * bflo(ld[c].y); st[3] = sp * st[3] + sl * bfhi(ld[c].y);
            if (do_n) { nloc[(size_t)(bh * 32 + c) * 128 + tid] = nst; nst = sp * nst + sl * nl[c]; }
            if (part == 0 && tid == 0) scal[2048 + bh * 32 + c] = m;
            m = mn;
        }
    }
}
__device__ __forceinline__ void b3_item(const Args& a, LAS unsigned char* hl, int item, int tl, int wv, int lane) {
    unsigned char* ws = a.ws; const bf16_t* z = (const bf16_t*)(ws + WS_Z); const float* gif = (const float*)(ws + WS_GIF); const float* conv_q = a.in[4]; const float* g_head = a.in[6];
    const bf16_t* kact = (const bf16_t*)(ws + WS_KACT); const float* nprev = (const float*)(ws + WS_NLOC) + (size_t)item * 128; const float* scal = (const float*)(ws + WS_SCAL);
    const unsigned char* Cb = (const unsigned char*)a.out + OB_C + (size_t)item * 32768; bf16_t* hm = (bf16_t*)((unsigned char*)a.out + OB_HM);
    const int bh = item >> 5, c = item & 31, b = bh >> 2, hh = bh & 3;
    const size_t tok_base = (size_t)b * SEQ + c * 64;
    const int cc = tl & 15, tg = tl >> 4, t0 = 4 * tg;
    LAS unsigned char* qi = hl; LAS unsigned char* ki = hl + 16384; LAS unsigned char* vi = hl + 32768; LAS float* sc = (LAS float*)(hl + 49152);
    const float mprev = scal[2048 + item];
    {
        u32x4 qr[7], kv[4], vr[4];
#pragma unroll
        for (int j = 0; j < 7; ++j) { const int t = t0 - 3 + j; qr[j] = (c * 64 + t >= 0) ? *(const u32x4*)(z + (tok_base + t) * NZ + 512 + hh * 128 + cc * 8) : (u32x4){0u, 0u, 0u, 0u}; }
#pragma unroll
        for (int i = 0; i < 4; ++i) { kv[i] = *(const u32x4*)(kact + (tok_base + t0 + i) * DM + hh * 128 + cc * 8); vr[i] = *(const u32x4*)(z + (tok_base + t0 + i) * NZ + 1536 + hh * 128 + cc * 8); }
        float cw[4][8];
#pragma unroll
        for (int j = 0; j < 4; ++j) { const f32x4 w0 = *(const f32x4*)(conv_q + j * DM + hh * 128 + cc * 8), w1 = *(const f32x4*)(conv_q + j * DM + hh * 128 + cc * 8 + 4);
            cw[j][0] = w0.x; cw[j][1] = w0.y; cw[j][2] = w0.z; cw[j][3] = w0.w; cw[j][4] = w1.x; cw[j][5] = w1.y; cw[j][6] = w1.z; cw[j][7] = w1.w; }
        if (wv == 0) {
            const size_t tok = tok_base + lane;
            const float ig = gif[tok * 8 + hh], fp = gif[tok * 8 + 4 + hh];
            const float bb = wave_prefix_sum(logsigmoidf_(fp), lane);
            const float gg = ig - bb;
            const float M = fmaxf(mprev, wave_prefix_max(gg, lane));
            sc[lane] = gg; sc[64 + lane] = M; sc[128 + lane] = bb;
        }
        float qa[4][8]; conv4_silu(qr, cw, 1.f, qa);
#pragma unroll
        for (int i = 0; i < 4; ++i) { u32x4 w; w.x = pk2(qa[i][0], qa[i][1]); w.y = pk2(qa[i][2], qa[i][3]); w.z = pk2(qa[i][4], qa[i][5]); w.w = pk2(qa[i][6], qa[i][7]);
            *(LAS u32x4*)(qi + img_off(t0 + i, cc)) = w; *(LAS u32x4*)(ki + img_off(t0 + i, cc)) = kv[i]; *(LAS u32x4*)(vi + img_off(t0 + i, cc)) = vr[i]; }
    }
    __syncthreads();
    {
        const int jt = wv, li = lane & 15, g = lane >> 4, trow = 16 * jt + li;
        bf16x8 qn[4];
#pragma unroll
        for (int ks = 0; ks < 4; ++ks) qn[ks] = *(const LAS bf16x8*)(qi + img_off(trow, 4 * ks + g));
        f32x4 accs[4];
#pragma unroll
        for (int i = 0; i < 4; ++i) { accs[i] = (f32x4){0.f, 0.f, 0.f, 0.f};
            if (i <= jt) {
#pragma unroll
                for (int ks = 0; ks < 4; ++ks) { const bf16x8 kf = *(const LAS bf16x8*)(ki + img_off(16 * i + li, 4 * ks + g)); accs[i] = __builtin_amdgcn_mfma_f32_16x16x32_bf16(kf, qn[ks], accs[i], 0, 0, 0); } } }
        const float Mt = sc[64 + trow], bt = sc[128 + trow];
        float rsum = 0.f;
#pragma unroll
        for (int i = 0; i < 4; ++i) { if (i <= jt) { const f32x4 gsv = *(const LAS f32x4*)(sc + 16 * i + 4 * g);
#pragma unroll
                for (int q = 0; q < 4; ++q) { float p = accs[i][q] * __expf(gsv[q] - Mt); if (i == jt && 4 * g + q > li) p = 0.f; accs[i][q] = p; rsum += p; } } }
        rsum += __shfl_xor(rsum, 16); rsum += __shfl_xor(rsum, 32);
        bf16x8 pf[2];
#pragma unroll
        for (int u = 0; u < 2; ++u) { u32x4 w; w.x = pk2(accs[2 * u][0], accs[2 * u][1]); w.y = pk2(accs[2 * u][2], accs[2 * u][3]); w.z = pk2(accs[2 * u + 1][0], accs[2 * u + 1][1]); w.w = pk2(accs[2 * u + 1][2], accs[2 * u + 1][3]); pf[u] = __builtin_bit_cast(bf16x8, w); }
        bf16x8 qp[4];
#pragma unroll
        for (int s4 = 0; s4 < 4; ++s4) { const u32x2 lo = *(const LAS u32x2*)(qi + img_off(trow, 4 * s4 + (g >> 1)) + 8 * (g & 1)), hi = *(const LAS u32x2*)(qi + img_off(trow, 4 * s4 + 2 + (g >> 1)) + 8 * (g & 1));
            qp[s4] = __builtin_bit_cast(bf16x8, (u32x4){lo.x, lo.y, hi.x, hi.y}); }
        f32x4 acco[8]; f32x4 accn = (f32x4){0.f, 0.f, 0.f, 0.f};
#pragma unroll
        for (int s4 = 0; s4 < 4; ++s4) { const f32x4 n0 = *(const f32x4*)(nprev + 32 * s4 + 4 * g), n1 = *(const f32x4*)(nprev + 32 * s4 + 16 + 4 * g);
            u32x4 w; w.x = pk2(n0.x, n0.y); w.y = pk2(n0.z, n0.w); w.z = pk2(n1.x, n1.y); w.w = pk2(n1.z, n1.w);
            accn = __builtin_amdgcn_mfma_f32_16x16x32_bf16(__builtin_bit_cast(bf16x8, w), qp[s4], accn, 0, 0, 0); }
#pragma unroll
        for (int jd = 0; jd < 8; ++jd) { acco[jd] = (f32x4){0.f, 0.f, 0.f, 0.f};
#pragma unroll
            for (int s4 = 0; s4 < 4; ++s4) { const bf16x8 cf = *(const bf16x8*)(Cb + ((size_t)((s4 * 8 + jd) * 64 + lane) << 4)); acco[jd] = __builtin_amdgcn_mfma_f32_16x16x32_bf16(cf, qp[s4], acco[jd], 0, 0, 0); } }
        const float winter = __expf(mprev - Mt);
#pragma unroll
        for (int jd = 0; jd < 8; ++jd) acco[jd] = acco[jd] * winter;
#pragma unroll
        for (int u = 0; u < 2; ++u) { if (2 * u <= jt) {
#pragma unroll
                for (int jd = 0; jd < 8; ++jd) { const bf16x8 vf = tr_frag(vi, 32 * u + 4 * g, 32 * u + 16 + 4 * g, 2 * jd, lane); acco[jd] = __builtin_amdgcn_mfma_f32_16x16x32_bf16(vf, pf[u], acco[jd], 0, 0, 0); } } }
        const float nq = winter * accn[0] + rsum;
        const float inv = 1.f / fmaxf(fabsf(nq), __expf(-bt - Mt));
        float s1 = 0.f;
#pragma unroll
        for (int jd = 0; jd < 8; ++jd) { acco[jd] = acco[jd] * inv; s1 += (acco[jd][0] + acco[jd][1]) + (acco[jd][2] + acco[jd][3]); }
        s1 += __shfl_xor(s1, 16); s1 += __shfl_xor(s1, 32);
        const float mu = s1 * (1.f / HD);
        float s2 = 0.f;
#pragma unroll
        for (int jd = 0; jd < 8; ++jd) { const f32x4 d = acco[jd] - mu; s2 += (d[0] * d[0] + d[1] * d[1]) + (d[2] * d[2] + d[3] * d[3]); }
        s2 += __shfl_xor(s2, 16); s2 += __shfl_xor(s2, 32);
        const float rstd = rsqrtf(s2 * (1.f / HD) + EPS);
        const size_t tok = tok_base + trow;
#pragma unroll
        for (int jd = 0; jd < 8; ++jd) { const int dv0 = hh * 128 + 16 * jd + 4 * g;
            const f32x4 gh = *(const f32x4*)(g_head + dv0); const u32x2 ov = *(const u32x2*)(z + tok * NZ + 2048 + dv0);
            const f32x4 hn = (acco[jd] - mu) * rstd * gh;
            u32x2 w; w.x = pk2(hn[0] * fsigmoid(bflo(ov.x)), hn[1] * fsigmoid(bfhi(ov.x))); w.y = pk2(hn[2] * fsigmoid(bflo(ov.y)), hn[3] * fsigmoid(bfhi(ov.y)));
            *(u32x2*)(hm + tok * DM + dv0) = w; }
    }
    __syncthreads();
}

constexpr int TR_PITCH = 144, TR_SCR = 64 * TR_PITCH;
struct TrDesc { const float* src; bf16_t* dst; const float* ksc; int ld, k0, n0s, dstK; };
__device__ __forceinline__ void tr64_load(const TrDesc& d, f32x4 (&v)[16], int lane) {
    const int lr = lane >> 4, lc = (lane & 15) * 4;
#pragma unroll
    for (int i = 0; i < 16; ++i) v[i] = *(const f32x4*)(d.src + (size_t)(d.k0 + 4 * i + lr) * d.ld + d.n0s + lc);
}
__device__ __forceinline__ void tr64_store(const TrDesc& d, const f32x4 (&v)[16], LAS unsigned char* scr, int lane) {
    const int lr = lane >> 4, lc = (lane & 15) * 4;
#pragma unroll
    for (int i = 0; i < 16; ++i) { f32x4 x = v[i]; if (d.ksc) x = x * d.ksc[d.k0 + 4 * i + lr];
        u32x2 w; w.x = pk2(x.x, x.y); w.y = pk2(x.z, x.w); *(LAS u32x2*)(scr + (4 * i + lr) * TR_PITCH + lc * 2) = w; }
    LDS_WAIT(); asm volatile("" ::: "memory");
    const int li = lane & 15, g = lane >> 4, q = li >> 2, p = li & 3;
#pragma unroll
    for (int nb = 0; nb < 4; ++nb)
#pragma unroll
        for (int kh = 0; kh < 2; ++kh) { const int kc = 4 * kh + g;
            LAS unsigned char* ap = scr + (8 * kc + q) * TR_PITCH + (nb * 16 + 4 * p) * 2;
            const v4i16_t lo = tr_read(ap), hi = tr_read(ap + 4 * TR_PITCH);
            const bf16x8 o = (bf16x8){lo[0], lo[1], lo[2], lo[3], hi[0], hi[1], hi[2], hi[3]};
            *(bf16x8*)(d.dst + (size_t)(nb * 16 + li) * d.dstK + d.k0 + 8 * kc) = o; }
    LDS_WAIT(); asm volatile("" ::: "memory");
}
template <class Dec>
__device__ __forceinline__ void tr64_stream(const Dec& dec, int it0, int stride, int n, LAS unsigned char* scr, int lane) {
    if (it0 >= n) return;
    TrDesc dc = dec(it0); f32x4 vc[16]; tr64_load(dc, vc, lane);
    for (int it = it0; it < n; it += stride) {
        const bool more = it + stride < n;
        TrDesc dn = dc; f32x4 vn[16];
        if (more) { dn = dec(it + stride); tr64_load(dn, vn, lane); }
        tr64_store(dc, vc, scr, lane);
        if (more) { dc = dn;
#pragma unroll
            for (int i = 0; i < 16; ++i) vc[i] = vn[i]; }
    }
}
struct DecP0 { const float *w_in, *w_br_b, *w_out, *w_eg, *w_eu, *g_ffn; unsigned char* ws;
    __device__ __forceinline__ TrDesc operator()(int r) const {
        constexpr int I_WZ = 16 * 72, I_WB = 8 * 16, I_WO = 16 * 16, I_EG = 32 * 16 * 8;
        TrDesc d; d.ksc = nullptr;
        if (r < I_WZ) { const int kb = r / 72, nb = r % 72, n0 = nb * 64; d.src = w_in; d.ld = NIN; d.k0 = kb * 64; d.n0s = zcol2orig(n0); d.dst = (bf16_t*)(ws + WS_WZ) + (size_t)n0 * D; d.dstK = D; return d; } r -= I_WZ;
        if (r < I_WB) { const int kb = r >> 4, nb = r & 15; d.src = w_br_b; d.ld = D; d.k0 = kb * 64; d.n0s = nb * 64; d.dst = (bf16_t*)(ws + WS_WBT) + (size_t)(nb * 64) * DM; d.dstK = DM; return d; } r -= I_WB;
        if (r < I_WO) { const int kb = r >> 4, nb = r & 15; d.src = w_out; d.ld = D; d.k0 = kb * 64; d.n0s = nb * 64; d.dst = (bf16_t*)(ws + WS_WOT) + (size_t)(nb * 64) * D; d.dstK = D; return d; } r -= I_WO;
        const int up = r >= I_EG; if (up) r -= I_EG; const int e = r >> 7, kb = (r >> 3) & 15, nb = r & 7, j0 = nb * 64;
        const int drow = (j0 >> 7) * 256 + up * 128 + (j0 & 127);
        d.src = (up ? w_eu : w_eg) + (size_t)e * D * DE; d.ld = DE; d.k0 = kb * 64; d.n0s = j0; d.dst = (bf16_t*)(ws + WS_WUP) + ((size_t)e * 1024 + drow) * D; d.dstK = D; d.ksc = g_ffn; return d; }
};
struct DecWd { const float* w_ed; unsigned char* ws;
    __device__ __forceinline__ TrDesc operator()(int r) const { const int e = r >> 7, kb = (r >> 4) & 7, nb = r & 15;
        TrDesc d; d.src = w_ed + (size_t)e * DE * D; d.ld = D; d.k0 = kb * 64; d.n0s = nb * 64; d.dst = (bf16_t*)(ws + WS_WDN) + ((size_t)e * 1024 + nb * 64) * DE; d.dstK = DE; d.ksc = nullptr; return d; }
};

__device__ __forceinline__ void p0_prologue(const Args& a, LAS unsigned char* lds, int tid, int lane, int wave, int vcu, int G) {
    const float* x = a.in[0]; const float* g_mix = a.in[1]; const float* w_in = a.in[2]; const float* b_if = a.in[3];
    const float* w_pool = a.in[7]; const float* pool_scale = a.in[8]; const float* w_br_a = a.in[9]; const float* w_br_b = a.in[10]; const float* w_out = a.in[11];
    const float* g_ffn = a.in[12]; const float* w_eg = a.in[17]; const float* w_eu = a.in[18];
    unsigned char* ws = a.ws;
    bf16_t* h = (bf16_t*)((unsigned char*)a.out + OB_H); float* gif = (float*)(ws + WS_GIF);
    const int gw = vcu * NWAVES + wave, NGW = G * NWAVES;
    LAS float* gwl = (LAS float*)(lds + 81920);
    for (int idx = tid; idx < 8192; idx += NWAVES * 64) { const int k = idx >> 3, o = idx & 7; gwl[o * 1024 + k] = w_in[(size_t)k * NIN + 2560 + o] * g_mix[k]; }
    __syncthreads();
    REP(20) {
        f32x4 gm[4];
#pragma unroll
        for (int j = 0; j < 4; ++j) gm[j] = *(const f32x4*)(g_mix + 4 * lane + 256 * j);
        f32x4 vn[4];
        if (gw < T) {
#pragma unroll
            for (int j = 0; j < 4; ++j) vn[j] = ((const f32x4*)(x + (size_t)gw * D) + lane)[64 * j]; }
        for (int m = gw; m < T; m += NGW) {
            f32x4 v[4];
#pragma unroll
            for (int j = 0; j < 4; ++j) v[j] = vn[j];
            if (m + NGW < T) {
#pragma unroll
                for (int j = 0; j < 4; ++j) vn[j] = ((const f32x4*)(x + (size_t)(m + NGW) * D) + lane)[64 * j]; }
            float s = 0.f;
#pragma unroll
            for (int j = 0; j < 4; ++j) s += (v[j].x * v[j].x + v[j].y * v[j].y) + (v[j].z * v[j].z + v[j].w * v[j].w);
            float acc[8];
#pragma unroll
            for (int o = 0; o < 8; ++o) { float t = 0.f;
#pragma unroll
                for (int j = 0; j < 4; ++j) { const f32x4 w = *(const LAS f32x4*)(gwl + o * 1024 + 4 * lane + 256 * j); t += (v[j].x * w.x + v[j].y * w.y) + (v[j].z * w.z + v[j].w * w.w); }
                acc[o] = t; }
            s = wave_sum(s);
#pragma unroll
            for (int o = 0; o < 8; ++o) acc[o] = wave_sum(acc[o]);
            const float rstd = rsqrtf(s * (1.f / D) + EPS);
            u32x2* o8 = (u32x2*)(h + (size_t)m * D) + lane;
#pragma unroll
            for (int j = 0; j < 4; ++j) { const f32x4 hv = v[j] * rstd * gm[j]; u32x2 w; w.x = pk2(hv.x, hv.y); w.y = pk2(hv.z, hv.w); o8[64 * j] = w; }
            if (lane < 8) { float r = acc[0];
#pragma unroll
                for (int o = 1; o < 8; ++o) r = (lane == o) ? acc[o] : r;
                gif[(size_t)m * 8 + lane] = r * rstd + b_if[lane]; }
        }
    }
    REP(21) {
        bf16_t* W2T = (bf16_t*)(ws + WS_W2T);
        for (int it = gw; it < DP * 4; it += NGW) {
            const int k = it >> 2, nq = it & 3, gq = k >> 7, n = nq * 256 + lane * 4;
            const float* wp = w_pool + (size_t)k * 128; const float* sc = pool_scale + gq * 128; const float* wa = w_br_a + (size_t)(gq * 128) * D + n;
            f32x4 acc = (f32x4){0.f, 0.f, 0.f, 0.f};
#pragma unroll 16
            for (int d = 0; d < 128; ++d) { const float w = wp[d] * sc[d]; acc += *(const f32x4*)(wa + (size_t)d * D) * w; }
            W2T[(size_t)n * DP + k] = f2bf(acc.x); W2T[(size_t)(n + 1) * DP + k] = f2bf(acc.y); W2T[(size_t)(n + 2) * DP + k] = f2bf(acc.z); W2T[(size_t)(n + 3) * DP + k] = f2bf(acc.w);
        }
    }
    LAS unsigned char* scr = lds + wave * TR_SCR;
    constexpr int NITEMS = 16 * 72 + 8 * 16 + 16 * 16 + 2 * 32 * 16 * 8;
    REP(22) tr64_stream(DecP0{w_in, w_br_b, w_out, w_eg, w_eu, g_ffn, ws}, gw, NGW, NITEMS, scr, lane);
    {
        const float* w_rg = a.in[13]; const float* w_re = a.in[15];
        const int gt = gw * 64 + lane;
        if (gt < 48 * 128) { const int col = gt >> 7, ch = gt & 127; float v[8];
#pragma unroll
            for (int q = 0; q < 8; ++q) { const int k = 8 * ch + q; v[q] = (col < 4 ? w_rg[k * NG + col] : col < 36 ? w_re[k * NE + col - 4] : 0.f) * g_ffn[k]; }
            u32x4 w; w.x = pk2(v[0], v[1]); w.y = pk2(v[2], v[3]); w.z = pk2(v[4], v[5]); w.w = pk2(v[6], v[7]);
            *(u32x4*)(ws + WS_WR + col * 2048 + ((ch ^ (col & 15)) << 4)) = w; }
    }
}

__device__ __forceinline__ void convert_wdown(const Args& a, LAS unsigned char* lds, int lane, int wave, int gi, int ngrp) {
    tr64_stream(DecWd{a.in[19], a.ws}, gi * NWAVES + wave, ngrp * NWAVES, 32 * 8 * 16, lds + wave * TR_SCR, lane);
}

__global__ void __launch_bounds__(NWAVES * 64, 2) mk_fwd(Args args) {
    extern __shared__ __attribute__((aligned(16))) unsigned char lds_raw[];
    LAS unsigned char* lds = (LAS unsigned char*)lds_raw;
    volatile LAS unsigned* MISC = (volatile LAS unsigned*)(lds + MISC_OFF);
    const int tid = threadIdx.x, lane = tid & 63, wave = __builtin_amdgcn_readfirstlane(tid >> 6);
    const int G = gridDim.x; const int bx = blockIdx.x; const int vcu = (G % 8 == 0) ? (bx % 8) * (G / 8) + bx / 8 : bx;
    unsigned char* ws = args.ws; unsigned* ctl = (unsigned*)(ws + WS_CTL);
    for (int u = tid; u < (LDS_BYTES - LDSCTL_OFF) / 4; u += NWAVES * 64) ((LAS unsigned*)(lds + LDSCTL_OFF))[u] = 0u;
    __syncthreads();
    XcdBarrier bar = xcd_barrier_post(ctl + CW_BAR + args.li * XCD_BAR_WORDS, MISC + 8);
    const int lo = args.ph_lo, hi = args.ph_hi;
#define IN(k) (lo <= (k) && (k) < hi)
#define BOTH(k) (IN(k) && IN((k) + 1))
#define GRID_BAR() xcd_barrier(bar)
#define STAMP(k) do { if (PROBE_PHASE >= 100 && bx == 0 && tid == 0) { const unsigned long long _t = __builtin_amdgcn_s_memrealtime(); if ((k) == PROBE_PHASE - 100) tstart = _t; if ((k) == PROBE_PHASE - 99) tend = _t; } } while (0)
    unsigned long long tstart = 0, tend = 0;
    STAMP(0);
    if (IN(0)) { REP(0) { p0_prologue(args, lds, tid, lane, wave, vcu, G); __syncthreads(); } if (BOTH(0)) GRID_BAR(); STAMP(1); }
    if (IN(1)) {
        SchedDense S{(const char*)args.out + OB_H, (const char*)(ws + WS_WZ), (size_t)256 * D * 2, (size_t)256 * D * 2, T / 256, NZ / 256, G, bx, (PROBE_PHASE == 1) ? 2 : 1};
        EpiZ E{(bf16_t*)(ws + WS_Z)};
        pg8::gemm_phase<EpiZ, SchedDense, false>(lds + RING_OFF, pg8::Cfg{D, D * 2, D * 2}, S, E);
        { const int nwg = (T / 256) * (NZ / 256), full = nwg % G;
          if (full == 0) convert_wdown(args, lds, lane, wave, bx, G); else if (bx >= full) convert_wdown(args, lds, lane, wave, bx - full, G - full); }
        if (BOTH(1)) GRID_BAR(); STAMP(2);
    }
    if (IN(2)) {
        REP(2) for (int pr = vcu; pr < 512; pr += G) b1_item(args, lds + (wave >> 2) * HALF_LDS, 2 * pr + (wave >> 2), tid & 255, wave & 3, lane);
        pool_pass(args, tid, vcu, G);
        if (BOTH(2)) GRID_BAR(); STAMP(3);
    }
    if (IN(3)) { p3_scan(args, tid, vcu, G); if (BOTH(3)) GRID_BAR(); STAMP(4); }
    if (IN(4)) {
        REP(4) for (int pr = vcu; pr < 512; pr += G) b3_item(args, lds + (wave >> 2) * HALF_LDS, 2 * pr + (wave >> 2), tid & 255, wave & 3, lane);
        if (BOTH(4)) GRID_BAR(); STAMP(5);
    }
    if (IN(5)) {
        SchedMerge S{(const char*)args.out + OB_DA, (const char*)args.out + OB_HM, (const char*)(ws + WS_W2T), (const char*)(ws + WS_WBT), T / 256, D / 256, G, bx};
        EpiMerge E{(const bf16_t*)(ws + WS_Z), (bf16_t*)((unsigned char*)args.out + OB_MERGED)};
        pg8::gemm_phase<EpiMerge, SchedMerge, false>(lds + RING_OFF, pg8::Cfg{DP, DP * 2, DP * 2}, S, E);
        if (BOTH(5)) GRID_BAR(); STAMP(6);
    }
    if (IN(6)) {
        SchedDense S{(const char*)args.out + OB_MERGED, (const char*)(ws + WS_WOT), (size_t)256 * D * 2, (size_t)256 * D * 2, T / 256, D / 256, G, bx, (PROBE_PHASE == 6) ? 2 : 1};
        EpiX1 E{args.in[0], (bf16_t*)(ws + WS_X1B)};
        pg8::gemm_phase<EpiX1, SchedDense, false>(lds + RING_OFF, pg8::Cfg{D, D * 2, D * 2}, S, E);
        if (BOTH(6)) GRID_BAR(); STAMP(7);
    }
    if (IN(7)) { p7_route(args, lds, MISC, tid, lane, wave, vcu, G); if (BOTH(7)) GRID_BAR(); STAMP(8); }
#if MOE_DYN
    if (IN(8)) {
        moe_tables(ctl + CW_CNT, MISC, tid);
        SchedMoEQ S{MISC, ctl, (const char*)(ws + WS_X1B), (const char*)(ws + WS_HID), (const char*)(ws + WS_WUP), (const char*)(ws + WS_WDN), (const int*)(ws + WS_ALIST), (const f32x2*)(ws + WS_RWLIST), ctl + CW_READY, (int)(bar.x & 7u), wave, lane};
        EpiUpQ E0{(bf16_t*)(ws + WS_HID)};
        EpiDownQ E1{(bf16_t*)args.out};
        pg8::gemm_phase_moe<SchedMoEQ, EpiUpQ, EpiDownQ>(lds + RING_OFF, lds + META_OFF, S, E0, E1);
        if (IN(10)) GRID_BAR(); STAMP(9); STAMP(10);
    }
#else
    if (IN(8)) {
        moe_tables(ctl + CW_CNT, MISC, tid);
        SchedMoE S{MISC, (const char*)(ws + WS_X1B), (const char*)(ws + WS_WUP), (const int*)(ws + WS_ALIST), (size_t)1024 * D * 2, (size_t)256 * D * 2, 0, G, vcu, 1, (PROBE_PHASE == 8) ? 2 : 1};
        EpiUp E{(const int*)(ws + WS_ALIST), (const f32x2*)(ws + WS_RWLIST), (bf16_t*)(ws + WS_HID)};
        pg8::gemm_phase<EpiUp, SchedMoE, true>(lds + RING_OFF, pg8::Cfg{D, D * 2, D * 2}, S, E);
        if (BOTH(8)) GRID_BAR(); STAMP(9);
    }
    if (IN(9)) {
        moe_tables(ctl + CW_CNT, MISC, tid);
        SchedMoE S{MISC, (const char*)(ws + WS_HID), (const char*)(ws + WS_WDN), (const int*)(ws + WS_ALIST), (size_t)1024 * DE * 2, (size_t)256 * DE * 2, (size_t)256 * DE * 2, G, vcu, 0, (PROBE_PHASE == 9) ? 2 : 1};
        EpiDown E{(const int*)(ws + WS_ALIST), (const f32x2*)(ws + WS_RWLIST), (bf16_t*)args.out};
        pg8::gemm_phase<EpiDown, SchedMoE, false>(lds + RING_OFF, pg8::Cfg{DE, DE * 2, DE * 2}, S, E);
        if (BOTH(9)) GRID_BAR(); STAMP(10);
    }
#endif
    if (IN(10)) p10_final(args, lane, wave, vcu, G);
    STAMP(11);
    if (PROBE_PHASE >= 100 && bx == 0 && tid == 0) { const unsigned long long d = (tend - tstart) * 8ull, t0 = __builtin_amdgcn_s_memrealtime(); while (__builtin_amdgcn_s_memrealtime() - t0 < d) __builtin_amdgcn_s_sleep(16); }
#undef IN
#undef BOTH
#undef GRID_BAR
}

}

extern "C" void kernel_launch(void* const* d_in, const int* in_sizes, int n_in, void* d_out, int out_size, void* d_ws, size_t ws_size, hipStream_t stream) {
    const float* x = (const float*)d_in[0];
    const float* conv_q = (const float*)d_in[4]; const float* conv_k = (const float*)d_in[5]; const float* g_head = (const float*)d_in[6]; const float* w_pool = (const float*)d_in[7];
    const float* pool_scale = (const float*)d_in[8]; const float* w_br_a = (const float*)d_in[9]; const float* w_br_b = (const float*)d_in[10]; const float* w_out = (const float*)d_in[11];
    const float* g_ffn = (const float*)d_in[12]; const float* w_rg = (const float*)d_in[13]; const float* b_rg = (const float*)d_in[14]; const float* w_re = (const float*)d_in[15];
    const float* b_re = (const float*)d_in[16]; const float* w_eg = (const float*)d_in[17]; const float* w_eu = (const float*)d_in[18]; const float* w_ed = (const float*)d_in[19];
    const float* g_final = (const float*)d_in[20];
    static int grid = 0;
    if (grid == 0) {
        if (n_in != 21 || out_size != T * D || ws_size < WS_END) { fprintf(stderr, "kernel_launch: unexpected shapes/ws (%d inputs, out %d, ws %zu)\n", n_in, out_size, ws_size); grid = -1; return; }
        int dev = 0, cus = 0, per_cu = 0;
        if (hipGetDevice(&dev) != hipSuccess || hipDeviceGetAttribute(&cus, hipDeviceAttributeMultiprocessorCount, dev) != hipSuccess) { grid = -1; return; }
        if (hipFuncSetAttribute((const void*)mk_fwd, hipFuncAttributeMaxDynamicSharedMemorySize, LDS_BYTES) != hipSuccess) { fprintf(stderr, "kernel_launch: hipFuncSetAttribute failed\n"); grid = -1; return; }
        if (hipOccupancyMaxActiveBlocksPerMultiprocessor(&per_cu, (const void*)mk_fwd, NWAVES * 64, LDS_BYTES) != hipSuccess || per_cu < 1) { fprintf(stderr, "kernel_launch: occupancy query says %d blocks per CU\n", per_cu); grid = -1; return; }
        (void)hipGetLastError();
        grid = cus;
    }
    if (grid < 0) return;
    unsigned char* ws = (unsigned char*)d_ws; unsigned char* ob = (unsigned char*)d_out;
    (void)hipMemsetAsync(ws + WS_CTL, 0, CTL_ZERO_BYTES, stream);
    Args a{};
    for (int i = 0; i < 21; ++i) a.in[i] = (const float*)d_in[i];
    a.out = (float*)d_out; a.ws = ws; a.flags = 0;
    a.ph_lo = 0; a.ph_hi = 11; a.li = 0;
    hipLaunchKernelGGL(mk_fwd, dim3(grid), dim3(NWAVES * 64), LDS_BYTES, stream, a);
}
```

```cpp
#include <hip/hip_runtime.h>
#include <cstdio>
#include <cstdint>

namespace {
constexpr int D = 1024, BATCH = 8, SEQ = 2048, T = BATCH * SEQ;
constexpr int DP = 512, DM = 512, NH = 4, HD = 128, NIN = 4616, NZ = 4608;
constexpr int NG = 4, EPG = 8, NE = 32, DE = 512;
constexpr float EPS = 1e-6f;
constexpr size_t MiB = 1u << 20;

typedef unsigned short bf16_t;
__device__ __forceinline__ bf16_t f2bf(float f) { unsigned u = __builtin_bit_cast(unsigned, f); return (bf16_t)((u + 0x7fffu + ((u >> 16) & 1u)) >> 16); }
__device__ __forceinline__ float bf2f(bf16_t b) { return __builtin_bit_cast(float, (unsigned)b << 16); }
__device__ __forceinline__ float sigmoidf_(float x) { return 1.f / (1.f + __expf(-x)); }
__device__ __forceinline__ float siluf_(float x) { return x / (1.f + __expf(-x)); }
__device__ __forceinline__ float logsigmoidf_(float x) { return fminf(x, 0.f) - log1pf(__expf(-fabsf(x))); }
__device__ __forceinline__ float wave_sum(float v) {
#pragma unroll
    for (int o = 1; o < 64; o <<= 1) v += __shfl_xor(v, o);
    return v;
}
__device__ __forceinline__ int zcol2orig(int c) { return c < 2560 ? c : c + 8; }

__global__ void __launch_bounds__(256) k_prep(const float* __restrict__ x, const float* __restrict__ g, const float* __restrict__ w_in,
                                               const float* __restrict__ b_if, bf16_t* __restrict__ h, float* __restrict__ gif) {
    const int wave = threadIdx.x >> 6, lane = threadIdx.x & 63;
    const int row = blockIdx.x * 4 + wave;
    if (row >= T) return;
    const float* xr = x + (size_t)row * D;
    float v[16]; float s = 0.f;
#pragma unroll
    for (int j = 0; j < 16; ++j) { v[j] = xr[lane + 64 * j]; s += v[j] * v[j]; }
    s = wave_sum(s);
    const float rstd = rsqrtf(s * (1.f / D) + EPS);
    float acc[8];
#pragma unroll
    for (int o = 0; o < 8; ++o) acc[o] = 0.f;
#pragma unroll
    for (int j = 0; j < 16; ++j) {
        const int k = lane + 64 * j;
        const float hv = v[j] * rstd * g[k];
        h[(size_t)row * D + k] = f2bf(hv);
#pragma unroll
        for (int o = 0; o < 8; ++o) acc[o] += hv * w_in[(size_t)k * NIN + 2560 + o];
    }
#pragma unroll
    for (int o = 0; o < 8; ++o) { acc[o] = wave_sum(acc[o]); }
    if (lane == 0) {
#pragma unroll
        for (int o = 0; o < 8; ++o) gif[(size_t)row * 8 + o] = acc[o] + b_if[o];
    }
}

template <class AL, class BL, class EP>
__global__ void __launch_bounds__(256) k_gemm(int M, int N, int K, AL al, BL bl, EP ep) {
    __shared__ float As[16][68];
    __shared__ float Bs[16][68];
    const int tid = threadIdx.x, tx = tid & 15, ty = tid >> 4;
    const int row0 = blockIdx.y * 64, col0 = blockIdx.x * 64;
    float acc[4][4];
#pragma unroll
    for (int i = 0; i < 4; ++i)
#pragma unroll
        for (int j = 0; j < 4; ++j) acc[i][j] = 0.f;
    for (int k0 = 0; k0 < K; k0 += 16) {
#pragma unroll
        for (int j = 0; j < 4; ++j) {
            const int idx = tid + j * 256;
            const int r = idx >> 4, kk = idx & 15;
            As[kk][r] = (row0 + r < M) ? al(row0 + r, k0 + kk) : 0.f;
            const int k2 = idx >> 6, n = idx & 63;
            Bs[k2][n] = (col0 + n < N) ? bl(k0 + k2, col0 + n) : 0.f;
        }
        __syncthreads();
#pragma unroll
        for (int kk = 0; kk < 16; ++kk) {
            float a[4], b[4];
#pragma unroll
            for (int i = 0; i < 4; ++i) a[i] = As[kk][ty * 4 + i];
#pragma unroll
            for (int j = 0; j < 4; ++j) b[j] = Bs[kk][tx * 4 + j];
#pragma unroll
            for (int i = 0; i < 4; ++i)
#pragma unroll
                for (int j = 0; j < 4; ++j) acc[i][j] += a[i] * b[j];
        }
        __syncthreads();
    }
#pragma unroll
    for (int i = 0; i < 4; ++i)
#pragma unroll
        for (int j = 0; j < 4; ++j) {
            const int r = row0 + ty * 4 + i, c = col0 + tx * 4 + j;
            if (r < M && c < N) ep(r, c, acc[i][j]);
        }
}

struct ALbf { const bf16_t* p; int ld; int pad; __device__ float operator()(int r, int k) const { return bf2f(p[(size_t)r * ld + k]); } };
struct ALf32 { const float* p; int ld; int pad; __device__ float operator()(int r, int k) const { return p[(size_t)r * ld + k]; } };
struct BLwin { const float* w; __device__ float operator()(int k, int n) const { return w[(size_t)k * NIN + zcol2orig(n)]; } };
struct BLplain { const float* w; int ld; int pad; __device__ float operator()(int k, int n) const { return w[(size_t)k * ld + n]; } };
struct EPz { bf16_t* z; __device__ void operator()(int r, int c, float v) const { z[(size_t)r * NZ + c] = f2bf(v); } };
struct EPf32 { float* o; int ld; int pad; __device__ void operator()(int r, int c, float v) const { o[(size_t)r * ld + c] = v; } };
struct EPmerge { const float* ya; const bf16_t* z; bf16_t* m;
    __device__ void operator()(int r, int c, float yb) const {
        const float ga = bf2f(z[(size_t)r * NZ + 2560 + c]), gb = bf2f(z[(size_t)r * NZ + 3584 + c]);
        m[(size_t)r * D + c] = f2bf(sigmoidf_(ga) * ya[(size_t)r * D + c] + sigmoidf_(gb) * yb); } };
struct EPres { const float* x; float* x1; __device__ void operator()(int r, int c, float v) const { x1[(size_t)r * D + c] = x[(size_t)r * D + c] + v; } };

__global__ void __launch_bounds__(256) k_conv(const bf16_t* __restrict__ z, const float* __restrict__ cq, const float* __restrict__ ck, bf16_t* __restrict__ qa, bf16_t* __restrict__ ka) {
    const size_t idx = (size_t)blockIdx.x * 256 + threadIdx.x;
    const int t = (int)(idx >> 9), c = (int)(idx & 511), s = t % SEQ;
    float aq = 0.f, ak = 0.f;
#pragma unroll
    for (int j = 0; j < 4; ++j) {
        const int ss = s - 3 + j;
        if (ss >= 0) {
            const size_t r = (size_t)(t - 3 + j) * NZ;
            aq += bf2f(z[r + 512 + c]) * cq[j * DM + c];
            ak += bf2f(z[r + 1024 + c]) * ck[j * DM + c];
        }
    }
    qa[idx] = f2bf(siluf_(aq));
    ka[idx] = f2bf(siluf_(ak) * 0.08838834764831845f);
}
__global__ void k_bcum(const float* __restrict__ gif, float* __restrict__ bcs) {
    const int bh = blockIdx.x * blockDim.x + threadIdx.x;
    if (bh >= BATCH * NH) return;
    const int b = bh / NH, hh = bh % NH;
    float acc = 0.f;
    for (int s = 0; s < SEQ; ++s) { acc += logsigmoidf_(gif[((size_t)b * SEQ + s) * 8 + 4 + hh]); bcs[(size_t)bh * SEQ + s] = acc; }
}
__global__ void __launch_bounds__(256) k_mlstm_naive(const bf16_t* __restrict__ qa, const bf16_t* __restrict__ ka, const bf16_t* __restrict__ z, const float* __restrict__ gif,
                                                      const float* __restrict__ bcs, const float* __restrict__ g_head, bf16_t* __restrict__ hm) {
    __shared__ float ks[32][129];
    __shared__ float vs[32][129];
    __shared__ float ws_[32];
    const int bh = blockIdx.x >> 5, qb = blockIdx.x & 31, b = bh / NH, hh = bh % NH;
    const int tid = threadIdx.x, tq = tid >> 2, part = tid & 3;
    const int t = qb * 64 + tq;
    const size_t rowq = (size_t)b * SEQ + t;
    float q[32];
#pragma unroll
    for (int j = 0; j < 32; ++j) q[j] = bf2f(qa[rowq * DM + hh * HD + part * 32 + j]);
    const float bt = bcs[(size_t)bh * SEQ + t];
    float num[32];
#pragma unroll
    for (int j = 0; j < 32; ++j) num[j] = 0.f;
    float nq = 0.f;
    for (int kb = 0; kb <= qb * 2 + 1; ++kb) {
        __syncthreads();
        for (int i = tid; i < 32 * 128; i += 256) {
            const int r = i >> 7, c = i & 127; const size_t row = (size_t)b * SEQ + kb * 32 + r;
            ks[r][c] = bf2f(ka[row * DM + hh * HD + c]);
            vs[r][c] = bf2f(z[row * NZ + 1536 + hh * HD + c]);
        }
        if (tid < 32) { const size_t row = (size_t)b * SEQ + kb * 32 + tid; ws_[tid] = gif[row * 8 + hh] - bcs[(size_t)bh * SEQ + kb * 32 + tid]; }
        __syncthreads();
        for (int s = 0; s < 32; ++s) {
            if (kb * 32 + s > t) break;
            float d = 0.f;
#pragma unroll
            for (int j = 0; j < 32; ++j) d += q[j] * ks[s][part * 32 + j];
            d += __shfl_xor(d, 1); d += __shfl_xor(d, 2);
            const float w = d * __expf(bt + ws_[s]);
            nq += w;
#pragma unroll
            for (int j = 0; j < 32; ++j) num[j] += w * vs[s][part * 32 + j];
        }
    }
    const float den = fmaxf(fabsf(nq), 1.f);
    float s1 = 0.f;
#pragma unroll
    for (int j = 0; j < 32; ++j) { num[j] /= den; s1 += num[j]; }
    s1 += __shfl_xor(s1, 1); s1 += __shfl_xor(s1, 2);
    const float mu = s1 * (1.f / HD);
    float s2 = 0.f;
#pragma unroll
    for (int j = 0; j < 32; ++j) { const float dd = num[j] - mu; s2 += dd * dd; }
    s2 += __shfl_xor(s2, 1); s2 += __shfl_xor(s2, 2);
    const float rstd = rsqrtf(s2 * (1.f / HD) + EPS);
#pragma unroll
    for (int j = 0; j < 32; ++j) {
        const int c = hh * HD + part * 32 + j;
        const float o = bf2f(z[rowq * NZ + 2048 + c]);
        hm[rowq * DM + c] = f2bf((num[j] - mu) * rstd * g_head[c] * sigmoidf_(o));
    }
}
__global__ void __launch_bounds__(256) k_pool(const bf16_t* __restrict__ z, bf16_t* __restrict__ dA) {
    const size_t idx = (size_t)blockIdx.x * 256 + threadIdx.x;
    const int t = (int)(idx >> 9), c = (int)(idx & 511), s = t % SEQ, g = c >> 7;
    const int w = 2 << g;
    const int start = max(s + 1 - w, 0), cnt = s + 1 - start;
    float acc = 0.f;
    for (int j = 0; j < cnt; ++j) acc += bf2f(z[(size_t)(t - j) * NZ + c]);
    dA[idx] = f2bf(acc / (float)cnt - bf2f(z[(size_t)t * NZ + c]));
}
__global__ void __launch_bounds__(256) k_poolmm(const bf16_t* __restrict__ dA, const float* __restrict__ w_pool, const float* __restrict__ scale, float* __restrict__ yp) {
    const size_t idx = (size_t)blockIdx.x * 256 + threadIdx.x;
    const int t = (int)(idx >> 9), j = (int)(idx & 511), g = j >> 7, jj = j & 127;
    float acc = 0.f;
    for (int c = 0; c < 128; ++c) acc += bf2f(dA[(size_t)t * DP + g * 128 + c]) * w_pool[((size_t)g * 128 + c) * 128 + jj];
    yp[idx] = acc * scale[j];
}

__global__ void __launch_bounds__(256) k_route(const float* __restrict__ x1, const float* __restrict__ g_ffn, const float* __restrict__ w_rg, const float* __restrict__ b_rg,
                                                const float* __restrict__ w_re, const float* __restrict__ b_re, float* __restrict__ rstd2, int* __restrict__ sel, float* __restrict__ gw,
                                                int* __restrict__ counts, int* __restrict__ lists) {
    const int wave = threadIdx.x >> 6, lane = threadIdx.x & 63;
    const int tok = blockIdx.x * 4 + wave;
    const float* xr = x1 + (size_t)tok * D;
    float v[16]; float s = 0.f;
#pragma unroll
    for (int j = 0; j < 16; ++j) { v[j] = xr[lane + 64 * j]; s += v[j] * v[j]; }
    s = wave_sum(s);
    const float rstd = rsqrtf(s * (1.f / D) + EPS);
    float lg[4] = {0.f, 0.f, 0.f, 0.f};
#pragma unroll
    for (int j = 0; j < 16; ++j) { const int k = lane + 64 * j; v[j] = v[j] * rstd * g_ffn[k];
#pragma unroll
        for (int o = 0; o < 4; ++o) lg[o] += v[j] * w_rg[k * NG + o]; }
#pragma unroll
    for (int o = 0; o < 4; ++o) lg[o] = wave_sum(lg[o]) + b_rg[o];
    int gs = 0; float gm = lg[0];
#pragma unroll
    for (int o = 1; o < 4; ++o) if (lg[o] > gm) { gm = lg[o]; gs = o; }
    float den = 0.f;
#pragma unroll
    for (int o = 0; o < 4; ++o) den += __expf(lg[o] - gm);
    const float pg = 1.f / den;
    float le[8];
#pragma unroll
    for (int o = 0; o < 8; ++o) le[o] = 0.f;
#pragma unroll
    for (int j = 0; j < 16; ++j) { const int k = lane + 64 * j;
#pragma unroll
        for (int o = 0; o < 8; ++o) le[o] += v[j] * w_re[k * NE + gs * EPG + o]; }
#pragma unroll
    for (int o = 0; o < 8; ++o) le[o] = wave_sum(le[o]) + b_re[gs * EPG + o];
    int i1 = 0; float m1 = le[0];
#pragma unroll
    for (int o = 1; o < 8; ++o) if (le[o] > m1) { m1 = le[o]; i1 = o; }
    int i2 = -1; float m2 = -3.0e38f;
#pragma unroll
    for (int o = 0; o < 8; ++o) if (o != i1 && le[o] > m2) { m2 = le[o]; i2 = o; }
    const float e2 = __expf(m2 - m1);
    const float p1 = 1.f / (1.f + e2), p2 = e2 / (1.f + e2);
    if (lane == 0) {
        rstd2[tok] = rstd;
        const int ea = gs * EPG + i1, eb = gs * EPG + i2;
        sel[tok * 2] = ea; sel[tok * 2 + 1] = eb;
        gw[tok * 2] = pg * p1; gw[tok * 2 + 1] = pg * p2;
        const int pa = atomicAdd(&counts[ea], 1); lists[ea * T + pa] = tok * 2;
        const int pb = atomicAdd(&counts[eb], 1); lists[eb * T + pb] = tok * 2 + 1;
    }
}
__global__ void __launch_bounds__(256) k_moe_up(const float* __restrict__ x1, const float* __restrict__ rstd2, const float* __restrict__ g_ffn, const float* __restrict__ wg, const float* __restrict__ wu,
                                                 const int* __restrict__ counts, const int* __restrict__ lists, float* __restrict__ hid) {
    const int e = blockIdx.z, rt = blockIdx.y, ct = blockIdx.x;
    const int cnt = counts[e];
    if (rt * 64 >= cnt) return;
    __shared__ float As[16][68]; __shared__ float Bg[16][68]; __shared__ float Bu[16][68];
    __shared__ int toks[64]; __shared__ float rs[64];
    const int tid = threadIdx.x, tx = tid & 15, ty = tid >> 4;
    if (tid < 64) { const int r = rt * 64 + tid; const int a = (r < cnt) ? lists[e * T + r] : -1; toks[tid] = a; rs[tid] = (a >= 0) ? rstd2[a >> 1] : 0.f; }
    __syncthreads();
    float ag[4][4], au[4][4];
#pragma unroll
    for (int i = 0; i < 4; ++i)
#pragma unroll
        for (int j = 0; j < 4; ++j) { ag[i][j] = 0.f; au[i][j] = 0.f; }
    const float* wge = wg + (size_t)e * D * DE; const float* wue = wu + (size_t)e * D * DE;
    for (int k0 = 0; k0 < D; k0 += 16) {
#pragma unroll
        for (int j = 0; j < 4; ++j) {
            const int idx = tid + j * 256; const int r = idx >> 4, kk = idx & 15;
            const int a = toks[r];
            As[kk][r] = (a >= 0) ? x1[(size_t)(a >> 1) * D + k0 + kk] * rs[r] * g_ffn[k0 + kk] : 0.f;
            const int k2 = idx >> 6, n = idx & 63;
            Bg[k2][n] = wge[(size_t)(k0 + k2) * DE + ct * 64 + n];
            Bu[k2][n] = wue[(size_t)(k0 + k2) * DE + ct * 64 + n];
        }
        __syncthreads();
#pragma unroll
        for (int kk = 0; kk < 16; ++kk) {
            float a[4], bg[4], bu[4];
#pragma unroll
            for (int i = 0; i < 4; ++i) a[i] = As[kk][ty * 4 + i];
#pragma unroll
            for (int j = 0; j < 4; ++j) { bg[j] = Bg[kk][tx * 4 + j]; bu[j] = Bu[kk][tx * 4 + j]; }
#pragma unroll
            for (int i = 0; i < 4; ++i)
#pragma unroll
                for (int j = 0; j < 4; ++j) { ag[i][j] += a[i] * bg[j]; au[i][j] += a[i] * bu[j]; }
        }
        __syncthreads();
    }
#pragma unroll
    for (int i = 0; i < 4; ++i) { const int a = toks[ty * 4 + i]; if (a < 0) continue;
#pragma unroll
        for (int j = 0; j < 4; ++j) hid[(size_t)a * DE + ct * 64 + tx * 4 + j] = siluf_(ag[i][j]) * au[i][j]; }
}
__global__ void __launch_bounds__(256) k_moe_down(const float* __restrict__ hid, const float* __restrict__ wd, const float* __restrict__ gw, const int* __restrict__ counts, const int* __restrict__ lists, bf16_t* __restrict__ yb) {
    const int e = blockIdx.z, rt = blockIdx.y, ct = blockIdx.x;
    const int cnt = counts[e];
    if (rt * 64 >= cnt) return;
    __shared__ float As[16][68]; __shared__ float Bs[16][68];
    __shared__ int toks[64];
    const int tid = threadIdx.x, tx = tid & 15, ty = tid >> 4;
    if (tid < 64) { const int r = rt * 64 + tid; toks[tid] = (r < cnt) ? lists[e * T + r] : -1; }
    __syncthreads();
    float acc[4][4];
#pragma unroll
    for (int i = 0; i < 4; ++i)
#pragma unroll
        for (int j = 0; j < 4; ++j) acc[i][j] = 0.f;
    const float* wde = wd + (size_t)e * DE * D;
    for (int k0 = 0; k0 < DE; k0 += 16) {
#pragma unroll
        for (int j = 0; j < 4; ++j) {
            const int idx = tid + j * 256; const int r = idx >> 4, kk = idx & 15;
            const int a = toks[r];
            As[kk][r] = (a >= 0) ? hid[(size_t)a * DE + k0 + kk] : 0.f;
            const int k2 = idx >> 6, n = idx & 63;
            Bs[k2][n] = wde[(size_t)(k0 + k2) * D + ct * 64 + n];
        }
        __syncthreads();
#pragma unroll
        for (int kk = 0; kk < 16; ++kk) {
            float a[4], b[4];
#pragma unroll
            for (int i = 0; i < 4; ++i) a[i] = As[kk][ty * 4 + i];
#pragma unroll
            for (int j = 0; j < 4; ++j) b[j] = Bs[kk][tx * 4 + j];
#pragma unroll
            for (int i = 0; i < 4; ++i)
#pragma unroll
                for (int j = 0; j < 4; ++j) acc[i][j] += a[i] * b[j];
        }
        __syncthreads();
    }
#pragma unroll
    for (int i = 0; i < 4; ++i) { const int a = toks[ty * 4 + i]; if (a < 0) continue; const float w = gw[a];
#pragma unroll
        for (int j = 0; j < 4; ++j) yb[(size_t)a * D + ct * 64 + tx * 4 + j] = f2bf(acc[i][j] * w); }
}
__global__ void __launch_bounds__(256) k_final(const float* __restrict__ x1, const bf16_t* __restrict__ yb, const float* __restrict__ g, float* __restrict__ out) {
    const int wave = threadIdx.x >> 6, lane = threadIdx.x & 63;
    const int tok = blockIdx.x * 4 + wave;
    float v[16]; float s = 0.f;
#pragma unroll
    for (int j = 0; j < 16; ++j) { const int k = lane + 64 * j;
        v[j] = x1[(size_t)tok * D + k] + bf2f(yb[(size_t)(tok * 2) * D + k]) + bf2f(yb[(size_t)(tok * 2 + 1) * D + k]); s += v[j] * v[j]; }
    s = wave_sum(s);
    const float rstd = rsqrtf(s * (1.f / D) + EPS);
#pragma unroll
    for (int j = 0; j < 16; ++j) { const int k = lane + 64 * j; out[(size_t)tok * D + k] = v[j] * rstd * g[k]; }
}

#define GAS __attribute__((address_space(1)))
#define LAS __attribute__((address_space(3)))
typedef short bf16x8 __attribute__((ext_vector_type(8)));
typedef float f32x4 __attribute__((ext_vector_type(4)));
typedef float f32x2 __attribute__((ext_vector_type(2)));
typedef unsigned u32x4 __attribute__((ext_vector_type(4)));
typedef unsigned u32x2 __attribute__((ext_vector_type(2)));
#define LDS_WAIT() asm volatile("s_waitcnt lgkmcnt(0)" ::: "memory")
#define VM_WAIT() asm volatile("s_waitcnt vmcnt(0)" ::: "memory")
__device__ __forceinline__ unsigned pk2(float lo, float hi) { return (unsigned)f2bf(lo) | ((unsigned)f2bf(hi) << 16); }
__device__ __forceinline__ unsigned cvt_pk_bf16(float lo, float hi) { unsigned r; asm volatile("v_cvt_pk_bf16_f32 %0, %1, %2" : "=v"(r) : "v"(lo), "v"(hi)); return r; }
__device__ __forceinline__ float u2f(unsigned u) { return __builtin_bit_cast(float, u); }
__device__ __forceinline__ float bflo(unsigned w) { return __builtin_bit_cast(float, w << 16); }
__device__ __forceinline__ float bfhi(unsigned w) { return __builtin_bit_cast(float, w & 0xffff0000u); }
__device__ __forceinline__ float fast_exp(float x) { return __builtin_amdgcn_exp2f(x * 1.4426950408889634f); }
__device__ __forceinline__ float fast_rcp(float x) { return __builtin_amdgcn_rcpf(x); }
__device__ __forceinline__ float fsigmoid(float x) { return fast_rcp(1.f + fast_exp(-x)); }

#define XB_TMO      128
#define XB_XCNT(j)  (256  + 64 * (j))
#define XB_XSUB(j)  (1280 + 64 * (j))
#define XB_XGEN(j)  (2304 + 64 * (j))
#define XB_TOP      3328
#define XB_TOPGEN   3392
#define XCD_BAR_WORDS 3456
#define XB_SPIN_CAP (1u << 18)
__device__ __forceinline__ unsigned xb_ld(unsigned* p)              { return __hip_atomic_load(p, __ATOMIC_RELAXED, __HIP_MEMORY_SCOPE_AGENT); }
__device__ __forceinline__ unsigned xb_add(unsigned* p, unsigned v) { return __hip_atomic_fetch_add(p, v, __ATOMIC_RELAXED, __HIP_MEMORY_SCOPE_AGENT); }
__device__ __forceinline__ unsigned xb_xcc_id() { return (unsigned)__builtin_amdgcn_s_getreg((3 << 11) | 20) & 0xFu; }
#define XB_SPIN(cond, bar) do { unsigned _sp = 0; while (cond) { __builtin_amdgcn_s_sleep(1); \
    if ((++_sp & 255u) == 0u) { if (xb_ld(&(bar)[XB_TMO])) break; if (_sp > XB_SPIN_CAP) { atomicAdd(&(bar)[XB_TMO], 1u); break; } } } } while (0)
struct XcdBarrier { unsigned* bar; unsigned x; volatile LAS unsigned* st; };
__device__ __forceinline__ XcdBarrier xcd_barrier_post(unsigned* bar, volatile LAS unsigned* st) {
    XcdBarrier b; b.bar = bar; b.x = xb_xcc_id(); b.st = st;
    if (threadIdx.x == 0) (void)xb_add(&bar[XB_XCNT(b.x)], 1u);
    return b;
}
__device__ __forceinline__ void xcd_barrier_complete(unsigned* bar, unsigned x, unsigned& nloc, unsigned& nx) {
    const unsigned G = gridDim.x * gridDim.y * gridDim.z;
    unsigned sum, cnt, mine, sp = 0u;
    for (;;) {
        sum = 0u; cnt = 0u; mine = 0u;
#pragma unroll
        for (unsigned j = 0; j < 16; ++j) { const unsigned c = xb_ld(&bar[XB_XCNT(j)]); sum += c; cnt += (c > 0u) ? 1u : 0u; mine = (j == x) ? c : mine; }
        if (sum == G) break;
        __builtin_amdgcn_s_sleep(1);
        if ((++sp & 255u) == 0u) { if (xb_ld(&bar[XB_TMO])) break; if (sp > XB_SPIN_CAP) { atomicAdd(&bar[XB_TMO], 1u); break; } }
    }
    nloc = mine > 0u ? mine : 1u; nx = cnt > 0u ? cnt : 1u;
}
__device__ __forceinline__ void xcd_barrier(const XcdBarrier& b) {
    asm volatile("s_waitcnt vmcnt(0)" ::: "memory");
    __syncthreads();
    if (threadIdx.x == 0) {
        unsigned* bar = b.bar;
        __builtin_amdgcn_s_waitcnt(0);
        unsigned nloc = b.st[0], nx = b.st[1];
        if (nloc == 0u) { xcd_barrier_complete(bar, b.x, nloc, nx); b.st[0] = nloc; b.st[1] = nx; }
        const unsigned old = xb_add(&bar[XB_XSUB(b.x)], 1u);
        const unsigned gen = old / nloc;
        if (old + 1u == (gen + 1u) * nloc) {
            __builtin_amdgcn_fence(__ATOMIC_RELEASE, "agent");
            asm volatile("s_waitcnt vmcnt(0)" ::: "memory");
            const unsigned og = xb_add(&bar[XB_TOP], 1u);
            const unsigned tg = og / nx;
            if (og + 1u == (tg + 1u) * nx) xb_add(&bar[XB_TOPGEN], 1u);
            else XB_SPIN(xb_ld(&bar[XB_TOPGEN]) == tg, bar);
            __builtin_amdgcn_fence(__ATOMIC_ACQUIRE, "agent");
            xb_add(&bar[XB_XGEN(b.x)], 1u);
            asm volatile("s_waitcnt vmcnt(0)" ::: "memory");
        } else {
            XB_SPIN(xb_ld(&bar[XB_XGEN(b.x)]) == gen, bar);
            __builtin_amdgcn_fence(__ATOMIC_ACQUIRE, "agent");
            asm volatile("s_waitcnt vmcnt(0)" ::: "memory");
        }
    }
    __syncthreads();
}

namespace pg8 {
constexpr int BM = 256, BK = 64, HALF = 128, HTB = HALF * BK * 2, STAGE_BYTES = 8 * HTB, NXCD = 8, WGM = 8;
__host__ __device__ __forceinline__ int lds_byte(int r, int c) { const int st = (r >> 4) * 2 + (c >> 5), rr = r & 15, cc = c & 31, ob = rr * 64 + cc * 2; return st * 1024 + (ob ^ (((ob >> 9) & 1) << 5)); }
__host__ __device__ __forceinline__ void stage_rc(int b, int& R, int& C) { const int st = b / 1024, sb = b % 1024, swz = sb ^ (((sb >> 9) & 1) << 5); R = (st >> 1) * 16 + swz / 64; C = (st & 1) * 32 + (swz % 64) / 2; }
__host__ __device__ __forceinline__ int perm32(int rho) { const int n = rho >> 4, i = rho & 15; return 8 * (i >> 2) + 4 * n + (i & 3); }

struct Unit { const char* A; const char* B; const int* rows; int pm, pn, ex, cnt; };
struct Cfg { int K; unsigned lda, ldb; };
__device__ __forceinline__ void tile_of(int L, int nM, int nN, int& pm, int& pn) {
    const int nwg = nM * nN; int wgid = L; { const int q = nwg / NXCD, r = nwg % NXCD, xcd = wgid % NXCD, off = wgid / NXCD; wgid = (xcd < r ? xcd * (q + 1) : r * (q + 1) + (xcd - r) * q) + off; }
    const int nig = WGM * nN, gid = wgid / nig, fm = gid * WGM, gsz = (nM - fm) < WGM ? (nM - fm) : WGM;
    pm = fm + ((wgid % nig) % gsz); pn = (wgid % nig) / gsz;
}

template <class Epi, class Sched, bool GATHER>
__device__ __forceinline__ void gemm_phase(LAS unsigned char* lds, const Cfg g, const Sched& S, const Epi& E) {
    const int tid = threadIdx.x, wid = __builtin_amdgcn_readfirstlane(tid >> 6), lane = tid & 63, wr = wid >> 2, wc = wid & 3, fr = lane & 15, fq = lane >> 4;
    const int nt = g.K / BK;
    unsigned voffB[2], vA[2][2], vN[2][2]; int Rr[2]; unsigned Cb[2];
#pragma unroll
    for (int i = 0; i < 2; ++i) { int R, C; stage_rc(tid * 16 + i * 8192, R, C); const int Rb = Epi::PERM ? ((R & ~31) + perm32(R & 31)) : R;
        Rr[i] = R; Cb[i] = (unsigned)C * 2u; voffB[i] = (unsigned)Rb * g.ldb + (unsigned)C * 2u;
        vA[0][i] = (unsigned)R * g.lda + (unsigned)C * 2u; vA[1][i] = (unsigned)(R + HALF) * g.lda + (unsigned)C * 2u; vN[0][i] = vA[0][i]; vN[1][i] = vA[1][i]; }
    const size_t kstep = (size_t)(BK * 2);
    const size_t hstepB = (size_t)HALF * g.ldb;
    const unsigned ldsw = (unsigned)wid * 1024u;
    const int aoff = lds_byte(wr * 64 + fr, fq * 8), boff = lds_byte(wc * 32 + fr, fq * 8);
#define PG8_SA(b, h) (((b) * 2 + (h)) * HTB)
#define PG8_SB(b, h) ((4 + (b) * 2 + (h)) * HTB)
#define PG8_STAGE(bufoff, gbase, voff) do { _Pragma("unroll") for (int _i = 0; _i < 2; ++_i) \
        __builtin_amdgcn_global_load_lds((const unsigned*)((const char*)(gbase) + (voff)[_i]), (LAS unsigned*)(lds + (bufoff) + ldsw + _i * 8192), 16, 0, 0); } while (0)
#define PG8_STAGE_AX(bufoff, gbase, h, usenext) do { unsigned _vo[2]; _vo[0] = (usenext) ? vN[h][0] : vA[h][0]; _vo[1] = (usenext) ? vN[h][1] : vA[h][1]; PG8_STAGE(bufoff, gbase, _vo); } while (0)
#define PG8_LDA(dst, b, h) do { _Pragma("unroll") for (int m = 0; m < 4; ++m) _Pragma("unroll") for (int k = 0; k < 2; ++k) dst[m][k] = *(const LAS bf16x8*)(lds + PG8_SA(b, h) + aoff + m * 2048 + k * 1024); } while (0)
#define PG8_LDB(dst, b, h) do { _Pragma("unroll") for (int n = 0; n < 2; ++n) _Pragma("unroll") for (int k = 0; k < 2; ++k) dst[n][k] = *(const LAS bf16x8*)(lds + PG8_SB(b, h) + boff + n * 2048 + k * 1024); } while (0)
#define PG8_MMA(ai, bj, At, Bt) do { __builtin_amdgcn_s_setprio(1); _Pragma("unroll") for (int m = 0; m < 4; ++m) _Pragma("unroll") for (int n = 0; n < 2; ++n) _Pragma("unroll") for (int k = 0; k < 2; ++k) \
        acc[ai][bj][m][n] = __builtin_amdgcn_mfma_f32_16x16x32_bf16(Bt[n][k], At[m][k], acc[ai][bj][m][n], 0, 0, 0); __builtin_amdgcn_s_setprio(0); } while (0)
#define PG8_WAIT_V(n) asm volatile("s_waitcnt vmcnt(" #n ")" ::: "memory")
#define PG8_WAIT_L(n) asm volatile("s_waitcnt lgkmcnt(" #n ")" ::: "memory")
#define PG8_BAR __builtin_amdgcn_s_barrier()
#define PG8_SCHED __builtin_amdgcn_sched_barrier(0)
#define PG8_GATHER_LOAD(dst, u) do { _Pragma("unroll") for (int _h = 0; _h < 2; ++_h) _Pragma("unroll") for (int _i = 0; _i < 2; ++_i) { const int _r = _h * HALF + Rr[_i]; \
        const int _a = (_r < (u).cnt) ? ((u).rows[_r] >> 1) : 0; dst[_h][_i] = (unsigned)_a * g.lda + Cb[_i]; } } while (0)
    Unit cur, nxt; int ui = 0;
    if (!S.next(0, cur)) return;
    f32x4 acc[2][2][4][2];
#pragma unroll
    for (int a = 0; a < 2; ++a)
#pragma unroll
        for (int b = 0; b < 2; ++b)
#pragma unroll
            for (int m = 0; m < 4; ++m)
#pragma unroll
                for (int n = 0; n < 2; ++n) acc[a][b][m][n] = (f32x4){0.f, 0.f, 0.f, 0.f};
    bf16x8 At[4][2], B0[2][2], B1[2][2];
    const char* cA = cur.A; const char* cB = cur.B;
    if constexpr (GATHER) { PG8_GATHER_LOAD(vA, cur); __builtin_amdgcn_s_waitcnt(0x0F70); }
    PG8_STAGE(PG8_SB(0, 0), cB, voffB); PG8_STAGE(PG8_SB(0, 1), cB + hstepB, voffB); PG8_STAGE(PG8_SA(0, 0), cA, vA[0]); PG8_STAGE(PG8_SA(0, 1), cA, vA[1]);
    if (wr == 1) PG8_BAR;
    PG8_WAIT_V(2); PG8_BAR;
    PG8_STAGE(PG8_SB(1, 0), cB + kstep, voffB); PG8_STAGE(PG8_SA(1, 0), cA + kstep, vA[0]); PG8_STAGE(PG8_SB(1, 1), cB + hstepB + kstep, voffB);
    PG8_WAIT_V(6); PG8_BAR;
    for (;;) {
        const bool has_next = S.next(ui + 1, nxt);
        const char* nA = has_next ? nxt.A : cA; const char* nB = has_next ? nxt.B : cB;
        if constexpr (GATHER) {
            if (has_next) { PG8_GATHER_LOAD(vN, nxt); __builtin_amdgcn_s_waitcnt(0x0F70); }
            else {
#pragma unroll
                for (int h = 0; h < 2; ++h)
#pragma unroll
                    for (int i = 0; i < 2; ++i) vN[h][i] = vA[h][i]; }
        }
        for (int t = 0; t < nt; t += 2) {
            const bool last = (t == nt - 2);
            const char* a1 = cA + (size_t)(t + 1) * kstep;
            const char* a2 = last ? nA : cA + (size_t)(t + 2) * kstep; const char* b2 = last ? nB : cB + (size_t)(t + 2) * kstep;
            const char* a3 = a2 + kstep; const char* b3 = b2 + kstep;
            const bool un = GATHER && last;
            PG8_LDB(B0, 0, 0); PG8_LDB(B1, 0, 1); PG8_SCHED; PG8_LDA(At, 0, 0); PG8_STAGE(PG8_SA(1, 1), a1, vA[1]);
            PG8_WAIT_V(8); PG8_WAIT_L(0); PG8_BAR; PG8_MMA(0, 0, At, B0); PG8_MMA(0, 1, At, B1); PG8_BAR; PG8_SCHED;
            PG8_LDA(At, 0, 1); PG8_STAGE(PG8_SB(0, 0), b2, voffB); PG8_STAGE(PG8_SB(0, 1), b2 + hstepB, voffB); PG8_STAGE_AX(PG8_SA(0, 0), a2, 0, un);
            PG8_WAIT_V(8); PG8_WAIT_L(0); PG8_BAR; PG8_MMA(1, 0, At, B0); PG8_MMA(1, 1, At, B1); PG8_BAR; PG8_SCHED;
            PG8_LDB(B0, 1, 0); PG8_LDB(B1, 1, 1); PG8_SCHED; PG8_LDA(At, 1, 0); PG8_STAGE_AX(PG8_SA(0, 1), a2, 1, un);
            PG8_WAIT_V(8); PG8_WAIT_L(0); PG8_BAR; PG8_MMA(0, 0, At, B0); PG8_MMA(0, 1, At, B1); PG8_BAR; PG8_SCHED;
            PG8_LDA(At, 1, 1); PG8_STAGE(PG8_SB(1, 0), b3, voffB); PG8_STAGE(PG8_SB(1, 1), b3 + hstepB, voffB); PG8_STAGE_AX(PG8_SA(1, 0), a3, 0, un);
            PG8_WAIT_V(8); PG8_WAIT_L(0); PG8_BAR; PG8_MMA(1, 0, At, B0); PG8_MMA(1, 1, At, B1); PG8_BAR; PG8_SCHED;
        }
        if (wr == 0) PG8_BAR;
        const bool keep = E(acc, cur, wr, wc, fr, fq);
        if (!has_next) break;
        if (!keep) {
#pragma unroll
        for (int a = 0; a < 2; ++a)
#pragma unroll
            for (int b = 0; b < 2; ++b)
#pragma unroll
                for (int m = 0; m < 4; ++m)
#pragma unroll
                    for (int n = 0; n < 2; ++n) acc[a][b][m][n] = (f32x4){0.f, 0.f, 0.f, 0.f};
        }
        cur = nxt; cA = nA; cB = nB; ++ui;
        if constexpr (GATHER) {
#pragma unroll
            for (int h = 0; h < 2; ++h)
#pragma unroll
                for (int i = 0; i < 2; ++i) vA[h][i] = vN[h][i]; }
        if (wr == 1) PG8_BAR;
    }
    PG8_WAIT_V(0);
    PG8_BAR;
#undef PG8_SA
#undef PG8_SB
#undef PG8_STAGE
#undef PG8_STAGE_AX
#undef PG8_LDA
#undef PG8_LDB
#undef PG8_MMA
#undef PG8_WAIT_V
#undef PG8_WAIT_L
#undef PG8_BAR
#undef PG8_SCHED
#undef PG8_GATHER_LOAD
}
}


namespace pg8 {
struct UnitM { const char* A; const char* B; const int* rows; int blk, pn, ex, cnt, type; };
template <class Sched, class Epi0, class Epi1>
__device__ __forceinline__ void gemm_phase_moe(LAS unsigned char* lds, LAS unsigned char* meta, const Sched& S, const Epi0& E0, const Epi1& E1) {
    const int tid = threadIdx.x, wid = __builtin_amdgcn_readfirstlane(tid >> 6), lane = tid & 63, wr = wid >> 2, wc = wid & 3, fr = lane & 15, fq = lane >> 4;
    unsigned vA[2][2], vN[2][2], vB[2];
    const size_t kstep = (size_t)(BK * 2);
    const unsigned ldsw = (unsigned)wid * 1024u;
    const int aoff = lds_byte(wr * 64 + fr, fq * 8), boff = lds_byte(wc * 32 + fr, fq * 8);
#define PG8_SA(b, h) (((b) * 2 + (h)) * HTB)
#define PG8_SB(b, h) ((4 + (b) * 2 + (h)) * HTB)
#define PG8_STAGE_A(bufoff, gbase, voff) do { _Pragma("unroll") for (int _i = 0; _i < 2; ++_i) \
        __builtin_amdgcn_global_load_lds((const unsigned*)((const char*)(gbase) + (voff)[_i]), (LAS unsigned*)(lds + (bufoff) + ldsw + _i * 8192), 16, 0, 16); } while (0)
#define PG8_STAGE_B(bufoff, gbase, voff) do { _Pragma("unroll") for (int _i = 0; _i < 2; ++_i) \
        __builtin_amdgcn_global_load_lds((const unsigned*)((const char*)(gbase) + (voff)[_i]), (LAS unsigned*)(lds + (bufoff) + ldsw + _i * 8192), 16, 0, 0); } while (0)
#define PG8_STAGE_AX(bufoff, gbase, h, usenext) do { unsigned _vo[2]; _vo[0] = (usenext) ? vN[h][0] : vA[h][0]; _vo[1] = (usenext) ? vN[h][1] : vA[h][1]; PG8_STAGE_A(bufoff, gbase, _vo); } while (0)
#define PG8_STAGE_BX(bufoff, gbase, usenext) do { unsigned _vo[2]; _vo[0] = (usenext) ? vBn[0] : vB[0]; _vo[1] = (usenext) ? vBn[1] : vB[1]; PG8_STAGE_B(bufoff, gbase, _vo); } while (0)
#define PG8_LDA(dst, b, h) do { _Pragma("unroll") for (int m = 0; m < 4; ++m) _Pragma("unroll") for (int k = 0; k < 2; ++k) dst[m][k] = *(const LAS bf16x8*)(lds + PG8_SA(b, h) + aoff + m * 2048 + k * 1024); } while (0)
#define PG8_LDB(dst, b, h) do { _Pragma("unroll") for (int n = 0; n < 2; ++n) _Pragma("unroll") for (int k = 0; k < 2; ++k) dst[n][k] = *(const LAS bf16x8*)(lds + PG8_SB(b, h) + boff + n * 2048 + k * 1024); } while (0)
#define PG8_MMA(ai, bj, At, Bt) do { __builtin_amdgcn_s_setprio(1); _Pragma("unroll") for (int m = 0; m < 4; ++m) _Pragma("unroll") for (int n = 0; n < 2; ++n) _Pragma("unroll") for (int k = 0; k < 2; ++k) \
        acc[ai][bj][m][n] = __builtin_amdgcn_mfma_f32_16x16x32_bf16(Bt[n][k], At[m][k], acc[ai][bj][m][n], 0, 0, 0); __builtin_amdgcn_s_setprio(0); } while (0)
#define PG8_WAIT_V(n) asm volatile("s_waitcnt vmcnt(" #n ")" ::: "memory")
#define PG8_WAIT_L(n) asm volatile("s_waitcnt lgkmcnt(" #n ")" ::: "memory")
#define PG8_BAR __builtin_amdgcn_s_barrier()
#define PG8_SCHED __builtin_amdgcn_sched_barrier(0)
#define PG8_SETUP(u, vAx, vBx) do { const unsigned _ld = (u).type ? 1024u : 2048u; \
        _Pragma("unroll") for (int _i = 0; _i < 2; ++_i) { int _R, _C; stage_rc(tid * 16 + _i * 8192, _R, _C); asm volatile("" : "+v"(_R), "+v"(_C)); const unsigned _cb = (unsigned)_C * 2u; \
            _Pragma("unroll") for (int _h = 0; _h < 2; ++_h) { const int _r = _h * HALF + _R; \
                const int _a = (u).type ? _r : ((_r < (u).cnt) ? ((u).rows[_r] >> 1) : 0); vAx[_h][_i] = (unsigned)_a * _ld + _cb; } \
            vBx[_i] = (unsigned)((_R & ~31) + perm32(_R & 31)) * _ld + _cb; } } while (0)
#define PG8_META(u, n) do { if (tid < 256) { u32x4 _mv = (u32x4){0xFFFFFFFFu, 0u, 0u, 0u}; \
        if (tid < (u).cnt) { const u32x2 _w2 = ((const u32x2*)S.rwlist)[((u).rows - S.alist) + tid]; _mv.x = (unsigned)(u).rows[tid]; _mv.y = _w2.x; _mv.z = _w2.y; } \
        *(LAS u32x4*)(meta + (((n) & 1) * 256 + tid) * 16) = _mv; } } while (0)
#define PG8_PUBLISH() do { if (pend >= 0) { if (lane == 0) __hip_atomic_fetch_add(S.ready + pend, 1u, __ATOMIC_RELAXED, __HIP_MEMORY_SCOPE_AGENT); pend = -1; } } while (0)
    int pend = -1;
    UnitM cur, nxt; int ui = 0;
    bool have = S.next(0, cur);
    f32x4 acc[2][2][4][2];
    bf16x8 At[4][2], B0[2][2], B1[2][2];
    while (have) {
#pragma unroll
        for (int a = 0; a < 2; ++a)
#pragma unroll
            for (int b = 0; b < 2; ++b)
#pragma unroll
                for (int m = 0; m < 4; ++m)
#pragma unroll
                    for (int n = 0; n < 2; ++n) acc[a][b][m][n] = (f32x4){0.f, 0.f, 0.f, 0.f};
        const char* cA = cur.A; const char* cB = cur.B; size_t hB = cur.type ? (size_t)HALF * 1024 : (size_t)HALF * 2048;
        PG8_SETUP(cur, vA, vB); PG8_META(cur, ui); __builtin_amdgcn_s_waitcnt(0x0F70); asm volatile("s_waitcnt vmcnt(0)" ::: "memory"); PG8_PUBLISH();
        if (cur.type) S.wait_ready(cur);
        PG8_STAGE_B(PG8_SB(0, 0), cB, vB); PG8_STAGE_B(PG8_SB(0, 1), cB + hB, vB); PG8_STAGE_A(PG8_SA(0, 0), cA, vA[0]); PG8_STAGE_A(PG8_SA(0, 1), cA, vA[1]);
        if (wr == 1) PG8_BAR;
        PG8_WAIT_V(2); PG8_BAR;
        PG8_STAGE_B(PG8_SB(1, 0), cB + kstep, vB); PG8_STAGE_A(PG8_SA(1, 0), cA + kstep, vA[0]); PG8_STAGE_B(PG8_SB(1, 1), cB + hB + kstep, vB);
        PG8_WAIT_V(6); PG8_BAR;
        bool has_next;
        for (;;) {
            has_next = S.next(ui + 1, nxt);
            const bool chain = has_next && nxt.type == cur.type;
            const char* nA = chain ? nxt.A : cA; const char* nB = chain ? nxt.B : cB;
            if (chain) { unsigned vBn[2]; PG8_SETUP(nxt, vN, vBn); PG8_META(nxt, ui + 1); __builtin_amdgcn_s_waitcnt(0x0F70); asm volatile("s_waitcnt vmcnt(0)" ::: "memory"); PG8_PUBLISH(); }
            else {
                if (pend >= 0) { asm volatile("s_waitcnt vmcnt(0)" ::: "memory"); PG8_PUBLISH(); }
#pragma unroll
                for (int h = 0; h < 2; ++h)
#pragma unroll
                    for (int i = 0; i < 2; ++i) vN[h][i] = vA[h][i]; }
            const int nt = cur.type ? 8 : 16;
            for (int t = 0; t < nt; t += 2) {
                const bool last = (t == nt - 2);
                if (last && chain && nxt.type) S.wait_ready(nxt);
                const char* a1 = cA + (size_t)(t + 1) * kstep;
                const char* a2 = last ? nA : cA + (size_t)(t + 2) * kstep; const char* b2 = last ? nB : cB + (size_t)(t + 2) * kstep; const size_t hB2 = hB;
                const char* a3 = a2 + kstep; const char* b3 = b2 + kstep;
                PG8_LDB(B0, 0, 0); PG8_LDB(B1, 0, 1); PG8_SCHED; PG8_LDA(At, 0, 0); PG8_STAGE_A(PG8_SA(1, 1), a1, vA[1]);
                PG8_WAIT_V(8); PG8_WAIT_L(0); PG8_BAR; PG8_MMA(0, 0, At, B0); PG8_MMA(0, 1, At, B1); PG8_BAR; PG8_SCHED;
                PG8_LDA(At, 0, 1); PG8_STAGE_B(PG8_SB(0, 0), b2, vB); PG8_STAGE_B(PG8_SB(0, 1), b2 + hB2, vB); PG8_STAGE_AX(PG8_SA(0, 0), a2, 0, last);
                PG8_WAIT_V(8); PG8_WAIT_L(0); PG8_BAR; PG8_MMA(1, 0, At, B0); PG8_MMA(1, 1, At, B1); PG8_BAR; PG8_SCHED;
                PG8_LDB(B0, 1, 0); PG8_LDB(B1, 1, 1); PG8_SCHED; PG8_LDA(At, 1, 0); PG8_STAGE_AX(PG8_SA(0, 1), a2, 1, last);
                PG8_WAIT_V(8); PG8_WAIT_L(0); PG8_BAR; PG8_MMA(0, 0, At, B0); PG8_MMA(0, 1, At, B1); PG8_BAR; PG8_SCHED;
                PG8_LDA(At, 1, 1); PG8_STAGE_B(PG8_SB(1, 0), b3, vB); PG8_STAGE_B(PG8_SB(1, 1), b3 + hB2, vB); PG8_STAGE_AX(PG8_SA(1, 0), a3, 0, last);
                PG8_WAIT_V(8); PG8_WAIT_L(0); PG8_BAR; PG8_MMA(1, 0, At, B0); PG8_MMA(1, 1, At, B1); PG8_BAR; PG8_SCHED;
            }
            if (wr == 0) PG8_BAR;
            if (cur.type == 0) { E0(acc, cur, wr, wc, fr, fq, meta + (ui & 1) * 4096); pend = cur.blk; } else E1(acc, cur, wr, wc, fr, fq, meta + (ui & 1) * 4096);
            if (!chain) break;
#pragma unroll
            for (int a = 0; a < 2; ++a)
#pragma unroll
                for (int b = 0; b < 2; ++b)
#pragma unroll
                    for (int m = 0; m < 4; ++m)
#pragma unroll
                        for (int n = 0; n < 2; ++n) acc[a][b][m][n] = (f32x4){0.f, 0.f, 0.f, 0.f};
            cur = nxt; cA = nA; cB = nB; ++ui;
#pragma unroll
            for (int h = 0; h < 2; ++h)
#pragma unroll
                for (int i = 0; i < 2; ++i) vA[h][i] = vN[h][i];
            if (wr == 1) PG8_BAR;
        }
        PG8_WAIT_V(0); PG8_PUBLISH();
        PG8_BAR;
        have = has_next; cur = nxt; ++ui;
    }
#undef PG8_SA
#undef PG8_SB
#undef PG8_STAGE_A
#undef PG8_STAGE_B
#undef PG8_STAGE_AX
#undef PG8_STAGE_BX
#undef PG8_LDA
#undef PG8_LDB
#undef PG8_MMA
#undef PG8_WAIT_V
#undef PG8_WAIT_L
#undef PG8_BAR
#undef PG8_SCHED
#undef PG8_SETUP
#undef PG8_PUBLISH
}
}

#ifndef MOE_DYN
#define MOE_DYN 1
#endif
#ifndef PROBE_PHASE
#define PROBE_PHASE -1
#endif
#define REP(k) _Pragma("nounroll") for (int _r = 0; _r < ((PROBE_PHASE == (k)) ? 2 : 1); ++_r)
constexpr int NWAVES = 8;
constexpr size_t WS_CTL = 0, CTL_ZERO_BYTES = 64 * 1024;
constexpr size_t WS_GIF = 1 * MiB;
constexpr size_t WS_NLOC = 1 * MiB + 512 * 1024;
constexpr size_t WS_SCAL = 2 * MiB;
constexpr size_t WS_GW = 2 * MiB + 256 * 1024;
constexpr size_t WS_ALIST = 4 * MiB;
constexpr size_t WS_RWLIST = 6 * MiB;
constexpr size_t WS_WR = 3 * MiB + 512 * 1024;
constexpr size_t WS_RSTD2 = 3 * MiB, WS_SEL = 3 * MiB + 256 * 1024;
constexpr size_t WS_WZ = 10 * MiB, WS_W2T = 19 * MiB, WS_WBT = 20 * MiB, WS_WOT = 21 * MiB, WS_WUP = 23 * MiB, WS_WDN = 87 * MiB;
constexpr size_t WS_Z = 119 * MiB;
constexpr size_t WS_KACT = 263 * MiB;
constexpr size_t WS_END = 279 * MiB;
constexpr size_t WS_X1 = WS_Z, WS_X1B = WS_Z + 64 * MiB, WS_HID = WS_Z + 96 * MiB;
constexpr size_t OB_H = 0, OB_C = 0, OB_DA = 32 * MiB, OB_HM = 48 * MiB, OB_MERGED = 0;
constexpr int CW_CNT = 64;
constexpr int CW_Q = 1024;
constexpr int CW_READY = 2048;
constexpr int CW_TMO = 8;
constexpr int CW_BAR = 4096;
constexpr int META_OFF = 131072 + 320 + 2048;
constexpr int TAB_CNT = 16, TAB_CUM = 48, TAB_HIST = 96, TAB_BASE = 128, TAB_Q = 160, TAB_XS = 164, TAB_BLK = 176;
constexpr int RING_OFF = 0, RING_BYTES = 131072, LDSCTL_OFF = RING_BYTES, MISC_OFF = LDSCTL_OFF + 320, LDS_BYTES = 147456;

struct Args { const float* in[21]; float* out; unsigned char* ws; int ph_lo, ph_hi, li, flags; };

struct SchedDense {
    const char* A; const char* B; size_t astep, bstep; int nM, nN, G, c, rep;
    __device__ __forceinline__ bool next(int i, pg8::Unit& u) const {
        long L = (long)i * G + c; if (L >= (long)nM * nN * rep) return false; L %= (long)nM * nN;
        int pm, pn; pg8::tile_of((int)L, nM, nN, pm, pn);
        u.pm = pm; u.pn = pn; u.ex = 0; u.cnt = 256; u.rows = nullptr; u.A = A + (size_t)pm * astep; u.B = B + (size_t)pn * bstep; return true; }
};
struct EpiZ {
    static constexpr bool PERM = true;
    bf16_t* z;
    __device__ __forceinline__ bool operator()(f32x4 (&acc)[2][2][4][2], const pg8::Unit& u, int wr, int wc, int fr, int fq) const {
        const int row0 = u.pm * 256 + wr * 64 + fr, col0 = u.pn * 256 + wc * 32 + 8 * fq;
#pragma unroll
        for (int ai = 0; ai < 2; ++ai)
#pragma unroll
            for (int m = 0; m < 4; ++m) { bf16_t* rowp = z + (size_t)(row0 + ai * 128 + m * 16) * NZ + col0;
#pragma unroll
                for (int bj = 0; bj < 2; ++bj) { const f32x4 v0 = acc[ai][bj][m][0], v1 = acc[ai][bj][m][1]; u32x4 w;
                    w.x = cvt_pk_bf16(v0[0], v0[1]); w.y = cvt_pk_bf16(v0[2], v0[3]); w.z = cvt_pk_bf16(v1[0], v1[1]); w.w = cvt_pk_bf16(v1[2], v1[3]);
                    *(u32x4*)(rowp + bj * 128) = w; } }
        return false;
    }
};

struct SchedMerge {
    const char* A0; const char* A1; const char* B0; const char* B1; int nM, nN, G, c;
    __device__ __forceinline__ bool next(int i, pg8::Unit& u) const {
        const long L = (long)(i >> 1) * G + c; if (L >= (long)nM * nN) return false;
        int pm, pn; pg8::tile_of((int)L, nM, nN, pm, pn); const int part = i & 1;
        u.pm = pm; u.pn = pn; u.ex = part; u.cnt = 256; u.rows = nullptr;
        u.A = (part ? A1 : A0) + (size_t)pm * 256 * DP * 2; u.B = (part ? B1 : B0) + (size_t)pn * 256 * DP * 2; return true; }
};
struct EpiMerge {
    static constexpr bool PERM = true;
    const bf16_t* z; bf16_t* mg;
    __device__ __forceinline__ bool operator()(f32x4 (&acc)[2][2][4][2], const pg8::Unit& u, int wr, int wc, int fr, int fq) const {
        const int row0 = u.pm * 256 + wr * 64 + fr, col0 = u.pn * 256 + wc * 32 + 8 * fq;
        if (u.ex == 0) {
#pragma unroll
            for (int ai = 0; ai < 2; ++ai)
#pragma unroll
                for (int m = 0; m < 4; ++m) { const bf16_t* zr = z + (size_t)(row0 + ai * 128 + m * 16) * NZ + col0;
#pragma unroll
                    for (int bj = 0; bj < 2; ++bj) { const u32x4 ga = *(const u32x4*)(zr + 2560 + bj * 128), gb = *(const u32x4*)(zr + 3584 + bj * 128);
                        float r[8];
#pragma unroll
                        for (int q = 0; q < 4; ++q) { const unsigned wa = ga[q], wb = gb[q];
                            r[2 * q] = (1.f + fast_exp(-bflo(wb))) * fast_rcp(1.f + fast_exp(-bflo(wa)));
                            r[2 * q + 1] = (1.f + fast_exp(-bfhi(wb))) * fast_rcp(1.f + fast_exp(-bfhi(wa))); }
#pragma unroll
                        for (int q = 0; q < 4; ++q) { acc[ai][bj][m][0][q] *= r[q]; acc[ai][bj][m][1][q] *= r[4 + q]; } } }
            return true;
        }
#pragma unroll
        for (int ai = 0; ai < 2; ++ai)
#pragma unroll
            for (int m = 0; m < 4; ++m) { const size_t row = (size_t)(row0 + ai * 128 + m * 16); const bf16_t* zr = z + row * NZ + col0; bf16_t* mr = mg + row * D + col0;
#pragma unroll
                for (int bj = 0; bj < 2; ++bj) { const u32x4 gb = *(const u32x4*)(zr + 3584 + bj * 128);
                    float sg[8];
#pragma unroll
                    for (int q = 0; q < 4; ++q) { sg[2 * q] = fsigmoid(bflo(gb[q])); sg[2 * q + 1] = fsigmoid(bfhi(gb[q])); }
                    const f32x4 v0 = acc[ai][bj][m][0], v1 = acc[ai][bj][m][1]; u32x4 w;
                    w.x = cvt_pk_bf16(v0[0] * sg[0], v0[1] * sg[1]); w.y = cvt_pk_bf16(v0[2] * sg[2], v0[3] * sg[3]);
                    w.z = cvt_pk_bf16(v1[0] * sg[4], v1[1] * sg[5]); w.w = cvt_pk_bf16(v1[2] * sg[6], v1[3] * sg[7]);
                    *(u32x4*)(mr + bj * 128) = w; } }
        return false;
    }
};
struct EpiX1 {
    static constexpr bool PERM = true;
    const float* x; bf16_t* x1b;
    __device__ __forceinline__ bool operator()(f32x4 (&acc)[2][2][4][2], const pg8::Unit& u, int wr, int wc, int fr, int fq) const {
        const int row0 = u.pm * 256 + wr * 64 + fr, col0 = u.pn * 256 + wc * 32 + 8 * fq;
#pragma unroll
        for (int ai = 0; ai < 2; ++ai)
#pragma unroll
            for (int m = 0; m < 4; ++m) { const size_t off = (size_t)(row0 + ai * 128 + m * 16) * D + col0;
#pragma unroll
                for (int bj = 0; bj < 2; ++bj) { const f32x4 x0 = *(const f32x4*)(x + off + bj * 128), x1v = *(const f32x4*)(x + off + bj * 128 + 4);
                    const f32x4 v0 = acc[ai][bj][m][0] + x0, v1 = acc[ai][bj][m][1] + x1v; u32x4 w;
                    w.x = cvt_pk_bf16(v0[0], v0[1]); w.y = cvt_pk_bf16(v0[2], v0[3]); w.z = cvt_pk_bf16(v1[0], v1[1]); w.w = cvt_pk_bf16(v1[2], v1[3]);
                    *(u32x4*)(x1b + off + bj * 128) = w; } }
        return false;
    }
};

struct SchedMoE {
    volatile LAS unsigned* M; const char* A; const char* Bw; const int* alist; size_t bstepE, bstepN, astepBlk; int G, c, gather, rep;
    __device__ __forceinline__ bool next(int i, pg8::Unit& u) const {
        int L = i * G + c; const int tot = (int)M[TAB_CUM + 32];
        if (L >= 4 * tot * rep) return false; L %= 4 * tot;
        int e = 0;
        while (e < 31 && L >= 4 * (int)M[TAB_CUM + e + 1]) ++e;
        const int cb = (int)M[TAB_CUM + e], nb = (int)M[TAB_CUM + e + 1] - cb, r = L - 4 * cb;
        int pn = r / nb, rb = r - pn * nb; int cnt = (int)M[TAB_CNT + e] - rb * 256; cnt = cnt > 256 ? 256 : cnt;
        e = __builtin_amdgcn_readfirstlane(e); pn = __builtin_amdgcn_readfirstlane(pn); rb = __builtin_amdgcn_readfirstlane(rb); cnt = __builtin_amdgcn_readfirstlane(cnt);
        const int blk = __builtin_amdgcn_readfirstlane(cb) + rb;
        u.pm = blk; u.pn = pn; u.ex = e; u.cnt = cnt; u.rows = alist + (size_t)e * T + rb * 256;
        u.A = gather ? A : A + (size_t)blk * astepBlk; u.B = Bw + (size_t)e * bstepE + (size_t)pn * bstepN; return true; }
};
struct EpiUp {
    static constexpr bool PERM = true;
    const int* alist; const f32x2* rwlist; bf16_t* hid;
    __device__ __forceinline__ bool operator()(f32x4 (&acc)[2][2][4][2], const pg8::Unit& u, int wr, int wc, int fr, int fq) const {
        const f32x2* rw = rwlist + (u.rows - alist);
        const int col0 = u.pn * 128 + wc * 32 + 8 * fq;
#pragma unroll
        for (int ai = 0; ai < 2; ++ai)
#pragma unroll
            for (int m = 0; m < 4; ++m) { const int r = ai * 128 + wr * 64 + m * 16 + fr; const float rs = (r < u.cnt) ? rw[r].x : 0.f;
                const f32x4 g0 = acc[ai][0][m][0] * rs, g1 = acc[ai][0][m][1] * rs, u0 = acc[ai][1][m][0] * rs, u1 = acc[ai][1][m][1] * rs;
                float o[8];
#pragma unroll
                for (int q = 0; q < 4; ++q) { o[q] = g0[q] * fsigmoid(g0[q]) * u0[q]; o[4 + q] = g1[q] * fsigmoid(g1[q]) * u1[q]; }
                u32x4 w; w.x = cvt_pk_bf16(o[0], o[1]); w.y = cvt_pk_bf16(o[2], o[3]); w.z = cvt_pk_bf16(o[4], o[5]); w.w = cvt_pk_bf16(o[6], o[7]);
                *(u32x4*)(hid + (size_t)(u.pm * 256 + r) * DE + col0) = w; }
        return false;
    }
};
struct EpiDown {
    static constexpr bool PERM = true;
    const int* alist; const f32x2* rwlist; bf16_t* yb;
    __device__ __forceinline__ bool operator()(f32x4 (&acc)[2][2][4][2], const pg8::Unit& u, int wr, int wc, int fr, int fq) const {
        const f32x2* rw = rwlist + (u.rows - alist);
        const int col0 = u.pn * 256 + wc * 32 + 8 * fq;
#pragma unroll
        for (int ai = 0; ai < 2; ++ai)
#pragma unroll
            for (int m = 0; m < 4; ++m) { const int r = ai * 128 + wr * 64 + m * 16 + fr;
                if (r < u.cnt) { const int a = u.rows[r]; const float w8 = rw[r].y; bf16_t* yr = yb + (size_t)a * D + col0;
#pragma unroll
                    for (int bj = 0; bj < 2; ++bj) { const f32x4 v0 = acc[ai][bj][m][0] * w8, v1 = acc[ai][bj][m][1] * w8; u32x4 w;
                        w.x = cvt_pk_bf16(v0[0], v0[1]); w.y = cvt_pk_bf16(v0[2], v0[3]); w.z = cvt_pk_bf16(v1[0], v1[1]); w.w = cvt_pk_bf16(v1[2], v1[3]);
                        *(u32x4*)(yr + bj * 128) = w; } } }
        return false;
    }
};

struct SchedMoEQ {
    volatile LAS unsigned* M; unsigned* ctl; const char* x1b; const char* hid; const char* wup; const char* wdn; const int* alist; const f32x2* rwlist; unsigned* ready; int xcc, wave, lane;
    __device__ __forceinline__ bool next(int i, pg8::UnitM& u) const {
        if (wave == 0) {
            if (lane == 0) {
                unsigned code = 0xFFFFFFFFu; int sft = (int)M[TAB_XS]; const int tot = (int)M[TAB_CUM + 32];
                while (sft < 8) { const int x = (xcc + sft) & 7; const int b0 = x * tot / 8, b1 = (x + 1) * tot / 8; const unsigned nq = (unsigned)(b1 - b0) * 4u;
                    const unsigned p = nq ? __hip_atomic_fetch_add(ctl + CW_Q + 64 * x, 1u, __ATOMIC_RELAXED, __HIP_MEMORY_SCOPE_AGENT) : 0xFFFFFFFFu;
                    if (p < 2u * nq) { code = (p < nq) ? ((unsigned)b0 * 4u + p) : (0x80000000u | ((unsigned)b0 * 4u + (p - nq))); break; }
                    ++sft; }
                M[TAB_XS] = (unsigned)sft; M[TAB_Q + (i & 1)] = code;
            }
            asm volatile("s_waitcnt lgkmcnt(0)" ::: "memory");
        }
        asm volatile("" ::: "memory"); __builtin_amdgcn_s_barrier(); asm volatile("" ::: "memory");
        const unsigned code = (unsigned)__builtin_amdgcn_readfirstlane((int)M[TAB_Q + (i & 1)]);
        if (code == 0xFFFFFFFFu) return false;
        const int type = (int)(code >> 31), L = (int)(code & 0x7FFFFFFFu), blk = L >> 2, pn = L & 3;
        const int e = __builtin_amdgcn_readfirstlane((int)M[TAB_BLK + blk]);
        const int rb = blk - __builtin_amdgcn_readfirstlane((int)M[TAB_CUM + e]); int cnt = __builtin_amdgcn_readfirstlane((int)M[TAB_CNT + e]) - rb * 256; cnt = cnt > 256 ? 256 : cnt;
        u.blk = blk; u.pn = pn; u.ex = e; u.cnt = cnt; u.type = type; u.rows = alist + (size_t)e * T + rb * 256;
        if (type == 0) { u.A = x1b; u.B = wup + ((size_t)e * 1024 + pn * 256) * (D * 2); }
        else { u.A = hid + (size_t)blk * 256 * (DE * 2); u.B = wdn + ((size_t)e * 1024 + pn * 256) * (DE * 2); }
        return true;
    }
    __device__ __forceinline__ void wait_ready(const pg8::UnitM& u) const {
        unsigned spins = 0;
        while ((unsigned)__builtin_amdgcn_readfirstlane((int)__hip_atomic_load(ctl + CW_READY + u.blk, __ATOMIC_RELAXED, __HIP_MEMORY_SCOPE_AGENT)) < 32u) {
            __builtin_amdgcn_s_sleep(2);
            if (++spins > (1u << 22)) { if (lane == 0) __hip_atomic_store(ctl + CW_TMO, 1u, __ATOMIC_RELAXED, __HIP_MEMORY_SCOPE_AGENT); break; } }
    }
};
struct EpiUpQ {
    bf16_t* hid;
    __device__ __forceinline__ void operator()(f32x4 (&acc)[2][2][4][2], const pg8::UnitM& u, int wr, int wc, int fr, int fq, const LAS unsigned char* meta) const {
        const __amdgpu_buffer_rsrc_t rs = __builtin_amdgcn_make_buffer_rsrc(hid, 0, 40960 * DE * 2, 0x00020000);
        const int col0 = u.pn * 128 + wc * 32 + 8 * fq;
#pragma unroll
        for (int ai = 0; ai < 2; ++ai)
#pragma unroll
            for (int m = 0; m < 4; ++m) { const int r = ai * 128 + wr * 64 + m * 16 + fr; const unsigned rbits = ((const LAS unsigned*)meta)[4 * r + 1]; const float rsd = u2f(rbits);
                const f32x4 g0 = acc[ai][0][m][0] * rsd, g1 = acc[ai][0][m][1] * rsd, u0 = acc[ai][1][m][0] * rsd, u1 = acc[ai][1][m][1] * rsd;
                float o[8];
#pragma unroll
                for (int q = 0; q < 4; ++q) { o[q] = g0[q] * fsigmoid(g0[q]) * u0[q]; o[4 + q] = g1[q] * fsigmoid(g1[q]) * u1[q]; }
                u32x4 w; w.x = cvt_pk_bf16(o[0], o[1]); w.y = cvt_pk_bf16(o[2], o[3]); w.z = cvt_pk_bf16(o[4], o[5]); w.w = cvt_pk_bf16(o[6], o[7]);
                __builtin_amdgcn_raw_buffer_store_b128(w, rs, (int)(((unsigned)(u.blk * 256 + r) * DE + col0) * 2u), 0, 16);
                if (m & 1) asm volatile("" ::: "memory"); }
    }
};
struct EpiDownQ {
    bf16_t* yb;
    __device__ __forceinline__ void operator()(f32x4 (&acc)[2][2][4][2], const pg8::UnitM& u, int wr, int wc, int fr, int fq, const LAS unsigned char* meta) const {
        const int col0 = u.pn * 256 + wc * 32 + 8 * fq;
#pragma unroll
        for (int ai = 0; ai < 2; ++ai)
#pragma unroll
            for (int m = 0; m < 4; ++m) { const int r = ai * 128 + wr * 64 + m * 16 + fr; const unsigned abits = ((const LAS unsigned*)meta)[4 * r], wbits = ((const LAS unsigned*)meta)[4 * r + 2];
                if ((int)abits >= 0) { const float w8 = u2f(wbits); bf16_t* yr = yb + (size_t)abits * D + col0;
#pragma unroll
                    for (int bj = 0; bj < 2; ++bj) { const f32x4 v0 = acc[ai][bj][m][0] * w8, v1 = acc[ai][bj][m][1] * w8; u32x4 w;
                        w.x = cvt_pk_bf16(v0[0], v0[1]); w.y = cvt_pk_bf16(v0[2], v0[3]); w.z = cvt_pk_bf16(v1[0], v1[1]); w.w = cvt_pk_bf16(v1[2], v1[3]);
                        *(u32x4*)(yr + bj * 128) = w; } } }
    }
};

__device__ __forceinline__ void p7_route(const Args& a, LAS unsigned char* lds, volatile LAS unsigned* MISC, int tid, int lane, int wave, int vcu, int G) {
    const float* b_rg = a.in[14]; const float* b_re = a.in[16];
    unsigned char* ws = a.ws;
    const bf16_t* x1b = (const bf16_t*)(ws + WS_X1B);
    int* alist = (int*)(ws + WS_ALIST); f32x2* rwlist = (f32x2*)(ws + WS_RWLIST); unsigned* counts = (unsigned*)(ws + WS_CTL) + CW_CNT;
    float* rstd2 = (float*)(ws + WS_RSTD2); float* gwd = (float*)(ws + WS_GW);
    { u32x4 t[12];
#pragma unroll
      for (int i = 0; i < 12; ++i) t[i] = *(const u32x4*)(ws + WS_WR + (size_t)(tid + i * 512) * 16);
#pragma unroll
      for (int i = 0; i < 12; ++i) *(LAS u32x4*)(lds + (tid + i * 512) * 16) = t[i]; }
    if (tid < 32) MISC[TAB_HIST + tid] = 0u;
    __syncthreads();
    LAS float* lgs = (LAS float*)(lds + 98304 + wave * 4096);
    for (int tile = vcu; tile < T / 64; tile += G) {
        int e1 = 0, e2 = 0, lp1 = 0, lp2 = 0; float gw1 = 0.f, gw2 = 0.f, rstd_t = 0.f;
        const int tok0 = tile * 64 + wave * 16;
        if (wave < 4) {
            const int row = lane & 15, kg = lane >> 4;
            const bf16_t* xbp = x1b + (size_t)(tok0 + row) * D + 8 * kg;
            f32x4 acc[3]; acc[0] = (f32x4){0.f, 0.f, 0.f, 0.f}; acc[1] = acc[0]; acc[2] = acc[0];
            float ss = 0.f;
#pragma unroll 8
            for (int s = 0; s < 32; ++s) {
                const u32x4 w = *(const u32x4*)(xbp + 32 * s);
#pragma unroll
                for (int q = 0; q < 4; ++q) { const float lo = bflo(w[q]), hi = bfhi(w[q]); ss += lo * lo + hi * hi; }
                const bf16x8 af = __builtin_bit_cast(bf16x8, w);
#pragma unroll
                for (int j = 0; j < 3; ++j) { const bf16x8 bfr = *(const LAS bf16x8*)(lds + (16 * j + row) * 2048 + (((4 * s + kg) ^ row) << 4));
                    acc[j] = __builtin_amdgcn_mfma_f32_16x16x32_bf16(af, bfr, acc[j], 0, 0, 0); }
            }
            ss += __shfl_xor(ss, 16); ss += __shfl_xor(ss, 32);
            const float rstd = rsqrtf(ss * (1.f / D) + EPS);
#pragma unroll
            for (int j = 0; j < 3; ++j)
#pragma unroll
                for (int q = 0; q < 4; ++q) lgs[(4 * kg + q) * 48 + 16 * j + row] = acc[j][q];
            if (lane < 16) lgs[768 + lane] = rstd;
            LDS_WAIT(); asm volatile("" ::: "memory");
            if (lane < 16) {
                rstd_t = lgs[768 + lane];
                const LAS float* lr = lgs + lane * 48;
                float lg[4];
#pragma unroll
                for (int o = 0; o < 4; ++o) lg[o] = lr[o] * rstd_t + b_rg[o];
                int gs = 0; float gm = lg[0];
#pragma unroll
                for (int o = 1; o < 4; ++o) if (lg[o] > gm) { gm = lg[o]; gs = o; }
                float den = 0.f;
#pragma unroll
                for (int o = 0; o < 4; ++o) den += __expf(lg[o] - gm);
                const float pg = 1.f / den;
                float le[8];
#pragma unroll
                for (int o = 0; o < 8; ++o) le[o] = lr[4 + gs * 8 + o] * rstd_t + b_re[gs * 8 + o];
                int i1 = 0; float m1 = le[0];
#pragma unroll
                for (int o = 1; o < 8; ++o) if (le[o] > m1) { m1 = le[o]; i1 = o; }
                int i2 = 0; float m2 = -3.0e38f;
#pragma unroll
                for (int o = 0; o < 8; ++o) if (o != i1 && le[o] > m2) { m2 = le[o]; i2 = o; }
                const float ex2 = __expf(m2 - m1), inv = 1.f / (1.f + ex2);
                e1 = gs * 8 + i1; e2 = gs * 8 + i2; gw1 = pg * inv; gw2 = pg * ex2 * inv;
                lp1 = (int)__hip_atomic_fetch_add((LAS unsigned*)&MISC[TAB_HIST + e1], 1u, __ATOMIC_RELAXED, __HIP_MEMORY_SCOPE_WORKGROUP);
                lp2 = (int)__hip_atomic_fetch_add((LAS unsigned*)&MISC[TAB_HIST + e2], 1u, __ATOMIC_RELAXED, __HIP_MEMORY_SCOPE_WORKGROUP);
            }
        }
        __syncthreads();
        if (tid < 32) { const unsigned hc = MISC[TAB_HIST + tid]; MISC[TAB_BASE + tid] = hc ? __hip_atomic_fetch_add(counts + tid, hc, __ATOMIC_RELAXED, __HIP_MEMORY_SCOPE_AGENT) : 0u; MISC[TAB_HIST + tid] = 0u; }
        __syncthreads();
        if (wave < 4 && lane < 16) {
            const int tok = tok0 + lane;
            const int p1 = (int)MISC[TAB_BASE + e1] + lp1, p2 = (int)MISC[TAB_BASE + e2] + lp2;
            alist[(size_t)e1 * T + p1] = tok * 2; rwlist[(size_t)e1 * T + p1] = (f32x2){rstd_t, gw1};
            alist[(size_t)e2 * T + p2] = tok * 2 + 1; rwlist[(size_t)e2 * T + p2] = (f32x2){rstd_t, gw2};
            rstd2[tok] = rstd_t; gwd[tok * 2] = gw1; gwd[tok * 2 + 1] = gw2;
        }
        __syncthreads();
    }
}
__device__ __forceinline__ void moe_tables(unsigned* counts, volatile LAS unsigned* MISC, int tid) {
    if (tid == 0) { unsigned cum = 0;
        for (int e = 0; e < 32; ++e) { const unsigned c = __hip_atomic_load(counts + e, __ATOMIC_RELAXED, __HIP_MEMORY_SCOPE_AGENT); MISC[TAB_CNT + e] = c; MISC[TAB_CUM + e] = cum; const unsigned nb = (c + 255u) >> 8;
            for (unsigned b = 0; b < nb; ++b) MISC[TAB_BLK + cum + b] = (unsigned)e; cum += nb; }
        MISC[TAB_CUM + 32] = cum; MISC[TAB_XS] = 0u; }
    __syncthreads();
}
__device__ __forceinline__ void p10_final(const Args& a, int lane, int wave, int vcu, int G) {
    const bf16_t* x1b = (const bf16_t*)(a.ws + WS_X1B); const float* gf = a.in[20];
    const int gw = vcu * NWAVES + wave, NGW = G * NWAVES;
    f32x4 gv[4];
#pragma unroll
    for (int j = 0; j < 4; ++j) gv[j] = *(const f32x4*)(gf + 4 * lane + 256 * j);
    u32x2 xn[4], pn[4], qn[4];
    if (gw < T) {
#pragma unroll
        for (int j = 0; j < 4; ++j) { xn[j] = ((const u32x2*)(x1b + (size_t)gw * D) + lane)[64 * j]; pn[j] = ((const u32x2*)(a.out + (size_t)gw * D) + lane)[64 * j]; qn[j] = ((const u32x2*)(a.out + (size_t)gw * D + 512) + lane)[64 * j]; } }
    for (int t = gw; t < T; t += NGW) {
        float* orow = a.out + (size_t)t * D;
        f32x4 v[4]; float s = 0.f;
#pragma unroll
        for (int j = 0; j < 4; ++j) { const u32x2 xv = xn[j], p = pn[j], q = qn[j];
            v[j].x = bflo(xv.x) + bflo(p.x) + bflo(q.x); v[j].y = bfhi(xv.x) + bfhi(p.x) + bfhi(q.x); v[j].z = bflo(xv.y) + bflo(p.y) + bflo(q.y); v[j].w = bfhi(xv.y) + bfhi(p.y) + bfhi(q.y);
            s += (v[j].x * v[j].x + v[j].y * v[j].y) + (v[j].z * v[j].z + v[j].w * v[j].w); }
        if (t + NGW < T) { const size_t tn = (size_t)(t + NGW);
#pragma unroll
            for (int j = 0; j < 4; ++j) { xn[j] = ((const u32x2*)(x1b + tn * D) + lane)[64 * j]; pn[j] = ((const u32x2*)(a.out + tn * D) + lane)[64 * j]; qn[j] = ((const u32x2*)(a.out + tn * D + 512) + lane)[64 * j]; } }
        s = wave_sum(s);
        const float rstd = rsqrtf(s * (1.f / D) + EPS);
#pragma unroll
        for (int j = 0; j < 4; ++j) ((f32x4*)orow)[lane + 64 * j] = v[j] * rstd * gv[j];
    }
}

typedef short v4i16_t __attribute__((ext_vector_type(4)));
__device__ __forceinline__ int img_off(int row, int ch) { return 2048 * (row >> 3) + 512 * (ch >> 2) + 64 * (row & 7) + 16 * ((ch & 3) ^ ((row >> 2) & 3)); }
__device__ __forceinline__ v4i16_t tr_read(LAS unsigned char* p) { return __builtin_amdgcn_ds_read_tr16_b64_v4i16((LAS v4i16_t*)p); }
__device__ __forceinline__ bf16x8 tr_frag(LAS unsigned char* img, int r0, int r1, int c0, int lane) {
    const int li = lane & 15, q = li >> 2, p = li & 3;
    const v4i16_t lo = tr_read(img + img_off(r0 + q, c0 + (p >> 1)) + 8 * (p & 1)), hi = tr_read(img + img_off(r1 + q, c0 + (p >> 1)) + 8 * (p & 1));
    return (bf16x8){lo[0], lo[1], lo[2], lo[3], hi[0], hi[1], hi[2], hi[3]};
}
__device__ __forceinline__ float wave_prefix_sum(float v, int lane) {
#pragma unroll
    for (int d = 1; d < 64; d <<= 1) { const float o = __shfl_up(v, d); if (lane >= d) v += o; }
    return v;
}
__device__ __forceinline__ float wave_prefix_max(float v, int lane) {
#pragma unroll
    for (int d = 1; d < 64; d <<= 1) { const float o = __shfl_up(v, d); if (lane >= d) v = fmaxf(v, o); }
    return v;
}
__device__ __forceinline__ float wave_max(float v) {
#pragma unroll
    for (int o = 1; o < 64; o <<= 1) v = fmaxf(v, __shfl_xor(v, o));
    return v;
}
constexpr int HALF_LDS = 50176;
__device__ __forceinline__ void conv4_silu(const u32x4 (&raw)[7], const float (&cw)[4][8], float scale, float (&out)[4][8]) {
#pragma unroll
    for (int i = 0; i < 4; ++i)
#pragma unroll
        for (int q = 0; q < 4; ++q) { float a0 = 0.f, a1 = 0.f;
#pragma unroll
            for (int j = 0; j < 4; ++j) { const unsigned w = raw[i + j][q]; a0 += bflo(w) * cw[j][2 * q]; a1 += bfhi(w) * cw[j][2 * q + 1]; }
            out[i][2 * q] = a0 * fsigmoid(a0) * scale; out[i][2 * q + 1] = a1 * fsigmoid(a1) * scale; }
}
__device__ __forceinline__ void b1_item(const Args& a, LAS unsigned char* hl, int item, int tl, int wv, int lane) {
    unsigned char* ws = a.ws; const bf16_t* z = (const bf16_t*)(ws + WS_Z); const float* gif = (const float*)(ws + WS_GIF); const float* conv_k = a.in[5];
    bf16_t* kact = (bf16_t*)(ws + WS_KACT); float* nloc = (float*)(ws + WS_NLOC); float* scal = (float*)(ws + WS_SCAL);
    unsigned char* Cb = (unsigned char*)a.out + OB_C + (size_t)item * 32768;
    const int bh = item >> 5, c = item & 31, b = bh >> 2, hh = bh & 3;
    const size_t tok_base = (size_t)b * SEQ + c * 64;
    const int cc = tl & 15, tg = tl >> 4, t0 = 4 * tg;
    u32x4 kr[7], vr[4];
#pragma unroll
    for (int j = 0; j < 7; ++j) { const int t = t0 - 3 + j; kr[j] = (c * 64 + t >= 0) ? *(const u32x4*)(z + (tok_base + t) * NZ + 1024 + hh * 128 + cc * 8) : (u32x4){0u, 0u, 0u, 0u}; }
#pragma unroll
    for (int i = 0; i < 4; ++i) vr[i] = *(const u32x4*)(z + (tok_base + t0 + i) * NZ + 1536 + hh * 128 + cc * 8);
    float cw[4][8];
#pragma unroll
    for (int j = 0; j < 4; ++j) { const f32x4 w0 = *(const f32x4*)(conv_k + j * DM + hh * 128 + cc * 8), w1 = *(const f32x4*)(conv_k + j * DM + hh * 128 + cc * 8 + 4);
        cw[j][0] = w0.x; cw[j][1] = w0.y; cw[j][2] = w0.z; cw[j][3] = w0.w; cw[j][4] = w1.x; cw[j][5] = w1.y; cw[j][6] = w1.z; cw[j][7] = w1.w; }
    LAS float* sc = (LAS float*)(hl + 49152);
    if (wv == 0) {
        const size_t tok = tok_base + lane;
        const float ig = gif[tok * 8 + hh], fp = gif[tok * 8 + 4 + hh];
        const float bb = wave_prefix_sum(logsigmoidf_(fp), lane);
        const float blast = __shfl(bb, 63);
        const float alog = blast - bb + ig;
        const float amax = wave_max(alog);
        sc[lane] = __expf(alog - amax);
        if (lane == 0) { scal[item] = amax; scal[1024 + item] = blast; }
    }
#pragma unroll
    for (int i = 0; i < 4; ++i) *(LAS u32x4*)(hl + 16384 + img_off(t0 + i, cc)) = vr[i];
    __syncthreads();
    {
        float ka[4][8]; conv4_silu(kr, cw, 0.08838834764831845f, ka);
#pragma unroll
        for (int i = 0; i < 4; ++i) { const float wl = sc[t0 + i];
            u32x4 w; w.x = pk2(ka[i][0], ka[i][1]); w.y = pk2(ka[i][2], ka[i][3]); w.z = pk2(ka[i][4], ka[i][5]); w.w = pk2(ka[i][6], ka[i][7]);
            *(u32x4*)(kact + (tok_base + t0 + i) * DM + hh * 128 + cc * 8) = w;
            u32x4 x; x.x = pk2(ka[i][0] * wl, ka[i][1] * wl); x.y = pk2(ka[i][2] * wl, ka[i][3] * wl); x.z = pk2(ka[i][4] * wl, ka[i][5] * wl); x.w = pk2(ka[i][6] * wl, ka[i][7] * wl);
            *(LAS u32x4*)(hl + img_off(t0 + i, cc)) = x; }
    }
    __syncthreads();
    {
        const int g = lane >> 4;
        bf16x8 af[2][2];
#pragma unroll
        for (int ii = 0; ii < 2; ++ii)
#pragma unroll
            for (int ks = 0; ks < 2; ++ks) af[ii][ks] = tr_frag(hl, 32 * ks + 8 * g, 32 * ks + 8 * g + 4, 2 * (2 * wv + ii), lane);
        const bf16x8 ones = (bf16x8){0x3F80, 0x3F80, 0x3F80, 0x3F80, 0x3F80, 0x3F80, 0x3F80, 0x3F80};
        f32x4 accn[2];
#pragma unroll
        for (int ii = 0; ii < 2; ++ii) { accn[ii] = (f32x4){0.f, 0.f, 0.f, 0.f};
#pragma unroll
            for (int ks = 0; ks < 2; ++ks) accn[ii] = __builtin_amdgcn_mfma_f32_16x16x32_bf16(af[ii][ks], ones, accn[ii], 0, 0, 0); }
#pragma unroll
        for (int j = 0; j < 8; ++j) {
            f32x4 acc0 = (f32x4){0.f, 0.f, 0.f, 0.f}, acc1 = acc0;
#pragma unroll
            for (int ks = 0; ks < 2; ++ks) { const bf16x8 bfv = tr_frag(hl + 16384, 32 * ks + 8 * g, 32 * ks + 8 * g + 4, 2 * j, lane);
                acc0 = __builtin_amdgcn_mfma_f32_16x16x32_bf16(af[0][ks], bfv, acc0, 0, 0, 0); acc1 = __builtin_amdgcn_mfma_f32_16x16x32_bf16(af[1][ks], bfv, acc1, 0, 0, 0); }
            u32x4 w; w.x = pk2(acc0[0], acc0[1]); w.y = pk2(acc0[2], acc0[3]); w.z = pk2(acc1[0], acc1[1]); w.w = pk2(acc1[2], acc1[3]);
            *(u32x4*)(Cb + ((size_t)((wv * 8 + j) * 64 + lane) << 4)) = w;
        }
        if ((lane & 15) == 0) {
#pragma unroll
            for (int ii = 0; ii < 2; ++ii) *(f32x4*)(nloc + (size_t)item * 128 + 16 * (2 * wv + ii) + 4 * g) = accn[ii]; }
    }
    __syncthreads();
}
__device__ __forceinline__ void pool_pass(const Args& a, int tid, int vcu, int G) {
    const bf16_t* z = (const bf16_t*)(a.ws + WS_Z); bf16_t* dA = (bf16_t*)((unsigned char*)a.out + OB_DA);
    for (int w = vcu * (NWAVES * 64) + tid; w < (T / 8) * 64; w += G * NWAVES * 64) {
        const int cc = w & 63, run = w >> 6, tokA = run * 8, s0 = tokA % SEQ, grp = cc >> 4, win = 2 << grp;
        const bf16_t* zp = z + (size_t)tokA * NZ + cc * 8;
        float S[8];
#pragma unroll
        for (int q = 0; q < 8; ++q) S[q] = 0.f;
        for (int j = 1; j <= win; ++j) if (s0 - j >= 0) { const u32x4 r = *(const u32x4*)(zp - (size_t)j * NZ);
#pragma unroll
            for (int q = 0; q < 4; ++q) { S[2 * q] += bflo(r[q]); S[2 * q + 1] += bfhi(r[q]); } }
#pragma unroll
        for (int i = 0; i < 8; ++i) {
            const int s = s0 + i; const u32x4 r = *(const u32x4*)(zp + (size_t)i * NZ);
            float cur[8];
#pragma unroll
            for (int q = 0; q < 4; ++q) { cur[2 * q] = bflo(r[q]); cur[2 * q + 1] = bfhi(r[q]); S[2 * q] += cur[2 * q]; S[2 * q + 1] += cur[2 * q + 1]; }
            if (s - win >= 0) { const u32x4 o = *(const u32x4*)(zp + (size_t)(i - win) * NZ);
#pragma unroll
                for (int q = 0; q < 4; ++q) { S[2 * q] -= bflo(o[q]); S[2 * q + 1] -= bfhi(o[q]); } }
            const float inv = 1.f / (float)(s + 1 < win ? s + 1 : win);
            u32x4 w4;
#pragma unroll
            for (int q = 0; q < 4; ++q) w4[q] = pk2(S[2 * q] * inv - cur[2 * q], S[2 * q + 1] * inv - cur[2 * q + 1]);
            *(u32x4*)(dA + (size_t)(tokA + i) * DP + cc * 8) = w4;
        }
    }
}
__device__ __forceinline__ void p3_scan(const Args& a, int tid, int vcu, int G) {
    float* scal = (float*)(a.ws + WS_SCAL); float* nloc = (float*)(a.ws + WS_NLOC);
    for (int w = vcu; w < 256; w += G) {
        const int bh = w >> 3, part = w & 7;
        unsigned char* Cp = (unsigned char*)a.out + OB_C + (size_t)bh * 32 * 32768 + (size_t)(part * 512 + tid) * 8;
        u32x2 ld[32];
#pragma unroll
        for (int c = 0; c < 32; ++c) ld[c] = *(const u32x2*)(Cp + (size_t)c * 32768);
        const bool do_n = (part == 0 && tid < 128);
        float nl[32];
        if (do_n) {
#pragma unroll
            for (int c = 0; c < 32; ++c) nl[c] = nloc[(size_t)(bh * 32 + c) * 128 + tid]; }
        float st[4] = {0.f, 0.f, 0.f, 0.f}; float m = 0.f, nst = 0.f;
#pragma unroll
        for (int c = 0; c < 32; ++c) {
            const float am = scal[bh * 32 + c], bl = scal[1024 + bh * 32 + c];
            const float mn = fmaxf(bl + m, am), sp = __expf(bl + m - mn), sl = __expf(am - mn);
            u32x2 o; o.x = pk2(st[0], st[1]); o.y = pk2(st[2], st[3]); *(u32x2*)(Cp + (size_t)c * 32768) = o;
            st[0] = sp * st[0] + sl * bflo(ld[c].x); st[1] = sp * st[1] + sl * bfhi(ld[c].x); st[2] = sp * st[2] + sl * bflo(ld[c].y); st[3] = sp * st[3] + sl * bfhi(ld[c].y);
            if (do_n) { nloc[(size_t)(bh * 32 + c) * 128 + tid] = nst; nst = sp * nst + sl * nl[c]; }
            if (part == 0 && tid == 0) scal[2048 + bh * 32 + c] = m;
            m = mn;
        }
    }
}
__device__ __forceinline__ void b3_item(const Args& a, LAS unsigned char* hl, const LAS float* ghl, int item, int tl, int wv, int lane) {
    unsigned char* ws = a.ws; const bf16_t* z = (const bf16_t*)(ws + WS_Z); const float* gif = (const float*)(ws + WS_GIF); const float* conv_q = a.in[4]; const float* g_head = a.in[6];
    const bf16_t* kact = (const bf16_t*)(ws + WS_KACT); const float* nprev = (const float*)(ws + WS_NLOC) + (size_t)item * 128; const float* scal = (const float*)(ws + WS_SCAL);
    const unsigned char* Cb = (const unsigned char*)a.out + OB_C + (size_t)item * 32768; bf16_t* hm = (bf16_t*)((unsigned char*)a.out + OB_HM);
    const int bh = item >> 5, c = item & 31, b = bh >> 2, hh = bh & 3;
    const size_t tok_base = (size_t)b * SEQ + c * 64;
    const int cc = tl & 15, tg = tl >> 4, t0 = 4 * tg;
    LAS unsigned char* qi = hl; LAS unsigned char* ki = hl + 16384; LAS unsigned char* vi = hl + 32768; LAS float* sc = (LAS float*)(hl + 49152);
    const float mprev = scal[2048 + item];
    u32x4 cpre[8]; u32x2 opre[8];
#pragma unroll
    for (int i = 0; i < 8; ++i) cpre[i] = *(const u32x4*)(Cb + ((size_t)((wv * 8 + i) * 64 + lane) << 4));
#pragma unroll
    for (int jd = 0; jd < 8; ++jd) opre[jd] = *(const u32x2*)(z + (tok_base + 16 * wv + (lane & 15)) * NZ + 2048 + hh * 128 + 16 * jd + 4 * (lane >> 4));
    {
        u32x4 qr[7], kv[4], vr[4];
#pragma unroll
        for (int j = 0; j < 7; ++j) { const int t = t0 - 3 + j; qr[j] = (c * 64 + t >= 0) ? *(const u32x4*)(z + (tok_base + t) * NZ + 512 + hh * 128 + cc * 8) : (u32x4){0u, 0u, 0u, 0u}; }
#pragma unroll
        for (int i = 0; i < 4; ++i) { kv[i] = *(const u32x4*)(kact + (tok_base + t0 + i) * DM + hh * 128 + cc * 8); vr[i] = *(const u32x4*)(z + (tok_base + t0 + i) * NZ + 1536 + hh * 128 + cc * 8); }
        float cw[4][8];
#pragma unroll
        for (int j = 0; j < 4; ++j) { const f32x4 w0 = *(const f32x4*)(conv_q + j * DM + hh * 128 + cc * 8), w1 = *(const f32x4*)(conv_q + j * DM + hh * 128 + cc * 8 + 4);
            cw[j][0] = w0.x; cw[j][1] = w0.y; cw[j][2] = w0.z; cw[j][3] = w0.w; cw[j][4] = w1.x; cw[j][5] = w1.y; cw[j][6] = w1.z; cw[j][7] = w1.w; }
        if (wv == 0) {
            const size_t tok = tok_base + lane;
            const float ig = gif[tok * 8 + hh], fp = gif[tok * 8 + 4 + hh];
            const float bb = wave_prefix_sum(logsigmoidf_(fp), lane);
            const float gg = ig - bb;
            const float M = fmaxf(mprev, wave_prefix_max(gg, lane));
            sc[lane] = gg; sc[64 + lane] = M; sc[128 + lane] = bb;
        }
        float qa[4][8]; conv4_silu(qr, cw, 1.f, qa);
#pragma unroll
        for (int i = 0; i < 4; ++i) { u32x4 w; w.x = pk2(qa[i][0], qa[i][1]); w.y = pk2(qa[i][2], qa[i][3]); w.z = pk2(qa[i][4], qa[i][5]); w.w = pk2(qa[i][6], qa[i][7]);
            *(LAS u32x4*)(qi + img_off(t0 + i, cc)) = w; *(LAS u32x4*)(ki + img_off(t0 + i, cc)) = kv[i]; *(LAS u32x4*)(vi + img_off(t0 + i, cc)) = vr[i]; }
    }
    __syncthreads();
    {
        const int jt = wv, li = lane & 15, g = lane >> 4, trow = 16 * jt + li;
        bf16x8 qn[4];
#pragma unroll
        for (int ks = 0; ks < 4; ++ks) qn[ks] = *(const LAS bf16x8*)(qi + img_off(trow, 4 * ks + g));
        f32x4 accs[4];
#pragma unroll
        for (int i = 0; i < 4; ++i) { accs[i] = (f32x4){0.f, 0.f, 0.f, 0.f};
            if (i <= jt) {
#pragma unroll
                for (int ks = 0; ks < 4; ++ks) { const bf16x8 kf = *(const LAS bf16x8*)(ki + img_off(16 * i + li, 4 * ks + g)); accs[i] = __builtin_amdgcn_mfma_f32_16x16x32_bf16(kf, qn[ks], accs[i], 0, 0, 0); } } }
        const float Mt = sc[64 + trow], bt = sc[128 + trow];
        float rsum = 0.f;
#pragma unroll
        for (int i = 0; i < 4; ++i) { if (i <= jt) { const f32x4 gsv = *(const LAS f32x4*)(sc + 16 * i + 4 * g);
#pragma unroll
                for (int q = 0; q < 4; ++q) { float p = accs[i][q] * __expf(gsv[q] - Mt); if (i == jt && 4 * g + q > li) p = 0.f; accs[i][q] = p; rsum += p; } } }
        rsum += __shfl_xor(rsum, 16); rsum += __shfl_xor(rsum, 32);
        bf16x8 pf[2];
#pragma unroll
        for (int u = 0; u < 2; ++u) { u32x4 w; w.x = pk2(accs[2 * u][0], accs[2 * u][1]); w.y = pk2(accs[2 * u][2], accs[2 * u][3]); w.z = pk2(accs[2 * u + 1][0], accs[2 * u + 1][1]); w.w = pk2(accs[2 * u + 1][2], accs[2 * u + 1][3]); pf[u] = __builtin_bit_cast(bf16x8, w); }
        bf16x8 qp[4];
#pragma unroll
        for (int s4 = 0; s4 < 4; ++s4) { const u32x2 lo = *(const LAS u32x2*)(qi + img_off(trow, 4 * s4 + (g >> 1)) + 8 * (g & 1)), hi = *(const LAS u32x2*)(qi + img_off(trow, 4 * s4 + 2 + (g >> 1)) + 8 * (g & 1));
            qp[s4] = __builtin_bit_cast(bf16x8, (u32x4){lo.x, lo.y, hi.x, hi.y}); }
        f32x4 acco[8]; f32x4 accn = (f32x4){0.f, 0.f, 0.f, 0.f};
#pragma unroll
        for (int s4 = 0; s4 < 4; ++s4) { const f32x4 n0 = *(const f32x4*)(nprev + 32 * s4 + 4 * g), n1 = *(const f32x4*)(nprev + 32 * s4 + 16 + 4 * g);
            u32x4 w; w.x = pk2(n0.x, n0.y); w.y = pk2(n0.z, n0.w); w.z = pk2(n1.x, n1.y); w.w = pk2(n1.z, n1.w);
            accn = __builtin_amdgcn_mfma_f32_16x16x32_bf16(__builtin_bit_cast(bf16x8, w), qp[s4], accn, 0, 0, 0); }
        LDS_WAIT(); __syncthreads();
#pragma unroll
        for (int i = 0; i < 8; ++i) *(LAS u32x4*)(hl + (((wv * 8 + i) * 64 + lane) << 4)) = cpre[i];
        LDS_WAIT(); __syncthreads();
#pragma unroll
        for (int jd = 0; jd < 8; ++jd) { acco[jd] = (f32x4){0.f, 0.f, 0.f, 0.f};
#pragma unroll
            for (int s4 = 0; s4 < 4; ++s4) { const bf16x8 cf = *(const LAS bf16x8*)(hl + (((s4 * 8 + jd) * 64 + lane) << 4)); acco[jd] = __builtin_amdgcn_mfma_f32_16x16x32_bf16(cf, qp[s4], acco[jd], 0, 0, 0); } }
        const float winter = __expf(mprev - Mt);
#pragma unroll
        for (int jd = 0; jd < 8; ++jd) acco[jd] = acco[jd] * winter;
#pragma unroll
        for (int u = 0; u < 2; ++u) { if (2 * u <= jt) {
#pragma unroll
                for (int jd = 0; jd < 8; ++jd) { const bf16x8 vf = tr_frag(vi, 32 * u + 4 * g, 32 * u + 16 + 4 * g, 2 * jd, lane); acco[jd] = __builtin_amdgcn_mfma_f32_16x16x32_bf16(vf, pf[u], acco[jd], 0, 0, 0); } } }
        const float nq = winter * accn[0] + rsum;
        const float inv = 1.f / fmaxf(fabsf(nq), __expf(-bt - Mt));
        float s1 = 0.f;
#pragma unroll
        for (int jd = 0; jd < 8; ++jd) { acco[jd] = acco[jd] * inv; s1 += (acco[jd][0] + acco[jd][1]) + (acco[jd][2] + acco[jd][3]); }
        s1 += __shfl_xor(s1, 16); s1 += __shfl_xor(s1, 32);
        const float mu = s1 * (1.f / HD);
        float s2 = 0.f;
#pragma unroll
        for (int jd = 0; jd < 8; ++jd) { const f32x4 d = acco[jd] - mu; s2 += (d[0] * d[0] + d[1] * d[1]) + (d[2] * d[2] + d[3] * d[3]); }
        s2 += __shfl_xor(s2, 16); s2 += __shfl_xor(s2, 32);
        const float rstd = rsqrtf(s2 * (1.f / HD) + EPS);
        const size_t tok = tok_base + trow;
#pragma unroll
        for (int jd = 0; jd < 8; ++jd) { const int dv0 = hh * 128 + 16 * jd + 4 * g;
            const f32x4 gh = *(const LAS f32x4*)(ghl + dv0); const u32x2 ov = opre[jd];
            const f32x4 hn = (acco[jd] - mu) * rstd * gh;
            u32x2 w; w.x = pk2(hn[0] * fsigmoid(bflo(ov.x)), hn[1] * fsigmoid(bfhi(ov.x))); w.y = pk2(hn[2] * fsigmoid(bflo(ov.y)), hn[3] * fsigmoid(bfhi(ov.y)));
            *(u32x2*)(hm + tok * DM + dv0) = w; }
    }
    __syncthreads();
}

constexpr int TR_PITCH = 144, TR_SCR = 64 * TR_PITCH;
struct TrDesc { const float* src; bf16_t* dst; const float* ksc; int ld, k0, n0s, dstK; };
__device__ __forceinline__ void tr64_load(const TrDesc& d, f32x4 (&v)[16], int lane) {
    const int lr = lane >> 4, lc = (lane & 15) * 4;
#pragma unroll
    for (int i = 0; i < 16; ++i) v[i] = *(const f32x4*)(d.src + (size_t)(d.k0 + 4 * i + lr) * d.ld + d.n0s + lc);
}
__device__ __forceinline__ void tr64_store(const TrDesc& d, const f32x4 (&v)[16], LAS unsigned char* scr, int lane) {
    const int lr = lane >> 4, lc = (lane & 15) * 4;
#pragma unroll
    for (int i = 0; i < 16; ++i) { f32x4 x = v[i]; if (d.ksc) x = x * d.ksc[d.k0 + 4 * i + lr];
        u32x2 w; w.x = pk2(x.x, x.y); w.y = pk2(x.z, x.w); *(LAS u32x2*)(scr + (4 * i + lr) * TR_PITCH + lc * 2) = w; }
    LDS_WAIT(); asm volatile("" ::: "memory");
    const int li = lane & 15, g = lane >> 4, q = li >> 2, p = li & 3;
#pragma unroll
    for (int nb = 0; nb < 4; ++nb)
#pragma unroll
        for (int kh = 0; kh < 2; ++kh) { const int kc = 4 * kh + g;
            LAS unsigned char* ap = scr + (8 * kc + q) * TR_PITCH + (nb * 16 + 4 * p) * 2;
            const v4i16_t lo = tr_read(ap), hi = tr_read(ap + 4 * TR_PITCH);
            const bf16x8 o = (bf16x8){lo[0], lo[1], lo[2], lo[3], hi[0], hi[1], hi[2], hi[3]};
            *(bf16x8*)(d.dst + (size_t)(nb * 16 + li) * d.dstK + d.k0 + 8 * kc) = o; }
    LDS_WAIT(); asm volatile("" ::: "memory");
}
template <class Dec>
__device__ __forceinline__ void tr64_stream(const Dec& dec, int it0, int stride, int n, LAS unsigned char* scr, int lane) {
    if (it0 >= n) return;
    TrDesc dc = dec(it0); f32x4 vc[16]; tr64_load(dc, vc, lane);
    for (int it = it0; it < n; it += stride) {
        const bool more = it + stride < n;
        TrDesc dn = dc; f32x4 vn[16];
        if (more) { dn = dec(it + stride); tr64_load(dn, vn, lane); }
        tr64_store(dc, vc, scr, lane);
        if (more) { dc = dn;
#pragma unroll
            for (int i = 0; i < 16; ++i) vc[i] = vn[i]; }
    }
}
struct DecP0 { const float *w_in, *w_br_b, *w_out, *w_eg, *w_eu, *g_ffn; unsigned char* ws;
    __device__ __forceinline__ TrDesc operator()(int r) const {
        constexpr int I_WZ = 16 * 72, I_WB = 8 * 16, I_WO = 16 * 16, I_EG = 32 * 16 * 8;
        TrDesc d; d.ksc = nullptr;
        if (r < I_WZ) { const int kb = r / 72, nb = r % 72, n0 = nb * 64; d.src = w_in; d.ld = NIN; d.k0 = kb * 64; d.n0s = zcol2orig(n0); d.dst = (bf16_t*)(ws + WS_WZ) + (size_t)n0 * D; d.dstK = D; return d; } r -= I_WZ;
        if (r < I_WB) { const int kb = r >> 4, nb = r & 15; d.src = w_br_b; d.ld = D; d.k0 = kb * 64; d.n0s = nb * 64; d.dst = (bf16_t*)(ws + WS_WBT) + (size_t)(nb * 64) * DM; d.dstK = DM; return d; } r -= I_WB;
        if (r < I_WO) { const int kb = r >> 4, nb = r & 15; d.src = w_out; d.ld = D; d.k0 = kb * 64; d.n0s = nb * 64; d.dst = (bf16_t*)(ws + WS_WOT) + (size_t)(nb * 64) * D; d.dstK = D; return d; } r -= I_WO;
        const int up = r >= I_EG; if (up) r -= I_EG; const int e = r >> 7, kb = (r >> 3) & 15, nb = r & 7, j0 = nb * 64;
        const int drow = (j0 >> 7) * 256 + up * 128 + (j0 & 127);
        d.src = (up ? w_eu : w_eg) + (size_t)e * D * DE; d.ld = DE; d.k0 = kb * 64; d.n0s = j0; d.dst = (bf16_t*)(ws + WS_WUP) + ((size_t)e * 1024 + drow) * D; d.dstK = D; d.ksc = g_ffn; return d; }
};
struct DecWd { const float* w_ed; unsigned char* ws;
    __device__ __forceinline__ TrDesc operator()(int r) const { const int e = r >> 7, kb = (r >> 4) & 7, nb = r & 15;
        TrDesc d; d.src = w_ed + (size_t)e * DE * D; d.ld = D; d.k0 = kb * 64; d.n0s = nb * 64; d.dst = (bf16_t*)(ws + WS_WDN) + ((size_t)e * 1024 + nb * 64) * DE; d.dstK = DE; d.ksc = nullptr; return d; }
};

__device__ __forceinline__ void p0_prologue(const Args& a, LAS unsigned char* lds, int tid, int lane, int wave, int vcu, int G) {
    const float* x = a.in[0]; const float* g_mix = a.in[1]; const float* w_in = a.in[2]; const float* b_if = a.in[3];
    const float* w_pool = a.in[7]; const float* pool_scale = a.in[8]; const float* w_br_a = a.in[9]; const float* w_br_b = a.in[10]; const float* w_out = a.in[11];
    const float* g_ffn = a.in[12]; const float* w_eg = a.in[17]; const float* w_eu = a.in[18];
    unsigned char* ws = a.ws;
    bf16_t* h = (bf16_t*)((unsigned char*)a.out + OB_H); float* gif = (float*)(ws + WS_GIF);
    const int gw = vcu * NWAVES + wave, NGW = G * NWAVES;
    LAS float* gwl = (LAS float*)(lds + 81920);
    for (int idx = tid; idx < 8192; idx += NWAVES * 64) { const int k = idx >> 3, o = idx & 7; gwl[o * 1024 + k] = w_in[(size_t)k * NIN + 2560 + o] * g_mix[k]; }
    __syncthreads();
    REP(20) {
        f32x4 gm[4];
#pragma unroll
        for (int j = 0; j < 4; ++j) gm[j] = *(const f32x4*)(g_mix + 4 * lane + 256 * j);
        f32x4 vn[4], vm[4];
        if (gw < T) {
#pragma unroll
            for (int j = 0; j < 4; ++j) vn[j] = ((const f32x4*)(x + (size_t)gw * D) + lane)[64 * j]; }
        if (gw + NGW < T) {
#pragma unroll
            for (int j = 0; j < 4; ++j) vm[j] = ((const f32x4*)(x + (size_t)(gw + NGW) * D) + lane)[64 * j]; }
        for (int m = gw; m < T; m += NGW) {
            f32x4 v[4];
#pragma unroll
            for (int j = 0; j < 4; ++j) { v[j] = vn[j]; vn[j] = vm[j]; }
            if (m + 2 * NGW < T) {
#pragma unroll
                for (int j = 0; j < 4; ++j) vm[j] = ((const f32x4*)(x + (size_t)(m + 2 * NGW) * D) + lane)[64 * j]; }
            float s = 0.f;
#pragma unroll
            for (int j = 0; j < 4; ++j) s += (v[j].x * v[j].x + v[j].y * v[j].y) + (v[j].z * v[j].z + v[j].w * v[j].w);
            float acc[8];
#pragma unroll
            for (int o = 0; o < 8; ++o) { float t = 0.f;
#pragma unroll
                for (int j = 0; j < 4; ++j) { const f32x4 w = *(const LAS f32x4*)(gwl + o * 1024 + 4 * lane + 256 * j); t += (v[j].x * w.x + v[j].y * w.y) + (v[j].z * w.z + v[j].w * w.w); }
                acc[o] = t; }
            s = wave_sum(s);
#pragma unroll
            for (int o = 0; o < 8; ++o) acc[o] = wave_sum(acc[o]);
            const float rstd = rsqrtf(s * (1.f / D) + EPS);
            u32x2* o8 = (u32x2*)(h + (size_t)m * D) + lane;
#pragma unroll
            for (int j = 0; j < 4; ++j) { const f32x4 hv = v[j] * rstd * gm[j]; u32x2 w; w.x = pk2(hv.x, hv.y); w.y = pk2(hv.z, hv.w); o8[64 * j] = w; }
            if (lane < 8) { float r = acc[0];
#pragma unroll
                for (int o = 1; o < 8; ++o) r = (lane == o) ? acc[o] : r;
                gif[(size_t)m * 8 + lane] = r * rstd + b_if[lane]; }
        }
    }
    REP(21) {
        bf16_t* W2T = (bf16_t*)(ws + WS_W2T);
        const int li = lane & 15, g = lane >> 4;
        for (int tile = gw; tile < 32 * 64; tile += NGW) {
            const int k0 = (tile >> 6) * 16, n0 = (tile & 63) * 16, gq = k0 >> 7;
            const float* wp = w_pool + (size_t)(k0 + li) * 128 + 8 * g; const float* sc = pool_scale + gq * 128 + 8 * g; const float* wa = w_br_a + (size_t)(gq * 128 + 8 * g) * D + n0 + li;
            f32x4 a0[4], a1[4], s0[4], s1[4]; float bv[4][8];
#pragma unroll
            for (int st = 0; st < 4; ++st) { a0[st] = *(const f32x4*)(wp + 32 * st); a1[st] = *(const f32x4*)(wp + 32 * st + 4); s0[st] = *(const f32x4*)(sc + 32 * st); s1[st] = *(const f32x4*)(sc + 32 * st + 4);
#pragma unroll
                for (int j = 0; j < 8; ++j) bv[st][j] = wa[(size_t)(32 * st + j) * D]; }
            f32x4 acc = (f32x4){0.f, 0.f, 0.f, 0.f};
#pragma unroll
            for (int st = 0; st < 4; ++st) { const f32x4 p0 = a0[st] * s0[st], p1 = a1[st] * s1[st];
                u32x4 aw; aw.x = pk2(p0.x, p0.y); aw.y = pk2(p0.z, p0.w); aw.z = pk2(p1.x, p1.y); aw.w = pk2(p1.z, p1.w);
                u32x4 bw; bw.x = pk2(bv[st][0], bv[st][1]); bw.y = pk2(bv[st][2], bv[st][3]); bw.z = pk2(bv[st][4], bv[st][5]); bw.w = pk2(bv[st][6], bv[st][7]);
                acc = __builtin_amdgcn_mfma_f32_16x16x32_bf16(__builtin_bit_cast(bf16x8, aw), __builtin_bit_cast(bf16x8, bw), acc, 0, 0, 0); }
            u32x2 o; o.x = pk2(acc[0], acc[1]); o.y = pk2(acc[2], acc[3]);
            *(u32x2*)(W2T + (size_t)(n0 + li) * DP + k0 + 4 * g) = o;
        }
    }
    LAS unsigned char* scr = lds + wave * TR_SCR;
    constexpr int NITEMS = 16 * 72 + 8 * 16 + 16 * 16 + 2 * 32 * 16 * 8;
    REP(22) tr64_stream(DecP0{w_in, w_br_b, w_out, w_eg, w_eu, g_ffn, ws}, gw, NGW, NITEMS, scr, lane);
    {
        const float* w_rg = a.in[13]; const float* w_re = a.in[15];
        const int gt = gw * 64 + lane;
        if (gt < 48 * 128) { const int col = gt >> 7, ch = gt & 127; float v[8];
#pragma unroll
            for (int q = 0; q < 8; ++q) { const int k = 8 * ch + q; v[q] = (col < 4 ? w_rg[k * NG + col] : col < 36 ? w_re[k * NE + col - 4] : 0.f) * g_ffn[k]; }
            u32x4 w; w.x = pk2(v[0], v[1]); w.y = pk2(v[2], v[3]); w.z = pk2(v[4], v[5]); w.w = pk2(v[6], v[7]);
            *(u32x4*)(ws + WS_WR + col * 2048 + ((ch ^ (col & 15)) << 4)) = w; }
    }
}

__device__ __forceinline__ void convert_wdown(const Args& a, LAS unsigned char* lds, int lane, int wave, int gi, int ngrp) {
    tr64_stream(DecWd{a.in[19], a.ws}, gi * NWAVES + wave, ngrp * NWAVES, 32 * 8 * 16, lds + wave * TR_SCR, lane);
}

__global__ void __launch_bounds__(NWAVES * 64, 2) mk_fwd(Args args) {
    extern __shared__ __attribute__((aligned(16))) unsigned char lds_raw[];
    LAS unsigned char* lds = (LAS unsigned char*)lds_raw;
    volatile LAS unsigned* MISC = (volatile LAS unsigned*)(lds + MISC_OFF);
    const int tid = threadIdx.x, lane = tid & 63, wave = __builtin_amdgcn_readfirstlane(tid >> 6);
    const int G = gridDim.x; const int bx = blockIdx.x; const int vcu = (G % 8 == 0) ? (bx % 8) * (G / 8) + bx / 8 : bx;
    unsigned char* ws = args.ws; unsigned* ctl = (unsigned*)(ws + WS_CTL);
    for (int u = tid; u < (LDS_BYTES - LDSCTL_OFF) / 4; u += NWAVES * 64) ((LAS unsigned*)(lds + LDSCTL_OFF))[u] = 0u;
    __syncthreads();
    XcdBarrier bar = xcd_barrier_post(ctl + CW_BAR + args.li * XCD_BAR_WORDS, MISC + 8);
    const int lo = args.ph_lo, hi = args.ph_hi;
#define IN(k) (lo <= (k) && (k) < hi)
#define BOTH(k) (IN(k) && IN((k) + 1))
#define GRID_BAR() xcd_barrier(bar)
#define STAMP(k) do { if (PROBE_PHASE >= 100 && bx == 0 && tid == 0) { const unsigned long long _t = __builtin_amdgcn_s_memrealtime(); if ((k) == PROBE_PHASE - 100) tstart = _t; if ((k) == PROBE_PHASE - 99) tend = _t; } } while (0)
    unsigned long long tstart = 0, tend = 0;
    STAMP(0);
    if (IN(0)) { REP(0) { p0_prologue(args, lds, tid, lane, wave, vcu, G); __syncthreads(); } if (BOTH(0)) GRID_BAR(); STAMP(1); }
    if (IN(1)) {
        SchedDense S{(const char*)args.out + OB_H, (const char*)(ws + WS_WZ), (size_t)256 * D * 2, (size_t)256 * D * 2, T / 256, NZ / 256, G, bx, (PROBE_PHASE == 1) ? 2 : 1};
        EpiZ E{(bf16_t*)(ws + WS_Z)};
        pg8::gemm_phase<EpiZ, SchedDense, false>(lds + RING_OFF, pg8::Cfg{D, D * 2, D * 2}, S, E);
        { const int nwg = (T / 256) * (NZ / 256), full = nwg % G;
          if (full == 0) convert_wdown(args, lds, lane, wave, bx, G); else if (bx >= full) convert_wdown(args, lds, lane, wave, bx - full, G - full); }
        if (BOTH(1)) GRID_BAR(); STAMP(2);
    }
    if (IN(2)) {
        REP(2) for (int pr = vcu; pr < 512; pr += G) b1_item(args, lds + (wave >> 2) * HALF_LDS, 2 * pr + (wave >> 2), tid & 255, wave & 3, lane);
        pool_pass(args, tid, vcu, G);
        if (BOTH(2)) GRID_BAR(); STAMP(3);
    }
    if (IN(3)) { p3_scan(args, tid, vcu, G); if (BOTH(3)) GRID_BAR(); STAMP(4); }
    if (IN(4)) {
        { LAS float* ghl = (LAS float*)(lds + META_OFF); ghl[tid] = args.in[6][tid]; __syncthreads();
          REP(4) for (int pr = vcu; pr < 512; pr += G) b3_item(args, lds + (wave >> 2) * HALF_LDS, ghl, 2 * pr + (wave >> 2), tid & 255, wave & 3, lane); }
        if (BOTH(4)) GRID_BAR(); STAMP(5);
    }
    if (IN(5)) {
        SchedMerge S{(const char*)args.out + OB_DA, (const char*)args.out + OB_HM, (const char*)(ws + WS_W2T), (const char*)(ws + WS_WBT), T / 256, D / 256, G, bx};
        EpiMerge E{(const bf16_t*)(ws + WS_Z), (bf16_t*)((unsigned char*)args.out + OB_MERGED)};
        pg8::gemm_phase<EpiMerge, SchedMerge, false>(lds + RING_OFF, pg8::Cfg{DP, DP * 2, DP * 2}, S, E);
        if (BOTH(5)) GRID_BAR(); STAMP(6);
    }
    if (IN(6)) {
        SchedDense S{(const char*)args.out + OB_MERGED, (const char*)(ws + WS_WOT), (size_t)256 * D * 2, (size_t)256 * D * 2, T / 256, D / 256, G, bx, (PROBE_PHASE == 6) ? 2 : 1};
        EpiX1 E{args.in[0], (bf16_t*)(ws + WS_X1B)};
        pg8::gemm_phase<EpiX1, SchedDense, false>(lds + RING_OFF, pg8::Cfg{D, D * 2, D * 2}, S, E);
        if (BOTH(6)) GRID_BAR(); STAMP(7);
    }
    if (IN(7)) { p7_route(args, lds, MISC, tid, lane, wave, vcu, G); if (BOTH(7)) GRID_BAR(); STAMP(8); }
#if MOE_DYN
    if (IN(8)) {
        moe_tables(ctl + CW_CNT, MISC, tid);
        SchedMoEQ S{MISC, ctl, (const char*)(ws + WS_X1B), (const char*)(ws + WS_HID), (const char*)(ws + WS_WUP), (const char*)(ws + WS_WDN), (const int*)(ws + WS_ALIST), (const f32x2*)(ws + WS_RWLIST), ctl + CW_READY, (int)(bar.x & 7u), wave, lane};
        EpiUpQ E0{(bf16_t*)(ws + WS_HID)};
        EpiDownQ E1{(bf16_t*)args.out};
        pg8::gemm_phase_moe<SchedMoEQ, EpiUpQ, EpiDownQ>(lds + RING_OFF, lds + META_OFF, S, E0, E1);
        if (IN(10)) GRID_BAR(); STAMP(9); STAMP(10);
    }
#else
    if (IN(8)) {
        moe_tables(ctl + CW_CNT, MISC, tid);
        SchedMoE S{MISC, (const char*)(ws + WS_X1B), (const char*)(ws + WS_WUP), (const int*)(ws + WS_ALIST), (size_t)1024 * D * 2, (size_t)256 * D * 2, 0, G, vcu, 1, (PROBE_PHASE == 8) ? 2 : 1};
        EpiUp E{(const int*)(ws + WS_ALIST), (const f32x2*)(ws + WS_RWLIST), (bf16_t*)(ws + WS_HID)};
        pg8::gemm_phase<EpiUp, SchedMoE, true>(lds + RING_OFF, pg8::Cfg{D, D * 2, D * 2}, S, E);
        if (BOTH(8)) GRID_BAR(); STAMP(9);
    }
    if (IN(9)) {
        moe_tables(ctl + CW_CNT, MISC, tid);
        SchedMoE S{MISC, (const char*)(ws + WS_HID), (const char*)(ws + WS_WDN), (const int*)(ws + WS_ALIST), (size_t)1024 * DE * 2, (size_t)256 * DE * 2, (size_t)256 * DE * 2, G, vcu, 0, (PROBE_PHASE == 9) ? 2 : 1};
        EpiDown E{(const int*)(ws + WS_ALIST), (const f32x2*)(ws + WS_RWLIST), (bf16_t*)args.out};
        pg8::gemm_phase<EpiDown, SchedMoE, false>(lds + RING_OFF, pg8::Cfg{DE, DE * 2, DE * 2}, S, E);
        if (BOTH(9)) GRID_BAR(); STAMP(10);
    }
#endif
    if (IN(10)) p10_final(args, lane, wave, vcu, G);
    STAMP(11);
    if (PROBE_PHASE >= 100 && bx == 0 && tid == 0) { const unsigned long long d = (tend - tstart) * 8ull, t0 = __builtin_amdgcn_s_memrealtime(); while (__builtin_amdgcn_s_memrealtime() - t0 < d) __builtin_amdgcn_s_sleep(16); }
#undef IN
#undef BOTH
#undef GRID_BAR
}

}

extern "C" void kernel_launch(void* const* d_in, const int* in_sizes, int n_in, void* d_out, int out_size, void* d_ws, size_t ws_size, hipStream_t stream) {
    const float* x = (const float*)d_in[0];
    const float* conv_q = (const float*)d_in[4]; const float* conv_k = (const float*)d_in[5]; const float* g_head = (const float*)d_in[6]; const float* w_pool = (const float*)d_in[7];
    const float* pool_scale = (const float*)d_in[8]; const float* w_br_a = (const float*)d_in[9]; const float* w_br_b = (const float*)d_in[10]; const float* w_out = (const float*)d_in[11];
    const float* g_ffn = (const float*)d_in[12]; const float* w_rg = (const float*)d_in[13]; const float* b_rg = (const float*)d_in[14]; const float* w_re = (const float*)d_in[15];
    const float* b_re = (const float*)d_in[16]; const float* w_eg = (const float*)d_in[17]; const float* w_eu = (const float*)d_in[18]; const float* w_ed = (const float*)d_in[19];
    const float* g_final = (const float*)d_in[20];
    static int grid = 0;
    if (grid == 0) {
        if (n_in != 21 || out_size != T * D || ws_size < WS_END) { fprintf(stderr, "kernel_launch: unexpected shapes/ws (%d inputs, out %d, ws %zu)\n", n_in, out_size, ws_size); grid = -1; return; }
        int dev = 0, cus = 0, per_cu = 0;
        if (hipGetDevice(&dev) != hipSuccess || hipDeviceGetAttribute(&cus, hipDeviceAttributeMultiprocessorCount, dev) != hipSuccess) { grid = -1; return; }
        if (hipFuncSetAttribute((const void*)mk_fwd, hipFuncAttributeMaxDynamicSharedMemorySize, LDS_BYTES) != hipSuccess) { fprintf(stderr, "kernel_launch: hipFuncSetAttribute failed\n"); grid = -1; return; }
        if (hipOccupancyMaxActiveBlocksPerMultiprocessor(&per_cu, (const void*)mk_fwd, NWAVES * 64, LDS_BYTES) != hipSuccess || per_cu < 1) { fprintf(stderr, "kernel_launch: occupancy query says %d blocks per CU\n", per_cu); grid = -1; return; }
        (void)hipGetLastError();
        grid = cus;
    }
    if (grid < 0) return;
    unsigned char* ws = (unsigned char*)d_ws; unsigned char* ob = (unsigned char*)d_out;
    (void)hipMemsetAsync(ws + WS_CTL, 0, CTL_ZERO_BYTES, stream);
    Args a{};
    for (int i = 0; i < 21; ++i) a.in[i] = (const float*)d_in[i];
    a.out = (float*)d_out; a.ws = ws; a.flags = 0;
    a.ph_lo = 0; a.ph_hi = 11; a.li = 0;
    hipLaunchKernelGGL(mk_fwd, dim3(grid), dim3(NWAVES * 64), LDS_BYTES, stream, a);
}
```

```cpp
#include <hip/hip_runtime.h>
#include <cstdio>
#include <cstdint>

namespace {
constexpr int D = 1024, BATCH = 8, SEQ = 2048, T = BATCH * SEQ;
constexpr int DP = 512, DM = 512, NH = 4, HD = 128, NIN = 4616, NZ = 4608;
constexpr int NG = 4, EPG = 8, NE = 32, DE = 512;
constexpr float EPS = 1e-6f;
constexpr size_t MiB = 1u << 20;

typedef unsigned short bf16_t;
__device__ __forceinline__ bf16_t f2bf(float f) { unsigned u = __builtin_bit_cast(unsigned, f); return (bf16_t)((u + 0x7fffu + ((u >> 16) & 1u)) >> 16); }
__device__ __forceinline__ float bf2f(bf16_t b) { return __builtin_bit_cast(float, (unsigned)b << 16); }
__device__ __forceinline__ float sigmoidf_(float x) { return 1.f / (1.f + __expf(-x)); }
__device__ __forceinline__ float siluf_(float x) { return x / (1.f + __expf(-x)); }
__device__ __forceinline__ float logsigmoidf_(float x) { return fminf(x, 0.f) - log1pf(__expf(-fabsf(x))); }
__device__ __forceinline__ float wave_sum(float v) {
#pragma unroll
    for (int o = 1; o < 64; o <<= 1) v += __shfl_xor(v, o);
    return v;
}
__host__ __device__ __forceinline__ size_t zoff(size_t tok, int col) { return ((size_t)(col >> 7) * T + tok) * 128 + (col & 127); }
__device__ __forceinline__ int zcol2orig(int c) { return c < 2560 ? c : c + 8; }

__global__ void __launch_bounds__(256) k_prep(const float* __restrict__ x, const float* __restrict__ g, const float* __restrict__ w_in,
                                               const float* __restrict__ b_if, bf16_t* __restrict__ h, float* __restrict__ gif) {
    const int wave = threadIdx.x >> 6, lane = threadIdx.x & 63;
    const int row = blockIdx.x * 4 + wave;
    if (row >= T) return;
    const float* xr = x + (size_t)row * D;
    float v[16]; float s = 0.f;
#pragma unroll
    for (int j = 0; j < 16; ++j) { v[j] = xr[lane + 64 * j]; s += v[j] * v[j]; }
    s = wave_sum(s);
    const float rstd = rsqrtf(s * (1.f / D) + EPS);
    float acc[8];
#pragma unroll
    for (int o = 0; o < 8; ++o) acc[o] = 0.f;
#pragma unroll
    for (int j = 0; j < 16; ++j) {
        const int k = lane + 64 * j;
        const float hv = v[j] * rstd * g[k];
        h[(size_t)row * D + k] = f2bf(hv);
#pragma unroll
        for (int o = 0; o < 8; ++o) acc[o] += hv * w_in[(size_t)k * NIN + 2560 + o];
    }
#pragma unroll
    for (int o = 0; o < 8; ++o) { acc[o] = wave_sum(acc[o]); }
    if (lane == 0) {
#pragma unroll
        for (int o = 0; o < 8; ++o) gif[(size_t)row * 8 + o] = acc[o] + b_if[o];
    }
}

template <class AL, class BL, class EP>
__global__ void __launch_bounds__(256) k_gemm(int M, int N, int K, AL al, BL bl, EP ep) {
    __shared__ float As[16][68];
    __shared__ float Bs[16][68];
    const int tid = threadIdx.x, tx = tid & 15, ty = tid >> 4;
    const int row0 = blockIdx.y * 64, col0 = blockIdx.x * 64;
    float acc[4][4];
#pragma unroll
    for (int i = 0; i < 4; ++i)
#pragma unroll
        for (int j = 0; j < 4; ++j) acc[i][j] = 0.f;
    for (int k0 = 0; k0 < K; k0 += 16) {
#pragma unroll
        for (int j = 0; j < 4; ++j) {
            const int idx = tid + j * 256;
            const int r = idx >> 4, kk = idx & 15;
            As[kk][r] = (row0 + r < M) ? al(row0 + r, k0 + kk) : 0.f;
            const int k2 = idx >> 6, n = idx & 63;
            Bs[k2][n] = (col0 + n < N) ? bl(k0 + k2, col0 + n) : 0.f;
        }
        __syncthreads();
#pragma unroll
        for (int kk = 0; kk < 16; ++kk) {
            float a[4], b[4];
#pragma unroll
            for (int i = 0; i < 4; ++i) a[i] = As[kk][ty * 4 + i];
#pragma unroll
            for (int j = 0; j < 4; ++j) b[j] = Bs[kk][tx * 4 + j];
#pragma unroll
            for (int i = 0; i < 4; ++i)
#pragma unroll
                for (int j = 0; j < 4; ++j) acc[i][j] += a[i] * b[j];
        }
        __syncthreads();
    }
#pragma unroll
    for (int i = 0; i < 4; ++i)
#pragma unroll
        for (int j = 0; j < 4; ++j) {
            const int r = row0 + ty * 4 + i, c = col0 + tx * 4 + j;
            if (r < M && c < N) ep(r, c, acc[i][j]);
        }
}

struct ALbf { const bf16_t* p; int ld; int pad; __device__ float operator()(int r, int k) const { return bf2f(p[(size_t)r * ld + k]); } };
struct ALf32 { const float* p; int ld; int pad; __device__ float operator()(int r, int k) const { return p[(size_t)r * ld + k]; } };
struct BLwin { const float* w; __device__ float operator()(int k, int n) const { return w[(size_t)k * NIN + zcol2orig(n)]; } };
struct BLplain { const float* w; int ld; int pad; __device__ float operator()(int k, int n) const { return w[(size_t)k * ld + n]; } };
struct EPz { bf16_t* z; __device__ void operator()(int r, int c, float v) const { z[(size_t)r * NZ + c] = f2bf(v); } };
struct EPf32 { float* o; int ld; int pad; __device__ void operator()(int r, int c, float v) const { o[(size_t)r * ld + c] = v; } };
struct EPmerge { const float* ya; const bf16_t* z; bf16_t* m;
    __device__ void operator()(int r, int c, float yb) const {
        const float ga = bf2f(z[(size_t)r * NZ + 2560 + c]), gb = bf2f(z[(size_t)r * NZ + 3584 + c]);
        m[(size_t)r * D + c] = f2bf(sigmoidf_(ga) * ya[(size_t)r * D + c] + sigmoidf_(gb) * yb); } };
struct EPres { const float* x; float* x1; __device__ void operator()(int r, int c, float v) const { x1[(size_t)r * D + c] = x[(size_t)r * D + c] + v; } };

__global__ void __launch_bounds__(256) k_conv(const bf16_t* __restrict__ z, const float* __restrict__ cq, const float* __restrict__ ck, bf16_t* __restrict__ qa, bf16_t* __restrict__ ka) {
    const size_t idx = (size_t)blockIdx.x * 256 + threadIdx.x;
    const int t = (int)(idx >> 9), c = (int)(idx & 511), s = t % SEQ;
    float aq = 0.f, ak = 0.f;
#pragma unroll
    for (int j = 0; j < 4; ++j) {
        const int ss = s - 3 + j;
        if (ss >= 0) {
            const size_t r = (size_t)(t - 3 + j) * NZ;
            aq += bf2f(z[r + 512 + c]) * cq[j * DM + c];
            ak += bf2f(z[r + 1024 + c]) * ck[j * DM + c];
        }
    }
    qa[idx] = f2bf(siluf_(aq));
    ka[idx] = f2bf(siluf_(ak) * 0.08838834764831845f);
}
__global__ void k_bcum(const float* __restrict__ gif, float* __restrict__ bcs) {
    const int bh = blockIdx.x * blockDim.x + threadIdx.x;
    if (bh >= BATCH * NH) return;
    const int b = bh / NH, hh = bh % NH;
    float acc = 0.f;
    for (int s = 0; s < SEQ; ++s) { acc += logsigmoidf_(gif[((size_t)b * SEQ + s) * 8 + 4 + hh]); bcs[(size_t)bh * SEQ + s] = acc; }
}
__global__ void __launch_bounds__(256) k_mlstm_naive(const bf16_t* __restrict__ qa, const bf16_t* __restrict__ ka, const bf16_t* __restrict__ z, const float* __restrict__ gif,
                                                      const float* __restrict__ bcs, const float* __restrict__ g_head, bf16_t* __restrict__ hm) {
    __shared__ float ks[32][129];
    __shared__ float vs[32][129];
    __shared__ float ws_[32];
    const int bh = blockIdx.x >> 5, qb = blockIdx.x & 31, b = bh / NH, hh = bh % NH;
    const int tid = threadIdx.x, tq = tid >> 2, part = tid & 3;
    const int t = qb * 64 + tq;
    const size_t rowq = (size_t)b * SEQ + t;
    float q[32];
#pragma unroll
    for (int j = 0; j < 32; ++j) q[j] = bf2f(qa[rowq * DM + hh * HD + part * 32 + j]);
    const float bt = bcs[(size_t)bh * SEQ + t];
    float num[32];
#pragma unroll
    for (int j = 0; j < 32; ++j) num[j] = 0.f;
    float nq = 0.f;
    for (int kb = 0; kb <= qb * 2 + 1; ++kb) {
        __syncthreads();
        for (int i = tid; i < 32 * 128; i += 256) {
            const int r = i >> 7, c = i & 127; const size_t row = (size_t)b * SEQ + kb * 32 + r;
            ks[r][c] = bf2f(ka[row * DM + hh * HD + c]);
            vs[r][c] = bf2f(z[row * NZ + 1536 + hh * HD + c]);
        }
        if (tid < 32) { const size_t row = (size_t)b * SEQ + kb * 32 + tid; ws_[tid] = gif[row * 8 + hh] - bcs[(size_t)bh * SEQ + kb * 32 + tid]; }
        __syncthreads();
        for (int s = 0; s < 32; ++s) {
            if (kb * 32 + s > t) break;
            float d = 0.f;
#pragma unroll
            for (int j = 0; j < 32; ++j) d += q[j] * ks[s][part * 32 + j];
            d += __shfl_xor(d, 1); d += __shfl_xor(d, 2);
            const float w = d * __expf(bt + ws_[s]);
            nq += w;
#pragma unroll
            for (int j = 0; j < 32; ++j) num[j] += w * vs[s][part * 32 + j];
        }
    }
    const float den = fmaxf(fabsf(nq), 1.f);
    float s1 = 0.f;
#pragma unroll
    for (int j = 0; j < 32; ++j) { num[j] /= den; s1 += num[j]; }
    s1 += __shfl_xor(s1, 1); s1 += __shfl_xor(s1, 2);
    const float mu = s1 * (1.f / HD);
    float s2 = 0.f;
#pragma unroll
    for (int j = 0; j < 32; ++j) { const float dd = num[j] - mu; s2 += dd * dd; }
    s2 += __shfl_xor(s2, 1); s2 += __shfl_xor(s2, 2);
    const float rstd = rsqrtf(s2 * (1.f / HD) + EPS);
#pragma unroll
    for (int j = 0; j < 32; ++j) {
        const int c = hh * HD + part * 32 + j;
        const float o = bf2f(z[rowq * NZ + 2048 + c]);
        hm[rowq * DM + c] = f2bf((num[j] - mu) * rstd * g_head[c] * sigmoidf_(o));
    }
}
__global__ void __launch_bounds__(256) k_pool(const bf16_t* __restrict__ z, bf16_t* __restrict__ dA) {
    const size_t idx = (size_t)blockIdx.x * 256 + threadIdx.x;
    const int t = (int)(idx >> 9), c = (int)(idx & 511), s = t % SEQ, g = c >> 7;
    const int w = 2 << g;
    const int start = max(s + 1 - w, 0), cnt = s + 1 - start;
    float acc = 0.f;
    for (int j = 0; j < cnt; ++j) acc += bf2f(z[(size_t)(t - j) * NZ + c]);
    dA[idx] = f2bf(acc / (float)cnt - bf2f(z[(size_t)t * NZ + c]));
}
__global__ void __launch_bounds__(256) k_poolmm(const bf16_t* __restrict__ dA, const float* __restrict__ w_pool, const float* __restrict__ scale, float* __restrict__ yp) {
    const size_t idx = (size_t)blockIdx.x * 256 + threadIdx.x;
    const int t = (int)(idx >> 9), j = (int)(idx & 511), g = j >> 7, jj = j & 127;
    float acc = 0.f;
    for (int c = 0; c < 128; ++c) acc += bf2f(dA[(size_t)t * DP + g * 128 + c]) * w_pool[((size_t)g * 128 + c) * 128 + jj];
    yp[idx] = acc * scale[j];
}

__global__ void __launch_bounds__(256) k_route(const float* __restrict__ x1, const float* __restrict__ g_ffn, const float* __restrict__ w_rg, const float* __restrict__ b_rg,
                                                const float* __restrict__ w_re, const float* __restrict__ b_re, float* __restrict__ rstd2, int* __restrict__ sel, float* __restrict__ gw,
                                                int* __restrict__ counts, int* __restrict__ lists) {
    const int wave = threadIdx.x >> 6, lane = threadIdx.x & 63;
    const int tok = blockIdx.x * 4 + wave;
    const float* xr = x1 + (size_t)tok * D;
    float v[16]; float s = 0.f;
#pragma unroll
    for (int j = 0; j < 16; ++j) { v[j] = xr[lane + 64 * j]; s += v[j] * v[j]; }
    s = wave_sum(s);
    const float rstd = rsqrtf(s * (1.f / D) + EPS);
    float lg[4] = {0.f, 0.f, 0.f, 0.f};
#pragma unroll
    for (int j = 0; j < 16; ++j) { const int k = lane + 64 * j; v[j] = v[j] * rstd * g_ffn[k];
#pragma unroll
        for (int o = 0; o < 4; ++o) lg[o] += v[j] * w_rg[k * NG + o]; }
#pragma unroll
    for (int o = 0; o < 4; ++o) lg[o] = wave_sum(lg[o]) + b_rg[o];
    int gs = 0; float gm = lg[0];
#pragma unroll
    for (int o = 1; o < 4; ++o) if (lg[o] > gm) { gm = lg[o]; gs = o; }
    float den = 0.f;
#pragma unroll
    for (int o = 0; o < 4; ++o) den += __expf(lg[o] - gm);
    const float pg = 1.f / den;
    float le[8];
#pragma unroll
    for (int o = 0; o < 8; ++o) le[o] = 0.f;
#pragma unroll
    for (int j = 0; j < 16; ++j) { const int k = lane + 64 * j;
#pragma unroll
        for (int o = 0; o < 8; ++o) le[o] += v[j] * w_re[k * NE + gs * EPG + o]; }
#pragma unroll
    for (int o = 0; o < 8; ++o) le[o] = wave_sum(le[o]) + b_re[gs * EPG + o];
    int i1 = 0; float m1 = le[0];
#pragma unroll
    for (int o = 1; o < 8; ++o) if (le[o] > m1) { m1 = le[o]; i1 = o; }
    int i2 = -1; float m2 = -3.0e38f;
#pragma unroll
    for (int o = 0; o < 8; ++o) if (o != i1 && le[o] > m2) { m2 = le[o]; i2 = o; }
    const float e2 = __expf(m2 - m1);
    const float p1 = 1.f / (1.f + e2), p2 = e2 / (1.f + e2);
    if (lane == 0) {
        rstd2[tok] = rstd;
        const int ea = gs * EPG + i1, eb = gs * EPG + i2;
        sel[tok * 2] = ea; sel[tok * 2 + 1] = eb;
        gw[tok * 2] = pg * p1; gw[tok * 2 + 1] = pg * p2;
        const int pa = atomicAdd(&counts[ea], 1); lists[ea * T + pa] = tok * 2;
        const int pb = atomicAdd(&counts[eb], 1); lists[eb * T + pb] = tok * 2 + 1;
    }
}
__global__ void __launch_bounds__(256) k_moe_up(const float* __restrict__ x1, const float* __restrict__ rstd2, const float* __restrict__ g_ffn, const float* __restrict__ wg, const float* __restrict__ wu,
                                                 const int* __restrict__ counts, const int* __restrict__ lists, float* __restrict__ hid) {
    const int e = blockIdx.z, rt = blockIdx.y, ct = blockIdx.x;
    const int cnt = counts[e];
    if (rt * 64 >= cnt) return;
    __shared__ float As[16][68]; __shared__ float Bg[16][68]; __shared__ float Bu[16][68];
    __shared__ int toks[64]; __shared__ float rs[64];
    const int tid = threadIdx.x, tx = tid & 15, ty = tid >> 4;
    if (tid < 64) { const int r = rt * 64 + tid; const int a = (r < cnt) ? lists[e * T + r] : -1; toks[tid] = a; rs[tid] = (a >= 0) ? rstd2[a >> 1] : 0.f; }
    __syncthreads();
    float ag[4][4], au[4][4];
#pragma unroll
    for (int i = 0; i < 4; ++i)
#pragma unroll
        for (int j = 0; j < 4; ++j) { ag[i][j] = 0.f; au[i][j] = 0.f; }
    const float* wge = wg + (size_t)e * D * DE; const float* wue = wu + (size_t)e * D * DE;
    for (int k0 = 0; k0 < D; k0 += 16) {
#pragma unroll
        for (int j = 0; j < 4; ++j) {
            const int idx = tid + j * 256; const int r = idx >> 4, kk = idx & 15;
            const int a = toks[r];
            As[kk][r] = (a >= 0) ? x1[(size_t)(a >> 1) * D + k0 + kk] * rs[r] * g_ffn[k0 + kk] : 0.f;
            const int k2 = idx >> 6, n = idx & 63;
            Bg[k2][n] = wge[(size_t)(k0 + k2) * DE + ct * 64 + n];
            Bu[k2][n] = wue[(size_t)(k0 + k2) * DE + ct * 64 + n];
        }
        __syncthreads();
#pragma unroll
        for (int kk = 0; kk < 16; ++kk) {
            float a[4], bg[4], bu[4];
#pragma unroll
            for (int i = 0; i < 4; ++i) a[i] = As[kk][ty * 4 + i];
#pragma unroll
            for (int j = 0; j < 4; ++j) { bg[j] = Bg[kk][tx * 4 + j]; bu[j] = Bu[kk][tx * 4 + j]; }
#pragma unroll
            for (int i = 0; i < 4; ++i)
#pragma unroll
                for (int j = 0; j < 4; ++j) { ag[i][j] += a[i] * bg[j]; au[i][j] += a[i] * bu[j]; }
        }
        __syncthreads();
    }
#pragma unroll
    for (int i = 0; i < 4; ++i) { const int a = toks[ty * 4 + i]; if (a < 0) continue;
#pragma unroll
        for (int j = 0; j < 4; ++j) hid[(size_t)a * DE + ct * 64 + tx * 4 + j] = siluf_(ag[i][j]) * au[i][j]; }
}
__global__ void __launch_bounds__(256) k_moe_down(const float* __restrict__ hid, const float* __restrict__ wd, const float* __restrict__ gw, const int* __restrict__ counts, const int* __restrict__ lists, bf16_t* __restrict__ yb) {
    const int e = blockIdx.z, rt = blockIdx.y, ct = blockIdx.x;
    const int cnt = counts[e];
    if (rt * 64 >= cnt) return;
    __shared__ float As[16][68]; __shared__ float Bs[16][68];
    __shared__ int toks[64];
    const int tid = threadIdx.x, tx = tid & 15, ty = tid >> 4;
    if (tid < 64) { const int r = rt * 64 + tid; toks[tid] = (r < cnt) ? lists[e * T + r] : -1; }
    __syncthreads();
    float acc[4][4];
#pragma unroll
    for (int i = 0; i < 4; ++i)
#pragma unroll
        for (int j = 0; j < 4; ++j) acc[i][j] = 0.f;
    const float* wde = wd + (size_t)e * DE * D;
    for (int k0 = 0; k0 < DE; k0 += 16) {
#pragma unroll
        for (int j = 0; j < 4; ++j) {
            const int idx = tid + j * 256; const int r = idx >> 4, kk = idx & 15;
            const int a = toks[r];
            As[kk][r] = (a >= 0) ? hid[(size_t)a * DE + k0 + kk] : 0.f;
            const int k2 = idx >> 6, n = idx & 63;
            Bs[k2][n] = wde[(size_t)(k0 + k2) * D + ct * 64 + n];
        }
        __syncthreads();
#pragma unroll
        for (int kk = 0; kk < 16; ++kk) {
            float a[4], b[4];
#pragma unroll
            for (int i = 0; i < 4; ++i) a[i] = As[kk][ty * 4 + i];
#pragma unroll
            for (int j = 0; j < 4; ++j) b[j] = Bs[kk][tx * 4 + j];
#pragma unroll
            for (int i = 0; i < 4; ++i)
#pragma unroll
                for (int j = 0; j < 4; ++j) acc[i][j] += a[i] * b[j];
        }
        __syncthreads();
    }
#pragma unroll
    for (int i = 0; i < 4; ++i) { const int a = toks[ty * 4 + i]; if (a < 0) continue; const float w = gw[a];
#pragma unroll
        for (int j = 0; j < 4; ++j) yb[(size_t)a * D + ct * 64 + tx * 4 + j] = f2bf(acc[i][j] * w); }
}
__global__ void __launch_bounds__(256) k_final(const float* __restrict__ x1, const bf16_t* __restrict__ yb, const float* __restrict__ g, float* __restrict__ out) {
    const int wave = threadIdx.x >> 6, lane = threadIdx.x & 63;
    const int tok = blockIdx.x * 4 + wave;
    float v[16]; float s = 0.f;
#pragma unroll
    for (int j = 0; j < 16; ++j) { const int k = lane + 64 * j;
        v[j] = x1[(size_t)tok * D + k] + bf2f(yb[(size_t)(tok * 2) * D + k]) + bf2f(yb[(size_t)(tok * 2 + 1) * D + k]); s += v[j] * v[j]; }
    s = wave_sum(s);
    const float rstd = rsqrtf(s * (1.f / D) + EPS);
#pragma unroll
    for (int j = 0; j < 16; ++j) { const int k = lane + 64 * j; out[(size_t)tok * D + k] = v[j] * rstd * g[k]; }
}

#define GAS __attribute__((address_space(1)))
#define LAS __attribute__((address_space(3)))
typedef short bf16x8 __attribute__((ext_vector_type(8)));
typedef float f32x4 __attribute__((ext_vector_type(4)));
typedef float f32x2 __attribute__((ext_vector_type(2)));
typedef unsigned u32x4 __attribute__((ext_vector_type(4)));
typedef unsigned u32x2 __attribute__((ext_vector_type(2)));
#define LDS_WAIT() asm volatile("s_waitcnt lgkmcnt(0)" ::: "memory")
#define VM_WAIT() asm volatile("s_waitcnt vmcnt(0)" ::: "memory")
__device__ __forceinline__ unsigned pk2(float lo, float hi) { return (unsigned)f2bf(lo) | ((unsigned)f2bf(hi) << 16); }
__device__ __forceinline__ unsigned cvt_pk_bf16(float lo, float hi) { unsigned r; asm volatile("v_cvt_pk_bf16_f32 %0, %1, %2" : "=v"(r) : "v"(lo), "v"(hi)); return r; }
__device__ __forceinline__ float u2f(unsigned u) { return __builtin_bit_cast(float, u); }
__device__ __forceinline__ float bflo(unsigned w) { return __builtin_bit_cast(float, w << 16); }
__device__ __forceinline__ float bfhi(unsigned w) { return __builtin_bit_cast(float, w & 0xffff0000u); }
constexpr float SW8 = 512.f, SX8 = 16.f, SH8 = 8.f;
__device__ __forceinline__ unsigned pk4_fp8(float a, float b, float c, float d) {
    a = __builtin_amdgcn_fmed3f(a, -448.f, 448.f); b = __builtin_amdgcn_fmed3f(b, -448.f, 448.f); c = __builtin_amdgcn_fmed3f(c, -448.f, 448.f); d = __builtin_amdgcn_fmed3f(d, -448.f, 448.f);
    unsigned w = 0u; w = __builtin_amdgcn_cvt_pk_fp8_f32(a, b, w, false); w = __builtin_amdgcn_cvt_pk_fp8_f32(c, d, w, true); return w; }
__device__ __forceinline__ float fast_exp(float x) { return __builtin_amdgcn_exp2f(x * 1.4426950408889634f); }
__device__ __forceinline__ float fast_rcp(float x) { return __builtin_amdgcn_rcpf(x); }
__device__ __forceinline__ float fsigmoid(float x) { return fast_rcp(1.f + fast_exp(-x)); }

#define XB_TMO      128
#define XB_XCNT(j)  (256  + 64 * (j))
#define XB_XSUB(j)  (1280 + 64 * (j))
#define XB_XGEN(j)  (2304 + 64 * (j))
#define XB_TOP      3328
#define XB_TOPGEN   3392
#define XCD_BAR_WORDS 3456
#define XB_SPIN_CAP (1u << 18)
__device__ __forceinline__ unsigned xb_ld(unsigned* p)              { return __hip_atomic_load(p, __ATOMIC_RELAXED, __HIP_MEMORY_SCOPE_AGENT); }
__device__ __forceinline__ unsigned xb_add(unsigned* p, unsigned v) { return __hip_atomic_fetch_add(p, v, __ATOMIC_RELAXED, __HIP_MEMORY_SCOPE_AGENT); }
__device__ __forceinline__ unsigned xb_xcc_id() { return (unsigned)__builtin_amdgcn_s_getreg((3 << 11) | 20) & 0xFu; }
#define XB_SPIN(cond, bar) do { unsigned _sp = 0; while (cond) { __builtin_amdgcn_s_sleep(1); \
    if ((++_sp & 255u) == 0u) { if (xb_ld(&(bar)[XB_TMO])) break; if (_sp > XB_SPIN_CAP) { atomicAdd(&(bar)[XB_TMO], 1u); break; } } } } while (0)
struct XcdBarrier { unsigned* bar; unsigned x; volatile LAS unsigned* st; };
__device__ __forceinline__ XcdBarrier xcd_barrier_post(unsigned* bar, volatile LAS unsigned* st) {
    XcdBarrier b; b.bar = bar; b.x = xb_xcc_id(); b.st = st;
    if (threadIdx.x == 0) (void)xb_add(&bar[XB_XCNT(b.x)], 1u);
    return b;
}
__device__ __forceinline__ void xcd_barrier_complete(unsigned* bar, unsigned x, unsigned& nloc, unsigned& nx) {
    const unsigned G = gridDim.x * gridDim.y * gridDim.z;
    unsigned sum, cnt, mine, sp = 0u;
    for (;;) {
        sum = 0u; cnt = 0u; mine = 0u;
#pragma unroll
        for (unsigned j = 0; j < 16; ++j) { const unsigned c = xb_ld(&bar[XB_XCNT(j)]); sum += c; cnt += (c > 0u) ? 1u : 0u; mine = (j == x) ? c : mine; }
        if (sum == G) break;
        __builtin_amdgcn_s_sleep(1);
        if ((++sp & 255u) == 0u) { if (xb_ld(&bar[XB_TMO])) break; if (sp > XB_SPIN_CAP) { atomicAdd(&bar[XB_TMO], 1u); break; } }
    }
    nloc = mine > 0u ? mine : 1u; nx = cnt > 0u ? cnt : 1u;
}
__device__ __forceinline__ void xcd_barrier(const XcdBarrier& b) {
    asm volatile("s_waitcnt vmcnt(0)" ::: "memory");
    __syncthreads();
    if (threadIdx.x == 0) {
        unsigned* bar = b.bar;
        __builtin_amdgcn_s_waitcnt(0);
        unsigned nloc = b.st[0], nx = b.st[1];
        if (nloc == 0u) { xcd_barrier_complete(bar, b.x, nloc, nx); b.st[0] = nloc; b.st[1] = nx; }
        const unsigned old = xb_add(&bar[XB_XSUB(b.x)], 1u);
        const unsigned gen = old / nloc;
        if (old + 1u == (gen + 1u) * nloc) {
            __builtin_amdgcn_fence(__ATOMIC_RELEASE, "agent");
            asm volatile("s_waitcnt vmcnt(0)" ::: "memory");
            const unsigned og = xb_add(&bar[XB_TOP], 1u);
            const unsigned tg = og / nx;
            if (og + 1u == (tg + 1u) * nx) xb_add(&bar[XB_TOPGEN], 1u);
            else XB_SPIN(xb_ld(&bar[XB_TOPGEN]) == tg, bar);
            __builtin_amdgcn_fence(__ATOMIC_ACQUIRE, "agent");
            xb_add(&bar[XB_XGEN(b.x)], 1u);
            asm volatile("s_waitcnt vmcnt(0)" ::: "memory");
        } else {
            XB_SPIN(xb_ld(&bar[XB_XGEN(b.x)]) == gen, bar);
            __builtin_amdgcn_fence(__ATOMIC_ACQUIRE, "agent");
            asm volatile("s_waitcnt vmcnt(0)" ::: "memory");
        }
    }
    __syncthreads();
}

namespace pg8 {
constexpr int BM = 256, BK = 64, HALF = 128, HTB = HALF * BK * 2, STAGE_BYTES = 8 * HTB, NXCD = 8, WGM = 8;
__host__ __device__ __forceinline__ int lds_byte(int r, int c) { const int st = (r >> 4) * 2 + (c >> 5), rr = r & 15, cc = c & 31, ob = rr * 64 + cc * 2; return st * 1024 + (ob ^ (((ob >> 9) & 1) << 5)); }
__host__ __device__ __forceinline__ void stage_rc(int b, int& R, int& C) { const int st = b / 1024, sb = b % 1024, swz = sb ^ (((sb >> 9) & 1) << 5); R = (st >> 1) * 16 + swz / 64; C = (st & 1) * 32 + (swz % 64) / 2; }
__host__ __device__ __forceinline__ int perm32(int rho) { const int n = rho >> 4, i = rho & 15; return 8 * (i >> 2) + 4 * n + (i & 3); }

struct Unit { const char* A; const char* B; const int* rows; int pm, pn, ex, cnt; };
struct Cfg { int K; unsigned lda, ldb; };
__device__ __forceinline__ void tile_of(int L, int nM, int nN, int& pm, int& pn) {
    const int nwg = nM * nN; int wgid = L; { const int q = nwg / NXCD, r = nwg % NXCD, xcd = wgid % NXCD, off = wgid / NXCD; wgid = (xcd < r ? xcd * (q + 1) : r * (q + 1) + (xcd - r) * q) + off; }
    const int nig = WGM * nN, gid = wgid / nig, fm = gid * WGM, gsz = (nM - fm) < WGM ? (nM - fm) : WGM;
    pm = fm + ((wgid % nig) % gsz); pn = (wgid % nig) / gsz;
}

template <class Epi, class Sched, bool GATHER>
__device__ __forceinline__ void gemm_phase(LAS unsigned char* lds, const Cfg g, const Sched& S, const Epi& E) {
    const int tid = threadIdx.x, wid = __builtin_amdgcn_readfirstlane(tid >> 6), lane = tid & 63, wr = wid >> 2, wc = wid & 3, fr = lane & 15, fq = lane >> 4;
    const int nt = g.K / BK;
    unsigned voffB[2], vA[2][2], vN[2][2]; int Rr[2]; unsigned Cb[2];
#pragma unroll
    for (int i = 0; i < 2; ++i) { int R, C; stage_rc(tid * 16 + i * 8192, R, C); const int Rb = Epi::PERM ? ((R & ~31) + perm32(R & 31)) : R;
        Rr[i] = R; Cb[i] = (unsigned)C * 2u; voffB[i] = (unsigned)Rb * g.ldb + (unsigned)C * 2u;
        vA[0][i] = (unsigned)R * g.lda + (unsigned)C * 2u; vA[1][i] = (unsigned)(R + HALF) * g.lda + (unsigned)C * 2u; vN[0][i] = vA[0][i]; vN[1][i] = vA[1][i]; }
    const size_t kstep = (size_t)(BK * 2);
    const size_t hstepB = (size_t)HALF * g.ldb;
    const unsigned ldsw = (unsigned)wid * 1024u;
    const int aoff = lds_byte(wr * 64 + fr, fq * 8), boff = lds_byte(wc * 32 + fr, fq * 8);
#define PG8_SA(b, h) (((b) * 2 + (h)) * HTB)
#define PG8_SB(b, h) ((4 + (b) * 2 + (h)) * HTB)
#define PG8_STAGE(bufoff, gbase, voff) do { _Pragma("unroll") for (int _i = 0; _i < 2; ++_i) \
        __builtin_amdgcn_global_load_lds((const unsigned*)((const char*)(gbase) + (voff)[_i]), (LAS unsigned*)(lds + (bufoff) + ldsw + _i * 8192), 16, 0, 0); } while (0)
#define PG8_STAGE_AX(bufoff, gbase, h, usenext) do { unsigned _vo[2]; _vo[0] = (usenext) ? vN[h][0] : vA[h][0]; _vo[1] = (usenext) ? vN[h][1] : vA[h][1]; PG8_STAGE(bufoff, gbase, _vo); } while (0)
#define PG8_LDA(dst, b, h) do { _Pragma("unroll") for (int m = 0; m < 4; ++m) _Pragma("unroll") for (int k = 0; k < 2; ++k) dst[m][k] = *(const LAS bf16x8*)(lds + PG8_SA(b, h) + aoff + m * 2048 + k * 1024); } while (0)
#define PG8_LDB(dst, b, h) do { _Pragma("unroll") for (int n = 0; n < 2; ++n) _Pragma("unroll") for (int k = 0; k < 2; ++k) dst[n][k] = *(const LAS bf16x8*)(lds + PG8_SB(b, h) + boff + n * 2048 + k * 1024); } while (0)
#define PG8_MMA(ai, bj, At, Bt) do { __builtin_amdgcn_s_setprio(1); _Pragma("unroll") for (int m = 0; m < 4; ++m) _Pragma("unroll") for (int n = 0; n < 2; ++n) _Pragma("unroll") for (int k = 0; k < 2; ++k) \
        acc[ai][bj][m][n] = __builtin_amdgcn_mfma_f32_16x16x32_bf16(Bt[n][k], At[m][k], acc[ai][bj][m][n], 0, 0, 0); __builtin_amdgcn_s_setprio(0); } while (0)
#define PG8_WAIT_V(n) asm volatile("s_waitcnt vmcnt(" #n ")" ::: "memory")
#define PG8_WAIT_L(n) asm volatile("s_waitcnt lgkmcnt(" #n ")" ::: "memory")
#define PG8_BAR __builtin_amdgcn_s_barrier()
#define PG8_SCHED __builtin_amdgcn_sched_barrier(0)
#define PG8_GATHER_LOAD(dst, u) do { _Pragma("unroll") for (int _h = 0; _h < 2; ++_h) _Pragma("unroll") for (int _i = 0; _i < 2; ++_i) { const int _r = _h * HALF + Rr[_i]; \
        const int _a = (_r < (u).cnt) ? ((u).rows[_r] >> 1) : 0; dst[_h][_i] = (unsigned)_a * g.lda + Cb[_i]; } } while (0)
    Unit cur, nxt; int ui = 0;
    if (!S.next(0, cur)) return;
    f32x4 acc[2][2][4][2];
#pragma unroll
    for (int a = 0; a < 2; ++a)
#pragma unroll
        for (int b = 0; b < 2; ++b)
#pragma unroll
            for (int m = 0; m < 4; ++m)
#pragma unroll
                for (int n = 0; n < 2; ++n) acc[a][b][m][n] = (f32x4){0.f, 0.f, 0.f, 0.f};
    bf16x8 At[4][2], B0[2][2], B1[2][2];
    const char* cA = cur.A; const char* cB = cur.B;
    if constexpr (GATHER) { PG8_GATHER_LOAD(vA, cur); __builtin_amdgcn_s_waitcnt(0x0F70); }
    PG8_STAGE(PG8_SB(0, 0), cB, voffB); PG8_STAGE(PG8_SB(0, 1), cB + hstepB, voffB); PG8_STAGE(PG8_SA(0, 0), cA, vA[0]); PG8_STAGE(PG8_SA(0, 1), cA, vA[1]);
    if (wr == 1) PG8_BAR;
    PG8_WAIT_V(2); PG8_BAR;
    PG8_STAGE(PG8_SB(1, 0), cB + kstep, voffB); PG8_STAGE(PG8_SA(1, 0), cA + kstep, vA[0]); PG8_STAGE(PG8_SB(1, 1), cB + hstepB + kstep, voffB);
    PG8_WAIT_V(6); PG8_BAR;
    for (;;) {
        const bool has_next = S.next(ui + 1, nxt);
        const char* nA = has_next ? nxt.A : cA; const char* nB = has_next ? nxt.B : cB;
        if constexpr (GATHER) {
            if (has_next) { PG8_GATHER_LOAD(vN, nxt); __builtin_amdgcn_s_waitcnt(0x0F70); }
            else {
#pragma unroll
                for (int h = 0; h < 2; ++h)
#pragma unroll
                    for (int i = 0; i < 2; ++i) vN[h][i] = vA[h][i]; }
        }
        for (int t = 0; t < nt; t += 2) {
            const bool last = (t == nt - 2);
            const char* a1 = cA + (size_t)(t + 1) * kstep;
            const char* a2 = last ? nA : cA + (size_t)(t + 2) * kstep; const char* b2 = last ? nB : cB + (size_t)(t + 2) * kstep;
            const char* a3 = a2 + kstep; const char* b3 = b2 + kstep;
            const bool un = GATHER && last;
            PG8_LDB(B0, 0, 0); PG8_LDB(B1, 0, 1); PG8_SCHED; PG8_LDA(At, 0, 0); PG8_STAGE(PG8_SA(1, 1), a1, vA[1]);
            PG8_WAIT_V(8); PG8_WAIT_L(0); PG8_BAR; PG8_MMA(0, 0, At, B0); PG8_MMA(0, 1, At, B1); PG8_BAR; PG8_SCHED;
            PG8_LDA(At, 0, 1); PG8_STAGE(PG8_SB(0, 0), b2, voffB); PG8_STAGE(PG8_SB(0, 1), b2 + hstepB, voffB); PG8_STAGE_AX(PG8_SA(0, 0), a2, 0, un);
            PG8_WAIT_V(8); PG8_WAIT_L(0); PG8_BAR; PG8_MMA(1, 0, At, B0); PG8_MMA(1, 1, At, B1); PG8_BAR; PG8_SCHED;
            PG8_LDB(B0, 1, 0); PG8_LDB(B1, 1, 1); PG8_SCHED; PG8_LDA(At, 1, 0); PG8_STAGE_AX(PG8_SA(0, 1), a2, 1, un);
            PG8_WAIT_V(8); PG8_WAIT_L(0); PG8_BAR; PG8_MMA(0, 0, At, B0); PG8_MMA(0, 1, At, B1); PG8_BAR; PG8_SCHED;
            PG8_LDA(At, 1, 1); PG8_STAGE(PG8_SB(1, 0), b3, voffB); PG8_STAGE(PG8_SB(1, 1), b3 + hstepB, voffB); PG8_STAGE_AX(PG8_SA(1, 0), a3, 0, un);
            PG8_WAIT_V(8); PG8_WAIT_L(0); PG8_BAR; PG8_MMA(1, 0, At, B0); PG8_MMA(1, 1, At, B1); PG8_BAR; PG8_SCHED;
        }
        if (wr == 0) PG8_BAR;
        const bool keep = E(acc, cur, wr, wc, fr, fq);
        if (!has_next) break;
        if (!keep) {
#pragma unroll
        for (int a = 0; a < 2; ++a)
#pragma unroll
            for (int b = 0; b < 2; ++b)
#pragma unroll
                for (int m = 0; m < 4; ++m)
#pragma unroll
                    for (int n = 0; n < 2; ++n) acc[a][b][m][n] = (f32x4){0.f, 0.f, 0.f, 0.f};
        }
        cur = nxt; cA = nA; cB = nB; ++ui;
        if constexpr (GATHER) {
#pragma unroll
            for (int h = 0; h < 2; ++h)
#pragma unroll
                for (int i = 0; i < 2; ++i) vA[h][i] = vN[h][i]; }
        if (wr == 1) PG8_BAR;
    }
    PG8_WAIT_V(0);
    PG8_BAR;
#undef PG8_SA
#undef PG8_SB
#undef PG8_STAGE
#undef PG8_STAGE_AX
#undef PG8_LDA
#undef PG8_LDB
#undef PG8_MMA
#undef PG8_WAIT_V
#undef PG8_WAIT_L
#undef PG8_BAR
#undef PG8_SCHED
#undef PG8_GATHER_LOAD
}
}


typedef int v8i_t __attribute__((ext_vector_type(8)));
typedef int v4i_t __attribute__((ext_vector_type(4)));
namespace pg8 {
struct UnitM { const char* A; const char* B; const int* rows; int blk, pn, ex, cnt, type; };
template <class Sched, class Epi0, class Epi1>
__device__ __forceinline__ void gemm_phase_moe(LAS unsigned char* lds, LAS unsigned char* meta, const Sched& S, const Epi0& E0, const Epi1& E1) {
    const int tid = threadIdx.x, wid = __builtin_amdgcn_readfirstlane(tid >> 6), lane = tid & 63, wr = wid >> 2, wc = wid & 3, fr = lane & 15, fq = lane >> 4;
    unsigned vA[2][2], vN[2][2], vB[2];
    const size_t kstep = (size_t)(BK * 2);
    const unsigned ldsw = (unsigned)wid * 1024u;
    const int aoff = lds_byte(wr * 64 + fr, fq * 8), boff = lds_byte(wc * 32 + fr, fq * 8);
#define PG8_SA(b, h) (((b) * 2 + (h)) * HTB)
#define PG8_SB(b, h) ((4 + (b) * 2 + (h)) * HTB)
#define PG8_STAGE_A(bufoff, gbase, voff) do { _Pragma("unroll") for (int _i = 0; _i < 2; ++_i) \
        __builtin_amdgcn_global_load_lds((const unsigned*)((const char*)(gbase) + (voff)[_i]), (LAS unsigned*)(lds + (bufoff) + ldsw + _i * 8192), 16, 0, 16); } while (0)
#define PG8_STAGE_B(bufoff, gbase, voff) do { _Pragma("unroll") for (int _i = 0; _i < 2; ++_i) \
        __builtin_amdgcn_global_load_lds((const unsigned*)((const char*)(gbase) + (voff)[_i]), (LAS unsigned*)(lds + (bufoff) + ldsw + _i * 8192), 16, 0, 0); } while (0)
#define PG8_STAGE_AX(bufoff, gbase, h, usenext) do { unsigned _vo[2]; _vo[0] = (usenext) ? vN[h][0] : vA[h][0]; _vo[1] = (usenext) ? vN[h][1] : vA[h][1]; PG8_STAGE_A(bufoff, gbase, _vo); } while (0)
#define PG8_STAGE_BX(bufoff, gbase, usenext) do { unsigned _vo[2]; _vo[0] = (usenext) ? vBn[0] : vB[0]; _vo[1] = (usenext) ? vBn[1] : vB[1]; PG8_STAGE_B(bufoff, gbase, _vo); } while (0)
#define PG8_LD32(p) __builtin_shufflevector(*(const LAS v4i_t*)(p), *(const LAS v4i_t*)((p) + 1024), 0, 1, 2, 3, 4, 5, 6, 7)
#define PG8_LDA(dst, b, h) do { _Pragma("unroll") for (int m = 0; m < 4; ++m) dst[m] = PG8_LD32(lds + PG8_SA(b, h) + aoff + m * 2048); } while (0)
#define PG8_LDB(dst, b, h) do { _Pragma("unroll") for (int n = 0; n < 2; ++n) dst[n] = PG8_LD32(lds + PG8_SB(b, h) + boff + n * 2048); } while (0)
#define PG8_MMA(ai, bj, At, Bt) do { __builtin_amdgcn_s_setprio(1); _Pragma("unroll") for (int m = 0; m < 4; ++m) _Pragma("unroll") for (int n = 0; n < 2; ++n) { \
        acc[ai][bj][m][n] = __builtin_amdgcn_mfma_scale_f32_16x16x128_f8f6f4(Bt[n], At[m], acc[ai][bj][m][n], 0, 0, 0, 0x7F7F7F7F, 0, 0x7F7F7F7F); asm volatile("" : "+v"(acc[ai][bj][m][n])); }     \
        __builtin_amdgcn_s_setprio(0); } while (0)
#define PG8_WAIT_V(n) asm volatile("s_waitcnt vmcnt(" #n ")" ::: "memory")
#define PG8_WAIT_L(n) asm volatile("s_waitcnt lgkmcnt(" #n ")" ::: "memory")
#define PG8_BAR __builtin_amdgcn_s_barrier()
#define PG8_SCHED __builtin_amdgcn_sched_barrier(0)
#define PG8_SETUP(u, vAx, vBx) do { const unsigned _ld = (u).type ? 512u : 1024u; \
        _Pragma("unroll") for (int _i = 0; _i < 2; ++_i) { int _R, _C; stage_rc(tid * 16 + _i * 8192, _R, _C); asm volatile("" : "+v"(_R), "+v"(_C)); const unsigned _cb = (unsigned)_C * 2u; \
            _Pragma("unroll") for (int _h = 0; _h < 2; ++_h) { const int _r = _h * HALF + _R; \
                const int _a = (u).type ? _r : ((_r < (u).cnt) ? ((u).rows[_r] >> 1) : 0); vAx[_h][_i] = (unsigned)_a * _ld + _cb; } \
            vBx[_i] = (unsigned)((_R & ~31) + perm32(_R & 31)) * _ld + _cb; } } while (0)
#define PG8_META(u, n) do { if (tid < 256) { u32x4 _mv = (u32x4){0xFFFFFFFFu, 0u, 0u, 0u}; \
        if (tid < (u).cnt) { const u32x2 _w2 = ((const u32x2*)S.rwlist)[((u).rows - S.alist) + tid]; _mv.x = (unsigned)(u).rows[tid]; _mv.y = _w2.x; _mv.z = _w2.y; } \
        *(LAS u32x4*)(meta + (((n) & 1) * 256 + tid) * 16) = _mv; } } while (0)
#define PG8_PUBLISH() do { if (pend >= 0) { if (lane == 0) __hip_atomic_fetch_add(S.ready + pend, 1u, __ATOMIC_RELAXED, __HIP_MEMORY_SCOPE_AGENT); pend = -1; } } while (0)
    int pend = -1;
    UnitM cur, nxt; int ui = 0;
    bool have = S.next(0, cur);
    f32x4 acc[2][2][4][2];
    v8i_t At[4], B0[2], B1[2];
    while (have) {
#pragma unroll
        for (int a = 0; a < 2; ++a)
#pragma unroll
            for (int b = 0; b < 2; ++b)
#pragma unroll
                for (int m = 0; m < 4; ++m)
#pragma unroll
                    for (int n = 0; n < 2; ++n) acc[a][b][m][n] = (f32x4){0.f, 0.f, 0.f, 0.f};
        const char* cA = cur.A; const char* cB = cur.B; size_t hB = cur.type ? (size_t)HALF * 512 : (size_t)HALF * 1024;
        PG8_SETUP(cur, vA, vB); PG8_META(cur, ui); __builtin_amdgcn_s_waitcnt(0x0F70); asm volatile("s_waitcnt vmcnt(0)" ::: "memory"); PG8_PUBLISH();
        if (cur.type) S.wait_ready(cur);
        PG8_STAGE_B(PG8_SB(0, 0), cB, vB); PG8_STAGE_B(PG8_SB(0, 1), cB + hB, vB); PG8_STAGE_A(PG8_SA(0, 0), cA, vA[0]); PG8_STAGE_A(PG8_SA(0, 1), cA, vA[1]);
        if (wr == 1) PG8_BAR;
        PG8_WAIT_V(2); PG8_BAR;
        PG8_STAGE_B(PG8_SB(1, 0), cB + kstep, vB); PG8_STAGE_A(PG8_SA(1, 0), cA + kstep, vA[0]); PG8_STAGE_B(PG8_SB(1, 1), cB + hB + kstep, vB);
        PG8_WAIT_V(6); PG8_BAR;
        bool has_next;
        for (;;) {
            has_next = S.next(ui + 1, nxt);
            const bool chain = has_next && nxt.type == cur.type;
            const char* nA = chain ? nxt.A : cA; const char* nB = chain ? nxt.B : cB;
            if (chain) { unsigned vBn[2]; PG8_SETUP(nxt, vN, vBn); PG8_META(nxt, ui + 1); __builtin_amdgcn_s_waitcnt(0x0F70); asm volatile("s_waitcnt vmcnt(0)" ::: "memory"); PG8_PUBLISH(); }
            else {
                if (pend >= 0) { asm volatile("s_waitcnt vmcnt(0)" ::: "memory"); PG8_PUBLISH(); }
#pragma unroll
                for (int h = 0; h < 2; ++h)
#pragma unroll
                    for (int i = 0; i < 2; ++i) vN[h][i] = vA[h][i]; }
            const int nt = cur.type ? 4 : 8;
            for (int t = 0; t < nt; t += 2) {
                const bool last = (t == nt - 2);
                if (last && chain && nxt.type) S.wait_ready(nxt);
                const char* a1 = cA + (size_t)(t + 1) * kstep;
                const char* a2 = last ? nA : cA + (size_t)(t + 2) * kstep; const char* b2 = last ? nB : cB + (size_t)(t + 2) * kstep; const size_t hB2 = hB;
                const char* a3 = a2 + kstep; const char* b3 = b2 + kstep;
                PG8_LDB(B0, 0, 0); PG8_LDB(B1, 0, 1); PG8_SCHED; PG8_LDA(At, 0, 0); PG8_STAGE_A(PG8_SA(1, 1), a1, vA[1]);
                PG8_WAIT_V(8); PG8_WAIT_L(0); PG8_BAR; PG8_MMA(0, 0, At, B0); PG8_MMA(0, 1, At, B1); PG8_BAR; PG8_SCHED;
                PG8_LDA(At, 0, 1); PG8_STAGE_B(PG8_SB(0, 0), b2, vB); PG8_STAGE_B(PG8_SB(0, 1), b2 + hB2, vB); PG8_STAGE_AX(PG8_SA(0, 0), a2, 0, last);
                PG8_WAIT_V(8); PG8_WAIT_L(0); PG8_BAR; PG8_MMA(1, 0, At, B0); PG8_MMA(1, 1, At, B1); PG8_BAR; PG8_SCHED;
                PG8_LDB(B0, 1, 0); PG8_LDB(B1, 1, 1); PG8_SCHED; PG8_LDA(At, 1, 0); PG8_STAGE_AX(PG8_SA(0, 1), a2, 1, last);
                PG8_WAIT_V(8); PG8_WAIT_L(0); PG8_BAR; PG8_MMA(0, 0, At, B0); PG8_MMA(0, 1, At, B1); PG8_BAR; PG8_SCHED;
                PG8_LDA(At, 1, 1); PG8_STAGE_B(PG8_SB(1, 0), b3, vB); PG8_STAGE_B(PG8_SB(1, 1), b3 + hB2, vB); PG8_STAGE_AX(PG8_SA(1, 0), a3, 0, last);
                PG8_WAIT_V(8); PG8_WAIT_L(0); PG8_BAR; PG8_MMA(1, 0, At, B0); PG8_MMA(1, 1, At, B1); PG8_BAR; PG8_SCHED;
            }
            if (wr == 0) PG8_BAR;
            if (cur.type == 0) { E0(acc, cur, wr, wc, fr, fq, meta + (ui & 1) * 4096); pend = cur.blk; } else E1(acc, cur, wr, wc, fr, fq, meta + (ui & 1) * 4096);
            if (!chain) break;
#pragma unroll
            for (int a = 0; a < 2; ++a)
#pragma unroll
                for (int b = 0; b < 2; ++b)
#pragma unroll
                    for (int m = 0; m < 4; ++m)
#pragma unroll
                        for (int n = 0; n < 2; ++n) acc[a][b][m][n] = (f32x4){0.f, 0.f, 0.f, 0.f};
            cur = nxt; cA = nA; cB = nB; ++ui;
#pragma unroll
            for (int h = 0; h < 2; ++h)
#pragma unroll
                for (int i = 0; i < 2; ++i) vA[h][i] = vN[h][i];
            if (wr == 1) PG8_BAR;
        }
        PG8_WAIT_V(0); PG8_PUBLISH();
        PG8_BAR;
        have = has_next; cur = nxt; ++ui;
    }
#undef PG8_SA
#undef PG8_SB
#undef PG8_STAGE_A
#undef PG8_STAGE_B
#undef PG8_STAGE_AX
#undef PG8_STAGE_BX
#undef PG8_LDA
#undef PG8_LD32
#undef PG8_LDB
#undef PG8_MMA
#undef PG8_WAIT_V
#undef PG8_WAIT_L
#undef PG8_BAR
#undef PG8_SCHED
#undef PG8_SETUP
#undef PG8_PUBLISH
}
}

#ifndef MOE_DYN
#define MOE_DYN 1
#endif
#ifndef PROBE_PHASE
#define PROBE_PHASE -1
#endif
#define REP(k) _Pragma("nounroll") for (int _r = 0; _r < ((PROBE_PHASE == (k)) ? 2 : 1); ++_r)
constexpr int NWAVES = 8;
constexpr size_t WS_CTL = 0, CTL_ZERO_BYTES = 64 * 1024;
constexpr size_t WS_GIF = 1 * MiB;
constexpr size_t WS_NLOC = 1 * MiB + 512 * 1024;
constexpr size_t WS_SCAL = 2 * MiB;
constexpr size_t WS_GW = 2 * MiB + 256 * 1024;
constexpr size_t WS_ALIST = 4 * MiB;
constexpr size_t WS_RWLIST = 6 * MiB;
constexpr size_t WS_WR = 3 * MiB + 512 * 1024;
constexpr size_t WS_RSTD2 = 3 * MiB, WS_SEL = 3 * MiB + 256 * 1024;
constexpr size_t WS_WZ = 10 * MiB, WS_W2T = 19 * MiB, WS_WBT = 20 * MiB, WS_WOT = 21 * MiB, WS_WUP = 23 * MiB, WS_WDN = 87 * MiB;
constexpr size_t WS_Z = 119 * MiB;
constexpr size_t WS_KACT = 263 * MiB;
constexpr size_t WS_END = 279 * MiB;
constexpr size_t WS_X1Q = WS_Z;
constexpr size_t WS_X1 = WS_Z, WS_X1B = WS_Z + 64 * MiB, WS_HID = WS_Z + 96 * MiB;
constexpr size_t OB_H = 0, OB_C = 0, OB_DA = 32 * MiB, OB_HM = 48 * MiB, OB_MERGED = 0;
constexpr int CW_CNT = 64;
constexpr int CW_Q = 1024;
constexpr int CW_READY = 2048;
constexpr int CW_TMO = 8;
constexpr int CW_BAR = 4096;
constexpr int META_OFF = 131072 + 320 + 2048;
constexpr int TAB_CNT = 16, TAB_CUM = 48, TAB_HIST = 96, TAB_BASE = 128, TAB_Q = 160, TAB_XS = 164, TAB_BLK = 176;
constexpr int RING_OFF = 0, RING_BYTES = 131072, LDSCTL_OFF = RING_BYTES, MISC_OFF = LDSCTL_OFF + 320, LDS_BYTES = 147456;

struct Args { const float* in[21]; float* out; unsigned char* ws; int ph_lo, ph_hi, li, flags; };

struct SchedDense {
    const char* A; const char* B; size_t astep, bstep; int nM, nN, G, c, rep;
    __device__ __forceinline__ bool next(int i, pg8::Unit& u) const {
        long L = (long)i * G + c; if (L >= (long)nM * nN * rep) return false; L %= (long)nM * nN;
        int pm, pn; pg8::tile_of((int)L, nM, nN, pm, pn);
        u.pm = pm; u.pn = pn; u.ex = 0; u.cnt = 256; u.rows = nullptr; u.A = A + (size_t)pm * astep; u.B = B + (size_t)pn * bstep; return true; }
};
struct EpiZ {
    static constexpr bool PERM = true;
    bf16_t* z;
    __device__ __forceinline__ bool operator()(f32x4 (&acc)[2][2][4][2], const pg8::Unit& u, int wr, int wc, int fr, int fq) const {
        const int row0 = u.pm * 256 + wr * 64 + fr, col0 = u.pn * 256 + wc * 32 + 8 * fq;
#pragma unroll
        for (int ai = 0; ai < 2; ++ai)
#pragma unroll
            for (int m = 0; m < 4; ++m) { const size_t row = (size_t)(row0 + ai * 128 + m * 16);
#pragma unroll
                for (int bj = 0; bj < 2; ++bj) { const f32x4 v0 = acc[ai][bj][m][0], v1 = acc[ai][bj][m][1]; u32x4 w;
                    w.x = cvt_pk_bf16(v0[0], v0[1]); w.y = cvt_pk_bf16(v0[2], v0[3]); w.z = cvt_pk_bf16(v1[0], v1[1]); w.w = cvt_pk_bf16(v1[2], v1[3]);
                    *(u32x4*)(z + zoff(row, col0 + bj * 128)) = w; } }
        return false;
    }
};

struct SchedMerge {
    const char* A0; const char* A1; const char* B0; const char* B1; int nM, nN, G, c;
    __device__ __forceinline__ bool next(int i, pg8::Unit& u) const {
        const long L = (long)(i >> 1) * G + c; if (L >= (long)nM * nN) return false;
        int pm, pn; pg8::tile_of((int)L, nM, nN, pm, pn); const int part = i & 1;
        u.pm = pm; u.pn = pn; u.ex = part; u.cnt = 256; u.rows = nullptr;
        u.A = (part ? A1 : A0) + (size_t)pm * 256 * DP * 2; u.B = (part ? B1 : B0) + (size_t)pn * 256 * DP * 2; return true; }
};
struct EpiMerge {
    static constexpr bool PERM = true;
    const bf16_t* z; bf16_t* mg;
    __device__ __forceinline__ bool operator()(f32x4 (&acc)[2][2][4][2], const pg8::Unit& u, int wr, int wc, int fr, int fq) const {
        const int row0 = u.pm * 256 + wr * 64 + fr, col0 = u.pn * 256 + wc * 32 + 8 * fq;
        if (u.ex == 0) {
#pragma unroll
            for (int ai = 0; ai < 2; ++ai)
#pragma unroll
                for (int m = 0; m < 4; ++m) { const size_t row = (size_t)(row0 + ai * 128 + m * 16);
#pragma unroll
                    for (int bj = 0; bj < 2; ++bj) { const u32x4 ga = *(const u32x4*)(z + zoff(row, 2560 + col0 + bj * 128)), gb = *(const u32x4*)(z + zoff(row, 3584 + col0 + bj * 128));
                        float r[8];
#pragma unroll
                        for (int q = 0; q < 4; ++q) { const unsigned wa = ga[q], wb = gb[q];
                            r[2 * q] = (1.f + fast_exp(-bflo(wb))) * fast_rcp(1.f + fast_exp(-bflo(wa)));
                            r[2 * q + 1] = (1.f + fast_exp(-bfhi(wb))) * fast_rcp(1.f + fast_exp(-bfhi(wa))); }
#pragma unroll
                        for (int q = 0; q < 4; ++q) { acc[ai][bj][m][0][q] *= r[q]; acc[ai][bj][m][1][q] *= r[4 + q]; } } }
            return true;
        }
#pragma unroll
        for (int ai = 0; ai < 2; ++ai)
#pragma unroll
            for (int m = 0; m < 4; ++m) { const size_t row = (size_t)(row0 + ai * 128 + m * 16); bf16_t* mr = mg + row * D + col0;
#pragma unroll
                for (int bj = 0; bj < 2; ++bj) { const u32x4 gb = *(const u32x4*)(z + zoff(row, 3584 + col0 + bj * 128));
                    float sg[8];
#pragma unroll
                    for (int q = 0; q < 4; ++q) { sg[2 * q] = fsigmoid(bflo(gb[q])); sg[2 * q + 1] = fsigmoid(bfhi(gb[q])); }
                    const f32x4 v0 = acc[ai][bj][m][0], v1 = acc[ai][bj][m][1]; u32x4 w;
                    w.x = cvt_pk_bf16(v0[0] * sg[0], v0[1] * sg[1]); w.y = cvt_pk_bf16(v0[2] * sg[2], v0[3] * sg[3]);
                    w.z = cvt_pk_bf16(v1[0] * sg[4], v1[1] * sg[5]); w.w = cvt_pk_bf16(v1[2] * sg[6], v1[3] * sg[7]);
                    *(u32x4*)(mr + bj * 128) = w; } }
        return false;
    }
};
struct EpiX1 {
    static constexpr bool PERM = true;
    const float* x; bf16_t* x1b; unsigned char* x1q;
    __device__ __forceinline__ bool operator()(f32x4 (&acc)[2][2][4][2], const pg8::Unit& u, int wr, int wc, int fr, int fq) const {
        const int row0 = u.pm * 256 + wr * 64 + fr, col0 = u.pn * 256 + wc * 32 + 8 * fq;
#pragma unroll
        for (int ai = 0; ai < 2; ++ai)
#pragma unroll
            for (int m = 0; m < 4; ++m) { const size_t off = (size_t)(row0 + ai * 128 + m * 16) * D + col0;
#pragma unroll
                for (int bj = 0; bj < 2; ++bj) { const f32x4 x0 = *(const f32x4*)(x + off + bj * 128), x1v = *(const f32x4*)(x + off + bj * 128 + 4);
                    const f32x4 v0 = acc[ai][bj][m][0] + x0, v1 = acc[ai][bj][m][1] + x1v; u32x4 w;
                    w.x = cvt_pk_bf16(v0[0], v0[1]); w.y = cvt_pk_bf16(v0[2], v0[3]); w.z = cvt_pk_bf16(v1[0], v1[1]); w.w = cvt_pk_bf16(v1[2], v1[3]);
                    *(u32x4*)(x1b + off + bj * 128) = w;
                    u32x2 q8; q8.x = pk4_fp8(v0[0] * SX8, v0[1] * SX8, v0[2] * SX8, v0[3] * SX8); q8.y = pk4_fp8(v1[0] * SX8, v1[1] * SX8, v1[2] * SX8, v1[3] * SX8);
                    *(u32x2*)(x1q + off + bj * 128) = q8; } }
        return false;
    }
};

struct SchedMoE {
    volatile LAS unsigned* M; const char* A; const char* Bw; const int* alist; size_t bstepE, bstepN, astepBlk; int G, c, gather, rep;
    __device__ __forceinline__ bool next(int i, pg8::Unit& u) const {
        int L = i * G + c; const int tot = (int)M[TAB_CUM + 32];
        if (L >= 4 * tot * rep) return false; L %= 4 * tot;
        int e = 0;
        while (e < 31 && L >= 4 * (int)M[TAB_CUM + e + 1]) ++e;
        const int cb = (int)M[TAB_CUM + e], nb = (int)M[TAB_CUM + e + 1] - cb, r = L - 4 * cb;
        int pn = r / nb, rb = r - pn * nb; int cnt = (int)M[TAB_CNT + e] - rb * 256; cnt = cnt > 256 ? 256 : cnt;
        e = __builtin_amdgcn_readfirstlane(e); pn = __builtin_amdgcn_readfirstlane(pn); rb = __builtin_amdgcn_readfirstlane(rb); cnt = __builtin_amdgcn_readfirstlane(cnt);
        const int blk = __builtin_amdgcn_readfirstlane(cb) + rb;
        u.pm = blk; u.pn = pn; u.ex = e; u.cnt = cnt; u.rows = alist + (size_t)e * T + rb * 256;
        u.A = gather ? A : A + (size_t)blk * astepBlk; u.B = Bw + (size_t)e * bstepE + (size_t)pn * bstepN; return true; }
};
struct EpiUp {
    static constexpr bool PERM = true;
    const int* alist; const f32x2* rwlist; bf16_t* hid;
    __device__ __forceinline__ bool operator()(f32x4 (&acc)[2][2][4][2], const pg8::Unit& u, int wr, int wc, int fr, int fq) const {
        const f32x2* rw = rwlist + (u.rows - alist);
        const int col0 = u.pn * 128 + wc * 32 + 8 * fq;
#pragma unroll
        for (int ai = 0; ai < 2; ++ai)
#pragma unroll
            for (int m = 0; m < 4; ++m) { const int r = ai * 128 + wr * 64 + m * 16 + fr; const float rs = (r < u.cnt) ? rw[r].x : 0.f;
                const f32x4 g0 = acc[ai][0][m][0] * rs, g1 = acc[ai][0][m][1] * rs, u0 = acc[ai][1][m][0] * rs, u1 = acc[ai][1][m][1] * rs;
                float o[8];
#pragma unroll
                for (int q = 0; q < 4; ++q) { o[q] = g0[q] * fsigmoid(g0[q]) * u0[q]; o[4 + q] = g1[q] * fsigmoid(g1[q]) * u1[q]; }
                u32x4 w; w.x = cvt_pk_bf16(o[0], o[1]); w.y = cvt_pk_bf16(o[2], o[3]); w.z = cvt_pk_bf16(o[4], o[5]); w.w = cvt_pk_bf16(o[6], o[7]);
                *(u32x4*)(hid + (size_t)(u.pm * 256 + r) * DE + col0) = w; }
        return false;
    }
};
struct EpiDown {
    static constexpr bool PERM = true;
    const int* alist; const f32x2* rwlist; bf16_t* yb;
    __device__ __forceinline__ bool operator()(f32x4 (&acc)[2][2][4][2], const pg8::Unit& u, int wr, int wc, int fr, int fq) const {
        const f32x2* rw = rwlist + (u.rows - alist);
        const int col0 = u.pn * 256 + wc * 32 + 8 * fq;
#pragma unroll
        for (int ai = 0; ai < 2; ++ai)
#pragma unroll
            for (int m = 0; m < 4; ++m) { const int r = ai * 128 + wr * 64 + m * 16 + fr;
                if (r < u.cnt) { const int a = u.rows[r]; const float w8 = rw[r].y; bf16_t* yr = yb + (size_t)a * D + col0;
#pragma unroll
                    for (int bj = 0; bj < 2; ++bj) { const f32x4 v0 = acc[ai][bj][m][0] * w8, v1 = acc[ai][bj][m][1] * w8; u32x4 w;
                        w.x = cvt_pk_bf16(v0[0], v0[1]); w.y = cvt_pk_bf16(v0[2], v0[3]); w.z = cvt_pk_bf16(v1[0], v1[1]); w.w = cvt_pk_bf16(v1[2], v1[3]);
                        *(u32x4*)(yr + bj * 128) = w; } } }
        return false;
    }
};

struct SchedMoEQ {
    volatile LAS unsigned* M; unsigned* ctl; const char* x1b; const char* hid; const char* wup; const char* wdn; const int* alist; const f32x2* rwlist; unsigned* ready; int xcc, wave, lane;
    __device__ __forceinline__ bool next(int i, pg8::UnitM& u) const {
        if (wave == 0) {
            if (lane == 0) {
                unsigned code = 0xFFFFFFFFu; int sft = (int)M[TAB_XS]; const int tot = (int)M[TAB_CUM + 32];
                while (sft < 8) { const int x = (xcc + sft) & 7; const int b0 = x * tot / 8, b1 = (x + 1) * tot / 8; const unsigned nq = (unsigned)(b1 - b0) * 4u;
                    const unsigned p = nq ? __hip_atomic_fetch_add(ctl + CW_Q + 64 * x, 1u, __ATOMIC_RELAXED, __HIP_MEMORY_SCOPE_AGENT) : 0xFFFFFFFFu;
                    if (p < 2u * nq) { code = (p < nq) ? ((unsigned)b0 * 4u + p) : (0x80000000u | ((unsigned)b0 * 4u + (p - nq))); break; }
                    ++sft; }
                M[TAB_XS] = (unsigned)sft; M[TAB_Q + (i & 1)] = code;
            }
            asm volatile("s_waitcnt lgkmcnt(0)" ::: "memory");
        }
        asm volatile("" ::: "memory"); __builtin_amdgcn_s_barrier(); asm volatile("" ::: "memory");
        const unsigned code = (unsigned)__builtin_amdgcn_readfirstlane((int)M[TAB_Q + (i & 1)]);
        if (code == 0xFFFFFFFFu) return false;
        const int type = (int)(code >> 31), L = (int)(code & 0x7FFFFFFFu), blk = L >> 2, pn = L & 3;
        const int e = __builtin_amdgcn_readfirstlane((int)M[TAB_BLK + blk]);
        const int rb = blk - __builtin_amdgcn_readfirstlane((int)M[TAB_CUM + e]); int cnt = __builtin_amdgcn_readfirstlane((int)M[TAB_CNT + e]) - rb * 256; cnt = cnt > 256 ? 256 : cnt;
        u.blk = blk; u.pn = pn; u.ex = e; u.cnt = cnt; u.type = type; u.rows = alist + (size_t)e * T + rb * 256;
        if (type == 0) { u.A = x1b; u.B = wup + ((size_t)e * 1024 + pn * 256) * D; }
        else { u.A = hid + (size_t)blk * 256 * DE; u.B = wdn + ((size_t)e * 1024 + pn * 256) * DE; }
        return true;
    }
    __device__ __forceinline__ void wait_ready(const pg8::UnitM& u) const {
        unsigned spins = 0;
        while ((unsigned)__builtin_amdgcn_readfirstlane((int)__hip_atomic_load(ctl + CW_READY + u.blk, __ATOMIC_RELAXED, __HIP_MEMORY_SCOPE_AGENT)) < 32u) {
            __builtin_amdgcn_s_sleep(2);
            if (++spins > (1u << 22)) { if (lane == 0) __hip_atomic_store(ctl + CW_TMO, 1u, __ATOMIC_RELAXED, __HIP_MEMORY_SCOPE_AGENT); break; } }
    }
};
struct EpiUpQ {
    bf16_t* hid;
    __device__ __forceinline__ void operator()(f32x4 (&acc)[2][2][4][2], const pg8::UnitM& u, int wr, int wc, int fr, int fq, const LAS unsigned char* meta) const {
        asm volatile("" : "+v"(fr), "+v"(fq));
        const __amdgpu_buffer_rsrc_t rs = __builtin_amdgcn_make_buffer_rsrc(hid, 0, 40960 * DE, 0x00020000);
        const int col0 = u.pn * 128 + wc * 32 + 8 * fq;
#pragma unroll
        for (int ai = 0; ai < 2; ++ai)
#pragma unroll
            for (int m = 0; m < 4; ++m) { const int r = ai * 128 + wr * 64 + m * 16 + fr; const unsigned rbits = ((const LAS unsigned*)meta)[4 * r + 1]; const float rsd = u2f(rbits) * (1.f / (SX8 * SW8));
                const f32x4 g0 = acc[ai][0][m][0] * rsd, g1 = acc[ai][0][m][1] * rsd, u0 = acc[ai][1][m][0] * rsd, u1 = acc[ai][1][m][1] * rsd;
                float o[8];
#pragma unroll
                for (int q = 0; q < 4; ++q) { o[q] = g0[q] * fsigmoid(g0[q]) * u0[q]; o[4 + q] = g1[q] * fsigmoid(g1[q]) * u1[q]; }
                u32x2 w; w.x = pk4_fp8(o[0] * SH8, o[1] * SH8, o[2] * SH8, o[3] * SH8); w.y = pk4_fp8(o[4] * SH8, o[5] * SH8, o[6] * SH8, o[7] * SH8);
                __builtin_amdgcn_raw_buffer_store_b64(w, rs, (int)((unsigned)(u.blk * 256 + r) * DE + col0), 0, 16);
                if (m & 1) asm volatile("" ::: "memory"); }
    }
};
struct EpiDownQ {
    bf16_t* yb;
    __device__ __forceinline__ void operator()(f32x4 (&acc)[2][2][4][2], const pg8::UnitM& u, int wr, int wc, int fr, int fq, const LAS unsigned char* meta) const {
        asm volatile("" : "+v"(fr), "+v"(fq));
        const int col0 = u.pn * 256 + wc * 32 + 8 * fq;
#pragma unroll
        for (int ai = 0; ai < 2; ++ai)
#pragma unroll
            for (int m = 0; m < 4; ++m) { const int r = ai * 128 + wr * 64 + m * 16 + fr; const unsigned abits = ((const LAS unsigned*)meta)[4 * r], wbits = ((const LAS unsigned*)meta)[4 * r + 2];
                if ((int)abits >= 0) { const float w8 = u2f(wbits) * (1.f / (SH8 * SW8)); bf16_t* yr = yb + (size_t)abits * D + col0;
#pragma unroll
                    for (int bj = 0; bj < 2; ++bj) { const f32x4 v0 = acc[ai][bj][m][0] * w8, v1 = acc[ai][bj][m][1] * w8; u32x4 w;
                        w.x = cvt_pk_bf16(v0[0], v0[1]); w.y = cvt_pk_bf16(v0[2], v0[3]); w.z = cvt_pk_bf16(v1[0], v1[1]); w.w = cvt_pk_bf16(v1[2], v1[3]);
                        *(u32x4*)(yr + bj * 128) = w; } } }
    }
};

__device__ __forceinline__ void p7_route(const Args& a, LAS unsigned char* lds, volatile LAS unsigned* MISC, int tid, int lane, int wave, int vcu, int G) {
    const float* b_rg = a.in[14]; const float* b_re = a.in[16];
    unsigned char* ws = a.ws;
    const bf16_t* x1b = (const bf16_t*)(ws + WS_X1B);
    int* alist = (int*)(ws + WS_ALIST); f32x2* rwlist = (f32x2*)(ws + WS_RWLIST); unsigned* counts = (unsigned*)(ws + WS_CTL) + CW_CNT;
    float* rstd2 = (float*)(ws + WS_RSTD2); float* gwd = (float*)(ws + WS_GW);
    { u32x4 t[12];
#pragma unroll
      for (int i = 0; i < 12; ++i) t[i] = *(const u32x4*)(ws + WS_WR + (size_t)(tid + i * 512) * 16);
#pragma unroll
      for (int i = 0; i < 12; ++i) *(LAS u32x4*)(lds + (tid + i * 512) * 16) = t[i]; }
    if (tid < 32) MISC[TAB_HIST + tid] = 0u;
    __syncthreads();
    LAS float* lgs = (LAS float*)(lds + 98304 + wave * 4096);
    for (int tile = vcu; tile < T / 64; tile += G) {
        int e1 = 0, e2 = 0, lp1 = 0, lp2 = 0; float gw1 = 0.f, gw2 = 0.f, rstd_t = 0.f;
        const int tok0 = tile * 64 + wave * 16;
        if (wave < 4) {
            const int row = lane & 15, kg = lane >> 4;
            const bf16_t* xbp = x1b + (size_t)(tok0 + row) * D + 8 * kg;
            f32x4 acc[3]; acc[0] = (f32x4){0.f, 0.f, 0.f, 0.f}; acc[1] = acc[0]; acc[2] = acc[0];
            float ss = 0.f;
#pragma unroll 8
            for (int s = 0; s < 32; ++s) {
                const u32x4 w = *(const u32x4*)(xbp + 32 * s);
#pragma unroll
                for (int q = 0; q < 4; ++q) { const float lo = bflo(w[q]), hi = bfhi(w[q]); ss += lo * lo + hi * hi; }
                const bf16x8 af = __builtin_bit_cast(bf16x8, w);
#pragma unroll
                for (int j = 0; j < 3; ++j) { const bf16x8 bfr = *(const LAS bf16x8*)(lds + (16 * j + row) * 2048 + (((4 * s + kg) ^ row) << 4));
                    acc[j] = __builtin_amdgcn_mfma_f32_16x16x32_bf16(af, bfr, acc[j], 0, 0, 0); }
            }
            ss += __shfl_xor(ss, 16); ss += __shfl_xor(ss, 32);
            const float rstd = rsqrtf(ss * (1.f / D) + EPS);
#pragma unroll
            for (int j = 0; j < 3; ++j)
#pragma unroll
                for (int q = 0; q < 4; ++q) lgs[(4 * kg + q) * 48 + 16 * j + row] = acc[j][q];
            if (lane < 16) lgs[768 + lane] = rstd;
            LDS_WAIT(); asm volatile("" ::: "memory");
            if (lane < 16) {
                rstd_t = lgs[768 + lane];
                const LAS float* lr = lgs + lane * 48;
                float lg[4];
#pragma unroll
                for (int o = 0; o < 4; ++o) lg[o] = lr[o] * rstd_t + b_rg[o];
                int gs = 0; float gm = lg[0];
#pragma unroll
                for (int o = 1; o < 4; ++o) if (lg[o] > gm) { gm = lg[o]; gs = o; }
                float den = 0.f;
#pragma unroll
                for (int o = 0; o < 4; ++o) den += __expf(lg[o] - gm);
                const float pg = 1.f / den;
                float le[8];
#pragma unroll
                for (int o = 0; o < 8; ++o) le[o] = lr[4 + gs * 8 + o] * rstd_t + b_re[gs * 8 + o];
                int i1 = 0; float m1 = le[0];
#pragma unroll
                for (int o = 1; o < 8; ++o) if (le[o] > m1) { m1 = le[o]; i1 = o; }
                int i2 = 0; float m2 = -3.0e38f;
#pragma unroll
                for (int o = 0; o < 8; ++o) if (o != i1 && le[o] > m2) { m2 = le[o]; i2 = o; }
                const float ex2 = __expf(m2 - m1), inv = 1.f / (1.f + ex2);
                e1 = gs * 8 + i1; e2 = gs * 8 + i2; gw1 = pg * inv; gw2 = pg * ex2 * inv;
                lp1 = (int)__hip_atomic_fetch_add((LAS unsigned*)&MISC[TAB_HIST + e1], 1u, __ATOMIC_RELAXED, __HIP_MEMORY_SCOPE_WORKGROUP);
                lp2 = (int)__hip_atomic_fetch_add((LAS unsigned*)&MISC[TAB_HIST + e2], 1u, __ATOMIC_RELAXED, __HIP_MEMORY_SCOPE_WORKGROUP);
            }
        }
        __syncthreads();
        if (tid < 32) { const unsigned hc = MISC[TAB_HIST + tid]; MISC[TAB_BASE + tid] = hc ? __hip_atomic_fetch_add(counts + tid, hc, __ATOMIC_RELAXED, __HIP_MEMORY_SCOPE_AGENT) : 0u; MISC[TAB_HIST + tid] = 0u; }
        __syncthreads();
        if (wave < 4 && lane < 16) {
            const int tok = tok0 + lane;
            const int p1 = (int)MISC[TAB_BASE + e1] + lp1, p2 = (int)MISC[TAB_BASE + e2] + lp2;
            alist[(size_t)e1 * T + p1] = tok * 2; rwlist[(size_t)e1 * T + p1] = (f32x2){rstd_t, gw1};
            alist[(size_t)e2 * T + p2] = tok * 2 + 1; rwlist[(size_t)e2 * T + p2] = (f32x2){rstd_t, gw2};
            rstd2[tok] = rstd_t; gwd[tok * 2] = gw1; gwd[tok * 2 + 1] = gw2;
        }
        __syncthreads();
    }
}
__device__ __forceinline__ void moe_tables(unsigned* counts, volatile LAS unsigned* MISC, int tid) {
    if (tid == 0) { unsigned cum = 0;
        for (int e = 0; e < 32; ++e) { const unsigned c = __hip_atomic_load(counts + e, __ATOMIC_RELAXED, __HIP_MEMORY_SCOPE_AGENT); MISC[TAB_CNT + e] = c; MISC[TAB_CUM + e] = cum; const unsigned nb = (c + 255u) >> 8;
            for (unsigned b = 0; b < nb; ++b) MISC[TAB_BLK + cum + b] = (unsigned)e; cum += nb; }
        MISC[TAB_CUM + 32] = cum; MISC[TAB_XS] = 0u; }
    __syncthreads();
}
__device__ __forceinline__ void p10_final(const Args& a, int lane, int wave, int vcu, int G) {
    const bf16_t* x1b = (const bf16_t*)(a.ws + WS_X1B); const float* gf = a.in[20];
    const int gw = vcu * NWAVES + wave, NGW = G * NWAVES;
    f32x4 gv[4];
#pragma unroll
    for (int j = 0; j < 4; ++j) gv[j] = *(const f32x4*)(gf + 4 * lane + 256 * j);
    u32x2 xn[4], pn[4], qn[4];
    if (gw < T) {
#pragma unroll
        for (int j = 0; j < 4; ++j) { xn[j] = ((const u32x2*)(x1b + (size_t)gw * D) + lane)[64 * j]; pn[j] = ((const u32x2*)(a.out + (size_t)gw * D) + lane)[64 * j]; qn[j] = ((const u32x2*)(a.out + (size_t)gw * D + 512) + lane)[64 * j]; } }
    for (int t = gw; t < T; t += NGW) {
        float* orow = a.out + (size_t)t * D;
        f32x4 v[4]; float s = 0.f;
#pragma unroll
        for (int j = 0; j < 4; ++j) { const u32x2 xv = xn[j], p = pn[j], q = qn[j];
            v[j].x = bflo(xv.x) + bflo(p.x) + bflo(q.x); v[j].y = bfhi(xv.x) + bfhi(p.x) + bfhi(q.x); v[j].z = bflo(xv.y) + bflo(p.y) + bflo(q.y); v[j].w = bfhi(xv.y) + bfhi(p.y) + bfhi(q.y);
            s += (v[j].x * v[j].x + v[j].y * v[j].y) + (v[j].z * v[j].z + v[j].w * v[j].w); }
        if (t + NGW < T) { const size_t tn = (size_t)(t + NGW);
#pragma unroll
            for (int j = 0; j < 4; ++j) { xn[j] = ((const u32x2*)(x1b + tn * D) + lane)[64 * j]; pn[j] = ((const u32x2*)(a.out + tn * D) + lane)[64 * j]; qn[j] = ((const u32x2*)(a.out + tn * D + 512) + lane)[64 * j]; } }
        s = wave_sum(s);
        const float rstd = rsqrtf(s * (1.f / D) + EPS);
#pragma unroll
        for (int j = 0; j < 4; ++j) ((f32x4*)orow)[lane + 64 * j] = v[j] * rstd * gv[j];
    }
}

typedef short v4i16_t __attribute__((ext_vector_type(4)));
__device__ __forceinline__ int img_off(int row, int ch) { return 2048 * (row >> 3) + 512 * (ch >> 2) + 64 * (row & 7) + 16 * ((ch & 3) ^ ((row >> 2) & 3)); }
__device__ __forceinline__ v4i16_t tr_read(LAS unsigned char* p) { return __builtin_amdgcn_ds_read_tr16_b64_v4i16((LAS v4i16_t*)p); }
__device__ __forceinline__ bf16x8 tr_frag(LAS unsigned char* img, int r0, int r1, int c0, int lane) {
    const int li = lane & 15, q = li >> 2, p = li & 3;
    const v4i16_t lo = tr_read(img + img_off(r0 + q, c0 + (p >> 1)) + 8 * (p & 1)), hi = tr_read(img + img_off(r1 + q, c0 + (p >> 1)) + 8 * (p & 1));
    return (bf16x8){lo[0], lo[1], lo[2], lo[3], hi[0], hi[1], hi[2], hi[3]};
}
__device__ __forceinline__ float wave_prefix_sum(float v, int lane) {
#pragma unroll
    for (int d = 1; d < 64; d <<= 1) { const float o = __shfl_up(v, d); if (lane >= d) v += o; }
    return v;
}
__device__ __forceinline__ float wave_prefix_max(float v, int lane) {
#pragma unroll
    for (int d = 1; d < 64; d <<= 1) { const float o = __shfl_up(v, d); if (lane >= d) v = fmaxf(v, o); }
    return v;
}
__device__ __forceinline__ float wave_max(float v) {
#pragma unroll
    for (int o = 1; o < 64; o <<= 1) v = fmaxf(v, __shfl_xor(v, o));
    return v;
}
constexpr int HALF_LDS = 50176;
__device__ __forceinline__ void conv4_silu(const u32x4 (&raw)[7], const float (&cw)[4][8], float scale, float (&out)[4][8]) {
#pragma unroll
    for (int i = 0; i < 4; ++i)
#pragma unroll
        for (int q = 0; q < 4; ++q) { float a0 = 0.f, a1 = 0.f;
#pragma unroll
            for (int j = 0; j < 4; ++j) { const unsigned w = raw[i + j][q]; a0 += bflo(w) * cw[j][2 * q]; a1 += bfhi(w) * cw[j][2 * q + 1]; }
            out[i][2 * q] = a0 * fsigmoid(a0) * scale; out[i][2 * q + 1] = a1 * fsigmoid(a1) * scale; }
}
__device__ __forceinline__ void b1_item(const Args& a, LAS unsigned char* hl, int item, int tl, int wv, int lane) {
    unsigned char* ws = a.ws; const bf16_t* z = (const bf16_t*)(ws + WS_Z); const float* gif = (const float*)(ws + WS_GIF); const float* conv_k = a.in[5];
    bf16_t* kact = (bf16_t*)(ws + WS_KACT); float* nloc = (float*)(ws + WS_NLOC); float* scal = (float*)(ws + WS_SCAL);
    unsigned char* Cb = (unsigned char*)a.out + OB_C + (size_t)item * 32768;
    const int bh = item >> 5, c = item & 31, b = bh >> 2, hh = bh & 3;
    const size_t tok_base = (size_t)b * SEQ + c * 64;
    const int cc = tl & 15, tg = tl >> 4, t0 = 4 * tg;
    u32x4 kr[7], vr[4];
#pragma unroll
    for (int j = 0; j < 7; ++j) { const int t = t0 - 3 + j; kr[j] = (c * 64 + t >= 0) ? *(const u32x4*)(z + zoff(tok_base + t, 1024 + hh * 128 + cc * 8)) : (u32x4){0u, 0u, 0u, 0u}; }
#pragma unroll
    for (int i = 0; i < 4; ++i) vr[i] = *(const u32x4*)(z + zoff(tok_base + t0 + i, 1536 + hh * 128 + cc * 8));
    float cw[4][8];
#pragma unroll
    for (int j = 0; j < 4; ++j) { const f32x4 w0 = *(const f32x4*)(conv_k + j * DM + hh * 128 + cc * 8), w1 = *(const f32x4*)(conv_k + j * DM + hh * 128 + cc * 8 + 4);
        cw[j][0] = w0.x; cw[j][1] = w0.y; cw[j][2] = w0.z; cw[j][3] = w0.w; cw[j][4] = w1.x; cw[j][5] = w1.y; cw[j][6] = w1.z; cw[j][7] = w1.w; }
    LAS float* sc = (LAS float*)(hl + 49152);
    if (wv == 0) {
        const size_t tok = tok_base + lane;
        const float ig = gif[tok * 8 + hh], fp = gif[tok * 8 + 4 + hh];
        const float bb = wave_prefix_sum(logsigmoidf_(fp), lane);
        const float blast = __shfl(bb, 63);
        const float alog = blast - bb + ig;
        const float amax = wave_max(alog);
        sc[lane] = __expf(alog - amax);
        if (lane == 0) { scal[item] = amax; scal[1024 + item] = blast; }
    }
#pragma unroll
    for (int i = 0; i < 4; ++i) *(LAS u32x4*)(hl + 16384 + img_off(t0 + i, cc)) = vr[i];
    __syncthreads();
    {
        float ka[4][8]; conv4_silu(kr, cw, 0.08838834764831845f, ka);
#pragma unroll
        for (int i = 0; i < 4; ++i) { const float wl = sc[t0 + i];
            u32x4 w; w.x = pk2(ka[i][0], ka[i][1]); w.y = pk2(ka[i][2], ka[i][3]); w.z = pk2(ka[i][4], ka[i][5]); w.w = pk2(ka[i][6], ka[i][7]);
            *(u32x4*)(kact + ((size_t)hh * T + tok_base + t0 + i) * 128 + cc * 8) = w;
            u32x4 x; x.x = pk2(ka[i][0] * wl, ka[i][1] * wl); x.y = pk2(ka[i][2] * wl, ka[i][3] * wl); x.z = pk2(ka[i][4] * wl, ka[i][5] * wl); x.w = pk2(ka[i][6] * wl, ka[i][7] * wl);
            *(LAS u32x4*)(hl + img_off(t0 + i, cc)) = x; }
    }
    __syncthreads();
    {
        const int g = lane >> 4;
        bf16x8 af[2][2];
#pragma unroll
        for (int ii = 0; ii < 2; ++ii)
#pragma unroll
            for (int ks = 0; ks < 2; ++ks) af[ii][ks] = tr_frag(hl, 32 * ks + 8 * g, 32 * ks + 8 * g + 4, 2 * (2 * wv + ii), lane);
        const bf16x8 ones = (bf16x8){0x3F80, 0x3F80, 0x3F80, 0x3F80, 0x3F80, 0x3F80, 0x3F80, 0x3F80};
        f32x4 accn[2];
#pragma unroll
        for (int ii = 0; ii < 2; ++ii) { accn[ii] = (f32x4){0.f, 0.f, 0.f, 0.f};
#pragma unroll
            for (int ks = 0; ks < 2; ++ks) accn[ii] = __builtin_amdgcn_mfma_f32_16x16x32_bf16(af[ii][ks], ones, accn[ii], 0, 0, 0); }
#pragma unroll
        for (int j = 0; j < 8; ++j) {
            f32x4 acc0 = (f32x4){0.f, 0.f, 0.f, 0.f}, acc1 = acc0;
#pragma unroll
            for (int ks = 0; ks < 2; ++ks) { const bf16x8 bfv = tr_frag(hl + 16384, 32 * ks + 8 * g, 32 * ks + 8 * g + 4, 2 * j, lane);
                acc0 = __builtin_amdgcn_mfma_f32_16x16x32_bf16(af[0][ks], bfv, acc0, 0, 0, 0); acc1 = __builtin_amdgcn_mfma_f32_16x16x32_bf16(af[1][ks], bfv, acc1, 0, 0, 0); }
            u32x4 w; w.x = pk2(acc0[0], acc0[1]); w.y = pk2(acc0[2], acc0[3]); w.z = pk2(acc1[0], acc1[1]); w.w = pk2(acc1[2], acc1[3]);
            *(u32x4*)(Cb + ((size_t)((wv * 8 + j) * 64 + lane) << 4)) = w;
        }
        if ((lane & 15) == 0) {
#pragma unroll
            for (int ii = 0; ii < 2; ++ii) *(f32x4*)(nloc + (size_t)item * 128 + 16 * (2 * wv + ii) + 4 * g) = accn[ii]; }
    }
    __syncthreads();
}
__device__ __forceinline__ void pool_pass(const Args& a, int tid, int vcu, int G) {
    const bf16_t* z = (const bf16_t*)(a.ws + WS_Z); bf16_t* dA = (bf16_t*)((unsigned char*)a.out + OB_DA);
    for (int w = vcu * (NWAVES * 64) + tid; w < (T / 8) * 64; w += G * NWAVES * 64) {
        const int cc = w & 63, run = w >> 6, tokA = run * 8, s0 = tokA % SEQ, grp = cc >> 4, win = 2 << grp;
        const bf16_t* zp = z + zoff((size_t)tokA, cc * 8);
        float S[8];
#pragma unroll
        for (int q = 0; q < 8; ++q) S[q] = 0.f;
        for (int j = 1; j <= win; ++j) if (s0 - j >= 0) { const u32x4 r = *(const u32x4*)(zp - (size_t)j * 128);
#pragma unroll
            for (int q = 0; q < 4; ++q) { S[2 * q] += bflo(r[q]); S[2 * q + 1] += bfhi(r[q]); } }
#pragma unroll
        for (int i = 0; i < 8; ++i) {
            const int s = s0 + i; const u32x4 r = *(const u32x4*)(zp + (size_t)i * 128);
            float cur[8];
#pragma unroll
            for (int q = 0; q < 4; ++q) { cur[2 * q] = bflo(r[q]); cur[2 * q + 1] = bfhi(r[q]); S[2 * q] += cur[2 * q]; S[2 * q + 1] += cur[2 * q + 1]; }
            if (s - win >= 0) { const u32x4 o = *(const u32x4*)(zp + (size_t)(i - win) * 128);
#pragma unroll
                for (int q = 0; q < 4; ++q) { S[2 * q] -= bflo(o[q]); S[2 * q + 1] -= bfhi(o[q]); } }
            const float inv = 1.f / (float)(s + 1 < win ? s + 1 : win);
            u32x4 w4;
#pragma unroll
            for (int q = 0; q < 4; ++q) w4[q] = pk2(S[2 * q] * inv - cur[2 * q], S[2 * q + 1] * inv - cur[2 * q + 1]);
            *(u32x4*)(dA + (size_t)(tokA + i) * DP + cc * 8) = w4;
        }
    }
}
__device__ __forceinline__ void p3_scan(const Args& a, int tid, int vcu, int G) {
    float* scal = (float*)(a.ws + WS_SCAL); float* nloc = (float*)(a.ws + WS_NLOC);
    for (int w = vcu; w < 256; w += G) {
        const int bh = w >> 3, part = w & 7;
        unsigned char* Cp = (unsigned char*)a.out + OB_C + (size_t)bh * 32 * 32768 + (size_t)(part * 512 + tid) * 8;
        u32x2 ld[32];
#pragma unroll
        for (int c = 0; c < 32; ++c) ld[c] = *(const u32x2*)(Cp + (size_t)c * 32768);
        const bool do_n = (part == 0 && tid < 128);
        float nl[32];
        if (do_n) {
#pragma unroll
            for (int c = 0; c < 32; ++c) nl[c] = nloc[(size_t)(bh * 32 + c) * 128 + tid]; }
        float st[4] = {0.f, 0.f, 0.f, 0.f}; float m = 0.f, nst = 0.f;
#pragma unroll
        for (int c = 0; c < 32; ++c) {
            const float am = scal[bh * 32 + c], bl = scal[1024 + bh * 32 + c];
            const float mn = fmaxf(bl + m, am), sp = __expf(bl + m - mn), sl = __expf(am - mn);
            u32x2 o; o.x = pk2(st[0], st[1]); o.y = pk2(st[2], st[3]); *(u32x2*)(Cp + (size_t)c * 32768) = o;
            st[0] = sp * st[0] + sl * bflo(ld[c].x); st[1] = sp * st[1] + sl * bfhi(ld[c].x); st[2] = sp * st[2] + sl * bflo(ld[c].y); st[3] = sp * st[3] + sl * bfhi(ld[c].y);
            if (do_n) { nloc[(size_t)(bh * 32 + c) * 128 + tid] = nst; nst = sp * nst + sl * nl[c]; }
            if (part == 0 && tid == 0) scal[2048 + bh * 32 + c] = m;
            m = mn;
        }
    }
}
__device__ __forceinline__ void b3_item(const Args& a, LAS unsigned char* hl, const LAS float* ghl, int item, int tl, int wv, int lane) {
    unsigned char* ws = a.ws; const bf16_t* z = (const bf16_t*)(ws + WS_Z); const float* gif = (const float*)(ws + WS_GIF); const float* conv_q = a.in[4]; const float* g_head = a.in[6];
    const bf16_t* kact = (const bf16_t*)(ws + WS_KACT); const float* nprev = (const float*)(ws + WS_NLOC) + (size_t)item * 128; const float* scal = (const float*)(ws + WS_SCAL);
    const unsigned char* Cb = (const unsigned char*)a.out + OB_C + (size_t)item * 32768; bf16_t* hm = (bf16_t*)((unsigned char*)a.out + OB_HM);
    const int bh = item >> 5, c = item & 31, b = bh >> 2, hh = bh & 3;
    const size_t tok_base = (size_t)b * SEQ + c * 64;
    const int cc = tl & 15, tg = tl >> 4, t0 = 4 * tg;
    LAS unsigned char* qi = hl; LAS unsigned char* ki = hl + 16384; LAS unsigned char* vi = hl + 32768; LAS float* sc = (LAS float*)(hl + 49152);
    const float mprev = scal[2048 + item];
    u32x4 cpre[8]; u32x2 opre[8];
#pragma unroll
    for (int i = 0; i < 8; ++i) cpre[i] = *(const u32x4*)(Cb + ((size_t)((wv * 8 + i) * 64 + lane) << 4));
#pragma unroll
    for (int jd = 0; jd < 8; ++jd) opre[jd] = *(const u32x2*)(z + zoff(tok_base + 16 * wv + (lane & 15), 2048 + hh * 128 + 16 * jd + 4 * (lane >> 4)));
    {
        u32x4 qr[7], kv[4], vr[4];
#pragma unroll
        for (int j = 0; j < 7; ++j) { const int t = t0 - 3 + j; qr[j] = (c * 64 + t >= 0) ? *(const u32x4*)(z + zoff(tok_base + t, 512 + hh * 128 + cc * 8)) : (u32x4){0u, 0u, 0u, 0u}; }
#pragma unroll
        for (int i = 0; i < 4; ++i) { kv[i] = *(const u32x4*)(kact + ((size_t)hh * T + tok_base + t0 + i) * 128 + cc * 8); vr[i] = *(const u32x4*)(z + zoff(tok_base + t0 + i, 1536 + hh * 128 + cc * 8)); }
        float cw[4][8];
#pragma unroll
        for (int j = 0; j < 4; ++j) { const f32x4 w0 = *(const f32x4*)(conv_q + j * DM + hh * 128 + cc * 8), w1 = *(const f32x4*)(conv_q + j * DM + hh * 128 + cc * 8 + 4);
            cw[j][0] = w0.x; cw[j][1] = w0.y; cw[j][2] = w0.z; cw[j][3] = w0.w; cw[j][4] = w1.x; cw[j][5] = w1.y; cw[j][6] = w1.z; cw[j][7] = w1.w; }
        if (wv == 0) {
            const size_t tok = tok_base + lane;
            const float ig = gif[tok * 8 + hh], fp = gif[tok * 8 + 4 + hh];
            const float bb = wave_prefix_sum(logsigmoidf_(fp), lane);
            const float gg = ig - bb;
            const float M = fmaxf(mprev, wave_prefix_max(gg, lane));
            sc[lane] = gg; sc[64 + lane] = M; sc[128 + lane] = bb;
        }
        float qa[4][8]; conv4_silu(qr, cw, 1.f, qa);
#pragma unroll
        for (int i = 0; i < 4; ++i) { u32x4 w; w.x = pk2(qa[i][0], qa[i][1]); w.y = pk2(qa[i][2], qa[i][3]); w.z = pk2(qa[i][4], qa[i][5]); w.w = pk2(qa[i][6], qa[i][7]);
            *(LAS u32x4*)(qi + img_off(t0 + i, cc)) = w; *(LAS u32x4*)(ki + img_off(t0 + i, cc)) = kv[i]; *(LAS u32x4*)(vi + img_off(t0 + i, cc)) = vr[i]; }
    }
    __syncthreads();
    {
        const int jt = wv, li = lane & 15, g = lane >> 4, trow = 16 * jt + li;
        bf16x8 qn[4];
#pragma unroll
        for (int ks = 0; ks < 4; ++ks) qn[ks] = *(const LAS bf16x8*)(qi + img_off(trow, 4 * ks + g));
        f32x4 accs[4];
#pragma unroll
        for (int i = 0; i < 4; ++i) { accs[i] = (f32x4){0.f, 0.f, 0.f, 0.f};
            if (i <= jt) {
#pragma unroll
                for (int ks = 0; ks < 4; ++ks) { const bf16x8 kf = *(const LAS bf16x8*)(ki + img_off(16 * i + li, 4 * ks + g)); accs[i] = __builtin_amdgcn_mfma_f32_16x16x32_bf16(kf, qn[ks], accs[i], 0, 0, 0); } } }
        const float Mt = sc[64 + trow], bt = sc[128 + trow];
        float rsum = 0.f;
#pragma unroll
        for (int i = 0; i < 4; ++i) { if (i <= jt) { const f32x4 gsv = *(const LAS f32x4*)(sc + 16 * i + 4 * g);
#pragma unroll
                for (int q = 0; q < 4; ++q) { float p = accs[i][q] * __expf(gsv[q] - Mt); if (i == jt && 4 * g + q > li) p = 0.f; accs[i][q] = p; rsum += p; } } }
        rsum += __shfl_xor(rsum, 16); rsum += __shfl_xor(rsum, 32);
        bf16x8 pf[2];
#pragma unroll
        for (int u = 0; u < 2; ++u) { u32x4 w; w.x = pk2(accs[2 * u][0], accs[2 * u][1]); w.y = pk2(accs[2 * u][2], accs[2 * u][3]); w.z = pk2(accs[2 * u + 1][0], accs[2 * u + 1][1]); w.w = pk2(accs[2 * u + 1][2], accs[2 * u + 1][3]); pf[u] = __builtin_bit_cast(bf16x8, w); }
        bf16x8 qp[4];
#pragma unroll
        for (int s4 = 0; s4 < 4; ++s4) { const u32x2 lo = *(const LAS u32x2*)(qi + img_off(trow, 4 * s4 + (g >> 1)) + 8 * (g & 1)), hi = *(const LAS u32x2*)(qi + img_off(trow, 4 * s4 + 2 + (g >> 1)) + 8 * (g & 1));
            qp[s4] = __builtin_bit_cast(bf16x8, (u32x4){lo.x, lo.y, hi.x, hi.y}); }
        f32x4 acco[8]; f32x4 accn = (f32x4){0.f, 0.f, 0.f, 0.f};
#pragma unroll
        for (int s4 = 0; s4 < 4; ++s4) { const f32x4 n0 = *(const f32x4*)(nprev + 32 * s4 + 4 * g), n1 = *(const f32x4*)(nprev + 32 * s4 + 16 + 4 * g);
            u32x4 w; w.x = pk2(n0.x, n0.y); w.y = pk2(n0.z, n0.w); w.z = pk2(n1.x, n1.y); w.w = pk2(n1.z, n1.w);
            accn = __builtin_amdgcn_mfma_f32_16x16x32_bf16(__builtin_bit_cast(bf16x8, w), qp[s4], accn, 0, 0, 0); }
        LDS_WAIT(); __syncthreads();
#pragma unroll
        for (int i = 0; i < 8; ++i) *(LAS u32x4*)(hl + (((wv * 8 + i) * 64 + lane) << 4)) = cpre[i];
        LDS_WAIT(); __syncthreads();
#pragma unroll
        for (int jd = 0; jd < 8; ++jd) { acco[jd] = (f32x4){0.f, 0.f, 0.f, 0.f};
#pragma unroll
            for (int s4 = 0; s4 < 4; ++s4) { const bf16x8 cf = *(const LAS bf16x8*)(hl + (((s4 * 8 + jd) * 64 + lane) << 4)); acco[jd] = __builtin_amdgcn_mfma_f32_16x16x32_bf16(cf, qp[s4], acco[jd], 0, 0, 0); } }
        const float winter = __expf(mprev - Mt);
#pragma unroll
        for (int jd = 0; jd < 8; ++jd) acco[jd] = acco[jd] * winter;
#pragma unroll
        for (int u = 0; u < 2; ++u) { if (2 * u <= jt) {
#pragma unroll
                for (int jd = 0; jd < 8; ++jd) { const bf16x8 vf = tr_frag(vi, 32 * u + 4 * g, 32 * u + 16 + 4 * g, 2 * jd, lane); acco[jd] = __builtin_amdgcn_mfma_f32_16x16x32_bf16(vf, pf[u], acco[jd], 0, 0, 0); } } }
        const float nq = winter * accn[0] + rsum;
        const float inv = 1.f / fmaxf(fabsf(nq), __expf(-bt - Mt));
        float s1 = 0.f;
#pragma unroll
        for (int jd = 0; jd < 8; ++jd) { acco[jd] = acco[jd] * inv; s1 += (acco[jd][0] + acco[jd][1]) + (acco[jd][2] + acco[jd][3]); }
        s1 += __shfl_xor(s1, 16); s1 += __shfl_xor(s1, 32);
        const float mu = s1 * (1.f / HD);
        float s2 = 0.f;
#pragma unroll
        for (int jd = 0; jd < 8; ++jd) { const f32x4 d = acco[jd] - mu; s2 += (d[0] * d[0] + d[1] * d[1]) + (d[2] * d[2] + d[3] * d[3]); }
        s2 += __shfl_xor(s2, 16); s2 += __shfl_xor(s2, 32);
        const float rstd = rsqrtf(s2 * (1.f / HD) + EPS);
        const size_t tok = tok_base + trow;
#pragma unroll
        for (int jd = 0; jd < 8; ++jd) { const int dv0 = hh * 128 + 16 * jd + 4 * g;
            const f32x4 gh = *(const LAS f32x4*)(ghl + dv0); const u32x2 ov = opre[jd];
            const f32x4 hn = (acco[jd] - mu) * rstd * gh;
            u32x2 w; w.x = pk2(hn[0] * fsigmoid(bflo(ov.x)), hn[1] * fsigmoid(bfhi(ov.x))); w.y = pk2(hn[2] * fsigmoid(bflo(ov.y)), hn[3] * fsigmoid(bfhi(ov.y)));
            *(u32x2*)(hm + tok * DM + dv0) = w; }
    }
    __syncthreads();
}

constexpr int TR_PITCH = 144, TR_SCR = 64 * TR_PITCH;
struct TrDesc { const float* src; bf16_t* dst; const float* ksc; int ld, k0, n0s, dstK, fp8; };
__device__ __forceinline__ void tr64_load(const TrDesc& d, f32x4 (&v)[16], int lane) {
    const int lr = lane >> 4, lc = (lane & 15) * 4;
#pragma unroll
    for (int i = 0; i < 16; ++i) v[i] = *(const f32x4*)(d.src + (size_t)(d.k0 + 4 * i + lr) * d.ld + d.n0s + lc);
}
__device__ __forceinline__ void tr64_store(const TrDesc& d, const f32x4 (&v)[16], LAS unsigned char* scr, int lane) {
    const int lr = lane >> 4, lc = (lane & 15) * 4;
#pragma unroll
    for (int i = 0; i < 16; ++i) { f32x4 x = v[i]; if (d.ksc) x = x * d.ksc[d.k0 + 4 * i + lr];
        u32x2 w; w.x = pk2(x.x, x.y); w.y = pk2(x.z, x.w); *(LAS u32x2*)(scr + (4 * i + lr) * TR_PITCH + lc * 2) = w; }
    LDS_WAIT(); asm volatile("" ::: "memory");
    const int li = lane & 15, g = lane >> 4, q = li >> 2, p = li & 3;
#pragma unroll
    for (int nb = 0; nb < 4; ++nb)
#pragma unroll
        for (int kh = 0; kh < 2; ++kh) { const int kc = 4 * kh + g;
            LAS unsigned char* ap = scr + (8 * kc + q) * TR_PITCH + (nb * 16 + 4 * p) * 2;
            const v4i16_t lo = tr_read(ap), hi = tr_read(ap + 4 * TR_PITCH);
            if (d.fp8) { const u32x2 l2 = __builtin_bit_cast(u32x2, lo), h2 = __builtin_bit_cast(u32x2, hi); const unsigned l0 = l2.x, l1 = l2.y, h0 = h2.x, h1 = h2.y;
                u32x2 o8; o8.x = pk4_fp8(bflo(l0) * SW8, bfhi(l0) * SW8, bflo(l1) * SW8, bfhi(l1) * SW8); o8.y = pk4_fp8(bflo(h0) * SW8, bfhi(h0) * SW8, bflo(h1) * SW8, bfhi(h1) * SW8);
                *(u32x2*)((unsigned char*)d.dst + (size_t)(nb * 16 + li) * d.dstK + d.k0 + 8 * kc) = o8; }
            else { const bf16x8 o = (bf16x8){lo[0], lo[1], lo[2], lo[3], hi[0], hi[1], hi[2], hi[3]};
                *(bf16x8*)(d.dst + (size_t)(nb * 16 + li) * d.dstK + d.k0 + 8 * kc) = o; } }
    LDS_WAIT(); asm volatile("" ::: "memory");
}
template <class Dec>
__device__ __forceinline__ void tr64_stream(const Dec& dec, int it0, int stride, int n, LAS unsigned char* scr, int lane) {
    if (it0 >= n) return;
    TrDesc dc = dec(it0); f32x4 vc[16]; tr64_load(dc, vc, lane);
    for (int it = it0; it < n; it += stride) {
        const bool more = it + stride < n;
        TrDesc dn = dc; f32x4 vn[16];
        if (more) { dn = dec(it + stride); tr64_load(dn, vn, lane); }
        tr64_store(dc, vc, scr, lane);
        if (more) { dc = dn;
#pragma unroll
            for (int i = 0; i < 16; ++i) vc[i] = vn[i]; }
    }
}
struct DecP0 { const float *w_in, *w_br_b, *w_out, *w_eg, *w_eu, *g_ffn; unsigned char* ws;
    __device__ __forceinline__ TrDesc operator()(int r) const {
        constexpr int I_WZ = 16 * 72, I_WB = 8 * 16, I_WO = 16 * 16, I_EG = 32 * 16 * 8;
        TrDesc d; d.ksc = nullptr; d.fp8 = 0;
        if (r < I_WZ) { const int kb = r / 72, nb = r % 72, n0 = nb * 64; d.src = w_in; d.ld = NIN; d.k0 = kb * 64; d.n0s = zcol2orig(n0); d.dst = (bf16_t*)(ws + WS_WZ) + (size_t)n0 * D; d.dstK = D; return d; } r -= I_WZ;
        if (r < I_WB) { const int kb = r >> 4, nb = r & 15; d.src = w_br_b; d.ld = D; d.k0 = kb * 64; d.n0s = nb * 64; d.dst = (bf16_t*)(ws + WS_WBT) + (size_t)(nb * 64) * DM; d.dstK = DM; return d; } r -= I_WB;
        if (r < I_WO) { const int kb = r >> 4, nb = r & 15; d.src = w_out; d.ld = D; d.k0 = kb * 64; d.n0s = nb * 64; d.dst = (bf16_t*)(ws + WS_WOT) + (size_t)(nb * 64) * D; d.dstK = D; return d; } r -= I_WO;
        const int up = r >= I_EG; if (up) r -= I_EG; const int e = r >> 7, kb = (r >> 3) & 15, nb = r & 7, j0 = nb * 64;
        const int drow = (j0 >> 7) * 256 + up * 128 + (j0 & 127);
        d.src = (up ? w_eu : w_eg) + (size_t)e * D * DE; d.ld = DE; d.k0 = kb * 64; d.n0s = j0; d.dst = (bf16_t*)(ws + WS_WUP + ((size_t)e * 1024 + drow) * D); d.dstK = D; d.ksc = g_ffn; d.fp8 = 1; return d; }
};
struct DecWd { const float* w_ed; unsigned char* ws;
    __device__ __forceinline__ TrDesc operator()(int r) const { const int e = r >> 7, kb = (r >> 4) & 7, nb = r & 15;
        TrDesc d; d.src = w_ed + (size_t)e * DE * D; d.ld = D; d.k0 = kb * 64; d.n0s = nb * 64; d.dst = (bf16_t*)(ws + WS_WDN + ((size_t)e * 1024 + nb * 64) * DE); d.dstK = DE; d.ksc = nullptr; d.fp8 = 1; return d; }
};

__device__ __forceinline__ void p0_prologue(const Args& a, LAS unsigned char* lds, int tid, int lane, int wave, int vcu, int G) {
    const float* x = a.in[0]; const float* g_mix = a.in[1]; const float* w_in = a.in[2]; const float* b_if = a.in[3];
    const float* w_pool = a.in[7]; const float* pool_scale = a.in[8]; const float* w_br_a = a.in[9]; const float* w_br_b = a.in[10]; const float* w_out = a.in[11];
    const float* g_ffn = a.in[12]; const float* w_eg = a.in[17]; const float* w_eu = a.in[18];
    unsigned char* ws = a.ws;
    bf16_t* h = (bf16_t*)((unsigned char*)a.out + OB_H); float* gif = (float*)(ws + WS_GIF);
    const int gw = vcu * NWAVES + wave, NGW = G * NWAVES;
    LAS float* gwl = (LAS float*)(lds + 81920);
    for (int idx = tid; idx < 8192; idx += NWAVES * 64) { const int k = idx >> 3, o = idx & 7; gwl[o * 1024 + k] = w_in[(size_t)k * NIN + 2560 + o] * g_mix[k]; }
    __syncthreads();
    REP(20) {
        f32x4 gm[4];
#pragma unroll
        for (int j = 0; j < 4; ++j) gm[j] = *(const f32x4*)(g_mix + 4 * lane + 256 * j);
        f32x4 vn[4], vm[4];
        if (gw < T) {
#pragma unroll
            for (int j = 0; j < 4; ++j) vn[j] = ((const f32x4*)(x + (size_t)gw * D) + lane)[64 * j]; }
        if (gw + NGW < T) {
#pragma unroll
            for (int j = 0; j < 4; ++j) vm[j] = ((const f32x4*)(x + (size_t)(gw + NGW) * D) + lane)[64 * j]; }
        for (int m = gw; m < T; m += NGW) {
            f32x4 v[4];
#pragma unroll
            for (int j = 0; j < 4; ++j) { v[j] = vn[j]; vn[j] = vm[j]; }
            if (m + 2 * NGW < T) {
#pragma unroll
                for (int j = 0; j < 4; ++j) vm[j] = ((const f32x4*)(x + (size_t)(m + 2 * NGW) * D) + lane)[64 * j]; }
            float s = 0.f;
#pragma unroll
            for (int j = 0; j < 4; ++j) s += (v[j].x * v[j].x + v[j].y * v[j].y) + (v[j].z * v[j].z + v[j].w * v[j].w);
            float acc[8];
#pragma unroll
            for (int o = 0; o < 8; ++o) { float t = 0.f;
#pragma unroll
                for (int j = 0; j < 4; ++j) { const f32x4 w = *(const LAS f32x4*)(gwl + o * 1024 + 4 * lane + 256 * j); t += (v[j].x * w.x + v[j].y * w.y) + (v[j].z * w.z + v[j].w * w.w); }
                acc[o] = t; }
            s = wave_sum(s);
#pragma unroll
            for (int o = 0; o < 8; ++o) acc[o] = wave_sum(acc[o]);
            const float rstd = rsqrtf(s * (1.f / D) + EPS);
            u32x2* o8 = (u32x2*)(h + (size_t)m * D) + lane;
#pragma unroll
            for (int j = 0; j < 4; ++j) { const f32x4 hv = v[j] * rstd * gm[j]; u32x2 w; w.x = pk2(hv.x, hv.y); w.y = pk2(hv.z, hv.w); o8[64 * j] = w; }
            if (lane < 8) { float r = acc[0];
#pragma unroll
                for (int o = 1; o < 8; ++o) r = (lane == o) ? acc[o] : r;
                gif[(size_t)m * 8 + lane] = r * rstd + b_if[lane]; }
        }
    }
    REP(21) {
        bf16_t* W2T = (bf16_t*)(ws + WS_W2T);
        const int li = lane & 15, g = lane >> 4;
        for (int tile = gw; tile < 32 * 64; tile += NGW) {
            const int k0 = (tile >> 6) * 16, n0 = (tile & 63) * 16, gq = k0 >> 7;
            const float* wp = w_pool + (size_t)(k0 + li) * 128 + 8 * g; const float* sc = pool_scale + gq * 128 + 8 * g; const float* wa = w_br_a + (size_t)(gq * 128 + 8 * g) * D + n0 + li;
            f32x4 a0[4], a1[4], s0[4], s1[4]; float bv[4][8];
#pragma unroll
            for (int st = 0; st < 4; ++st) { a0[st] = *(const f32x4*)(wp + 32 * st); a1[st] = *(const f32x4*)(wp + 32 * st + 4); s0[st] = *(const f32x4*)(sc + 32 * st); s1[st] = *(const f32x4*)(sc + 32 * st + 4);
#pragma unroll
                for (int j = 0; j < 8; ++j) bv[st][j] = wa[(size_t)(32 * st + j) * D]; }
            f32x4 acc = (f32x4){0.f, 0.f, 0.f, 0.f};
#pragma unroll
            for (int st = 0; st < 4; ++st) { const f32x4 p0 = a0[st] * s0[st], p1 = a1[st] * s1[st];
                u32x4 aw; aw.x = pk2(p0.x, p0.y); aw.y = pk2(p0.z, p0.w); aw.z = pk2(p1.x, p1.y); aw.w = pk2(p1.z, p1.w);
                u32x4 bw; bw.x = pk2(bv[st][0], bv[st][1]); bw.y = pk2(bv[st][2], bv[st][3]); bw.z = pk2(bv[st][4], bv[st][5]); bw.w = pk2(bv[st][6], bv[st][7]);
                acc = __builtin_amdgcn_mfma_f32_16x16x32_bf16(__builtin_bit_cast(bf16x8, aw), __builtin_bit_cast(bf16x8, bw), acc, 0, 0, 0); }
            u32x2 o; o.x = pk2(acc[0], acc[1]); o.y = pk2(acc[2], acc[3]);
            *(u32x2*)(W2T + (size_t)(n0 + li) * DP + k0 + 4 * g) = o;
        }
    }
    LAS unsigned char* scr = lds + wave * TR_SCR;
    constexpr int NITEMS = 16 * 72 + 8 * 16 + 16 * 16 + 2 * 32 * 16 * 8;
    REP(22) tr64_stream(DecP0{w_in, w_br_b, w_out, w_eg, w_eu, g_ffn, ws}, gw, NGW, NITEMS, scr, lane);
    {
        const float* w_rg = a.in[13]; const float* w_re = a.in[15];
        const int gt = gw * 64 + lane;
        if (gt < 48 * 128) { const int col = gt >> 7, ch = gt & 127; float v[8];
#pragma unroll
            for (int q = 0; q < 8; ++q) { const int k = 8 * ch + q; v[q] = (col < 4 ? w_rg[k * NG + col] : col < 36 ? w_re[k * NE + col - 4] : 0.f) * g_ffn[k]; }
            u32x4 w; w.x = pk2(v[0], v[1]); w.y = pk2(v[2], v[3]); w.z = pk2(v[4], v[5]); w.w = pk2(v[6], v[7]);
            *(u32x4*)(ws + WS_WR + col * 2048 + ((ch ^ (col & 15)) << 4)) = w; }
    }
}

__device__ __forceinline__ void convert_wdown(const Args& a, LAS unsigned char* lds, int lane, int wave, int gi, int ngrp) {
    tr64_stream(DecWd{a.in[19], a.ws}, gi * NWAVES + wave, ngrp * NWAVES, 32 * 8 * 16, lds + wave * TR_SCR, lane);
}

__global__ void __launch_bounds__(NWAVES * 64, 2) mk_fwd(Args args) {
    extern __shared__ __attribute__((aligned(16))) unsigned char lds_raw[];
    LAS unsigned char* lds = (LAS unsigned char*)lds_raw;
    volatile LAS unsigned* MISC = (volatile LAS unsigned*)(lds + MISC_OFF);
    const int tid = threadIdx.x, lane = tid & 63, wave = __builtin_amdgcn_readfirstlane(tid >> 6);
    const int G = gridDim.x; const int bx = blockIdx.x; const int vcu = (G % 8 == 0) ? (bx % 8) * (G / 8) + bx / 8 : bx;
    unsigned char* ws = args.ws; unsigned* ctl = (unsigned*)(ws + WS_CTL);
    for (int u = tid; u < (LDS_BYTES - LDSCTL_OFF) / 4; u += NWAVES * 64) ((LAS unsigned*)(lds + LDSCTL_OFF))[u] = 0u;
    __syncthreads();
    XcdBarrier bar = xcd_barrier_post(ctl + CW_BAR + args.li * XCD_BAR_WORDS, MISC + 8);
    const int lo = args.ph_lo, hi = args.ph_hi;
#define IN(k) (lo <= (k) && (k) < hi)
#define BOTH(k) (IN(k) && IN((k) + 1))
#define GRID_BAR() xcd_barrier(bar)
#define STAMP(k) do { if (PROBE_PHASE >= 100 && bx == 0 && tid == 0) { const unsigned long long _t = __builtin_amdgcn_s_memrealtime(); if ((k) == PROBE_PHASE - 100) tstart = _t; if ((k) == PROBE_PHASE - 99) tend = _t; } } while (0)
    unsigned long long tstart = 0, tend = 0;
    STAMP(0);
    if (IN(0)) { REP(0) { p0_prologue(args, lds, tid, lane, wave, vcu, G); __syncthreads(); } if (BOTH(0)) GRID_BAR(); STAMP(1); }
    if (IN(1)) {
        SchedDense S{(const char*)args.out + OB_H, (const char*)(ws + WS_WZ), (size_t)256 * D * 2, (size_t)256 * D * 2, T / 256, NZ / 256, G, bx, (PROBE_PHASE == 1) ? 2 : 1};
        EpiZ E{(bf16_t*)(ws + WS_Z)};
        pg8::gemm_phase<EpiZ, SchedDense, false>(lds + RING_OFF, pg8::Cfg{D, D * 2, D * 2}, S, E);
        { const int nwg = (T / 256) * (NZ / 256), full = nwg % G;
          if (full == 0) convert_wdown(args, lds, lane, wave, bx, G); else if (bx >= full) convert_wdown(args, lds, lane, wave, bx - full, G - full); }
        if (BOTH(1)) GRID_BAR(); STAMP(2);
    }
    if (IN(2)) {
        REP(2) for (int pr = vcu; pr < 512; pr += G) b1_item(args, lds + (wave >> 2) * HALF_LDS, 2 * pr + (wave >> 2), tid & 255, wave & 3, lane);
        pool_pass(args, tid, vcu, G);
        if (BOTH(2)) GRID_BAR(); STAMP(3);
    }
    if (IN(3)) { p3_scan(args, tid, vcu, G); if (BOTH(3)) GRID_BAR(); STAMP(4); }
    if (IN(4)) {
        { LAS float* ghl = (LAS float*)(lds + META_OFF); ghl[tid] = args.in[6][tid]; __syncthreads();
          REP(4) for (int pr = vcu; pr < 512; pr += G) b3_item(args, lds + (wave >> 2) * HALF_LDS, ghl, 2 * pr + (wave >> 2), tid & 255, wave & 3, lane); }
        if (BOTH(4)) GRID_BAR(); STAMP(5);
    }
    if (IN(5)) {
        SchedMerge S{(const char*)args.out + OB_DA, (const char*)args.out + OB_HM, (const char*)(ws + WS_W2T), (const char*)(ws + WS_WBT), T / 256, D / 256, G, bx};
        EpiMerge E{(const bf16_t*)(ws + WS_Z), (bf16_t*)((unsigned char*)args.out + OB_MERGED)};
        pg8::gemm_phase<EpiMerge, SchedMerge, false>(lds + RING_OFF, pg8::Cfg{DP, DP * 2, DP * 2}, S, E);
        if (BOTH(5)) GRID_BAR(); STAMP(6);
    }
    if (IN(6)) {
        SchedDense S{(const char*)args.out + OB_MERGED, (const char*)(ws + WS_WOT), (size_t)256 * D * 2, (size_t)256 * D * 2, T / 256, D / 256, G, bx, (PROBE_PHASE == 6) ? 2 : 1};
        EpiX1 E{args.in[0], (bf16_t*)(ws + WS_X1B), ws + WS_X1Q};
        pg8::gemm_phase<EpiX1, SchedDense, false>(lds + RING_OFF, pg8::Cfg{D, D * 2, D * 2}, S, E);
        if (BOTH(6)) GRID_BAR(); STAMP(7);
    }
    if (IN(7)) { p7_route(args, lds, MISC, tid, lane, wave, vcu, G); if (BOTH(7)) GRID_BAR(); STAMP(8); }
#if MOE_DYN
    if (IN(8)) {
        moe_tables(ctl + CW_CNT, MISC, tid);
        SchedMoEQ S{MISC, ctl, (const char*)(ws + WS_X1Q), (const char*)(ws + WS_HID), (const char*)(ws + WS_WUP), (const char*)(ws + WS_WDN), (const int*)(ws + WS_ALIST), (const f32x2*)(ws + WS_RWLIST), ctl + CW_READY, (int)(bar.x & 7u), wave, lane};
        EpiUpQ E0{(bf16_t*)(ws + WS_HID)};
        EpiDownQ E1{(bf16_t*)args.out};
        pg8::gemm_phase_moe<SchedMoEQ, EpiUpQ, EpiDownQ>(lds + RING_OFF, lds + META_OFF, S, E0, E1);
        if (IN(10)) GRID_BAR(); STAMP(9); STAMP(10);
    }
#else
    if (IN(8)) {
        moe_tables(ctl + CW_CNT, MISC, tid);
        SchedMoE S{MISC, (const char*)(ws + WS_X1B), (const char*)(ws + WS_WUP), (const int*)(ws + WS_ALIST), (size_t)1024 * D * 2, (size_t)256 * D * 2, 0, G, vcu, 1, (PROBE_PHASE == 8) ? 2 : 1};
        EpiUp E{(const int*)(ws + WS_ALIST), (const f32x2*)(ws + WS_RWLIST), (bf16_t*)(ws + WS_HID)};
        pg8::gemm_phase<EpiUp, SchedMoE, true>(lds + RING_OFF, pg8::Cfg{D, D * 2, D * 2}, S, E);
        if (BOTH(8)) GRID_BAR(); STAMP(9);
    }
    if (IN(9)) {
        moe_tables(ctl + CW_CNT, MISC, tid);
        SchedMoE S{MISC, (const char*)(ws + WS_HID), (const char*)(ws + WS_WDN), (const int*)(ws + WS_ALIST), (size_t)1024 * DE * 2, (size_t)256 * DE * 2, (size_t)256 * DE * 2, G, vcu, 0, (PROBE_PHASE == 9) ? 2 : 1};
        EpiDown E{(const int*)(ws + WS_ALIST), (const f32x2*)(ws + WS_RWLIST), (bf16_t*)args.out};
        pg8::gemm_phase<EpiDown, SchedMoE, false>(lds + RING_OFF, pg8::Cfg{DE, DE * 2, DE * 2}, S, E);
        if (BOTH(9)) GRID_BAR(); STAMP(10);
    }
#endif
    if (IN(10)) p10_final(args, lane, wave, vcu, G);
    STAMP(11);
    if (PROBE_PHASE >= 100 && bx == 0 && tid == 0) { const unsigned long long d = (tend - tstart) * 8ull, t0 = __builtin_amdgcn_s_memrealtime(); while (__builtin_amdgcn_s_memrealtime() - t0 < d) __builtin_amdgcn_s_sleep(16); }
#undef IN
#undef BOTH
#undef GRID_BAR
}

}

extern "C" void kernel_launch(void* const* d_in, const int* in_sizes, int n_in, void* d_out, int out_size, void* d_ws, size_t ws_size, hipStream_t stream) {
    const float* x = (const float*)d_in[0];
    const float* conv_q = (const float*)d_in[4]; const float* conv_k = (const float*)d_in[5]; const float* g_head = (const float*)d_in[6]; const float* w_pool = (const float*)d_in[7];
    const float* pool_scale = (const float*)d_in[8]; const float* w_br_a = (const float*)d_in[9]; const float* w_br_b = (const float*)d_in[10]; const float* w_out = (const float*)d_in[11];
    const float* g_ffn = (const float*)d_in[12]; const float* w_rg = (const float*)d_in[13]; const float* b_rg = (const float*)d_in[14]; const float* w_re = (const float*)d_in[15];
    const float* b_re = (const float*)d_in[16]; const float* w_eg = (const float*)d_in[17]; const float* w_eu = (const float*)d_in[18]; const float* w_ed = (const float*)d_in[19];
    const float* g_final = (const float*)d_in[20];
    static int grid = 0;
    if (grid == 0) {
        if (n_in != 21 || out_size != T * D || ws_size < WS_END) { fprintf(stderr, "kernel_launch: unexpected shapes/ws (%d inputs, out %d, ws %zu)\n", n_in, out_size, ws_size); grid = -1; return; }
        int dev = 0, cus = 0, per_cu = 0;
        if (hipGetDevice(&dev) != hipSuccess || hipDeviceGetAttribute(&cus, hipDeviceAttributeMultiprocessorCount, dev) != hipSuccess) { grid = -1; return; }
        if (hipFuncSetAttribute((const void*)mk_fwd, hipFuncAttributeMaxDynamicSharedMemorySize, LDS_BYTES) != hipSuccess) { fprintf(stderr, "kernel_launch: hipFuncSetAttribute failed\n"); grid = -1; return; }
        if (hipOccupancyMaxActiveBlocksPerMultiprocessor(&per_cu, (const void*)mk_fwd, NWAVES * 64, LDS_BYTES) != hipSuccess || per_cu < 1) { fprintf(stderr, "kernel_launch: occupancy query says %d blocks per CU\n", per_cu); grid = -1; return; }
        (void)hipGetLastError();
        grid = cus;
    }
    if (grid < 0) return;
    unsigned char* ws = (unsigned char*)d_ws; unsigned char* ob = (unsigned char*)d_out;
    (void)hipMemsetAsync(ws + WS_CTL, 0, CTL_ZERO_BYTES, stream);
    Args a{};
    for (int i = 0; i < 21; ++i) a.in[i] = (const float*)d_in[i];
    a.out = (float*)d_out; a.ws = ws; a.flags = 0;
    a.ph_lo = 0; a.ph_hi = 11; a.li = 0;
    hipLaunchKernelGGL(mk_fwd, dim3(grid), dim3(NWAVES * 64), LDS_BYTES, stream, a);
}
```

```cpp
#include <hip/hip_runtime.h>
#include <cstdio>
#include <cstdint>

namespace {
constexpr int D = 1024, BATCH = 8, SEQ = 2048, T = BATCH * SEQ;
constexpr int DP = 512, DM = 512, NH = 4, HD = 128, NIN = 4616, NZ = 4608;
constexpr int NG = 4, EPG = 8, NE = 32, DE = 512;
constexpr float EPS = 1e-6f;
constexpr size_t MiB = 1u << 20;

typedef unsigned short bf16_t;
__device__ __forceinline__ bf16_t f2bf(float f) { unsigned u = __builtin_bit_cast(unsigned, f); return (bf16_t)((u + 0x7fffu + ((u >> 16) & 1u)) >> 16); }
__device__ __forceinline__ float bf2f(bf16_t b) { return __builtin_bit_cast(float, (unsigned)b << 16); }
__device__ __forceinline__ float sigmoidf_(float x) { return 1.f / (1.f + __expf(-x)); }
__device__ __forceinline__ float siluf_(float x) { return x / (1.f + __expf(-x)); }
__device__ __forceinline__ float logsigmoidf_(float x) { return fminf(x, 0.f) - log1pf(__expf(-fabsf(x))); }
__device__ __forceinline__ float wave_sum(float v) {
#pragma unroll
    for (int o = 1; o < 64; o <<= 1) v += __shfl_xor(v, o);
    return v;
}
__host__ __device__ __forceinline__ size_t zoff(size_t tok, int col) { return ((size_t)(col >> 7) * T + tok) * 128 + (col & 127); }
__device__ __forceinline__ int zcol2orig(int c) { return c < 2560 ? c : c + 8; }

__global__ void __launch_bounds__(256) k_prep(const float* __restrict__ x, const float* __restrict__ g, const float* __restrict__ w_in,
                                               const float* __restrict__ b_if, bf16_t* __restrict__ h, float* __restrict__ gif) {
    const int wave = threadIdx.x >> 6, lane = threadIdx.x & 63;
    const int row = blockIdx.x * 4 + wave;
    if (row >= T) return;
    const float* xr = x + (size_t)row * D;
    float v[16]; float s = 0.f;
#pragma unroll
    for (int j = 0; j < 16; ++j) { v[j] = xr[lane + 64 * j]; s += v[j] * v[j]; }
    s = wave_sum(s);
    const float rstd = rsqrtf(s * (1.f / D) + EPS);
    float acc[8];
#pragma unroll
    for (int o = 0; o < 8; ++o) acc[o] = 0.f;
#pragma unroll
    for (int j = 0; j < 16; ++j) {
        const int k = lane + 64 * j;
        const float hv = v[j] * rstd * g[k];
        h[(size_t)row * D + k] = f2bf(hv);
#pragma unroll
        for (int o = 0; o < 8; ++o) acc[o] += hv * w_in[(size_t)k * NIN + 2560 + o];
    }
#pragma unroll
    for (int o = 0; o < 8; ++o) { acc[o] = wave_sum(acc[o]); }
    if (lane == 0) {
#pragma unroll
        for (int o = 0; o < 8; ++o) gif[(size_t)row * 8 + o] = acc[o] + b_if[o];
    }
}

template <class AL, class BL, class EP>
__global__ void __launch_bounds__(256) k_gemm(int M, int N, int K, AL al, BL bl, EP ep) {
    __shared__ float As[16][68];
    __shared__ float Bs[16][68];
    const int tid = threadIdx.x, tx = tid & 15, ty = tid >> 4;
    const int row0 = blockIdx.y * 64, col0 = blockIdx.x * 64;
    float acc[4][4];
#pragma unroll
    for (int i = 0; i < 4; ++i)
#pragma unroll
        for (int j = 0; j < 4; ++j) acc[i][j] = 0.f;
    for (int k0 = 0; k0 < K; k0 += 16) {
#pragma unroll
        for (int j = 0; j < 4; ++j) {
            const int idx = tid + j * 256;
            const int r = idx >> 4, kk = idx & 15;
            As[kk][r] = (row0 + r < M) ? al(row0 + r, k0 + kk) : 0.f;
            const int k2 = idx >> 6, n = idx & 63;
            Bs[k2][n] = (col0 + n < N) ? bl(k0 + k2, col0 + n) : 0.f;
        }
        __syncthreads();
#pragma unroll
        for (int kk = 0; kk < 16; ++kk) {
            float a[4], b[4];
#pragma unroll
            for (int i = 0; i < 4; ++i) a[i] = As[kk][ty * 4 + i];
#pragma unroll
            for (int j = 0; j < 4; ++j) b[j] = Bs[kk][tx * 4 + j];
#pragma unroll
            for (int i = 0; i < 4; ++i)
#pragma unroll
                for (int j = 0; j < 4; ++j) acc[i][j] += a[i] * b[j];
        }
        __syncthreads();
    }
#pragma unroll
    for (int i = 0; i < 4; ++i)
#pragma unroll
        for (int j = 0; j < 4; ++j) {
            const int r = row0 + ty * 4 + i, c = col0 + tx * 4 + j;
            if (r < M && c < N) ep(r, c, acc[i][j]);
        }
}

struct ALbf { const bf16_t* p; int ld; int pad; __device__ float operator()(int r, int k) const { return bf2f(p[(size_t)r * ld + k]); } };
struct ALf32 { const float* p; int ld; int pad; __device__ float operator()(int r, int k) const { return p[(size_t)r * ld + k]; } };
struct BLwin { const float* w; __device__ float operator()(int k, int n) const { return w[(size_t)k * NIN + zcol2orig(n)]; } };
struct BLplain { const float* w; int ld; int pad; __device__ float operator()(int k, int n) const { return w[(size_t)k * ld + n]; } };
struct EPz { bf16_t* z; __device__ void operator()(int r, int c, float v) const { z[(size_t)r * NZ + c] = f2bf(v); } };
struct EPf32 { float* o; int ld; int pad; __device__ void operator()(int r, int c, float v) const { o[(size_t)r * ld + c] = v; } };
struct EPmerge { const float* ya; const bf16_t* z; bf16_t* m;
    __device__ void operator()(int r, int c, float yb) const {
        const float ga = bf2f(z[(size_t)r * NZ + 2560 + c]), gb = bf2f(z[(size_t)r * NZ + 3584 + c]);
        m[(size_t)r * D + c] = f2bf(sigmoidf_(ga) * ya[(size_t)r * D + c] + sigmoidf_(gb) * yb); } };
struct EPres { const float* x; float* x1; __device__ void operator()(int r, int c, float v) const { x1[(size_t)r * D + c] = x[(size_t)r * D + c] + v; } };

__global__ void __launch_bounds__(256) k_conv(const bf16_t* __restrict__ z, const float* __restrict__ cq, const float* __restrict__ ck, bf16_t* __restrict__ qa, bf16_t* __restrict__ ka) {
    const size_t idx = (size_t)blockIdx.x * 256 + threadIdx.x;
    const int t = (int)(idx >> 9), c = (int)(idx & 511), s = t % SEQ;
    float aq = 0.f, ak = 0.f;
#pragma unroll
    for (int j = 0; j < 4; ++j) {
        const int ss = s - 3 + j;
        if (ss >= 0) {
            const size_t r = (size_t)(t - 3 + j) * NZ;
            aq += bf2f(z[r + 512 + c]) * cq[j * DM + c];
            ak += bf2f(z[r + 1024 + c]) * ck[j * DM + c];
        }
    }
    qa[idx] = f2bf(siluf_(aq));
    ka[idx] = f2bf(siluf_(ak) * 0.08838834764831845f);
}
__global__ void k_bcum(const float* __restrict__ gif, float* __restrict__ bcs) {
    const int bh = blockIdx.x * blockDim.x + threadIdx.x;
    if (bh >= BATCH * NH) return;
    const int b = bh / NH, hh = bh % NH;
    float acc = 0.f;
    for (int s = 0; s < SEQ; ++s) { acc += logsigmoidf_(gif[((size_t)b * SEQ + s) * 8 + 4 + hh]); bcs[(size_t)bh * SEQ + s] = acc; }
}
__global__ void __launch_bounds__(256) k_mlstm_naive(const bf16_t* __restrict__ qa, const bf16_t* __restrict__ ka, const bf16_t* __restrict__ z, const float* __restrict__ gif,
                                                      const float* __restrict__ bcs, const float* __restrict__ g_head, bf16_t* __restrict__ hm) {
    __shared__ float ks[32][129];
    __shared__ float vs[32][129];
    __shared__ float ws_[32];
    const int bh = blockIdx.x >> 5, qb = blockIdx.x & 31, b = bh / NH, hh = bh % NH;
    const int tid = threadIdx.x, tq = tid >> 2, part = tid & 3;
    const int t = qb * 64 + tq;
    const size_t rowq = (size_t)b * SEQ + t;
    float q[32];
#pragma unroll
    for (int j = 0; j < 32; ++j) q[j] = bf2f(qa[rowq * DM + hh * HD + part * 32 + j]);
    const float bt = bcs[(size_t)bh * SEQ + t];
    float num[32];
#pragma unroll
    for (int j = 0; j < 32; ++j) num[j] = 0.f;
    float nq = 0.f;
    for (int kb = 0; kb <= qb * 2 + 1; ++kb) {
        __syncthreads();
        for (int i = tid; i < 32 * 128; i += 256) {
            const int r = i >> 7, c = i & 127; const size_t row = (size_t)b * SEQ + kb * 32 + r;
            ks[r][c] = bf2f(ka[row * DM + hh * HD + c]);
            vs[r][c] = bf2f(z[row * NZ + 1536 + hh * HD + c]);
        }
        if (tid < 32) { const size_t row = (size_t)b * SEQ + kb * 32 + tid; ws_[tid] = gif[row * 8 + hh] - bcs[(size_t)bh * SEQ + kb * 32 + tid]; }
        __syncthreads();
        for (int s = 0; s < 32; ++s) {
            if (kb * 32 + s > t) break;
            float d = 0.f;
#pragma unroll
            for (int j = 0; j < 32; ++j) d += q[j] * ks[s][part * 32 + j];
            d += __shfl_xor(d, 1); d += __shfl_xor(d, 2);
            const float w = d * __expf(bt + ws_[s]);
            nq += w;
#pragma unroll
            for (int j = 0; j < 32; ++j) num[j] += w * vs[s][part * 32 + j];
        }
    }
    const float den = fmaxf(fabsf(nq), 1.f);
    float s1 = 0.f;
#pragma unroll
    for (int j = 0; j < 32; ++j) { num[j] /= den; s1 += num[j]; }
    s1 += __shfl_xor(s1, 1); s1 += __shfl_xor(s1, 2);
    const float mu = s1 * (1.f / HD);
    float s2 = 0.f;
#pragma unroll
    for (int j = 0; j < 32; ++j) { const float dd = num[j] - mu; s2 += dd * dd; }
    s2 += __shfl_xor(s2, 1); s2 += __shfl_xor(s2, 2);
    const float rstd = rsqrtf(s2 * (1.f / HD) + EPS);
#pragma unroll
    for (int j = 0; j < 32; ++j) {
        const int c = hh * HD + part * 32 + j;
        const float o = bf2f(z[rowq * NZ + 2048 + c]);
        hm[rowq * DM + c] = f2bf((num[j] - mu) * rstd * g_head[c] * sigmoidf_(o));
    }
}
__global__ void __launch_bounds__(256) k_pool(const bf16_t* __restrict__ z, bf16_t* __restrict__ dA) {
    const size_t idx = (size_t)blockIdx.x * 256 + threadIdx.x;
    const int t = (int)(idx >> 9), c = (int)(idx & 511), s = t % SEQ, g = c >> 7;
    const int w = 2 << g;
    const int start = max(s + 1 - w, 0), cnt = s + 1 - start;
    float acc = 0.f;
    for (int j = 0; j < cnt; ++j) acc += bf2f(z[(size_t)(t - j) * NZ + c]);
    dA[idx] = f2bf(acc / (float)cnt - bf2f(z[(size_t)t * NZ + c]));
}
__global__ void __launch_bounds__(256) k_poolmm(const bf16_t* __restrict__ dA, const float* __restrict__ w_pool, const float* __restrict__ scale, float* __restrict__ yp) {
    const size_t idx = (size_t)blockIdx.x * 256 + threadIdx.x;
    const int t = (int)(idx >> 9), j = (int)(idx & 511), g = j >> 7, jj = j & 127;
    float acc = 0.f;
    for (int c = 0; c < 128; ++c) acc += bf2f(dA[(size_t)t * DP + g * 128 + c]) * w_pool[((size_t)g * 128 + c) * 128 + jj];
    yp[idx] = acc * scale[j];
}

__global__ void __launch_bounds__(256) k_route(const float* __restrict__ x1, const float* __restrict__ g_ffn, const float* __restrict__ w_rg, const float* __restrict__ b_rg,
                                                const float* __restrict__ w_re, const float* __restrict__ b_re, float* __restrict__ rstd2, int* __restrict__ sel, float* __restrict__ gw,
                                                int* __restrict__ counts, int* __restrict__ lists) {
    const int wave = threadIdx.x >> 6, lane = threadIdx.x & 63;
    const int tok = blockIdx.x * 4 + wave;
    const float* xr = x1 + (size_t)tok * D;
    float v[16]; float s = 0.f;
#pragma unroll
    for (int j = 0; j < 16; ++j) { v[j] = xr[lane + 64 * j]; s += v[j] * v[j]; }
    s = wave_sum(s);
    const float rstd = rsqrtf(s * (1.f / D) + EPS);
    float lg[4] = {0.f, 0.f, 0.f, 0.f};
#pragma unroll
    for (int j = 0; j < 16; ++j) { const int k = lane + 64 * j; v[j] = v[j] * rstd * g_ffn[k];
#pragma unroll
        for (int o = 0; o < 4; ++o) lg[o] += v[j] * w_rg[k * NG + o]; }
#pragma unroll
    for (int o = 0; o < 4; ++o) lg[o] = wave_sum(lg[o]) + b_rg[o];
    int gs = 0; float gm = lg[0];
#pragma unroll
    for (int o = 1; o < 4; ++o) if (lg[o] > gm) { gm = lg[o]; gs = o; }
    float den = 0.f;
#pragma unroll
    for (int o = 0; o < 4; ++o) den += __expf(lg[o] - gm);
    const float pg = 1.f / den;
    float le[8];
#pragma unroll
    for (int o = 0; o < 8; ++o) le[o] = 0.f;
#pragma unroll
    for (int j = 0; j < 16; ++j) { const int k = lane + 64 * j;
#pragma unroll
        for (int o = 0; o < 8; ++o) le[o] += v[j] * w_re[k * NE + gs * EPG + o]; }
#pragma unroll
    for (int o = 0; o < 8; ++o) le[o] = wave_sum(le[o]) + b_re[gs * EPG + o];
    int i1 = 0; float m1 = le[0];
#pragma unroll
    for (int o = 1; o < 8; ++o) if (le[o] > m1) { m1 = le[o]; i1 = o; }
    int i2 = -1; float m2 = -3.0e38f;
#pragma unroll
    for (int o = 0; o < 8; ++o) if (o != i1 && le[o] > m2) { m2 = le[o]; i2 = o; }
    const float e2 = __expf(m2 - m1);
    const float p1 = 1.f / (1.f + e2), p2 = e2 / (1.f + e2);
    if (lane == 0) {
        rstd2[tok] = rstd;
        const int ea = gs * EPG + i1, eb = gs * EPG + i2;
        sel[tok * 2] = ea; sel[tok * 2 + 1] = eb;
        gw[tok * 2] = pg * p1; gw[tok * 2 + 1] = pg * p2;
        const int pa = atomicAdd(&counts[ea], 1); lists[ea * T + pa] = tok * 2;
        const int pb = atomicAdd(&counts[eb], 1); lists[eb * T + pb] = tok * 2 + 1;
    }
}
__global__ void __launch_bounds__(256) k_moe_up(const float* __restrict__ x1, const float* __restrict__ rstd2, const float* __restrict__ g_ffn, const float* __restrict__ wg, const float* __restrict__ wu,
                                                 const int* __restrict__ counts, const int* __restrict__ lists, float* __restrict__ hid) {
    const int e = blockIdx.z, rt = blockIdx.y, ct = blockIdx.x;
    const int cnt = counts[e];
    if (rt * 64 >= cnt) return;
    __shared__ float As[16][68]; __shared__ float Bg[16][68]; __shared__ float Bu[16][68];
    __shared__ int toks[64]; __shared__ float rs[64];
    const int tid = threadIdx.x, tx = tid & 15, ty = tid >> 4;
    if (tid < 64) { const int r = rt * 64 + tid; const int a = (r < cnt) ? lists[e * T + r] : -1; toks[tid] = a; rs[tid] = (a >= 0) ? rstd2[a >> 1] : 0.f; }
    __syncthreads();
    float ag[4][4], au[4][4];
#pragma unroll
    for (int i = 0; i < 4; ++i)
#pragma unroll
        for (int j = 0; j < 4; ++j) { ag[i][j] = 0.f; au[i][j] = 0.f; }
    const float* wge = wg + (size_t)e * D * DE; const float* wue = wu + (size_t)e * D * DE;
    for (int k0 = 0; k0 < D; k0 += 16) {
#pragma unroll
        for (int j = 0; j < 4; ++j) {
            const int idx = tid + j * 256; const int r = idx >> 4, kk = idx & 15;
            const int a = toks[r];
            As[kk][r] = (a >= 0) ? x1[(size_t)(a >> 1) * D + k0 + kk] * rs[r] * g_ffn[k0 + kk] : 0.f;
            const int k2 = idx >> 6, n = idx & 63;
            Bg[k2][n] = wge[(size_t)(k0 + k2) * DE + ct * 64 + n];
            Bu[k2][n] = wue[(size_t)(k0 + k2) * DE + ct * 64 + n];
        }
        __syncthreads();
#pragma unroll
        for (int kk = 0; kk < 16; ++kk) {
            float a[4], bg[4], bu[4];
#pragma unroll
            for (int i = 0; i < 4; ++i) a[i] = As[kk][ty * 4 + i];
#pragma unroll
            for (int j = 0; j < 4; ++j) { bg[j] = Bg[kk][tx * 4 + j]; bu[j] = Bu[kk][tx * 4 + j]; }
#pragma unroll
            for (int i = 0; i < 4; ++i)
#pragma unroll
                for (int j = 0; j < 4; ++j) { ag[i][j] += a[i] * bg[j]; au[i][j] += a[i] * bu[j]; }
        }
        __syncthreads();
    }
#pragma unroll
    for (int i = 0; i < 4; ++i) { const int a = toks[ty * 4 + i]; if (a < 0) continue;
#pragma unroll
        for (int j = 0; j < 4; ++j) hid[(size_t)a * DE + ct * 64 + tx * 4 + j] = siluf_(ag[i][j]) * au[i][j]; }
}
__global__ void __launch_bounds__(256) k_moe_down(const float* __restrict__ hid, const float* __restrict__ wd, const float* __restrict__ gw, const int* __restrict__ counts, const int* __restrict__ lists, bf16_t* __restrict__ yb) {
    const int e = blockIdx.z, rt = blockIdx.y, ct = blockIdx.x;
    const int cnt = counts[e];
    if (rt * 64 >= cnt) return;
    __shared__ float As[16][68]; __shared__ float Bs[16][68];
    __shared__ int toks[64];
    const int tid = threadIdx.x, tx = tid & 15, ty = tid >> 4;
    if (tid < 64) { const int r = rt * 64 + tid; toks[tid] = (r < cnt) ? lists[e * T + r] : -1; }
    __syncthreads();
    float acc[4][4];
#pragma unroll
    for (int i = 0; i < 4; ++i)
#pragma unroll
        for (int j = 0; j < 4; ++j) acc[i][j] = 0.f;
    const float* wde = wd + (size_t)e * DE * D;
    for (int k0 = 0; k0 < DE; k0 += 16) {
#pragma unroll
        for (int j = 0; j < 4; ++j) {
            const int idx = tid + j * 256; const int r = idx >> 4, kk = idx & 15;
            const int a = toks[r];
            As[kk][r] = (a >= 0) ? hid[(size_t)a * DE + k0 + kk] : 0.f;
            const int k2 = idx >> 6, n = idx & 63;
            Bs[k2][n] = wde[(size_t)(k0 + k2) * D + ct * 64 + n];
        }
        __syncthreads();
#pragma unroll
        for (int kk = 0; kk < 16; ++kk) {
            float a[4], b[4];
#pragma unroll
            for (int i = 0; i < 4; ++i) a[i] = As[kk][ty * 4 + i];
#pragma unroll
            for (int j = 0; j < 4; ++j) b[j] = Bs[kk][tx * 4 + j];
#pragma unroll
            for (int i = 0; i < 4; ++i)
#pragma unroll
                for (int j = 0; j < 4; ++j) acc[i][j] += a[i] * b[j];
        }
        __syncthreads();
    }
#pragma unroll
    for (int i = 0; i < 4; ++i) { const int a = toks[ty * 4 + i]; if (a < 0) continue; const float w = gw[a];
#pragma unroll
        for (int j = 0; j < 4; ++j) yb[(size_t)a * D + ct * 64 + tx * 4 + j] = f2bf(acc[i][j] * w); }
}
__global__ void __launch_bounds__(256) k_final(const float* __restrict__ x1, const bf16_t* __restrict__ yb, const float* __restrict__ g, float* __restrict__ out) {
    const int wave = threadIdx.x >> 6, lane = threadIdx.x & 63;
    const int tok = blockIdx.x * 4 + wave;
    float v[16]; float s = 0.f;
#pragma unroll
    for (int j = 0; j < 16; ++j) { const int k = lane + 64 * j;
        v[j] = x1[(size_t)tok * D + k] + bf2f(yb[(size_t)(tok * 2) * D + k]) + bf2f(yb[(size_t)(tok * 2 + 1) * D + k]); s += v[j] * v[j]; }
    s = wave_sum(s);
    const float rstd = rsqrtf(s * (1.f / D) + EPS);
#pragma unroll
    for (int j = 0; j < 16; ++j) { const int k = lane + 64 * j; out[(size_t)tok * D + k] = v[j] * rstd * g[k]; }
}

#define GAS __attribute__((address_space(1)))
#define LAS __attribute__((address_space(3)))
typedef short bf16x8 __attribute__((ext_vector_type(8)));
typedef float f32x4 __attribute__((ext_vector_type(4)));
typedef float f32x2 __attribute__((ext_vector_type(2)));
typedef unsigned u32x4 __attribute__((ext_vector_type(4)));
typedef unsigned u32x2 __attribute__((ext_vector_type(2)));
#define LDS_WAIT() asm volatile("s_waitcnt lgkmcnt(0)" ::: "memory")
#define VM_WAIT() asm volatile("s_waitcnt vmcnt(0)" ::: "memory")
__device__ __forceinline__ unsigned pk2(float lo, float hi) { return (unsigned)f2bf(lo) | ((unsigned)f2bf(hi) << 16); }
__device__ __forceinline__ unsigned cvt_pk_bf16(float lo, float hi) { unsigned r; asm volatile("v_cvt_pk_bf16_f32 %0, %1, %2" : "=v"(r) : "v"(lo), "v"(hi)); return r; }
__device__ __forceinline__ float u2f(unsigned u) { return __builtin_bit_cast(float, u); }
__device__ __forceinline__ float bflo(unsigned w) { return __builtin_bit_cast(float, w << 16); }
__device__ __forceinline__ float bfhi(unsigned w) { return __builtin_bit_cast(float, w & 0xffff0000u); }
constexpr float SW8 = 512.f, SX8 = 16.f, SH8 = 8.f;
__device__ __forceinline__ unsigned pk4_fp8(float a, float b, float c, float d) {
    a = __builtin_amdgcn_fmed3f(a, -448.f, 448.f); b = __builtin_amdgcn_fmed3f(b, -448.f, 448.f); c = __builtin_amdgcn_fmed3f(c, -448.f, 448.f); d = __builtin_amdgcn_fmed3f(d, -448.f, 448.f);
    unsigned w = 0u; w = __builtin_amdgcn_cvt_pk_fp8_f32(a, b, w, false); w = __builtin_amdgcn_cvt_pk_fp8_f32(c, d, w, true); return w; }
__device__ __forceinline__ float fast_exp(float x) { return __builtin_amdgcn_exp2f(x * 1.4426950408889634f); }
__device__ __forceinline__ float fast_rcp(float x) { return __builtin_amdgcn_rcpf(x); }
__device__ __forceinline__ float fsigmoid(float x) { return fast_rcp(1.f + fast_exp(-x)); }

#define XB_TMO      128
#define XB_XCNT(j)  (256  + 64 * (j))
#define XB_XSUB(j)  (1280 + 64 * (j))
#define XB_XGEN(j)  (2304 + 64 * (j))
#define XB_TOP      3328
#define XB_TOPGEN   3392
#define XCD_BAR_WORDS 3456
#define XB_SPIN_CAP (1u << 18)
__device__ __forceinline__ unsigned xb_ld(unsigned* p)              { return __hip_atomic_load(p, __ATOMIC_RELAXED, __HIP_MEMORY_SCOPE_AGENT); }
__device__ __forceinline__ unsigned xb_add(unsigned* p, unsigned v) { return __hip_atomic_fetch_add(p, v, __ATOMIC_RELAXED, __HIP_MEMORY_SCOPE_AGENT); }
__device__ __forceinline__ unsigned xb_xcc_id() { return (unsigned)__builtin_amdgcn_s_getreg((3 << 11) | 20) & 0xFu; }
#define XB_SPIN(cond, bar) do { unsigned _sp = 0; while (cond) { __builtin_amdgcn_s_sleep(1); \
    if ((++_sp & 255u) == 0u) { if (xb_ld(&(bar)[XB_TMO])) break; if (_sp > XB_SPIN_CAP) { atomicAdd(&(bar)[XB_TMO], 1u); break; } } } } while (0)
struct XcdBarrier { unsigned* bar; unsigned x; volatile LAS unsigned* st; };
__device__ __forceinline__ XcdBarrier xcd_barrier_post(unsigned* bar, volatile LAS unsigned* st) {
    XcdBarrier b; b.bar = bar; b.x = xb_xcc_id(); b.st = st;
    if (threadIdx.x == 0) (void)xb_add(&bar[XB_XCNT(b.x)], 1u);
    return b;
}
__device__ __forceinline__ void xcd_barrier_complete(unsigned* bar, unsigned x, unsigned& nloc, unsigned& nx) {
    const unsigned G = gridDim.x * gridDim.y * gridDim.z;
    unsigned sum, cnt, mine, sp = 0u;
    for (;;) {
        sum = 0u; cnt = 0u; mine = 0u;
#pragma unroll
        for (unsigned j = 0; j < 16; ++j) { const unsigned c = xb_ld(&bar[XB_XCNT(j)]); sum += c; cnt += (c > 0u) ? 1u : 0u; mine = (j == x) ? c : mine; }
        if (sum == G) break;
        __builtin_amdgcn_s_sleep(1);
        if ((++sp & 255u) == 0u) { if (xb_ld(&bar[XB_TMO])) break; if (sp > XB_SPIN_CAP) { atomicAdd(&bar[XB_TMO], 1u); break; } }
    }
    nloc = mine > 0u ? mine : 1u; nx = cnt > 0u ? cnt : 1u;
}
__device__ __forceinline__ void xcd_barrier(const XcdBarrier& b) {
    asm volatile("s_waitcnt vmcnt(0)" ::: "memory");
    __syncthreads();
    if (threadIdx.x == 0) {
        unsigned* bar = b.bar;
        __builtin_amdgcn_s_waitcnt(0);
        unsigned nloc = b.st[0], nx = b.st[1];
        if (nloc == 0u) { xcd_barrier_complete(bar, b.x, nloc, nx); b.st[0] = nloc; b.st[1] = nx; }
        const unsigned old = xb_add(&bar[XB_XSUB(b.x)], 1u);
        const unsigned gen = old / nloc;
        if (old + 1u == (gen + 1u) * nloc) {
            __builtin_amdgcn_fence(__ATOMIC_RELEASE, "agent");
            asm volatile("s_waitcnt vmcnt(0)" ::: "memory");
            const unsigned og = xb_add(&bar[XB_TOP], 1u);
            const unsigned tg = og / nx;
            if (og + 1u == (tg + 1u) * nx) xb_add(&bar[XB_TOPGEN], 1u);
            else XB_SPIN(xb_ld(&bar[XB_TOPGEN]) == tg, bar);
            __builtin_amdgcn_fence(__ATOMIC_ACQUIRE, "agent");
            xb_add(&bar[XB_XGEN(b.x)], 1u);
            asm volatile("s_waitcnt vmcnt(0)" ::: "memory");
        } else {
            XB_SPIN(xb_ld(&bar[XB_XGEN(b.x)]) == gen, bar);
            __builtin_amdgcn_fence(__ATOMIC_ACQUIRE, "agent");
            asm volatile("s_waitcnt vmcnt(0)" ::: "memory");
        }
    }
    __syncthreads();
}

namespace pg8 {
constexpr int BM = 256, BK = 64, HALF = 128, HTB = HALF * BK * 2, STAGE_BYTES = 8 * HTB, NXCD = 8, WGM = 8;
__host__ __device__ __forceinline__ int lds_byte(int r, int c) { const int st = (r >> 4) * 2 + (c >> 5), rr = r & 15, cc = c & 31, ob = rr * 64 + cc * 2; return st * 1024 + (ob ^ (((ob >> 9) & 1) << 5)); }
__host__ __device__ __forceinline__ void stage_rc(int b, int& R, int& C) { const int st = b / 1024, sb = b % 1024, swz = sb ^ (((sb >> 9) & 1) << 5); R = (st >> 1) * 16 + swz / 64; C = (st & 1) * 32 + (swz % 64) / 2; }
__host__ __device__ __forceinline__ int perm32(int rho) { const int n = rho >> 4, i = rho & 15; return 8 * (i >> 2) + 4 * n + (i & 3); }

struct Unit { const char* A; const char* B; const int* rows; int pm, pn, ex, cnt; };
struct Cfg { int K; unsigned lda, ldb; };
__device__ __forceinline__ void tile_of(int L, int nM, int nN, int& pm, int& pn) {
    const int nwg = nM * nN; int wgid = L; { const int q = nwg / NXCD, r = nwg % NXCD, xcd = wgid % NXCD, off = wgid / NXCD; wgid = (xcd < r ? xcd * (q + 1) : r * (q + 1) + (xcd - r) * q) + off; }
    const int nig = WGM * nN, gid = wgid / nig, fm = gid * WGM, gsz = (nM - fm) < WGM ? (nM - fm) : WGM;
    pm = fm + ((wgid % nig) % gsz); pn = (wgid % nig) / gsz;
}

template <class Epi, class Sched, bool GATHER>
__device__ __forceinline__ void gemm_phase(LAS unsigned char* lds, const Cfg g, const Sched& S, const Epi& E) {
    const int tid = threadIdx.x, wid = __builtin_amdgcn_readfirstlane(tid >> 6), lane = tid & 63, wr = wid >> 2, wc = wid & 3, fr = lane & 15, fq = lane >> 4;
    const int nt = g.K / BK;
    unsigned voffB[2], vA[2][2], vN[2][2]; int Rr[2]; unsigned Cb[2];
#pragma unroll
    for (int i = 0; i < 2; ++i) { int R, C; stage_rc(tid * 16 + i * 8192, R, C); const int Rb = Epi::PERM ? ((R & ~31) + perm32(R & 31)) : R;
        Rr[i] = R; Cb[i] = (unsigned)C * 2u; voffB[i] = (unsigned)Rb * g.ldb + (unsigned)C * 2u;
        vA[0][i] = (unsigned)R * g.lda + (unsigned)C * 2u; vA[1][i] = (unsigned)(R + HALF) * g.lda + (unsigned)C * 2u; vN[0][i] = vA[0][i]; vN[1][i] = vA[1][i]; }
    const size_t kstep = (size_t)(BK * 2);
    const size_t hstepB = (size_t)HALF * g.ldb;
    const unsigned ldsw = (unsigned)wid * 1024u;
    const int aoff = lds_byte(wr * 64 + fr, fq * 8), boff = lds_byte(wc * 32 + fr, fq * 8);
#define PG8_SA(b, h) (((b) * 2 + (h)) * HTB)
#define PG8_SB(b, h) ((4 + (b) * 2 + (h)) * HTB)
#define PG8_STAGE(bufoff, gbase, voff) do { _Pragma("unroll") for (int _i = 0; _i < 2; ++_i) \
        __builtin_amdgcn_global_load_lds((const unsigned*)((const char*)(gbase) + (voff)[_i]), (LAS unsigned*)(lds + (bufoff) + ldsw + _i * 8192), 16, 0, 0); } while (0)
#define PG8_STAGE_AX(bufoff, gbase, h, usenext) do { unsigned _vo[2]; _vo[0] = (usenext) ? vN[h][0] : vA[h][0]; _vo[1] = (usenext) ? vN[h][1] : vA[h][1]; PG8_STAGE(bufoff, gbase, _vo); } while (0)
#define PG8_LDA(dst, b, h) do { _Pragma("unroll") for (int m = 0; m < 4; ++m) _Pragma("unroll") for (int k = 0; k < 2; ++k) dst[m][k] = *(const LAS bf16x8*)(lds + PG8_SA(b, h) + aoff + m * 2048 + k * 1024); } while (0)
#define PG8_LDB(dst, b, h) do { _Pragma("unroll") for (int n = 0; n < 2; ++n) _Pragma("unroll") for (int k = 0; k < 2; ++k) dst[n][k] = *(const LAS bf16x8*)(lds + PG8_SB(b, h) + boff + n * 2048 + k * 1024); } while (0)
#define PG8_MMA(ai, bj, At, Bt) do { __builtin_amdgcn_s_setprio(1); _Pragma("unroll") for (int m = 0; m < 4; ++m) _Pragma("unroll") for (int n = 0; n < 2; ++n) _Pragma("unroll") for (int k = 0; k < 2; ++k) \
        acc[ai][bj][m][n] = __builtin_amdgcn_mfma_f32_16x16x32_bf16(Bt[n][k], At[m][k], acc[ai][bj][m][n], 0, 0, 0); __builtin_amdgcn_s_setprio(0); } while (0)
#define PG8_WAIT_V(n) asm volatile("s_waitcnt vmcnt(" #n ")" ::: "memory")
#define PG8_WAIT_L(n) asm volatile("s_waitcnt lgkmcnt(" #n ")" ::: "memory")
#define PG8_BAR __builtin_amdgcn_s_barrier()
#define PG8_SCHED __builtin_amdgcn_sched_barrier(0)
#define PG8_GATHER_LOAD(dst, u) do { _Pragma("unroll") for (int _h = 0; _h < 2; ++_h) _Pragma("unroll") for (int _i = 0; _i < 2; ++_i) { const int _r = _h * HALF + Rr[_i]; \
        const int _a = (_r < (u).cnt) ? ((u).rows[_r] >> 1) : 0; dst[_h][_i] = (unsigned)_a * g.lda + Cb[_i]; } } while (0)
    Unit cur, nxt; int ui = 0;
    if (!S.next(0, cur)) return;
    f32x4 acc[2][2][4][2];
#pragma unroll
    for (int a = 0; a < 2; ++a)
#pragma unroll
        for (int b = 0; b < 2; ++b)
#pragma unroll
            for (int m = 0; m < 4; ++m)
#pragma unroll
                for (int n = 0; n < 2; ++n) acc[a][b][m][n] = (f32x4){0.f, 0.f, 0.f, 0.f};
    bf16x8 At[4][2], B0[2][2], B1[2][2];
    const char* cA = cur.A; const char* cB = cur.B;
    if constexpr (GATHER) { PG8_GATHER_LOAD(vA, cur); __builtin_amdgcn_s_waitcnt(0x0F70); }
    PG8_STAGE(PG8_SB(0, 0), cB, voffB); PG8_STAGE(PG8_SB(0, 1), cB + hstepB, voffB); PG8_STAGE(PG8_SA(0, 0), cA, vA[0]); PG8_STAGE(PG8_SA(0, 1), cA, vA[1]);
    if (wr == 1) PG8_BAR;
    PG8_WAIT_V(2); PG8_BAR;
    PG8_STAGE(PG8_SB(1, 0), cB + kstep, voffB); PG8_STAGE(PG8_SA(1, 0), cA + kstep, vA[0]); PG8_STAGE(PG8_SB(1, 1), cB + hstepB + kstep, voffB);
    PG8_WAIT_V(6); PG8_BAR;
    for (;;) {
        const bool has_next = S.next(ui + 1, nxt);
        const char* nA = has_next ? nxt.A : cA; const char* nB = has_next ? nxt.B : cB;
        if constexpr (GATHER) {
            if (has_next) { PG8_GATHER_LOAD(vN, nxt); __builtin_amdgcn_s_waitcnt(0x0F70); }
            else {
#pragma unroll
                for (int h = 0; h < 2; ++h)
#pragma unroll
                    for (int i = 0; i < 2; ++i) vN[h][i] = vA[h][i]; }
        }
        for (int t = 0; t < nt; t += 2) {
            const bool last = (t == nt - 2);
            const char* a1 = cA + (size_t)(t + 1) * kstep;
            const char* a2 = last ? nA : cA + (size_t)(t + 2) * kstep; const char* b2 = last ? nB : cB + (size_t)(t + 2) * kstep;
            const char* a3 = a2 + kstep; const char* b3 = b2 + kstep;
            const bool un = GATHER && last;
            PG8_LDB(B0, 0, 0); PG8_LDB(B1, 0, 1); PG8_SCHED; PG8_LDA(At, 0, 0); PG8_STAGE(PG8_SA(1, 1), a1, vA[1]);
            PG8_WAIT_V(8); PG8_WAIT_L(0); PG8_BAR; PG8_MMA(0, 0, At, B0); PG8_MMA(0, 1, At, B1); PG8_BAR; PG8_SCHED;
            PG8_LDA(At, 0, 1); PG8_STAGE(PG8_SB(0, 0), b2, voffB); PG8_STAGE(PG8_SB(0, 1), b2 + hstepB, voffB); PG8_STAGE_AX(PG8_SA(0, 0), a2, 0, un);
            PG8_WAIT_V(8); PG8_WAIT_L(0); PG8_BAR; PG8_MMA(1, 0, At, B0); PG8_MMA(1, 1, At, B1); PG8_BAR; PG8_SCHED;
            PG8_LDB(B0, 1, 0); PG8_LDB(B1, 1, 1); PG8_SCHED; PG8_LDA(At, 1, 0); PG8_STAGE_AX(PG8_SA(0, 1), a2, 1, un);
            PG8_WAIT_V(8); PG8_WAIT_L(0); PG8_BAR; PG8_MMA(0, 0, At, B0); PG8_MMA(0, 1, At, B1); PG8_BAR; PG8_SCHED;
            PG8_LDA(At, 1, 1); PG8_STAGE(PG8_SB(1, 0), b3, voffB); PG8_STAGE(PG8_SB(1, 1), b3 + hstepB, voffB); PG8_STAGE_AX(PG8_SA(1, 0), a3, 0, un);
            PG8_WAIT_V(8); PG8_WAIT_L(0); PG8_BAR; PG8_MMA(1, 0, At, B0); PG8_MMA(1, 1, At, B1); PG8_BAR; PG8_SCHED;
        }
        if (wr == 0) PG8_BAR;
        const bool keep = E(acc, cur, wr, wc, fr, fq);
        if (!has_next) break;
        if (!keep) {
#pragma unroll
        for (int a = 0; a < 2; ++a)
#pragma unroll
            for (int b = 0; b < 2; ++b)
#pragma unroll
                for (int m = 0; m < 4; ++m)
#pragma unroll
                    for (int n = 0; n < 2; ++n) acc[a][b][m][n] = (f32x4){0.f, 0.f, 0.f, 0.f};
        }
        cur = nxt; cA = nA; cB = nB; ++ui;
        if constexpr (GATHER) {
#pragma unroll
            for (int h = 0; h < 2; ++h)
#pragma unroll
                for (int i = 0; i < 2; ++i) vA[h][i] = vN[h][i]; }
        if (wr == 1) PG8_BAR;
    }
    PG8_WAIT_V(0);
    PG8_BAR;
#undef PG8_SA
#undef PG8_SB
#undef PG8_STAGE
#undef PG8_STAGE_AX
#undef PG8_LDA
#undef PG8_LDB
#undef PG8_MMA
#undef PG8_WAIT_V
#undef PG8_WAIT_L
#undef PG8_BAR
#undef PG8_SCHED
#undef PG8_GATHER_LOAD
}
}


typedef int v8i_t __attribute__((ext_vector_type(8)));
typedef int v4i_t __attribute__((ext_vector_type(4)));
namespace pg8 {
struct UnitM { const char* A; const char* B; const int* rows; int blk, pn, ex, cnt, type; };
template <class Sched, class Epi0, class Epi1>
__device__ __forceinline__ void gemm_phase_moe(LAS unsigned char* lds, LAS unsigned char* meta, const Sched& S, const Epi0& E0, const Epi1& E1) {
    const int tid = threadIdx.x, wid = __builtin_amdgcn_readfirstlane(tid >> 6), lane = tid & 63, wr = wid >> 2, wc = wid & 3, fr = lane & 15, fq = lane >> 4;
    unsigned vA[2][2], vN[2][2], vB[2];
    const size_t kstep = (size_t)(BK * 2);
    const unsigned ldsw = (unsigned)wid * 1024u;
    const int aoff = lds_byte(wr * 64 + fr, fq * 8), boff = lds_byte(wc * 32 + fr, fq * 8);
#define PG8_SA(b, h) (((b) * 2 + (h)) * HTB)
#define PG8_SB(b, h) ((4 + (b) * 2 + (h)) * HTB)
#define PG8_STAGE_A(bufoff, gbase, voff) do { _Pragma("unroll") for (int _i = 0; _i < 2; ++_i) \
        __builtin_amdgcn_global_load_lds((const unsigned*)((const char*)(gbase) + (voff)[_i]), (LAS unsigned*)(lds + (bufoff) + ldsw + _i * 8192), 16, 0, 16); } while (0)
#define PG8_STAGE_B(bufoff, gbase, voff) do { _Pragma("unroll") for (int _i = 0; _i < 2; ++_i) \
        __builtin_amdgcn_global_load_lds((const unsigned*)((const char*)(gbase) + (voff)[_i]), (LAS unsigned*)(lds + (bufoff) + ldsw + _i * 8192), 16, 0, 0); } while (0)
#define PG8_STAGE_AX(bufoff, gbase, h, usenext) do { unsigned _vo[2]; _vo[0] = (usenext) ? vN[h][0] : vA[h][0]; _vo[1] = (usenext) ? vN[h][1] : vA[h][1]; PG8_STAGE_A(bufoff, gbase, _vo); } while (0)
#define PG8_STAGE_BX(bufoff, gbase, usenext) do { unsigned _vo[2]; _vo[0] = (usenext) ? vBn[0] : vB[0]; _vo[1] = (usenext) ? vBn[1] : vB[1]; PG8_STAGE_B(bufoff, gbase, _vo); } while (0)
#define PG8_LD32(p) __builtin_shufflevector(*(const LAS v4i_t*)(p), *(const LAS v4i_t*)((p) + 1024), 0, 1, 2, 3, 4, 5, 6, 7)
#define PG8_LDA(dst, b, h) do { _Pragma("unroll") for (int m = 0; m < 4; ++m) dst[m] = PG8_LD32(lds + PG8_SA(b, h) + aoff + m * 2048); } while (0)
#define PG8_LDB(dst, b, h) do { _Pragma("unroll") for (int n = 0; n < 2; ++n) dst[n] = PG8_LD32(lds + PG8_SB(b, h) + boff + n * 2048); } while (0)
#define PG8_MMA(ai, bj, At, Bt) do { __builtin_amdgcn_s_setprio(1); _Pragma("unroll") for (int m = 0; m < 4; ++m) _Pragma("unroll") for (int n = 0; n < 2; ++n) { \
        acc[ai][bj][m][n] = __builtin_amdgcn_mfma_scale_f32_16x16x128_f8f6f4(Bt[n], At[m], acc[ai][bj][m][n], 0, 0, 0, 0x7F7F7F7F, 0, 0x7F7F7F7F); asm volatile("" : "+v"(acc[ai][bj][m][n])); }     \
        __builtin_amdgcn_s_setprio(0); } while (0)
#define PG8_WAIT_V(n) asm volatile("s_waitcnt vmcnt(" #n ")" ::: "memory")
#define PG8_WAIT_L(n) asm volatile("s_waitcnt lgkmcnt(" #n ")" ::: "memory")
#define PG8_BAR __builtin_amdgcn_s_barrier()
#define PG8_SCHED __builtin_amdgcn_sched_barrier(0)
#define PG8_SETUP(u, vAx, vBx) do { const unsigned _ld = (u).type ? 512u : 1024u; \
        _Pragma("unroll") for (int _i = 0; _i < 2; ++_i) { int _R, _C; stage_rc(tid * 16 + _i * 8192, _R, _C); asm volatile("" : "+v"(_R), "+v"(_C)); const unsigned _cb = (unsigned)_C * 2u; \
            _Pragma("unroll") for (int _h = 0; _h < 2; ++_h) { const int _r = _h * HALF + _R; \
                const int _a = (u).type ? _r : ((_r < (u).cnt) ? ((u).rows[_r] >> 1) : 0); vAx[_h][_i] = (unsigned)_a * _ld + _cb; } \
            vBx[_i] = (unsigned)((_R & ~31) + perm32(_R & 31)) * _ld + _cb; } } while (0)
#define PG8_META(u, n) do { if (tid < 256) { u32x4 _mv = (u32x4){0xFFFFFFFFu, 0u, 0u, 0u}; \
        if (tid < (u).cnt) { const u32x2 _w2 = ((const u32x2*)S.rwlist)[((u).rows - S.alist) + tid]; _mv.x = (unsigned)(u).rows[tid]; _mv.y = _w2.x; _mv.z = _w2.y; } \
        *(LAS u32x4*)(meta + (((n) & 1) * 256 + tid) * 16) = _mv; } } while (0)
#define PG8_PUBLISH() do { if (pend >= 0) { if (lane == 0) __hip_atomic_fetch_add(S.ready + pend, 1u, __ATOMIC_RELAXED, __HIP_MEMORY_SCOPE_AGENT); pend = -1; } } while (0)
    int pend = -1;
    UnitM cur, nxt; int ui = 0;
    bool have = S.next(0, cur);
    f32x4 acc[2][2][4][2];
    v8i_t At[4], B0[2], B1[2];
    while (have) {
#pragma unroll
        for (int a = 0; a < 2; ++a)
#pragma unroll
            for (int b = 0; b < 2; ++b)
#pragma unroll
                for (int m = 0; m < 4; ++m)
#pragma unroll
                    for (int n = 0; n < 2; ++n) acc[a][b][m][n] = (f32x4){0.f, 0.f, 0.f, 0.f};
        const char* cA = cur.A; const char* cB = cur.B; size_t hB = cur.type ? (size_t)HALF * 512 : (size_t)HALF * 1024;
        PG8_SETUP(cur, vA, vB); PG8_META(cur, ui); __builtin_amdgcn_s_waitcnt(0x0F70); asm volatile("s_waitcnt vmcnt(0)" ::: "memory"); PG8_PUBLISH();
        if (cur.type) S.wait_ready(cur);
        PG8_STAGE_B(PG8_SB(0, 0), cB, vB); PG8_STAGE_B(PG8_SB(0, 1), cB + hB, vB); PG8_STAGE_A(PG8_SA(0, 0), cA, vA[0]); PG8_STAGE_A(PG8_SA(0, 1), cA, vA[1]);
        if (wr == 1) PG8_BAR;
        PG8_WAIT_V(2); PG8_BAR;
        PG8_STAGE_B(PG8_SB(1, 0), cB + kstep, vB); PG8_STAGE_A(PG8_SA(1, 0), cA + kstep, vA[0]); PG8_STAGE_B(PG8_SB(1, 1), cB + hB + kstep, vB);
        PG8_WAIT_V(6); PG8_BAR;
        bool has_next;
        for (;;) {
            has_next = S.next(ui + 1, nxt);
            const bool chain = has_next && nxt.type == cur.type;
            const char* nA = chain ? nxt.A : cA; const char* nB = chain ? nxt.B : cB;
            if (chain) { unsigned vBn[2]; PG8_SETUP(nxt, vN, vBn); PG8_META(nxt, ui + 1); __builtin_amdgcn_s_waitcnt(0x0F70); asm volatile("s_waitcnt vmcnt(0)" ::: "memory"); PG8_PUBLISH(); }
            else {
                if (pend >= 0) { asm volatile("s_waitcnt vmcnt(0)" ::: "memory"); PG8_PUBLISH(); }
#pragma unroll
                for (int h = 0; h < 2; ++h)
#pragma unroll
                    for (int i = 0; i < 2; ++i) vN[h][i] = vA[h][i]; }
            const int nt = cur.type ? 4 : 8;
            for (int t = 0; t < nt; t += 2) {
                const bool last = (t == nt - 2);
                if (last && chain && nxt.type) S.wait_ready(nxt);
                const char* a1 = cA + (size_t)(t + 1) * kstep;
                const char* a2 = last ? nA : cA + (size_t)(t + 2) * kstep; const char* b2 = last ? nB : cB + (size_t)(t + 2) * kstep; const size_t hB2 = hB;
                const char* a3 = a2 + kstep; const char* b3 = b2 + kstep;
                PG8_LDB(B0, 0, 0); PG8_LDB(B1, 0, 1); PG8_SCHED; PG8_LDA(At, 0, 0); PG8_STAGE_A(PG8_SA(1, 1), a1, vA[1]);
                PG8_WAIT_V(8); PG8_WAIT_L(0); PG8_BAR; PG8_MMA(0, 0, At, B0); PG8_MMA(0, 1, At, B1); PG8_BAR; PG8_SCHED;
                PG8_LDA(At, 0, 1); PG8_STAGE_B(PG8_SB(0, 0), b2, vB); PG8_STAGE_B(PG8_SB(0, 1), b2 + hB2, vB); PG8_STAGE_AX(PG8_SA(0, 0), a2, 0, last);
                PG8_WAIT_V(8); PG8_WAIT_L(0); PG8_BAR; PG8_MMA(1, 0, At, B0); PG8_MMA(1, 1, At, B1); PG8_BAR; PG8_SCHED;
                PG8_LDB(B0, 1, 0); PG8_LDB(B1, 1, 1); PG8_SCHED; PG8_LDA(At, 1, 0); PG8_STAGE_AX(PG8_SA(0, 1), a2, 1, last);
                PG8_WAIT_V(8); PG8_WAIT_L(0); PG8_BAR; PG8_MMA(0, 0, At, B0); PG8_MMA(0, 1, At, B1); PG8_BAR; PG8_SCHED;
                PG8_LDA(At, 1, 1); PG8_STAGE_B(PG8_SB(1, 0), b3, vB); PG8_STAGE_B(PG8_SB(1, 1), b3 + hB2, vB); PG8_STAGE_AX(PG8_SA(1, 0), a3, 0, last);
                PG8_WAIT_V(8); PG8_WAIT_L(0); PG8_BAR; PG8_MMA(1, 0, At, B0); PG8_MMA(1, 1, At, B1); PG8_BAR; PG8_SCHED;
            }
            if (wr == 0) PG8_BAR;
            if (cur.type == 0) { E0(acc, cur, wr, wc, fr, fq, meta + (ui & 1) * 4096); pend = cur.blk; } else E1(acc, cur, wr, wc, fr, fq, meta + (ui & 1) * 4096);
            if (!chain) break;
#pragma unroll
            for (int a = 0; a < 2; ++a)
#pragma unroll
                for (int b = 0; b < 2; ++b)
#pragma unroll
                    for (int m = 0; m < 4; ++m)
#pragma unroll
                        for (int n = 0; n < 2; ++n) acc[a][b][m][n] = (f32x4){0.f, 0.f, 0.f, 0.f};
            cur = nxt; cA = nA; cB = nB; ++ui;
#pragma unroll
            for (int h = 0; h < 2; ++h)
#pragma unroll
                for (int i = 0; i < 2; ++i) vA[h][i] = vN[h][i];
            if (wr == 1) PG8_BAR;
        }
        PG8_WAIT_V(0); PG8_PUBLISH();
        PG8_BAR;
        have = has_next; cur = nxt; ++ui;
    }
#undef PG8_SA
#undef PG8_SB
#undef PG8_STAGE_A
#undef PG8_STAGE_B
#undef PG8_STAGE_AX
#undef PG8_STAGE_BX
#undef PG8_LDA
#undef PG8_LD32
#undef PG8_LDB
#undef PG8_MMA
#undef PG8_WAIT_V
#undef PG8_WAIT_L
#undef PG8_BAR
#undef PG8_SCHED
#undef PG8_SETUP
#undef PG8_PUBLISH
}

struct UnitX { const char* A; const char* B; int pm, pn, ld, fp8; };
template <bool FP8, class Sched, class Epi>
__device__ __forceinline__ bool mix_segment(LAS unsigned char* lds, const Sched& S, const Epi& E, UnitX& cur, int& ui) {
    const int tid = threadIdx.x, wid = __builtin_amdgcn_readfirstlane(tid >> 6), lane = tid & 63, wr = wid >> 2, wc = wid & 3, fr = lane & 15, fq = lane >> 4;
    unsigned vA[2][2], vB[2];
    const size_t kstep = (size_t)(BK * 2);
    const unsigned ldsw = (unsigned)wid * 1024u;
    const int aoff = lds_byte(wr * 64 + fr, fq * 8), boff = lds_byte(wc * 32 + fr, fq * 8);
#define PG8_SA(b, h) (((b) * 2 + (h)) * HTB)
#define PG8_SB(b, h) ((4 + (b) * 2 + (h)) * HTB)
#define PG8_STAGE(bufoff, gbase, voff) do { _Pragma("unroll") for (int _i = 0; _i < 2; ++_i) \
        __builtin_amdgcn_global_load_lds((const unsigned*)((const char*)(gbase) + (voff)[_i]), (LAS unsigned*)(lds + (bufoff) + ldsw + _i * 8192), 16, 0, 0); } while (0)
#define PG8_LD32(p) __builtin_shufflevector(*(const LAS v4i_t*)(p), *(const LAS v4i_t*)((p) + 1024), 0, 1, 2, 3, 4, 5, 6, 7)
#define PG8_LDA(dst, b, h) do { _Pragma("unroll") for (int m = 0; m < 4; ++m) dst[m] = PG8_LD32(lds + PG8_SA(b, h) + aoff + m * 2048); } while (0)
#define PG8_LDB(dst, b, h) do { _Pragma("unroll") for (int n = 0; n < 2; ++n) dst[n] = PG8_LD32(lds + PG8_SB(b, h) + boff + n * 2048); } while (0)
#define PG8_H0(v) __builtin_bit_cast(bf16x8, __builtin_shufflevector(v, v, 0, 1, 2, 3))
#define PG8_H1(v) __builtin_bit_cast(bf16x8, __builtin_shufflevector(v, v, 4, 5, 6, 7))
#define PG8_MMA(ai, bj, At, Bt) do { __builtin_amdgcn_s_setprio(1); \
        if (FP8) { _Pragma("unroll") for (int m = 0; m < 4; ++m) _Pragma("unroll") for (int n = 0; n < 2; ++n) { \
            acc[ai][bj][m][n] = __builtin_amdgcn_mfma_scale_f32_16x16x128_f8f6f4(Bt[n], At[m], acc[ai][bj][m][n], 0, 0, 0, 0x7F7F7F7F, 0, 0x7F7F7F7F); asm volatile("" : "+v"(acc[ai][bj][m][n])); } } \
        else { _Pragma("unroll") for (int m = 0; m < 4; ++m) _Pragma("unroll") for (int n = 0; n < 2; ++n) { \
            acc[ai][bj][m][n] = __builtin_amdgcn_mfma_f32_16x16x32_bf16(PG8_H0(Bt[n]), PG8_H0(At[m]), acc[ai][bj][m][n], 0, 0, 0); \
            acc[ai][bj][m][n] = __builtin_amdgcn_mfma_f32_16x16x32_bf16(PG8_H1(Bt[n]), PG8_H1(At[m]), acc[ai][bj][m][n], 0, 0, 0); asm volatile("" : "+v"(acc[ai][bj][m][n])); } } \
        __builtin_amdgcn_s_setprio(0); } while (0)
#define PG8_WAIT_V(n) asm volatile("s_waitcnt vmcnt(" #n ")" ::: "memory")
#define PG8_WAIT_L(n) asm volatile("s_waitcnt lgkmcnt(" #n ")" ::: "memory")
#define PG8_BAR __builtin_amdgcn_s_barrier()
#define PG8_SCHED __builtin_amdgcn_sched_barrier(0)
    {
        const unsigned ld = (unsigned)cur.ld;
#pragma unroll
        for (int i = 0; i < 2; ++i) { int R, C; stage_rc(tid * 16 + i * 8192, R, C); const unsigned cb = (unsigned)C * 2u;
            vA[0][i] = (unsigned)R * ld + cb; vA[1][i] = (unsigned)(HALF + R) * ld + cb; vB[i] = (unsigned)((R & ~31) + perm32(R & 31)) * ld + cb; }
    }
    UnitX nxt; bool has_next = false;
    f32x4 acc[2][2][4][2];
    v8i_t At[4], B0[2], B1[2];
#pragma unroll
    for (int a = 0; a < 2; ++a)
#pragma unroll
        for (int b = 0; b < 2; ++b)
#pragma unroll
            for (int m = 0; m < 4; ++m)
#pragma unroll
                for (int n = 0; n < 2; ++n) acc[a][b][m][n] = (f32x4){0.f, 0.f, 0.f, 0.f};
    const char* cA = cur.A; const char* cB = cur.B; const size_t hB = (size_t)HALF * cur.ld;
    const int nt = cur.ld >> 7;
    PG8_STAGE(PG8_SB(0, 0), cB, vB); PG8_STAGE(PG8_SB(0, 1), cB + hB, vB); PG8_STAGE(PG8_SA(0, 0), cA, vA[0]); PG8_STAGE(PG8_SA(0, 1), cA, vA[1]);
    if (wr == 1) PG8_BAR;
    PG8_WAIT_V(2); PG8_BAR;
    PG8_STAGE(PG8_SB(1, 0), cB + kstep, vB); PG8_STAGE(PG8_SA(1, 0), cA + kstep, vA[0]); PG8_STAGE(PG8_SB(1, 1), cB + hB + kstep, vB);
    PG8_WAIT_V(6); PG8_BAR;
    for (;;) {
        has_next = S.next(ui + 1, nxt);
        const bool chain = has_next && nxt.ld == cur.ld && nxt.fp8 == cur.fp8;
        const char* nA = chain ? nxt.A : cA; const char* nB = chain ? nxt.B : cB;
        for (int t = 0; t < nt; t += 2) {
            const bool last = (t == nt - 2);
            const char* a1 = cA + (size_t)(t + 1) * kstep;
            const char* a2 = last ? nA : cA + (size_t)(t + 2) * kstep; const char* b2 = last ? nB : cB + (size_t)(t + 2) * kstep;
            const char* a3 = a2 + kstep; const char* b3 = b2 + kstep;
            PG8_LDB(B0, 0, 0); PG8_LDB(B1, 0, 1); PG8_SCHED; PG8_LDA(At, 0, 0); PG8_STAGE(PG8_SA(1, 1), a1, vA[1]);
            PG8_WAIT_V(8); PG8_WAIT_L(0); PG8_BAR; PG8_MMA(0, 0, At, B0); PG8_MMA(0, 1, At, B1); PG8_BAR; PG8_SCHED;
            PG8_LDA(At, 0, 1); PG8_STAGE(PG8_SB(0, 0), b2, vB); PG8_STAGE(PG8_SB(0, 1), b2 + hB, vB); PG8_STAGE(PG8_SA(0, 0), a2, vA[0]);
            PG8_WAIT_V(8); PG8_WAIT_L(0); PG8_BAR; PG8_MMA(1, 0, At, B0); PG8_MMA(1, 1, At, B1); PG8_BAR; PG8_SCHED;
            PG8_LDB(B0, 1, 0); PG8_LDB(B1, 1, 1); PG8_SCHED; PG8_LDA(At, 1, 0); PG8_STAGE(PG8_SA(0, 1), a2, vA[1]);
            PG8_WAIT_V(8); PG8_WAIT_L(0); PG8_BAR; PG8_MMA(0, 0, At, B0); PG8_MMA(0, 1, At, B1); PG8_BAR; PG8_SCHED;
            PG8_LDA(At, 1, 1); PG8_STAGE(PG8_SB(1, 0), b3, vB); PG8_STAGE(PG8_SB(1, 1), b3 + hB, vB); PG8_STAGE(PG8_SA(1, 0), a3, vA[0]);
            PG8_WAIT_V(8); PG8_WAIT_L(0); PG8_BAR; PG8_MMA(1, 0, At, B0); PG8_MMA(1, 1, At, B1); PG8_BAR; PG8_SCHED;
        }
        if (wr == 0) PG8_BAR;
        E(acc, cur, wr, wc, fr, fq);
        if (!chain) break;
#pragma unroll
        for (int a = 0; a < 2; ++a)
#pragma unroll
            for (int b = 0; b < 2; ++b)
#pragma unroll
                for (int m = 0; m < 4; ++m)
#pragma unroll
                    for (int n = 0; n < 2; ++n) acc[a][b][m][n] = (f32x4){0.f, 0.f, 0.f, 0.f};
        cur = nxt; cA = nA; cB = nB; ++ui;
        if (wr == 1) PG8_BAR;
    }
    PG8_WAIT_V(0);
    PG8_BAR;
    cur = nxt; ++ui;
    return has_next;
#undef PG8_SA
#undef PG8_SB
#undef PG8_STAGE
#undef PG8_LD32
#undef PG8_LDA
#undef PG8_LDB
#undef PG8_H0
#undef PG8_H1
#undef PG8_MMA
#undef PG8_WAIT_V
#undef PG8_WAIT_L
#undef PG8_BAR
#undef PG8_SCHED
}
template <class Sched, class Epi>
__device__ __forceinline__ void gemm_phase_mix(LAS unsigned char* lds, const Sched& S, const Epi& E) {
    UnitX cur; int ui = 0;
    bool have = S.next(0, cur);
    while (have) have = cur.fp8 ? mix_segment<true>(lds, S, E, cur, ui) : mix_segment<false>(lds, S, E, cur, ui);
}
}

#ifndef MOE_DYN
#define MOE_DYN 1
#endif
#ifndef PROBE_PHASE
#define PROBE_PHASE -1
#endif
#define REP(k) _Pragma("nounroll") for (int _r = 0; _r < ((PROBE_PHASE == (k)) ? 2 : 1); ++_r)
constexpr int NWAVES = 8;
constexpr size_t WS_CTL = 0, CTL_ZERO_BYTES = 64 * 1024;
constexpr size_t WS_GIF = 1 * MiB;
constexpr size_t WS_NLOC = 1 * MiB + 512 * 1024;
constexpr size_t WS_SCAL = 2 * MiB;
constexpr size_t WS_GW = 2 * MiB + 256 * 1024;
constexpr size_t WS_ALIST = 4 * MiB;
constexpr size_t WS_RWLIST = 6 * MiB;
constexpr size_t WS_WR = 3 * MiB + 512 * 1024;
constexpr size_t WS_RSTD2 = 3 * MiB, WS_SEL = 3 * MiB + 256 * 1024;
constexpr size_t WS_WZ = 10 * MiB, WS_W2T = 19 * MiB, WS_WBT = 20 * MiB, WS_WOT = 21 * MiB, WS_WUP = 23 * MiB, WS_WDN = 87 * MiB;
constexpr size_t WS_Z = 119 * MiB;
constexpr size_t WS_KACT = 263 * MiB;
constexpr size_t WS_END = 279 * MiB;
constexpr size_t WS_GATES = WS_Z + 80 * MiB;
constexpr size_t WS_X1Q = WS_Z;
constexpr size_t WS_X1 = WS_Z, WS_X1B = WS_Z + 64 * MiB, WS_HID = WS_Z + 96 * MiB;
constexpr size_t OB_H8 = 32 * MiB;
constexpr size_t WS_WZ8 = WS_WZ + (size_t)2560 * D * 2;
constexpr size_t OB_H = 0, OB_C = 0, OB_DA = 32 * MiB, OB_HM = 48 * MiB, OB_MERGED = 0;
constexpr int CW_CNT = 64;
constexpr int CW_Q = 1024;
constexpr int CW_READY = 2048;
constexpr int CW_TMO = 8;
constexpr int CW_BAR = 4096;
constexpr int META_OFF = 131072 + 320 + 2048;
constexpr int TAB_CNT = 16, TAB_CUM = 48, TAB_HIST = 96, TAB_BASE = 128, TAB_Q = 160, TAB_XS = 164, TAB_BLK = 176;
constexpr int RING_OFF = 0, RING_BYTES = 131072, LDSCTL_OFF = RING_BYTES, MISC_OFF = LDSCTL_OFF + 320, LDS_BYTES = 147456;

struct Args { const float* in[21]; float* out; unsigned char* ws; int ph_lo, ph_hi, li, flags; };

struct SchedDense {
    const char* A; const char* B; size_t astep, bstep; int nM, nN, G, c, rep;
    __device__ __forceinline__ bool next(int i, pg8::Unit& u) const {
        long L = (long)i * G + c; if (L >= (long)nM * nN * rep) return false; L %= (long)nM * nN;
        int pm, pn; pg8::tile_of((int)L, nM, nN, pm, pn);
        u.pm = pm; u.pn = pn; u.ex = 0; u.cnt = 256; u.rows = nullptr; u.A = A + (size_t)pm * astep; u.B = B + (size_t)pn * bstep; return true; }
};
struct EpiZ {
    static constexpr bool PERM = true;
    bf16_t* z; unsigned char* gates;
    __device__ __forceinline__ bool operator()(f32x4 (&acc)[2][2][4][2], const pg8::Unit& u, int wr, int wc, int fr, int fq) const {
        const int row0 = u.pm * 256 + wr * 64 + fr, col0 = u.pn * 256 + wc * 32 + 8 * fq;
        if (u.pn >= 10) {
            const int gc0 = col0 - 2560; const float lo = (gc0 >= 1024) ? 1.f : 0.f;
#pragma unroll
            for (int ai = 0; ai < 2; ++ai)
#pragma unroll
                for (int m = 0; m < 4; ++m) { const size_t row = (size_t)(row0 + ai * 128 + m * 16);
#pragma unroll
                    for (int bj = 0; bj < 2; ++bj) { const f32x4 v0 = acc[ai][bj][m][0], v1 = acc[ai][bj][m][1]; unsigned w0 = 0u, w1 = 0u;
#pragma unroll
                        for (int q = 0; q < 4; ++q) { w0 = __builtin_amdgcn_cvt_pk_u8_f32(fmaxf(fsigmoid(v0[q]) * 255.f, lo), q, w0); w1 = __builtin_amdgcn_cvt_pk_u8_f32(fmaxf(fsigmoid(v1[q]) * 255.f, lo), q, w1); }
                        *(u32x2*)(gates + row * 2048 + gc0 + bj * 128) = (u32x2){w0, w1}; } }
            return false;
        }
#pragma unroll
        for (int ai = 0; ai < 2; ++ai)
#pragma unroll
            for (int m = 0; m < 4; ++m) { const size_t row = (size_t)(row0 + ai * 128 + m * 16);
#pragma unroll
                for (int bj = 0; bj < 2; ++bj) { const f32x4 v0 = acc[ai][bj][m][0], v1 = acc[ai][bj][m][1]; u32x4 w;
                    w.x = cvt_pk_bf16(v0[0], v0[1]); w.y = cvt_pk_bf16(v0[2], v0[3]); w.z = cvt_pk_bf16(v1[0], v1[1]); w.w = cvt_pk_bf16(v1[2], v1[3]);
                    *(u32x4*)(z + zoff(row, col0 + bj * 128)) = w; } }
        return false;
    }
};


struct SchedP1X {
    const char* h; const char* h8; const char* wz; const char* wz8; int nM, nN, G, c;
    __device__ __forceinline__ bool next(int i, pg8::UnitX& u) const {
        const long L = (long)i * G + c; if (L >= (long)nM * nN) return false;
        int pm, pn; pg8::tile_of((int)L, nM, nN, pm, pn);
        u.pm = pm; u.pn = pn; u.fp8 = pn >= 10;
        if (u.fp8) { u.ld = D; u.A = h8 + (size_t)pm * 256 * D; u.B = wz8 + (size_t)(pn - 10) * 256 * D; }
        else { u.ld = D * 2; u.A = h + (size_t)pm * 256 * D * 2; u.B = wz + (size_t)pn * 256 * D * 2; }
        return true; }
};
struct EpiZX {
    bf16_t* z; unsigned char* gates;
    __device__ __forceinline__ void operator()(f32x4 (&acc)[2][2][4][2], const pg8::UnitX& u, int wr, int wc, int fr, int fq) const {
        asm volatile("" : "+v"(fr), "+v"(fq));
        const int row0 = u.pm * 256 + wr * 64 + fr, col0 = u.pn * 256 + wc * 32 + 8 * fq;
        if (u.pn >= 10) {
            const int gc0 = col0 - 2560; const float lo = (gc0 >= 1024) ? 1.f : 0.f; constexpr float ds = 1.f / (SX8 * SW8);
#pragma unroll
            for (int ai = 0; ai < 2; ++ai)
#pragma unroll
                for (int m = 0; m < 4; ++m) { const size_t row = (size_t)(row0 + ai * 128 + m * 16);
#pragma unroll
                    for (int bj = 0; bj < 2; ++bj) { const f32x4 v0 = acc[ai][bj][m][0] * ds, v1 = acc[ai][bj][m][1] * ds; unsigned w0 = 0u, w1 = 0u;
#pragma unroll
                        for (int q = 0; q < 4; ++q) { w0 = __builtin_amdgcn_cvt_pk_u8_f32(fmaxf(fsigmoid(v0[q]) * 255.f, lo), q, w0); w1 = __builtin_amdgcn_cvt_pk_u8_f32(fmaxf(fsigmoid(v1[q]) * 255.f, lo), q, w1); }
                        *(u32x2*)(gates + row * 2048 + gc0 + bj * 128) = (u32x2){w0, w1}; } }
            return;
        }
#pragma unroll
        for (int ai = 0; ai < 2; ++ai)
#pragma unroll
            for (int m = 0; m < 4; ++m) { const size_t row = (size_t)(row0 + ai * 128 + m * 16);
#pragma unroll
                for (int bj = 0; bj < 2; ++bj) { const f32x4 v0 = acc[ai][bj][m][0], v1 = acc[ai][bj][m][1]; u32x4 w;
                    w.x = cvt_pk_bf16(v0[0], v0[1]); w.y = cvt_pk_bf16(v0[2], v0[3]); w.z = cvt_pk_bf16(v1[0], v1[1]); w.w = cvt_pk_bf16(v1[2], v1[3]);
                    *(u32x4*)(z + zoff(row, col0 + bj * 128)) = w; } }
    }
};
struct SchedMerge {
    const char* A0; const char* A1; const char* B0; const char* B1; int nM, nN, G, c;
    __device__ __forceinline__ bool next(int i, pg8::Unit& u) const {
        const long L = (long)(i >> 1) * G + c; if (L >= (long)nM * nN) return false;
        int pm, pn; pg8::tile_of((int)L, nM, nN, pm, pn); const int part = i & 1;
        u.pm = pm; u.pn = pn; u.ex = part; u.cnt = 256; u.rows = nullptr;
        u.A = (part ? A1 : A0) + (size_t)pm * 256 * DP * 2; u.B = (part ? B1 : B0) + (size_t)pn * 256 * DP * 2; return true; }
};
struct EpiMerge {
    static constexpr bool PERM = true;
    const unsigned char* gates; bf16_t* mg;
    __device__ __forceinline__ bool operator()(f32x4 (&acc)[2][2][4][2], const pg8::Unit& u, int wr, int wc, int fr, int fq) const {
        const int row0 = u.pm * 256 + wr * 64 + fr, col0 = u.pn * 256 + wc * 32 + 8 * fq;
        if (u.ex == 0) {
#pragma unroll
            for (int ai = 0; ai < 2; ++ai)
#pragma unroll
                for (int m = 0; m < 4; ++m) { const unsigned char* gr = gates + (size_t)(row0 + ai * 128 + m * 16) * 2048 + col0;
#pragma unroll
                    for (int bj = 0; bj < 2; ++bj) { const u32x2 ga = *(const u32x2*)(gr + bj * 128), gb = *(const u32x2*)(gr + 1024 + bj * 128);
                        const unsigned a0 = ga.x, a1 = ga.y, b0 = gb.x, b1 = gb.y;
#pragma unroll
                        for (int q = 0; q < 4; ++q) { acc[ai][bj][m][0][q] *= (float)((a0 >> (8 * q)) & 255u) * fast_rcp((float)((b0 >> (8 * q)) & 255u));
                                                      acc[ai][bj][m][1][q] *= (float)((a1 >> (8 * q)) & 255u) * fast_rcp((float)((b1 >> (8 * q)) & 255u)); } } }
            return true;
        }
#pragma unroll
        for (int ai = 0; ai < 2; ++ai)
#pragma unroll
            for (int m = 0; m < 4; ++m) { const size_t row = (size_t)(row0 + ai * 128 + m * 16); const unsigned char* gr = gates + row * 2048 + 1024 + col0; bf16_t* mr = mg + row * D + col0;
#pragma unroll
                for (int bj = 0; bj < 2; ++bj) { const u32x2 gb = *(const u32x2*)(gr + bj * 128); const unsigned b0 = gb.x, b1 = gb.y;
                    f32x4 v0 = acc[ai][bj][m][0], v1 = acc[ai][bj][m][1];
#pragma unroll
                    for (int q = 0; q < 4; ++q) { v0[q] *= (float)((b0 >> (8 * q)) & 255u) * (1.f / 255.f); v1[q] *= (float)((b1 >> (8 * q)) & 255u) * (1.f / 255.f); }
                    u32x4 w; w.x = cvt_pk_bf16(v0[0], v0[1]); w.y = cvt_pk_bf16(v0[2], v0[3]); w.z = cvt_pk_bf16(v1[0], v1[1]); w.w = cvt_pk_bf16(v1[2], v1[3]);
                    *(u32x4*)(mr + bj * 128) = w; } }
        return false;
    }
};
struct EpiX1 {
    static constexpr bool PERM = true;
    const float* x; bf16_t* x1b; unsigned char* x1q;
    __device__ __forceinline__ bool operator()(f32x4 (&acc)[2][2][4][2], const pg8::Unit& u, int wr, int wc, int fr, int fq) const {
        const int row0 = u.pm * 256 + wr * 64 + fr, col0 = u.pn * 256 + wc * 32 + 8 * fq;
#pragma unroll
        for (int ai = 0; ai < 2; ++ai)
#pragma unroll
            for (int m = 0; m < 4; ++m) { const size_t off = (size_t)(row0 + ai * 128 + m * 16) * D + col0;
#pragma unroll
                for (int bj = 0; bj < 2; ++bj) { const f32x4 x0 = *(const f32x4*)(x + off + bj * 128), x1v = *(const f32x4*)(x + off + bj * 128 + 4);
                    const f32x4 v0 = acc[ai][bj][m][0] + x0, v1 = acc[ai][bj][m][1] + x1v; u32x4 w;
                    w.x = cvt_pk_bf16(v0[0], v0[1]); w.y = cvt_pk_bf16(v0[2], v0[3]); w.z = cvt_pk_bf16(v1[0], v1[1]); w.w = cvt_pk_bf16(v1[2], v1[3]);
                    *(u32x4*)(x1b + off + bj * 128) = w;
                    u32x2 q8; q8.x = pk4_fp8(v0[0] * SX8, v0[1] * SX8, v0[2] * SX8, v0[3] * SX8); q8.y = pk4_fp8(v1[0] * SX8, v1[1] * SX8, v1[2] * SX8, v1[3] * SX8);
                    *(u32x2*)(x1q + off + bj * 128) = q8; } }
        return false;
    }
};

struct SchedMoE {
    volatile LAS unsigned* M; const char* A; const char* Bw; const int* alist; size_t bstepE, bstepN, astepBlk; int G, c, gather, rep;
    __device__ __forceinline__ bool next(int i, pg8::Unit& u) const {
        int L = i * G + c; const int tot = (int)M[TAB_CUM + 32];
        if (L >= 4 * tot * rep) return false; L %= 4 * tot;
        int e = 0;
        while (e < 31 && L >= 4 * (int)M[TAB_CUM + e + 1]) ++e;
        const int cb = (int)M[TAB_CUM + e], nb = (int)M[TAB_CUM + e + 1] - cb, r = L - 4 * cb;
        int pn = r / nb, rb = r - pn * nb; int cnt = (int)M[TAB_CNT + e] - rb * 256; cnt = cnt > 256 ? 256 : cnt;
        e = __builtin_amdgcn_readfirstlane(e); pn = __builtin_amdgcn_readfirstlane(pn); rb = __builtin_amdgcn_readfirstlane(rb); cnt = __builtin_amdgcn_readfirstlane(cnt);
        const int blk = __builtin_amdgcn_readfirstlane(cb) + rb;
        u.pm = blk; u.pn = pn; u.ex = e; u.cnt = cnt; u.rows = alist + (size_t)e * T + rb * 256;
        u.A = gather ? A : A + (size_t)blk * astepBlk; u.B = Bw + (size_t)e * bstepE + (size_t)pn * bstepN; return true; }
};
struct EpiUp {
    static constexpr bool PERM = true;
    const int* alist; const f32x2* rwlist; bf16_t* hid;
    __device__ __forceinline__ bool operator()(f32x4 (&acc)[2][2][4][2], const pg8::Unit& u, int wr, int wc, int fr, int fq) const {
        const f32x2* rw = rwlist + (u.rows - alist);
        const int col0 = u.pn * 128 + wc * 32 + 8 * fq;
#pragma unroll
        for (int ai = 0; ai < 2; ++ai)
#pragma unroll
            for (int m = 0; m < 4; ++m) { const int r = ai * 128 + wr * 64 + m * 16 + fr; const float rs = (r < u.cnt) ? rw[r].x : 0.f;
                const f32x4 g0 = acc[ai][0][m][0] * rs, g1 = acc[ai][0][m][1] * rs, u0 = acc[ai][1][m][0] * rs, u1 = acc[ai][1][m][1] * rs;
                float o[8];
#pragma unroll
                for (int q = 0; q < 4; ++q) { o[q] = g0[q] * fsigmoid(g0[q]) * u0[q]; o[4 + q] = g1[q] * fsigmoid(g1[q]) * u1[q]; }
                u32x4 w; w.x = cvt_pk_bf16(o[0], o[1]); w.y = cvt_pk_bf16(o[2], o[3]); w.z = cvt_pk_bf16(o[4], o[5]); w.w = cvt_pk_bf16(o[6], o[7]);
                *(u32x4*)(hid + (size_t)(u.pm * 256 + r) * DE + col0) = w; }
        return false;
    }
};
struct EpiDown {
    static constexpr bool PERM = true;
    const int* alist; const f32x2* rwlist; bf16_t* yb;
    __device__ __forceinline__ bool operator()(f32x4 (&acc)[2][2][4][2], const pg8::Unit& u, int wr, int wc, int fr, int fq) const {
        const f32x2* rw = rwlist + (u.rows - alist);
        const int col0 = u.pn * 256 + wc * 32 + 8 * fq;
#pragma unroll
        for (int ai = 0; ai < 2; ++ai)
#pragma unroll
            for (int m = 0; m < 4; ++m) { const int r = ai * 128 + wr * 64 + m * 16 + fr;
                if (r < u.cnt) { const int a = u.rows[r]; const float w8 = rw[r].y; bf16_t* yr = yb + (size_t)a * D + col0;
#pragma unroll
                    for (int bj = 0; bj < 2; ++bj) { const f32x4 v0 = acc[ai][bj][m][0] * w8, v1 = acc[ai][bj][m][1] * w8; u32x4 w;
                        w.x = cvt_pk_bf16(v0[0], v0[1]); w.y = cvt_pk_bf16(v0[2], v0[3]); w.z = cvt_pk_bf16(v1[0], v1[1]); w.w = cvt_pk_bf16(v1[2], v1[3]);
                        *(u32x4*)(yr + bj * 128) = w; } } }
        return false;
    }
};

struct SchedMoEQ {
    volatile LAS unsigned* M; unsigned* ctl; const char* x1b; const char* hid; const char* wup; const char* wdn; const int* alist; const f32x2* rwlist; unsigned* ready; int xcc, wave, lane;
    __device__ __forceinline__ bool next(int i, pg8::UnitM& u) const {
        if (wave == 0) {
            if (lane == 0) {
                unsigned code = 0xFFFFFFFFu; int sft = (int)M[TAB_XS]; const int tot = (int)M[TAB_CUM + 32];
                while (sft < 8) { const int x = (xcc + sft) & 7; const int b0 = x * tot / 8, b1 = (x + 1) * tot / 8; const unsigned nq = (unsigned)(b1 - b0) * 4u;
                    const unsigned p = nq ? __hip_atomic_fetch_add(ctl + CW_Q + 64 * x, 1u, __ATOMIC_RELAXED, __HIP_MEMORY_SCOPE_AGENT) : 0xFFFFFFFFu;
                    if (p < 2u * nq) { code = (p < nq) ? ((unsigned)b0 * 4u + p) : (0x80000000u | ((unsigned)b0 * 4u + (p - nq))); break; }
                    ++sft; }
                M[TAB_XS] = (unsigned)sft; M[TAB_Q + (i & 1)] = code;
            }
            asm volatile("s_waitcnt lgkmcnt(0)" ::: "memory");
        }
        asm volatile("" ::: "memory"); __builtin_amdgcn_s_barrier(); asm volatile("" ::: "memory");
        const unsigned code = (unsigned)__builtin_amdgcn_readfirstlane((int)M[TAB_Q + (i & 1)]);
        if (code == 0xFFFFFFFFu) return false;
        const int type = (int)(code >> 31), L = (int)(code & 0x7FFFFFFFu), blk = L >> 2, pn = L & 3;
        const int e = __builtin_amdgcn_readfirstlane((int)M[TAB_BLK + blk]);
        const int rb = blk - __builtin_amdgcn_readfirstlane((int)M[TAB_CUM + e]); int cnt = __builtin_amdgcn_readfirstlane((int)M[TAB_CNT + e]) - rb * 256; cnt = cnt > 256 ? 256 : cnt;
        u.blk = blk; u.pn = pn; u.ex = e; u.cnt = cnt; u.type = type; u.rows = alist + (size_t)e * T + rb * 256;
        if (type == 0) { u.A = x1b; u.B = wup + ((size_t)e * 1024 + pn * 256) * D; }
        else { u.A = hid + (size_t)blk * 256 * DE; u.B = wdn + ((size_t)e * 1024 + pn * 256) * DE; }
        return true;
    }
    __device__ __forceinline__ void wait_ready(const pg8::UnitM& u) const {
        unsigned spins = 0;
        while ((unsigned)__builtin_amdgcn_readfirstlane((int)__hip_atomic_load(ctl + CW_READY + u.blk, __ATOMIC_RELAXED, __HIP_MEMORY_SCOPE_AGENT)) < 32u) {
            __builtin_amdgcn_s_sleep(2);
            if (++spins > (1u << 22)) { if (lane == 0) __hip_atomic_store(ctl + CW_TMO, 1u, __ATOMIC_RELAXED, __HIP_MEMORY_SCOPE_AGENT); break; } }
    }
};
struct EpiUpQ {
    bf16_t* hid;
    __device__ __forceinline__ void operator()(f32x4 (&acc)[2][2][4][2], const pg8::UnitM& u, int wr, int wc, int fr, int fq, const LAS unsigned char* meta) const {
        asm volatile("" : "+v"(fr), "+v"(fq));
        const __amdgpu_buffer_rsrc_t rs = __builtin_amdgcn_make_buffer_rsrc(hid, 0, 40960 * DE, 0x00020000);
        const int col0 = u.pn * 128 + wc * 32 + 8 * fq;
#pragma unroll
        for (int ai = 0; ai < 2; ++ai)
#pragma unroll
            for (int m = 0; m < 4; ++m) { const int r = ai * 128 + wr * 64 + m * 16 + fr; const unsigned rbits = ((const LAS unsigned*)meta)[4 * r + 1]; const float rsd = u2f(rbits) * (1.f / (SX8 * SW8));
                const f32x4 g0 = acc[ai][0][m][0] * rsd, g1 = acc[ai][0][m][1] * rsd, u0 = acc[ai][1][m][0] * rsd, u1 = acc[ai][1][m][1] * rsd;
                float o[8];
#pragma unroll
                for (int q = 0; q < 4; ++q) { o[q] = g0[q] * fsigmoid(g0[q]) * u0[q]; o[4 + q] = g1[q] * fsigmoid(g1[q]) * u1[q]; }
                u32x2 w; w.x = pk4_fp8(o[0] * SH8, o[1] * SH8, o[2] * SH8, o[3] * SH8); w.y = pk4_fp8(o[4] * SH8, o[5] * SH8, o[6] * SH8, o[7] * SH8);
                __builtin_amdgcn_raw_buffer_store_b64(w, rs, (int)((unsigned)(u.blk * 256 + r) * DE + col0), 0, 16);
                if (m & 1) asm volatile("" ::: "memory"); }
    }
};
struct EpiDownQ {
    bf16_t* yb;
    __device__ __forceinline__ void operator()(f32x4 (&acc)[2][2][4][2], const pg8::UnitM& u, int wr, int wc, int fr, int fq, const LAS unsigned char* meta) const {
        asm volatile("" : "+v"(fr), "+v"(fq));
        const int col0 = u.pn * 256 + wc * 32 + 8 * fq;
#pragma unroll
        for (int ai = 0; ai < 2; ++ai)
#pragma unroll
            for (int m = 0; m < 4; ++m) { const int r = ai * 128 + wr * 64 + m * 16 + fr; const unsigned abits = ((const LAS unsigned*)meta)[4 * r], wbits = ((const LAS unsigned*)meta)[4 * r + 2];
                if ((int)abits >= 0) { const float w8 = u2f(wbits) * (1.f / (SH8 * SW8)); bf16_t* yr = yb + (size_t)abits * D + col0;
#pragma unroll
                    for (int bj = 0; bj < 2; ++bj) { const f32x4 v0 = acc[ai][bj][m][0] * w8, v1 = acc[ai][bj][m][1] * w8; u32x4 w;
                        w.x = cvt_pk_bf16(v0[0], v0[1]); w.y = cvt_pk_bf16(v0[2], v0[3]); w.z = cvt_pk_bf16(v1[0], v1[1]); w.w = cvt_pk_bf16(v1[2], v1[3]);
                        *(u32x4*)(yr + bj * 128) = w; } } }
    }
};

__device__ __forceinline__ void p7_route(const Args& a, LAS unsigned char* lds, volatile LAS unsigned* MISC, int tid, int lane, int wave, int vcu, int G) {
    const float* b_rg = a.in[14]; const float* b_re = a.in[16];
    unsigned char* ws = a.ws;
    const bf16_t* x1b = (const bf16_t*)(ws + WS_X1B);
    int* alist = (int*)(ws + WS_ALIST); f32x2* rwlist = (f32x2*)(ws + WS_RWLIST); unsigned* counts = (unsigned*)(ws + WS_CTL) + CW_CNT;
    float* rstd2 = (float*)(ws + WS_RSTD2); float* gwd = (float*)(ws + WS_GW);
    { u32x4 t[12];
#pragma unroll
      for (int i = 0; i < 12; ++i) t[i] = *(const u32x4*)(ws + WS_WR + (size_t)(tid + i * 512) * 16);
#pragma unroll
      for (int i = 0; i < 12; ++i) *(LAS u32x4*)(lds + (tid + i * 512) * 16) = t[i]; }
    if (tid < 32) MISC[TAB_HIST + tid] = 0u;
    __syncthreads();
    LAS float* lgs = (LAS float*)(lds + 98304 + wave * 4096);
    for (int tile = vcu; tile < T / 64; tile += G) {
        int e1 = 0, e2 = 0, lp1 = 0, lp2 = 0; float gw1 = 0.f, gw2 = 0.f, rstd_t = 0.f;
        const int tok0 = tile * 64 + wave * 16;
        if (wave < 4) {
            const int row = lane & 15, kg = lane >> 4;
            const bf16_t* xbp = x1b + (size_t)(tok0 + row) * D + 8 * kg;
            f32x4 acc[3]; acc[0] = (f32x4){0.f, 0.f, 0.f, 0.f}; acc[1] = acc[0]; acc[2] = acc[0];
            float ss = 0.f;
#pragma unroll 8
            for (int s = 0; s < 32; ++s) {
                const u32x4 w = *(const u32x4*)(xbp + 32 * s);
#pragma unroll
                for (int q = 0; q < 4; ++q) { const float lo = bflo(w[q]), hi = bfhi(w[q]); ss += lo * lo + hi * hi; }
                const bf16x8 af = __builtin_bit_cast(bf16x8, w);
#pragma unroll
                for (int j = 0; j < 3; ++j) { const bf16x8 bfr = *(const LAS bf16x8*)(lds + (16 * j + row) * 2048 + (((4 * s + kg) ^ row) << 4));
                    acc[j] = __builtin_amdgcn_mfma_f32_16x16x32_bf16(af, bfr, acc[j], 0, 0, 0); }
            }
            ss += __shfl_xor(ss, 16); ss += __shfl_xor(ss, 32);
            const float rstd = rsqrtf(ss * (1.f / D) + EPS);
#pragma unroll
            for (int j = 0; j < 3; ++j)
#pragma unroll
                for (int q = 0; q < 4; ++q) lgs[(4 * kg + q) * 48 + 16 * j + row] = acc[j][q];
            if (lane < 16) lgs[768 + lane] = rstd;
            LDS_WAIT(); asm volatile("" ::: "memory");
            if (lane < 16) {
                rstd_t = lgs[768 + lane];
                const LAS float* lr = lgs + lane * 48;
                float lg[4];
#pragma unroll
                for (int o = 0; o < 4; ++o) lg[o] = lr[o] * rstd_t + b_rg[o];
                int gs = 0; float gm = lg[0];
#pragma unroll
                for (int o = 1; o < 4; ++o) if (lg[o] > gm) { gm = lg[o]; gs = o; }
                float den = 0.f;
#pragma unroll
                for (int o = 0; o < 4; ++o) den += __expf(lg[o] - gm);
                const float pg = 1.f / den;
                float le[8];
#pragma unroll
                for (int o = 0; o < 8; ++o) le[o] = lr[4 + gs * 8 + o] * rstd_t + b_re[gs * 8 + o];
                int i1 = 0; float m1 = le[0];
#pragma unroll
                for (int o = 1; o < 8; ++o) if (le[o] > m1) { m1 = le[o]; i1 = o; }
                int i2 = 0; float m2 = -3.0e38f;
#pragma unroll
                for (int o = 0; o < 8; ++o) if (o != i1 && le[o] > m2) { m2 = le[o]; i2 = o; }
                const float ex2 = __expf(m2 - m1), inv = 1.f / (1.f + ex2);
                e1 = gs * 8 + i1; e2 = gs * 8 + i2; gw1 = pg * inv; gw2 = pg * ex2 * inv;
                lp1 = (int)__hip_atomic_fetch_add((LAS unsigned*)&MISC[TAB_HIST + e1], 1u, __ATOMIC_RELAXED, __HIP_MEMORY_SCOPE_WORKGROUP);
                lp2 = (int)__hip_atomic_fetch_add((LAS unsigned*)&MISC[TAB_HIST + e2], 1u, __ATOMIC_RELAXED, __HIP_MEMORY_SCOPE_WORKGROUP);
            }
        }
        __syncthreads();
        if (tid < 32) { const unsigned hc = MISC[TAB_HIST + tid]; MISC[TAB_BASE + tid] = hc ? __hip_atomic_fetch_add(counts + tid, hc, __ATOMIC_RELAXED, __HIP_MEMORY_SCOPE_AGENT) : 0u; MISC[TAB_HIST + tid] = 0u; }
        __syncthreads();
        if (wave < 4 && lane < 16) {
            const int tok = tok0 + lane;
            const int p1 = (int)MISC[TAB_BASE + e1] + lp1, p2 = (int)MISC[TAB_BASE + e2] + lp2;
            alist[(size_t)e1 * T + p1] = tok * 2; rwlist[(size_t)e1 * T + p1] = (f32x2){rstd_t, gw1};
            alist[(size_t)e2 * T + p2] = tok * 2 + 1; rwlist[(size_t)e2 * T + p2] = (f32x2){rstd_t, gw2};
            rstd2[tok] = rstd_t; gwd[tok * 2] = gw1; gwd[tok * 2 + 1] = gw2;
        }
        __syncthreads();
    }
}
__device__ __forceinline__ void moe_tables(unsigned* counts, volatile LAS unsigned* MISC, int tid) {
    if (tid == 0) { unsigned cum = 0;
        for (int e = 0; e < 32; ++e) { const unsigned c = __hip_atomic_load(counts + e, __ATOMIC_RELAXED, __HIP_MEMORY_SCOPE_AGENT); MISC[TAB_CNT + e] = c; MISC[TAB_CUM + e] = cum; const unsigned nb = (c + 255u) >> 8;
            for (unsigned b = 0; b < nb; ++b) MISC[TAB_BLK + cum + b] = (unsigned)e; cum += nb; }
        MISC[TAB_CUM + 32] = cum; MISC[TAB_XS] = 0u; }
    __syncthreads();
}
__device__ __forceinline__ void p10_final(const Args& a, int lane, int wave, int vcu, int G) {
    const bf16_t* x1b = (const bf16_t*)(a.ws + WS_X1B); const float* gf = a.in[20];
    const int gw = vcu * NWAVES + wave, NGW = G * NWAVES;
    f32x4 gv[4];
#pragma unroll
    for (int j = 0; j < 4; ++j) gv[j] = *(const f32x4*)(gf + 4 * lane + 256 * j);
    u32x2 xn[4], pn[4], qn[4];
    if (gw < T) {
#pragma unroll
        for (int j = 0; j < 4; ++j) { xn[j] = ((const u32x2*)(x1b + (size_t)gw * D) + lane)[64 * j]; pn[j] = ((const u32x2*)(a.out + (size_t)gw * D) + lane)[64 * j]; qn[j] = ((const u32x2*)(a.out + (size_t)gw * D + 512) + lane)[64 * j]; } }
    for (int t = gw; t < T; t += NGW) {
        float* orow = a.out + (size_t)t * D;
        f32x4 v[4]; float s = 0.f;
#pragma unroll
        for (int j = 0; j < 4; ++j) { const u32x2 xv = xn[j], p = pn[j], q = qn[j];
            v[j].x = bflo(xv.x) + bflo(p.x) + bflo(q.x); v[j].y = bfhi(xv.x) + bfhi(p.x) + bfhi(q.x); v[j].z = bflo(xv.y) + bflo(p.y) + bflo(q.y); v[j].w = bfhi(xv.y) + bfhi(p.y) + bfhi(q.y);
            s += (v[j].x * v[j].x + v[j].y * v[j].y) + (v[j].z * v[j].z + v[j].w * v[j].w); }
        if (t + NGW < T) { const size_t tn = (size_t)(t + NGW);
#pragma unroll
            for (int j = 0; j < 4; ++j) { xn[j] = ((const u32x2*)(x1b + tn * D) + lane)[64 * j]; pn[j] = ((const u32x2*)(a.out + tn * D) + lane)[64 * j]; qn[j] = ((const u32x2*)(a.out + tn * D + 512) + lane)[64 * j]; } }
        s = wave_sum(s);
        const float rstd = rsqrtf(s * (1.f / D) + EPS);
#pragma unroll
        for (int j = 0; j < 4; ++j) ((f32x4*)orow)[lane + 64 * j] = v[j] * rstd * gv[j];
    }
}

typedef short v4i16_t __attribute__((ext_vector_type(4)));
__device__ __forceinline__ int img_off(int row, int ch) { return 2048 * (row >> 3) + 512 * (ch >> 2) + 64 * (row & 7) + 16 * ((ch & 3) ^ ((row >> 2) & 3)); }
__device__ __forceinline__ v4i16_t tr_read(LAS unsigned char* p) { return __builtin_amdgcn_ds_read_tr16_b64_v4i16((LAS v4i16_t*)p); }
__device__ __forceinline__ bf16x8 tr_frag(LAS unsigned char* img, int r0, int r1, int c0, int lane) {
    const int li = lane & 15, q = li >> 2, p = li & 3;
    const v4i16_t lo = tr_read(img + img_off(r0 + q, c0 + (p >> 1)) + 8 * (p & 1)), hi = tr_read(img + img_off(r1 + q, c0 + (p >> 1)) + 8 * (p & 1));
    return (bf16x8){lo[0], lo[1], lo[2], lo[3], hi[0], hi[1], hi[2], hi[3]};
}
__device__ __forceinline__ float wave_prefix_sum(float v, int lane) {
#pragma unroll
    for (int d = 1; d < 64; d <<= 1) { const float o = __shfl_up(v, d); if (lane >= d) v += o; }
    return v;
}
__device__ __forceinline__ float wave_prefix_max(float v, int lane) {
#pragma unroll
    for (int d = 1; d < 64; d <<= 1) { const float o = __shfl_up(v, d); if (lane >= d) v = fmaxf(v, o); }
    return v;
}
__device__ __forceinline__ float wave_max(float v) {
#pragma unroll
    for (int o = 1; o < 64; o <<= 1) v = fmaxf(v, __shfl_xor(v, o));
    return v;
}
constexpr int HALF_LDS = 50176;
__device__ __forceinline__ void conv4_silu(const u32x4 (&raw)[7], const float (&cw)[4][8], float scale, float (&out)[4][8]) {
#pragma unroll
    for (int i = 0; i < 4; ++i)
#pragma unroll
        for (int q = 0; q < 4; ++q) { float a0 = 0.f, a1 = 0.f;
#pragma unroll
            for (int j = 0; j < 4; ++j) { const unsigned w = raw[i + j][q]; a0 += bflo(w) * cw[j][2 * q]; a1 += bfhi(w) * cw[j][2 * q + 1]; }
            out[i][2 * q] = a0 * fsigmoid(a0) * scale; out[i][2 * q + 1] = a1 * fsigmoid(a1) * scale; }
}
__device__ __forceinline__ void b1_item(const Args& a, LAS unsigned char* hl, int item, int tl, int wv, int lane) {
    unsigned char* ws = a.ws; const bf16_t* z = (const bf16_t*)(ws + WS_Z); const float* gif = (const float*)(ws + WS_GIF); const float* conv_k = a.in[5];
    bf16_t* kact = (bf16_t*)(ws + WS_KACT); float* nloc = (float*)(ws + WS_NLOC); float* scal = (float*)(ws + WS_SCAL);
    unsigned char* Cb = (unsigned char*)a.out + OB_C + (size_t)item * 32768;
    const int bh = item >> 5, c = item & 31, b = bh >> 2, hh = bh & 3;
    const size_t tok_base = (size_t)b * SEQ + c * 64;
    const int cc = tl & 15, tg = tl >> 4, t0 = 4 * tg;
    u32x4 kr[7], vr[4];
#pragma unroll
    for (int j = 0; j < 7; ++j) { const int t = t0 - 3 + j; kr[j] = (c * 64 + t >= 0) ? *(const u32x4*)(z + zoff(tok_base + t, 1024 + hh * 128 + cc * 8)) : (u32x4){0u, 0u, 0u, 0u}; }
#pragma unroll
    for (int i = 0; i < 4; ++i) vr[i] = *(const u32x4*)(z + zoff(tok_base + t0 + i, 1536 + hh * 128 + cc * 8));
    float cw[4][8];
#pragma unroll
    for (int j = 0; j < 4; ++j) { const f32x4 w0 = *(const f32x4*)(conv_k + j * DM + hh * 128 + cc * 8), w1 = *(const f32x4*)(conv_k + j * DM + hh * 128 + cc * 8 + 4);
        cw[j][0] = w0.x; cw[j][1] = w0.y; cw[j][2] = w0.z; cw[j][3] = w0.w; cw[j][4] = w1.x; cw[j][5] = w1.y; cw[j][6] = w1.z; cw[j][7] = w1.w; }
    LAS float* sc = (LAS float*)(hl + 49152);
    if (wv == 0) {
        const size_t tok = tok_base + lane;
        const float ig = gif[tok * 8 + hh], fp = gif[tok * 8 + 4 + hh];
        const float bb = wave_prefix_sum(logsigmoidf_(fp), lane);
        const float blast = __shfl(bb, 63);
        const float alog = blast - bb + ig;
        const float amax = wave_max(alog);
        sc[lane] = __expf(alog - amax);
        if (lane == 0) { scal[item] = amax; scal[1024 + item] = blast; }
    }
#pragma unroll
    for (int i = 0; i < 4; ++i) *(LAS u32x4*)(hl + 16384 + img_off(t0 + i, cc)) = vr[i];
    __syncthreads();
    {
        float ka[4][8]; conv4_silu(kr, cw, 0.08838834764831845f, ka);
#pragma unroll
        for (int i = 0; i < 4; ++i) { const float wl = sc[t0 + i];
            u32x4 w; w.x = pk2(ka[i][0], ka[i][1]); w.y = pk2(ka[i][2], ka[i][3]); w.z = pk2(ka[i][4], ka[i][5]); w.w = pk2(ka[i][6], ka[i][7]);
            *(u32x4*)(kact + ((size_t)hh * T + tok_base + t0 + i) * 128 + cc * 8) = w;
            u32x4 x; x.x = pk2(ka[i][0] * wl, ka[i][1] * wl); x.y = pk2(ka[i][2] * wl, ka[i][3] * wl); x.z = pk2(ka[i][4] * wl, ka[i][5] * wl); x.w = pk2(ka[i][6] * wl, ka[i][7] * wl);
            *(LAS u32x4*)(hl + img_off(t0 + i, cc)) = x; }
    }
    __syncthreads();
    {
        const int g = lane >> 4;
        bf16x8 af[2][2];
#pragma unroll
        for (int ii = 0; ii < 2; ++ii)
#pragma unroll
            for (int ks = 0; ks < 2; ++ks) af[ii][ks] = tr_frag(hl, 32 * ks + 8 * g, 32 * ks + 8 * g + 4, 2 * (2 * wv + ii), lane);
        const bf16x8 ones = (bf16x8){0x3F80, 0x3F80, 0x3F80, 0x3F80, 0x3F80, 0x3F80, 0x3F80, 0x3F80};
        f32x4 accn[2];
#pragma unroll
        for (int ii = 0; ii < 2; ++ii) { accn[ii] = (f32x4){0.f, 0.f, 0.f, 0.f};
#pragma unroll
            for (int ks = 0; ks < 2; ++ks) accn[ii] = __builtin_amdgcn_mfma_f32_16x16x32_bf16(af[ii][ks], ones, accn[ii], 0, 0, 0); }
#pragma unroll
        for (int j = 0; j < 8; ++j) {
            f32x4 acc0 = (f32x4){0.f, 0.f, 0.f, 0.f}, acc1 = acc0;
#pragma unroll
            for (int ks = 0; ks < 2; ++ks) { const bf16x8 bfv = tr_frag(hl + 16384, 32 * ks + 8 * g, 32 * ks + 8 * g + 4, 2 * j, lane);
                acc0 = __builtin_amdgcn_mfma_f32_16x16x32_bf16(af[0][ks], bfv, acc0, 0, 0, 0); acc1 = __builtin_amdgcn_mfma_f32_16x16x32_bf16(af[1][ks], bfv, acc1, 0, 0, 0); }
            u32x4 w; w.x = pk2(acc0[0], acc0[1]); w.y = pk2(acc0[2], acc0[3]); w.z = pk2(acc1[0], acc1[1]); w.w = pk2(acc1[2], acc1[3]);
            *(u32x4*)(Cb + ((size_t)((wv * 8 + j) * 64 + lane) << 4)) = w;
        }
        if ((lane & 15) == 0) {
#pragma unroll
            for (int ii = 0; ii < 2; ++ii) *(f32x4*)(nloc + (size_t)item * 128 + 16 * (2 * wv + ii) + 4 * g) = accn[ii]; }
    }
    __syncthreads();
}
__device__ __forceinline__ void pool_pass(const Args& a, int tid, int vcu, int G) {
    const bf16_t* z = (const bf16_t*)(a.ws + WS_Z); bf16_t* dA = (bf16_t*)((unsigned char*)a.out + OB_DA);
    for (int w = vcu * (NWAVES * 64) + tid; w < (T / 8) * 64; w += G * NWAVES * 64) {
        const int cc = w & 63, run = w >> 6, tokA = run * 8, s0 = tokA % SEQ, grp = cc >> 4, win = 2 << grp;
        const bf16_t* zp = z + zoff((size_t)tokA, cc * 8);
        float S[8];
#pragma unroll
        for (int q = 0; q < 8; ++q) S[q] = 0.f;
        for (int j = 1; j <= win; ++j) if (s0 - j >= 0) { const u32x4 r = *(const u32x4*)(zp - (size_t)j * 128);
#pragma unroll
            for (int q = 0; q < 4; ++q) { S[2 * q] += bflo(r[q]); S[2 * q + 1] += bfhi(r[q]); } }
#pragma unroll
        for (int i = 0; i < 8; ++i) {
            const int s = s0 + i; const u32x4 r = *(const u32x4*)(zp + (size_t)i * 128);
            float cur[8];
#pragma unroll
            for (int q = 0; q < 4; ++q) { cur[2 * q] = bflo(r[q]); cur[2 * q + 1] = bfhi(r[q]); S[2 * q] += cur[2 * q]; S[2 * q + 1] += cur[2 * q + 1]; }
            if (s - win >= 0) { const u32x4 o = *(const u32x4*)(zp + (size_t)(i - win) * 128);
#pragma unroll
                for (int q = 0; q < 4; ++q) { S[2 * q] -= bflo(o[q]); S[2 * q + 1] -= bfhi(o[q]); } }
            const float inv = 1.f / (float)(s + 1 < win ? s + 1 : win);
            u32x4 w4;
#pragma unroll
            for (int q = 0; q < 4; ++q) w4[q] = pk2(S[2 * q] * inv - cur[2 * q], S[2 * q + 1] * inv - cur[2 * q + 1]);
            *(u32x4*)(dA + (size_t)(tokA + i) * DP + cc * 8) = w4;
        }
    }
}
__device__ __forceinline__ void p3_scan(const Args& a, int tid, int vcu, int G) {
    float* scal = (float*)(a.ws + WS_SCAL); float* nloc = (float*)(a.ws + WS_NLOC);
    for (int w = vcu; w < 256; w += G) {
        const int bh = w >> 3, part = w & 7;
        unsigned char* Cp = (unsigned char*)a.out + OB_C + (size_t)bh * 32 * 32768 + (size_t)(part * 512 + tid) * 8;
        u32x2 ld[32];
#pragma unroll
        for (int c = 0; c < 32; ++c) ld[c] = *(const u32x2*)(Cp + (size_t)c * 32768);
        const bool do_n = (part == 0 && tid < 128);
        float nl[32];
        if (do_n) {
#pragma unroll
            for (int c = 0; c < 32; ++c) nl[c] = nloc[(size_t)(bh * 32 + c) * 128 + tid]; }
        float st[4] = {0.f, 0.f, 0.f, 0.f}; float m = 0.f, nst = 0.f;
#pragma unroll
        for (int c = 0; c < 32; ++c) {
            const float am = scal[bh * 32 + c], bl = scal[1024 + bh * 32 + c];
            const float mn = fmaxf(bl + m, am), sp = __expf(bl + m - mn), sl = __expf(am - mn);
            u32x2 o; o.x = pk2(st[0], st[1]); o.y = pk2(st[2], st[3]); *(u32x2*)(Cp + (size_t)c * 32768) = o;
            st[0] = sp * st[0] + sl * bflo(ld[c].x); st[1] = sp * st[1] + sl * bfhi(ld[c].x); st[2] = sp * st[2] + sl * bflo(ld[c].y); st[3] = sp * st[3] + sl * bfhi(ld[c].y);
            if (do_n) { nloc[(size_t)(bh * 32 + c) * 128 + tid] = nst; nst = sp * nst + sl * nl[c]; }
            if (part == 0 && tid == 0) scal[2048 + bh * 32 + c] = m;
            m = mn;
        }
    }
}
__device__ __forceinline__ void b3_item(const Args& a, LAS unsigned char* hl, const LAS float* ghl, int item, int tl, int wv, int lane) {
    unsigned char* ws = a.ws; const bf16_t* z = (const bf16_t*)(ws + WS_Z); const float* gif = (const float*)(ws + WS_GIF); const float* conv_q = a.in[4]; const float* g_head = a.in[6];
    const bf16_t* kact = (const bf16_t*)(ws + WS_KACT); const float* nprev = (const float*)(ws + WS_NLOC) + (size_t)item * 128; const float* scal = (const float*)(ws + WS_SCAL);
    const unsigned char* Cb = (const unsigned char*)a.out + OB_C + (size_t)item * 32768; bf16_t* hm = (bf16_t*)((unsigned char*)a.out + OB_HM);
    const int bh = item >> 5, c = item & 31, b = bh >> 2, hh = bh & 3;
    const size_t tok_base = (size_t)b * SEQ + c * 64;
    const int cc = tl & 15, tg = tl >> 4, t0 = 4 * tg;
    LAS unsigned char* qi = hl; LAS unsigned char* ki = hl + 16384; LAS unsigned char* vi = hl + 32768; LAS float* sc = (LAS float*)(hl + 49152);
    const float mprev = scal[2048 + item];
    u32x4 cpre[8]; u32x2 opre[8];
#pragma unroll
    for (int i = 0; i < 8; ++i) cpre[i] = *(const u32x4*)(Cb + ((size_t)((wv * 8 + i) * 64 + lane) << 4));
#pragma unroll
    for (int jd = 0; jd < 8; ++jd) opre[jd] = *(const u32x2*)(z + zoff(tok_base + 16 * wv + (lane & 15), 2048 + hh * 128 + 16 * jd + 4 * (lane >> 4)));
    {
        u32x4 qr[7], kv[4], vr[4];
#pragma unroll
        for (int j = 0; j < 7; ++j) { const int t = t0 - 3 + j; qr[j] = (c * 64 + t >= 0) ? *(const u32x4*)(z + zoff(tok_base + t, 512 + hh * 128 + cc * 8)) : (u32x4){0u, 0u, 0u, 0u}; }
#pragma unroll
        for (int i = 0; i < 4; ++i) { kv[i] = *(const u32x4*)(kact + ((size_t)hh * T + tok_base + t0 + i) * 128 + cc * 8); vr[i] = *(const u32x4*)(z + zoff(tok_base + t0 + i, 1536 + hh * 128 + cc * 8)); }
        float cw[4][8];
#pragma unroll
        for (int j = 0; j < 4; ++j) { const f32x4 w0 = *(const f32x4*)(conv_q + j * DM + hh * 128 + cc * 8), w1 = *(const f32x4*)(conv_q + j * DM + hh * 128 + cc * 8 + 4);
            cw[j][0] = w0.x; cw[j][1] = w0.y; cw[j][2] = w0.z; cw[j][3] = w0.w; cw[j][4] = w1.x; cw[j][5] = w1.y; cw[j][6] = w1.z; cw[j][7] = w1.w; }
        if (wv == 0) {
            const size_t tok = tok_base + lane;
            const float ig = gif[tok * 8 + hh], fp = gif[tok * 8 + 4 + hh];
            const float bb = wave_prefix_sum(logsigmoidf_(fp), lane);
            const float gg = ig - bb;
            const float M = fmaxf(mprev, wave_prefix_max(gg, lane));
            sc[lane] = gg; sc[64 + lane] = M; sc[128 + lane] = bb;
        }
        float qa[4][8]; conv4_silu(qr, cw, 1.f, qa);
#pragma unroll
        for (int i = 0; i < 4; ++i) { u32x4 w; w.x = pk2(qa[i][0], qa[i][1]); w.y = pk2(qa[i][2], qa[i][3]); w.z = pk2(qa[i][4], qa[i][5]); w.w = pk2(qa[i][6], qa[i][7]);
            *(LAS u32x4*)(qi + img_off(t0 + i, cc)) = w; *(LAS u32x4*)(ki + img_off(t0 + i, cc)) = kv[i]; *(LAS u32x4*)(vi + img_off(t0 + i, cc)) = vr[i]; }
    }
    __syncthreads();
    {
        const int jt = wv, li = lane & 15, g = lane >> 4, trow = 16 * jt + li;
        bf16x8 qn[4];
#pragma unroll
        for (int ks = 0; ks < 4; ++ks) qn[ks] = *(const LAS bf16x8*)(qi + img_off(trow, 4 * ks + g));
        f32x4 accs[4];
#pragma unroll
        for (int i = 0; i < 4; ++i) { accs[i] = (f32x4){0.f, 0.f, 0.f, 0.f};
            if (i <= jt) {
#pragma unroll
                for (int ks = 0; ks < 4; ++ks) { const bf16x8 kf = *(const LAS bf16x8*)(ki + img_off(16 * i + li, 4 * ks + g)); accs[i] = __builtin_amdgcn_mfma_f32_16x16x32_bf16(kf, qn[ks], accs[i], 0, 0, 0); } } }
        const float Mt = sc[64 + trow], bt = sc[128 + trow];
        float rsum = 0.f;
#pragma unroll
        for (int i = 0; i < 4; ++i) { if (i <= jt) { const f32x4 gsv = *(const LAS f32x4*)(sc + 16 * i + 4 * g);
#pragma unroll
                for (int q = 0; q < 4; ++q) { float p = accs[i][q] * __expf(gsv[q] - Mt); if (i == jt && 4 * g + q > li) p = 0.f; accs[i][q] = p; rsum += p; } } }
        rsum += __shfl_xor(rsum, 16); rsum += __shfl_xor(rsum, 32);
        bf16x8 pf[2];
#pragma unroll
        for (int u = 0; u < 2; ++u) { u32x4 w; w.x = pk2(accs[2 * u][0], accs[2 * u][1]); w.y = pk2(accs[2 * u][2], accs[2 * u][3]); w.z = pk2(accs[2 * u + 1][0], accs[2 * u + 1][1]); w.w = pk2(accs[2 * u + 1][2], accs[2 * u + 1][3]); pf[u] = __builtin_bit_cast(bf16x8, w); }
        bf16x8 qp[4];
#pragma unroll
        for (int s4 = 0; s4 < 4; ++s4) { const u32x2 lo = *(const LAS u32x2*)(qi + img_off(trow, 4 * s4 + (g >> 1)) + 8 * (g & 1)), hi = *(const LAS u32x2*)(qi + img_off(trow, 4 * s4 + 2 + (g >> 1)) + 8 * (g & 1));
            qp[s4] = __builtin_bit_cast(bf16x8, (u32x4){lo.x, lo.y, hi.x, hi.y}); }
        f32x4 acco[8]; f32x4 accn = (f32x4){0.f, 0.f, 0.f, 0.f};
#pragma unroll
        for (int s4 = 0; s4 < 4; ++s4) { const f32x4 n0 = *(const f32x4*)(nprev + 32 * s4 + 4 * g), n1 = *(const f32x4*)(nprev + 32 * s4 + 16 + 4 * g);
            u32x4 w; w.x = pk2(n0.x, n0.y); w.y = pk2(n0.z, n0.w); w.z = pk2(n1.x, n1.y); w.w = pk2(n1.z, n1.w);
            accn = __builtin_amdgcn_mfma_f32_16x16x32_bf16(__builtin_bit_cast(bf16x8, w), qp[s4], accn, 0, 0, 0); }
        LDS_WAIT(); __syncthreads();
#pragma unroll
        for (int i = 0; i < 8; ++i) *(LAS u32x4*)(hl + (((wv * 8 + i) * 64 + lane) << 4)) = cpre[i];
        LDS_WAIT(); __syncthreads();
#pragma unroll
        for (int jd = 0; jd < 8; ++jd) { acco[jd] = (f32x4){0.f, 0.f, 0.f, 0.f};
#pragma unroll
            for (int s4 = 0; s4 < 4; ++s4) { const bf16x8 cf = *(const LAS bf16x8*)(hl + (((s4 * 8 + jd) * 64 + lane) << 4)); acco[jd] = __builtin_amdgcn_mfma_f32_16x16x32_bf16(cf, qp[s4], acco[jd], 0, 0, 0); } }
        const float winter = __expf(mprev - Mt);
#pragma unroll
        for (int jd = 0; jd < 8; ++jd) acco[jd] = acco[jd] * winter;
#pragma unroll
        for (int u = 0; u < 2; ++u) { if (2 * u <= jt) {
#pragma unroll
                for (int jd = 0; jd < 8; ++jd) { const bf16x8 vf = tr_frag(vi, 32 * u + 4 * g, 32 * u + 16 + 4 * g, 2 * jd, lane); acco[jd] = __builtin_amdgcn_mfma_f32_16x16x32_bf16(vf, pf[u], acco[jd], 0, 0, 0); } } }
        const float nq = winter * accn[0] + rsum;
        const float inv = 1.f / fmaxf(fabsf(nq), __expf(-bt - Mt));
        float s1 = 0.f;
#pragma unroll
        for (int jd = 0; jd < 8; ++jd) { acco[jd] = acco[jd] * inv; s1 += (acco[jd][0] + acco[jd][1]) + (acco[jd][2] + acco[jd][3]); }
        s1 += __shfl_xor(s1, 16); s1 += __shfl_xor(s1, 32);
        const float mu = s1 * (1.f / HD);
        float s2 = 0.f;
#pragma unroll
        for (int jd = 0; jd < 8; ++jd) { const f32x4 d = acco[jd] - mu; s2 += (d[0] * d[0] + d[1] * d[1]) + (d[2] * d[2] + d[3] * d[3]); }
        s2 += __shfl_xor(s2, 16); s2 += __shfl_xor(s2, 32);
        const float rstd = rsqrtf(s2 * (1.f / HD) + EPS);
        const size_t tok = tok_base + trow;
#pragma unroll
        for (int jd = 0; jd < 8; ++jd) { const int dv0 = hh * 128 + 16 * jd + 4 * g;
            const f32x4 gh = *(const LAS f32x4*)(ghl + dv0); const u32x2 ov = opre[jd];
            const f32x4 hn = (acco[jd] - mu) * rstd * gh;
            u32x2 w; w.x = pk2(hn[0] * fsigmoid(bflo(ov.x)), hn[1] * fsigmoid(bfhi(ov.x))); w.y = pk2(hn[2] * fsigmoid(bflo(ov.y)), hn[3] * fsigmoid(bfhi(ov.y)));
            *(u32x2*)(hm + tok * DM + dv0) = w; }
    }
    __syncthreads();
}

constexpr int TR_PITCH = 144, TR_SCR = 64 * TR_PITCH;
struct TrDesc { const float* src; bf16_t* dst; const float* ksc; int ld, k0, n0s, dstK, fp8; };
__device__ __forceinline__ void tr64_load(const TrDesc& d, f32x4 (&v)[16], int lane) {
    const int lr = lane >> 4, lc = (lane & 15) * 4;
#pragma unroll
    for (int i = 0; i < 16; ++i) v[i] = *(const f32x4*)(d.src + (size_t)(d.k0 + 4 * i + lr) * d.ld + d.n0s + lc);
}
__device__ __forceinline__ void tr64_store(const TrDesc& d, const f32x4 (&v)[16], LAS unsigned char* scr, int lane) {
    const int lr = lane >> 4, lc = (lane & 15) * 4;
#pragma unroll
    for (int i = 0; i < 16; ++i) { f32x4 x = v[i]; if (d.ksc) x = x * d.ksc[d.k0 + 4 * i + lr];
        u32x2 w; w.x = pk2(x.x, x.y); w.y = pk2(x.z, x.w); *(LAS u32x2*)(scr + (4 * i + lr) * TR_PITCH + lc * 2) = w; }
    LDS_WAIT(); asm volatile("" ::: "memory");
    const int li = lane & 15, g = lane >> 4, q = li >> 2, p = li & 3;
#pragma unroll
    for (int nb = 0; nb < 4; ++nb)
#pragma unroll
        for (int kh = 0; kh < 2; ++kh) { const int kc = 4 * kh + g;
            LAS unsigned char* ap = scr + (8 * kc + q) * TR_PITCH + (nb * 16 + 4 * p) * 2;
            const v4i16_t lo = tr_read(ap), hi = tr_read(ap + 4 * TR_PITCH);
            if (d.fp8) { const u32x2 l2 = __builtin_bit_cast(u32x2, lo), h2 = __builtin_bit_cast(u32x2, hi); const unsigned l0 = l2.x, l1 = l2.y, h0 = h2.x, h1 = h2.y;
                u32x2 o8; o8.x = pk4_fp8(bflo(l0) * SW8, bfhi(l0) * SW8, bflo(l1) * SW8, bfhi(l1) * SW8); o8.y = pk4_fp8(bflo(h0) * SW8, bfhi(h0) * SW8, bflo(h1) * SW8, bfhi(h1) * SW8);
                *(u32x2*)((unsigned char*)d.dst + (size_t)(nb * 16 + li) * d.dstK + d.k0 + 8 * kc) = o8; }
            else { const bf16x8 o = (bf16x8){lo[0], lo[1], lo[2], lo[3], hi[0], hi[1], hi[2], hi[3]};
                *(bf16x8*)(d.dst + (size_t)(nb * 16 + li) * d.dstK + d.k0 + 8 * kc) = o; } }
    LDS_WAIT(); asm volatile("" ::: "memory");
}
template <class Dec>
__device__ __forceinline__ void tr64_stream(const Dec& dec, int it0, int stride, int n, LAS unsigned char* scr, int lane) {
    if (it0 >= n) return;
    TrDesc dc = dec(it0); f32x4 vc[16]; tr64_load(dc, vc, lane);
    for (int it = it0; it < n; it += stride) {
        const bool more = it + stride < n;
        TrDesc dn = dc; f32x4 vn[16];
        if (more) { dn = dec(it + stride); tr64_load(dn, vn, lane); }
        tr64_store(dc, vc, scr, lane);
        if (more) { dc = dn;
#pragma unroll
            for (int i = 0; i < 16; ++i) vc[i] = vn[i]; }
    }
}
struct DecP0 { const float *w_in, *w_br_b, *w_out, *w_eg, *w_eu, *g_ffn; unsigned char* ws;
    __device__ __forceinline__ TrDesc operator()(int r) const {
        constexpr int I_WZ = 16 * 72, I_WB = 8 * 16, I_WO = 16 * 16, I_EG = 32 * 16 * 8;
        TrDesc d; d.ksc = nullptr; d.fp8 = 0;
        if (r < I_WZ) { const int kb = r / 72, nb = r % 72, n0 = nb * 64; d.src = w_in; d.ld = NIN; d.k0 = kb * 64; d.n0s = zcol2orig(n0); d.dst = (bf16_t*)(ws + WS_WZ) + (size_t)n0 * D; d.dstK = D;
            if (n0 >= 2560) { d.dst = (bf16_t*)(ws + WS_WZ8 + (size_t)(n0 - 2560) * D); d.fp8 = 1; } return d; } r -= I_WZ;
        if (r < I_WB) { const int kb = r >> 4, nb = r & 15; d.src = w_br_b; d.ld = D; d.k0 = kb * 64; d.n0s = nb * 64; d.dst = (bf16_t*)(ws + WS_WBT) + (size_t)(nb * 64) * DM; d.dstK = DM; return d; } r -= I_WB;
        if (r < I_WO) { const int kb = r >> 4, nb = r & 15; d.src = w_out; d.ld = D; d.k0 = kb * 64; d.n0s = nb * 64; d.dst = (bf16_t*)(ws + WS_WOT) + (size_t)(nb * 64) * D; d.dstK = D; return d; } r -= I_WO;
        const int up = r >= I_EG; if (up) r -= I_EG; const int e = r >> 7, kb = (r >> 3) & 15, nb = r & 7, j0 = nb * 64;
        const int drow = (j0 >> 7) * 256 + up * 128 + (j0 & 127);
        d.src = (up ? w_eu : w_eg) + (size_t)e * D * DE; d.ld = DE; d.k0 = kb * 64; d.n0s = j0; d.dst = (bf16_t*)(ws + WS_WUP + ((size_t)e * 1024 + drow) * D); d.dstK = D; d.ksc = g_ffn; d.fp8 = 1; return d; }
};
struct DecWd { const float* w_ed; unsigned char* ws;
    __device__ __forceinline__ TrDesc operator()(int r) const { const int e = r >> 7, kb = (r >> 4) & 7, nb = r & 15;
        TrDesc d; d.src = w_ed + (size_t)e * DE * D; d.ld = D; d.k0 = kb * 64; d.n0s = nb * 64; d.dst = (bf16_t*)(ws + WS_WDN + ((size_t)e * 1024 + nb * 64) * DE); d.dstK = DE; d.ksc = nullptr; d.fp8 = 1; return d; }
};

__device__ __forceinline__ void p0_prologue(const Args& a, LAS unsigned char* lds, int tid, int lane, int wave, int vcu, int G) {
    const float* x = a.in[0]; const float* g_mix = a.in[1]; const float* w_in = a.in[2]; const float* b_if = a.in[3];
    const float* w_pool = a.in[7]; const float* pool_scale = a.in[8]; const float* w_br_a = a.in[9]; const float* w_br_b = a.in[10]; const float* w_out = a.in[11];
    const float* g_ffn = a.in[12]; const float* w_eg = a.in[17]; const float* w_eu = a.in[18];
    unsigned char* ws = a.ws;
    bf16_t* h = (bf16_t*)((unsigned char*)a.out + OB_H); float* gif = (float*)(ws + WS_GIF); unsigned char* h8 = (unsigned char*)a.out + OB_H8;
    const int gw = vcu * NWAVES + wave, NGW = G * NWAVES;
    LAS float* gwl = (LAS float*)(lds + 81920);
    for (int idx = tid; idx < 8192; idx += NWAVES * 64) { const int k = idx >> 3, o = idx & 7; gwl[o * 1024 + k] = w_in[(size_t)k * NIN + 2560 + o] * g_mix[k]; }
    __syncthreads();
    REP(20) {
        f32x4 gm[4];
#pragma unroll
        for (int j = 0; j < 4; ++j) gm[j] = *(const f32x4*)(g_mix + 4 * lane + 256 * j);
        f32x4 vn[4], vm[4];
        if (gw < T) {
#pragma unroll
            for (int j = 0; j < 4; ++j) vn[j] = ((const f32x4*)(x + (size_t)gw * D) + lane)[64 * j]; }
        if (gw + NGW < T) {
#pragma unroll
            for (int j = 0; j < 4; ++j) vm[j] = ((const f32x4*)(x + (size_t)(gw + NGW) * D) + lane)[64 * j]; }
        for (int m = gw; m < T; m += NGW) {
            f32x4 v[4];
#pragma unroll
            for (int j = 0; j < 4; ++j) { v[j] = vn[j]; vn[j] = vm[j]; }
            if (m + 2 * NGW < T) {
#pragma unroll
                for (int j = 0; j < 4; ++j) vm[j] = ((const f32x4*)(x + (size_t)(m + 2 * NGW) * D) + lane)[64 * j]; }
            float s = 0.f;
#pragma unroll
            for (int j = 0; j < 4; ++j) s += (v[j].x * v[j].x + v[j].y * v[j].y) + (v[j].z * v[j].z + v[j].w * v[j].w);
            float acc[8];
#pragma unroll
            for (int o = 0; o < 8; ++o) { float t = 0.f;
#pragma unroll
                for (int j = 0; j < 4; ++j) { const f32x4 w = *(const LAS f32x4*)(gwl + o * 1024 + 4 * lane + 256 * j); t += (v[j].x * w.x + v[j].y * w.y) + (v[j].z * w.z + v[j].w * w.w); }
                acc[o] = t; }
            s = wave_sum(s);
#pragma unroll
            for (int o = 0; o < 8; ++o) acc[o] = wave_sum(acc[o]);
            const float rstd = rsqrtf(s * (1.f / D) + EPS);
            u32x2* o8 = (u32x2*)(h + (size_t)m * D) + lane;
#pragma unroll
            for (int j = 0; j < 4; ++j) { const f32x4 hv = v[j] * rstd * gm[j]; u32x2 w; w.x = pk2(hv.x, hv.y); w.y = pk2(hv.z, hv.w); o8[64 * j] = w;
                ((unsigned*)(h8 + (size_t)m * D))[lane + 64 * j] = pk4_fp8(hv.x * SX8, hv.y * SX8, hv.z * SX8, hv.w * SX8); }
            if (lane < 8) { float r = acc[0];
#pragma unroll
                for (int o = 1; o < 8; ++o) r = (lane == o) ? acc[o] : r;
                gif[(size_t)m * 8 + lane] = r * rstd + b_if[lane]; }
        }
    }
    REP(21) {
        bf16_t* W2T = (bf16_t*)(ws + WS_W2T);
        const int li = lane & 15, g = lane >> 4;
        for (int tile = gw; tile < 32 * 64; tile += NGW) {
            const int k0 = (tile >> 6) * 16, n0 = (tile & 63) * 16, gq = k0 >> 7;
            const float* wp = w_pool + (size_t)(k0 + li) * 128 + 8 * g; const float* sc = pool_scale + gq * 128 + 8 * g; const float* wa = w_br_a + (size_t)(gq * 128 + 8 * g) * D + n0 + li;
            f32x4 a0[4], a1[4], s0[4], s1[4]; float bv[4][8];
#pragma unroll
            for (int st = 0; st < 4; ++st) { a0[st] = *(const f32x4*)(wp + 32 * st); a1[st] = *(const f32x4*)(wp + 32 * st + 4); s0[st] = *(const f32x4*)(sc + 32 * st); s1[st] = *(const f32x4*)(sc + 32 * st + 4);
#pragma unroll
                for (int j = 0; j < 8; ++j) bv[st][j] = wa[(size_t)(32 * st + j) * D]; }
            f32x4 acc = (f32x4){0.f, 0.f, 0.f, 0.f};
#pragma unroll
            for (int st = 0; st < 4; ++st) { const f32x4 p0 = a0[st] * s0[st], p1 = a1[st] * s1[st];
                u32x4 aw; aw.x = pk2(p0.x, p0.y); aw.y = pk2(p0.z, p0.w); aw.z = pk2(p1.x, p1.y); aw.w = pk2(p1.z, p1.w);
                u32x4 bw; bw.x = pk2(bv[st][0], bv[st][1]); bw.y = pk2(bv[st][2], bv[st][3]); bw.z = pk2(bv[st][4], bv[st][5]); bw.w = pk2(bv[st][6], bv[st][7]);
                acc = __builtin_amdgcn_mfma_f32_16x16x32_bf16(__builtin_bit_cast(bf16x8, aw), __builtin_bit_cast(bf16x8, bw), acc, 0, 0, 0); }
            u32x2 o; o.x = pk2(acc[0], acc[1]); o.y = pk2(acc[2], acc[3]);
            *(u32x2*)(W2T + (size_t)(n0 + li) * DP + k0 + 4 * g) = o;
        }
    }
    LAS unsigned char* scr = lds + wave * TR_SCR;
    constexpr int NITEMS = 16 * 72 + 8 * 16 + 16 * 16 + 2 * 32 * 16 * 8;
    REP(22) tr64_stream(DecP0{w_in, w_br_b, w_out, w_eg, w_eu, g_ffn, ws}, gw, NGW, NITEMS, scr, lane);
    {
        const float* w_rg = a.in[13]; const float* w_re = a.in[15];
        const int gt = gw * 64 + lane;
        if (gt < 48 * 128) { const int col = gt >> 7, ch = gt & 127; float v[8];
#pragma unroll
            for (int q = 0; q < 8; ++q) { const int k = 8 * ch + q; v[q] = (col < 4 ? w_rg[k * NG + col] : col < 36 ? w_re[k * NE + col - 4] : 0.f) * g_ffn[k]; }
            u32x4 w; w.x = pk2(v[0], v[1]); w.y = pk2(v[2], v[3]); w.z = pk2(v[4], v[5]); w.w = pk2(v[6], v[7]);
            *(u32x4*)(ws + WS_WR + col * 2048 + ((ch ^ (col & 15)) << 4)) = w; }
    }
}

__device__ __forceinline__ void convert_wdown(const Args& a, LAS unsigned char* lds, int lane, int wave, int gi, int ngrp) {
    tr64_stream(DecWd{a.in[19], a.ws}, gi * NWAVES + wave, ngrp * NWAVES, 32 * 8 * 16, lds + wave * TR_SCR, lane);
}

__global__ void __launch_bounds__(NWAVES * 64, 2) mk_fwd(Args args) {
    extern __shared__ __attribute__((aligned(16))) unsigned char lds_raw[];
    LAS unsigned char* lds = (LAS unsigned char*)lds_raw;
    volatile LAS unsigned* MISC = (volatile LAS unsigned*)(lds + MISC_OFF);
    const int tid = threadIdx.x, lane = tid & 63, wave = __builtin_amdgcn_readfirstlane(tid >> 6);
    const int G = gridDim.x; const int bx = blockIdx.x; const int vcu = (G % 8 == 0) ? (bx % 8) * (G / 8) + bx / 8 : bx;
    unsigned char* ws = args.ws; unsigned* ctl = (unsigned*)(ws + WS_CTL);
    for (int u = tid; u < (LDS_BYTES - LDSCTL_OFF) / 4; u += NWAVES * 64) ((LAS unsigned*)(lds + LDSCTL_OFF))[u] = 0u;
    __syncthreads();
    XcdBarrier bar = xcd_barrier_post(ctl + CW_BAR + args.li * XCD_BAR_WORDS, MISC + 8);
    const int lo = args.ph_lo, hi = args.ph_hi;
#define IN(k) (lo <= (k) && (k) < hi)
#define BOTH(k) (IN(k) && IN((k) + 1))
#define GRID_BAR() xcd_barrier(bar)
#define STAMP(k) do { if (PROBE_PHASE >= 100 && bx == 0 && tid == 0) { const unsigned long long _t = __builtin_amdgcn_s_memrealtime(); if ((k) == PROBE_PHASE - 100) tstart = _t; if ((k) == PROBE_PHASE - 99) tend = _t; } } while (0)
    unsigned long long tstart = 0, tend = 0;
    STAMP(0);
    if (IN(0)) { REP(0) { p0_prologue(args, lds, tid, lane, wave, vcu, G); __syncthreads(); } if (BOTH(0)) GRID_BAR(); STAMP(1); }
    if (IN(1)) {
        SchedP1X S{(const char*)args.out + OB_H, (const char*)args.out + OB_H8, (const char*)(ws + WS_WZ), (const char*)(ws + WS_WZ8), T / 256, NZ / 256, G, bx};
        EpiZX E{(bf16_t*)(ws + WS_Z), ws + WS_GATES};
        pg8::gemm_phase_mix<SchedP1X, EpiZX>(lds + RING_OFF, S, E);
        { const int nwg = (T / 256) * (NZ / 256), full = nwg % G;
          if (full == 0) convert_wdown(args, lds, lane, wave, bx, G); else if (bx >= full) convert_wdown(args, lds, lane, wave, bx - full, G - full); }
        if (BOTH(1)) GRID_BAR(); STAMP(2);
    }
    if (IN(2)) {
        REP(2) for (int pr = vcu; pr < 512; pr += G) b1_item(args, lds + (wave >> 2) * HALF_LDS, 2 * pr + (wave >> 2), tid & 255, wave & 3, lane);
        pool_pass(args, tid, vcu, G);
        if (BOTH(2)) GRID_BAR(); STAMP(3);
    }
    if (IN(3)) { p3_scan(args, tid, vcu, G); if (BOTH(3)) GRID_BAR(); STAMP(4); }
    if (IN(4)) {
        { LAS float* ghl = (LAS float*)(lds + META_OFF); ghl[tid] = args.in[6][tid]; __syncthreads();
          REP(4) for (int pr = vcu; pr < 512; pr += G) b3_item(args, lds + (wave >> 2) * HALF_LDS, ghl, 2 * pr + (wave >> 2), tid & 255, wave & 3, lane); }
        if (BOTH(4)) GRID_BAR(); STAMP(5);
    }
    if (IN(5)) {
        SchedMerge S{(const char*)args.out + OB_DA, (const char*)args.out + OB_HM, (const char*)(ws + WS_W2T), (const char*)(ws + WS_WBT), T / 256, D / 256, G, bx};
        EpiMerge E{ws + WS_GATES, (bf16_t*)((unsigned char*)args.out + OB_MERGED)};
        pg8::gemm_phase<EpiMerge, SchedMerge, false>(lds + RING_OFF, pg8::Cfg{DP, DP * 2, DP * 2}, S, E);
        if (BOTH(5)) GRID_BAR(); STAMP(6);
    }
    if (IN(6)) {
        SchedDense S{(const char*)args.out + OB_MERGED, (const char*)(ws + WS_WOT), (size_t)256 * D * 2, (size_t)256 * D * 2, T / 256, D / 256, G, bx, (PROBE_PHASE == 6) ? 2 : 1};
        EpiX1 E{args.in[0], (bf16_t*)(ws + WS_X1B), ws + WS_X1Q};
        pg8::gemm_phase<EpiX1, SchedDense, false>(lds + RING_OFF, pg8::Cfg{D, D * 2, D * 2}, S, E);
        if (BOTH(6)) GRID_BAR(); STAMP(7);
    }
    if (IN(7)) { p7_route(args, lds, MISC, tid, lane, wave, vcu, G); if (BOTH(7)) GRID_BAR(); STAMP(8); }
#if MOE_DYN
    if (IN(8)) {
        moe_tables(ctl + CW_CNT, MISC, tid);
        SchedMoEQ S{MISC, ctl, (const char*)(ws + WS_X1Q), (const char*)(ws + WS_HID), (const char*)(ws + WS_WUP), (const char*)(ws + WS_WDN), (const int*)(ws + WS_ALIST), (const f32x2*)(ws + WS_RWLIST), ctl + CW_READY, (int)(bar.x & 7u), wave, lane};
        EpiUpQ E0{(bf16_t*)(ws + WS_HID)};
        EpiDownQ E1{(bf16_t*)args.out};
        pg8::gemm_phase_moe<SchedMoEQ, EpiUpQ, EpiDownQ>(lds + RING_OFF, lds + META_OFF, S, E0, E1);
        if (IN(10)) GRID_BAR(); STAMP(9); STAMP(10);
    }
#else
    if (IN(8)) {
        moe_tables(ctl + CW_CNT, MISC, tid);
        SchedMoE S{MISC, (const char*)(ws + WS_X1B), (const char*)(ws + WS_WUP), (const int*)(ws + WS_ALIST), (size_t)1024 * D * 2, (size_t)256 * D * 2, 0, G, vcu, 1, (PROBE_PHASE == 8) ? 2 : 1};
        EpiUp E{(const int*)(ws + WS_ALIST), (const f32x2*)(ws + WS_RWLIST), (bf16_t*)(ws + WS_HID)};
        pg8::gemm_phase<EpiUp, SchedMoE, true>(lds + RING_OFF, pg8::Cfg{D, D * 2, D * 2}, S, E);
        if (BOTH(8)) GRID_BAR(); STAMP(9);
    }
    if (IN(9)) {
        moe_tables(ctl + CW_CNT, MISC, tid);
        SchedMoE S{MISC, (const char*)(ws + WS_HID), (const char*)(ws + WS_WDN), (const int*)(ws + WS_ALIST), (size_t)1024 * DE * 2, (size_t)256 * DE * 2, (size_t)256 * DE * 2, G, vcu, 0, (PROBE_PHASE == 9) ? 2 : 1};
        EpiDown E{(const int*)(ws + WS_ALIST), (const f32x2*)(ws + WS_RWLIST), (bf16_t*)args.out};
        pg8::gemm_phase<EpiDown, SchedMoE, false>(lds + RING_OFF, pg8::Cfg{DE, DE * 2, DE * 2}, S, E);
        if (BOTH(9)) GRID_BAR(); STAMP(10);
    }
#endif
    if (IN(10)) p10_final(args, lane, wave, vcu, G);
    STAMP(11);
    if (PROBE_PHASE >= 100 && bx == 0 && tid == 0) { const unsigned long long d = (tend - tstart) * 8ull, t0 = __builtin_amdgcn_s_memrealtime(); while (__builtin_amdgcn_s_memrealtime() - t0 < d) __builtin_amdgcn_s_sleep(16); }
#undef IN
#undef BOTH
#undef GRID_BAR
}

}

extern "C" void kernel_launch(void* const* d_in, const int* in_sizes, int n_in, void* d_out, int out_size, void* d_ws, size_t ws_size, hipStream_t stream) {
    const float* x = (const float*)d_in[0];
    const float* conv_q = (const float*)d_in[4]; const float* conv_k = (const float*)d_in[5]; const float* g_head = (const float*)d_in[6]; const float* w_pool = (const float*)d_in[7];
    const float* pool_scale = (const float*)d_in[8]; const float* w_br_a = (const float*)d_in[9]; const float* w_br_b = (const float*)d_in[10]; const float* w_out = (const float*)d_in[11];
    const float* g_ffn = (const float*)d_in[12]; const float* w_rg = (const float*)d_in[13]; const float* b_rg = (const float*)d_in[14]; const float* w_re = (const float*)d_in[15];
    const float* b_re = (const float*)d_in[16]; const float* w_eg = (const float*)d_in[17]; const float* w_eu = (const float*)d_in[18]; const float* w_ed = (const float*)d_in[19];
    const float* g_final = (const float*)d_in[20];
    static int grid = 0;
    if (grid == 0) {
        if (n_in != 21 || out_size != T * D || ws_size < WS_END) { fprintf(stderr, "kernel_launch: unexpected shapes/ws (%d inputs, out %d, ws %zu)\n", n_in, out_size, ws_size); grid = -1; return; }
        int dev = 0, cus = 0, per_cu = 0;
        if (hipGetDevice(&dev) != hipSuccess || hipDeviceGetAttribute(&cus, hipDeviceAttributeMultiprocessorCount, dev) != hipSuccess) { grid = -1; return; }
        if (hipFuncSetAttribute((const void*)mk_fwd, hipFuncAttributeMaxDynamicSharedMemorySize, LDS_BYTES) != hipSuccess) { fprintf(stderr, "kernel_launch: hipFuncSetAttribute failed\n"); grid = -1; return; }
        if (hipOccupancyMaxActiveBlocksPerMultiprocessor(&per_cu, (const void*)mk_fwd, NWAVES * 64, LDS_BYTES) != hipSuccess || per_cu < 1) { fprintf(stderr, "kernel_launch: occupancy query says %d blocks per CU\n", per_cu); grid = -1; return; }
        (void)hipGetLastError();
        grid = cus;
    }
    if (grid < 0) return;
    unsigned char* ws = (unsigned char*)d_ws; unsigned char* ob = (unsigned char*)d_out;
    (void)hipMemsetAsync(ws + WS_CTL, 0, CTL_ZERO_BYTES, stream);
    Args a{};
    for (int i = 0; i < 21; ++i) a.in[i] = (const float*)d_in[i];
    a.out = (float*)d_out; a.ws = ws; a.flags = 0;
    a.ph_lo = 0; a.ph_hi = 11; a.li = 0;
    hipLaunchKernelGGL(mk_fwd, dim3(grid), dim3(NWAVES * 64), LDS_BYTES, stream, a);
}
```

```cpp
#include <hip/hip_runtime.h>
#include <cstdio>
#include <cstdint>

namespace {
constexpr int D = 1024, BATCH = 8, SEQ = 2048, T = BATCH * SEQ;
constexpr int DP = 512, DM = 512, NH = 4, HD = 128, NIN = 4616, NZ = 4608;
constexpr int NG = 4, EPG = 8, NE = 32, DE = 512;
constexpr float EPS = 1e-6f;
constexpr size_t MiB = 1u << 20;

typedef unsigned short bf16_t;
__device__ __forceinline__ bf16_t f2bf(float f) { unsigned u = __builtin_bit_cast(unsigned, f); return (bf16_t)((u + 0x7fffu + ((u >> 16) & 1u)) >> 16); }
__device__ __forceinline__ float bf2f(bf16_t b) { return __builtin_bit_cast(float, (unsigned)b << 16); }
__device__ __forceinline__ float sigmoidf_(float x) { return 1.f / (1.f + __expf(-x)); }
__device__ __forceinline__ float siluf_(float x) { return x / (1.f + __expf(-x)); }
__device__ __forceinline__ float logsigmoidf_(float x) { return fminf(x, 0.f) - log1pf(__expf(-fabsf(x))); }
__device__ __forceinline__ float wave_sum(float v) {
#pragma unroll
    for (int o = 1; o < 64; o <<= 1) v += __shfl_xor(v, o);
    return v;
}
__host__ __device__ __forceinline__ size_t zoff(size_t tok, int col) { return ((size_t)(col >> 7) * T + tok) * 128 + (col & 127); }
__device__ __forceinline__ int zcol2orig(int c) { return c < 2560 ? c : c + 8; }

__global__ void __launch_bounds__(256) k_prep(const float* __restrict__ x, const float* __restrict__ g, const float* __restrict__ w_in,
                                               const float* __restrict__ b_if, bf16_t* __restrict__ h, float* __restrict__ gif) {
    const int wave = threadIdx.x >> 6, lane = threadIdx.x & 63;
    const int row = blockIdx.x * 4 + wave;
    if (row >= T) return;
    const float* xr = x + (size_t)row * D;
    float v[16]; float s = 0.f;
#pragma unroll
    for (int j = 0; j < 16; ++j) { v[j] = xr[lane + 64 * j]; s += v[j] * v[j]; }
    s = wave_sum(s);
    const float rstd = rsqrtf(s * (1.f / D) + EPS);
    float acc[8];
#pragma unroll
    for (int o = 0; o < 8; ++o) acc[o] = 0.f;
#pragma unroll
    for (int j = 0; j < 16; ++j) {
        const int k = lane + 64 * j;
        const float hv = v[j] * rstd * g[k];
        h[(size_t)row * D + k] = f2bf(hv);
#pragma unroll
        for (int o = 0; o < 8; ++o) acc[o] += hv * w_in[(size_t)k * NIN + 2560 + o];
    }
#pragma unroll
    for (int o = 0; o < 8; ++o) { acc[o] = wave_sum(acc[o]); }
    if (lane == 0) {
#pragma unroll
        for (int o = 0; o < 8; ++o) gif[(size_t)row * 8 + o] = acc[o] + b_if[o];
    }
}

template <class AL, class BL, class EP>
__global__ void __launch_bounds__(256) k_gemm(int M, int N, int K, AL al, BL bl, EP ep) {
    __shared__ float As[16][68];
    __shared__ float Bs[16][68];
    const int tid = threadIdx.x, tx = tid & 15, ty = tid >> 4;
    const int row0 = blockIdx.y * 64, col0 = blockIdx.x * 64;
    float acc[4][4];
#pragma unroll
    for (int i = 0; i < 4; ++i)
#pragma unroll
        for (int j = 0; j < 4; ++j) acc[i][j] = 0.f;
    for (int k0 = 0; k0 < K; k0 += 16) {
#pragma unroll
        for (int j = 0; j < 4; ++j) {
            const int idx = tid + j * 256;
            const int r = idx >> 4, kk = idx & 15;
            As[kk][r] = (row0 + r < M) ? al(row0 + r, k0 + kk) : 0.f;
            const int k2 = idx >> 6, n = idx & 63;
            Bs[k2][n] = (col0 + n < N) ? bl(k0 + k2, col0 + n) : 0.f;
        }
        __syncthreads();
#pragma unroll
        for (int kk = 0; kk < 16; ++kk) {
            float a[4], b[4];
#pragma unroll
            for (int i = 0; i < 4; ++i) a[i] = As[kk][ty * 4 + i];
#pragma unroll
            for (int j = 0; j < 4; ++j) b[j] = Bs[kk][tx * 4 + j];
#pragma unroll
            for (int i = 0; i < 4; ++i)
#pragma unroll
                for (int j = 0; j < 4; ++j) acc[i][j] += a[i] * b[j];
        }
        __syncthreads();
    }
#pragma unroll
    for (int i = 0; i < 4; ++i)
#pragma unroll
        for (int j = 0; j < 4; ++j) {
            const int r = row0 + ty * 4 + i, c = col0 + tx * 4 + j;
            if (r < M && c < N) ep(r, c, acc[i][j]);
        }
}

struct ALbf { const bf16_t* p; int ld; int pad; __device__ float operator()(int r, int k) const { return bf2f(p[(size_t)r * ld + k]); } };
struct ALf32 { const float* p; int ld; int pad; __device__ float operator()(int r, int k) const { return p[(size_t)r * ld + k]; } };
struct BLwin { const float* w; __device__ float operator()(int k, int n) const { return w[(size_t)k * NIN + zcol2orig(n)]; } };
struct BLplain { const float* w; int ld; int pad; __device__ float operator()(int k, int n) const { return w[(size_t)k * ld + n]; } };
struct EPz { bf16_t* z; __device__ void operator()(int r, int c, float v) const { z[(size_t)r * NZ + c] = f2bf(v); } };
struct EPf32 { float* o; int ld; int pad; __device__ void operator()(int r, int c, float v) const { o[(size_t)r * ld + c] = v; } };
struct EPmerge { const float* ya; const bf16_t* z; bf16_t* m;
    __device__ void operator()(int r, int c, float yb) const {
        const float ga = bf2f(z[(size_t)r * NZ + 2560 + c]), gb = bf2f(z[(size_t)r * NZ + 3584 + c]);
        m[(size_t)r * D + c] = f2bf(sigmoidf_(ga) * ya[(size_t)r * D + c] + sigmoidf_(gb) * yb); } };
struct EPres { const float* x; float* x1; __device__ void operator()(int r, int c, float v) const { x1[(size_t)r * D + c] = x[(size_t)r * D + c] + v; } };

__global__ void __launch_bounds__(256) k_conv(const bf16_t* __restrict__ z, const float* __restrict__ cq, const float* __restrict__ ck, bf16_t* __restrict__ qa, bf16_t* __restrict__ ka) {
    const size_t idx = (size_t)blockIdx.x * 256 + threadIdx.x;
    const int t = (int)(idx >> 9), c = (int)(idx & 511), s = t % SEQ;
    float aq = 0.f, ak = 0.f;
#pragma unroll
    for (int j = 0; j < 4; ++j) {
        const int ss = s - 3 + j;
        if (ss >= 0) {
            const size_t r = (size_t)(t - 3 + j) * NZ;
            aq += bf2f(z[r + 512 + c]) * cq[j * DM + c];
            ak += bf2f(z[r + 1024 + c]) * ck[j * DM + c];
        }
    }
    qa[idx] = f2bf(siluf_(aq));
    ka[idx] = f2bf(siluf_(ak) * 0.08838834764831845f);
}
__global__ void k_bcum(const float* __restrict__ gif, float* __restrict__ bcs) {
    const int bh = blockIdx.x * blockDim.x + threadIdx.x;
    if (bh >= BATCH * NH) return;
    const int b = bh / NH, hh = bh % NH;
    float acc = 0.f;
    for (int s = 0; s < SEQ; ++s) { acc += logsigmoidf_(gif[((size_t)b * SEQ + s) * 8 + 4 + hh]); bcs[(size_t)bh * SEQ + s] = acc; }
}
__global__ void __launch_bounds__(256) k_mlstm_naive(const bf16_t* __restrict__ qa, const bf16_t* __restrict__ ka, const bf16_t* __restrict__ z, const float* __restrict__ gif,
                                                      const float* __restrict__ bcs, const float* __restrict__ g_head, bf16_t* __restrict__ hm) {
    __shared__ float ks[32][129];
    __shared__ float vs[32][129];
    __shared__ float ws_[32];
    const int bh = blockIdx.x >> 5, qb = blockIdx.x & 31, b = bh / NH, hh = bh % NH;
    const int tid = threadIdx.x, tq = tid >> 2, part = tid & 3;
    const int t = qb * 64 + tq;
    const size_t rowq = (size_t)b * SEQ + t;
    float q[32];
#pragma unroll
    for (int j = 0; j < 32; ++j) q[j] = bf2f(qa[rowq * DM + hh * HD + part * 32 + j]);
    const float bt = bcs[(size_t)bh * SEQ + t];
    float num[32];
#pragma unroll
    for (int j = 0; j < 32; ++j) num[j] = 0.f;
    float nq = 0.f;
    for (int kb = 0; kb <= qb * 2 + 1; ++kb) {
        __syncthreads();
        for (int i = tid; i < 32 * 128; i += 256) {
            const int r = i >> 7, c = i & 127; const size_t row = (size_t)b * SEQ + kb * 32 + r;
            ks[r][c] = bf2f(ka[row * DM + hh * HD + c]);
            vs[r][c] = bf2f(z[row * NZ + 1536 + hh * HD + c]);
        }
        if (tid < 32) { const size_t row = (size_t)b * SEQ + kb * 32 + tid; ws_[tid] = gif[row * 8 + hh] - bcs[(size_t)bh * SEQ + kb * 32 + tid]; }
        __syncthreads();
        for (int s = 0; s < 32; ++s) {
            if (kb * 32 + s > t) break;
            float d = 0.f;
#pragma unroll
            for (int j = 0; j < 32; ++j) d += q[j] * ks[s][part * 32 + j];
            d += __shfl_xor(d, 1); d += __shfl_xor(d, 2);
            const float w = d * __expf(bt + ws_[s]);
            nq += w;
#pragma unroll
            for (int j = 0; j < 32; ++j) num[j] += w * vs[s][part * 32 + j];
        }
    }
    const float den = fmaxf(fabsf(nq), 1.f);
    float s1 = 0.f;
#pragma unroll
    for (int j = 0; j < 32; ++j) { num[j] /= den; s1 += num[j]; }
    s1 += __shfl_xor(s1, 1); s1 += __shfl_xor(s1, 2);
    const float mu = s1 * (1.f / HD);
    float s2 = 0.f;
#pragma unroll
    for (int j = 0; j < 32; ++j) { const float dd = num[j] - mu; s2 += dd * dd; }
    s2 += __shfl_xor(s2, 1); s2 += __shfl_xor(s2, 2);
    const float rstd = rsqrtf(s2 * (1.f / HD) + EPS);
#pragma unroll
    for (int j = 0; j < 32; ++j) {
        const int c = hh * HD + part * 32 + j;
        const float o = bf2f(z[rowq * NZ + 2048 + c]);
        hm[rowq * DM + c] = f2bf((num[j] - mu) * rstd * g_head[c] * sigmoidf_(o));
    }
}
__global__ void __launch_bounds__(256) k_pool(const bf16_t* __restrict__ z, bf16_t* __restrict__ dA) {
    const size_t idx = (size_t)blockIdx.x * 256 + threadIdx.x;
    const int t = (int)(idx >> 9), c = (int)(idx & 511), s = t % SEQ, g = c >> 7;
    const int w = 2 << g;
    const int start = max(s + 1 - w, 0), cnt = s + 1 - start;
    float acc = 0.f;
    for (int j = 0; j < cnt; ++j) acc += bf2f(z[(size_t)(t - j) * NZ + c]);
    dA[idx] = f2bf(acc / (float)cnt - bf2f(z[(size_t)t * NZ + c]));
}
__global__ void __launch_bounds__(256) k_poolmm(const bf16_t* __restrict__ dA, const float* __restrict__ w_pool, const float* __restrict__ scale, float* __restrict__ yp) {
    const size_t idx = (size_t)blockIdx.x * 256 + threadIdx.x;
    const int t = (int)(idx >> 9), j = (int)(idx & 511), g = j >> 7, jj = j & 127;
    float acc = 0.f;
    for (int c = 0; c < 128; ++c) acc += bf2f(dA[(size_t)t * DP + g * 128 + c]) * w_pool[((size_t)g * 128 + c) * 128 + jj];
    yp[idx] = acc * scale[j];
}

__global__ void __launch_bounds__(256) k_route(const float* __restrict__ x1, const float* __restrict__ g_ffn, const float* __restrict__ w_rg, const float* __restrict__ b_rg,
                                                const float* __restrict__ w_re, const float* __restrict__ b_re, float* __restrict__ rstd2, int* __restrict__ sel, float* __restrict__ gw,
                                                int* __restrict__ counts, int* __restrict__ lists) {
    const int wave = threadIdx.x >> 6, lane = threadIdx.x & 63;
    const int tok = blockIdx.x * 4 + wave;
    const float* xr = x1 + (size_t)tok * D;
    float v[16]; float s = 0.f;
#pragma unroll
    for (int j = 0; j < 16; ++j) { v[j] = xr[lane + 64 * j]; s += v[j] * v[j]; }
    s = wave_sum(s);
    const float rstd = rsqrtf(s * (1.f / D) + EPS);
    float lg[4] = {0.f, 0.f, 0.f, 0.f};
#pragma unroll
    for (int j = 0; j < 16; ++j) { const int k = lane + 64 * j; v[j] = v[j] * rstd * g_ffn[k];
#pragma unroll
        for (int o = 0; o < 4; ++o) lg[o] += v[j] * w_rg[k * NG + o]; }
#pragma unroll
    for (int o = 0; o < 4; ++o) lg[o] = wave_sum(lg[o]) + b_rg[o];
    int gs = 0; float gm = lg[0];
#pragma unroll
    for (int o = 1; o < 4; ++o) if (lg[o] > gm) { gm = lg[o]; gs = o; }
    float den = 0.f;
#pragma unroll
    for (int o = 0; o < 4; ++o) den += __expf(lg[o] - gm);
    const float pg = 1.f / den;
    float le[8];
#pragma unroll
    for (int o = 0; o < 8; ++o) le[o] = 0.f;
#pragma unroll
    for (int j = 0; j < 16; ++j) { const int k = lane + 64 * j;
#pragma unroll
        for (int o = 0; o < 8; ++o) le[o] += v[j] * w_re[k * NE + gs * EPG + o]; }
#pragma unroll
    for (int o = 0; o < 8; ++o) le[o] = wave_sum(le[o]) + b_re[gs * EPG + o];
    int i1 = 0; float m1 = le[0];
#pragma unroll
    for (int o = 1; o < 8; ++o) if (le[o] > m1) { m1 = le[o]; i1 = o; }
    int i2 = -1; float m2 = -3.0e38f;
#pragma unroll
    for (int o = 0; o < 8; ++o) if (o != i1 && le[o] > m2) { m2 = le[o]; i2 = o; }
    const float e2 = __expf(m2 - m1);
    const float p1 = 1.f / (1.f + e2), p2 = e2 / (1.f + e2);
    if (lane == 0) {
        rstd2[tok] = rstd;
        const int ea = gs * EPG + i1, eb = gs * EPG + i2;
        sel[tok * 2] = ea; sel[tok * 2 + 1] = eb;
        gw[tok * 2] = pg * p1; gw[tok * 2 + 1] = pg * p2;
        const int pa = atomicAdd(&counts[ea], 1); lists[ea * T + pa] = tok * 2;
        const int pb = atomicAdd(&counts[eb], 1); lists[eb * T + pb] = tok * 2 + 1;
    }
}
__global__ void __launch_bounds__(256) k_moe_up(const float* __restrict__ x1, const float* __restrict__ rstd2, const float* __restrict__ g_ffn, const float* __restrict__ wg, const float* __restrict__ wu,
                                                 const int* __restrict__ counts, const int* __restrict__ lists, float* __restrict__ hid) {
    const int e = blockIdx.z, rt = blockIdx.y, ct = blockIdx.x;
    const int cnt = counts[e];
    if (rt * 64 >= cnt) return;
    __shared__ float As[16][68]; __shared__ float Bg[16][68]; __shared__ float Bu[16][68];
    __shared__ int toks[64]; __shared__ float rs[64];
    const int tid = threadIdx.x, tx = tid & 15, ty = tid >> 4;
    if (tid < 64) { const int r = rt * 64 + tid; const int a = (r < cnt) ? lists[e * T + r] : -1; toks[tid] = a; rs[tid] = (a >= 0) ? rstd2[a >> 1] : 0.f; }
    __syncthreads();
    float ag[4][4], au[4][4];
#pragma unroll
    for (int i = 0; i < 4; ++i)
#pragma unroll
        for (int j = 0; j < 4; ++j) { ag[i][j] = 0.f; au[i][j] = 0.f; }
    const float* wge = wg + (size_t)e * D * DE; const float* wue = wu + (size_t)e * D * DE;
    for (int k0 = 0; k0 < D; k0 += 16) {
#pragma unroll
        for (int j = 0; j < 4; ++j) {
            const int idx = tid + j * 256; const int r = idx >> 4, kk = idx & 15;
            const int a = toks[r];
            As[kk][r] = (a >= 0) ? x1[(size_t)(a >> 1) * D + k0 + kk] * rs[r] * g_ffn[k0 + kk] : 0.f;
            const int k2 = idx >> 6, n = idx & 63;
            Bg[k2][n] = wge[(size_t)(k0 + k2) * DE + ct * 64 + n];
            Bu[k2][n] = wue[(size_t)(k0 + k2) * DE + ct * 64 + n];
        }
        __syncthreads();
#pragma unroll
        for (int kk = 0; kk < 16; ++kk) {
            float a[4], bg[4], bu[4];
#pragma unroll
            for (int i = 0; i < 4; ++i) a[i] = As[kk][ty * 4 + i];
#pragma unroll
            for (int j = 0; j < 4; ++j) { bg[j] = Bg[kk][tx * 4 + j]; bu[j] = Bu[kk][tx * 4 + j]; }
#pragma unroll
            for (int i = 0; i < 4; ++i)
#pragma unroll
                for (int j = 0; j < 4; ++j) { ag[i][j] += a[i] * bg[j]; au[i][j] += a[i] * bu[j]; }
        }
        __syncthreads();
    }
#pragma unroll
    for (int i = 0; i < 4; ++i) { const int a = toks[ty * 4 + i]; if (a < 0) continue;
#pragma unroll
        for (int j = 0; j < 4; ++j) hid[(size_t)a * DE + ct * 64 + tx * 4 + j] = siluf_(ag[i][j]) * au[i][j]; }
}
__global__ void __launch_bounds__(256) k_moe_down(const float* __restrict__ hid, const float* __restrict__ wd, const float* __restrict__ gw, const int* __restrict__ counts, const int* __restrict__ lists, bf16_t* __restrict__ yb) {
    const int e = blockIdx.z, rt = blockIdx.y, ct = blockIdx.x;
    const int cnt = counts[e];
    if (rt * 64 >= cnt) return;
    __shared__ float As[16][68]; __shared__ float Bs[16][68];
    __shared__ int toks[64];
    const int tid = threadIdx.x, tx = tid & 15, ty = tid >> 4;
    if (tid < 64) { const int r = rt * 64 + tid; toks[tid] = (r < cnt) ? lists[e * T + r] : -1; }
    __syncthreads();
    float acc[4][4];
#pragma unroll
    for (int i = 0; i < 4; ++i)
#pragma unroll
        for (int j = 0; j < 4; ++j) acc[i][j] = 0.f;
    const float* wde = wd + (size_t)e * DE * D;
    for (int k0 = 0; k0 < DE; k0 += 16) {
#pragma unroll
        for (int j = 0; j < 4; ++j) {
            const int idx = tid + j * 256; const int r = idx >> 4, kk = idx & 15;
            const int a = toks[r];
            As[kk][r] = (a >= 0) ? hid[(size_t)a * DE + k0 + kk] : 0.f;
            const int k2 = idx >> 6, n = idx & 63;
            Bs[k2][n] = wde[(size_t)(k0 + k2) * D + ct * 64 + n];
        }
        __syncthreads();
#pragma unroll
        for (int kk = 0; kk < 16; ++kk) {
            float a[4], b[4];
#pragma unroll
            for (int i = 0; i < 4; ++i) a[i] = As[kk][ty * 4 + i];
#pragma unroll
            for (int j = 0; j < 4; ++j) b[j] = Bs[kk][tx * 4 + j];
#pragma unroll
            for (int i = 0; i < 4; ++i)
#pragma unroll
                for (int j = 0; j < 4; ++j) acc[i][j] += a[i] * b[j];
        }
        __syncthreads();
    }
#pragma unroll
    for (int i = 0; i < 4; ++i) { const int a = toks[ty * 4 + i]; if (a < 0) continue; const float w = gw[a];
#pragma unroll
        for (int j = 0; j < 4; ++j) yb[(size_t)a * D + ct * 64 + tx * 4 + j] = f2bf(acc[i][j] * w); }
}
__global__ void __launch_bounds__(256) k_final(const float* __restrict__ x1, const bf16_t* __restrict__ yb, const float* __restrict__ g, float* __restrict__ out) {
    const int wave = threadIdx.x >> 6, lane = threadIdx.x & 63;
    const int tok = blockIdx.x * 4 + wave;
    float v[16]; float s = 0.f;
#pragma unroll
    for (int j = 0; j < 16; ++j) { const int k = lane + 64 * j;
        v[j] = x1[(size_t)tok * D + k] + bf2f(yb[(size_t)(tok * 2) * D + k]) + bf2f(yb[(size_t)(tok * 2 + 1) * D + k]); s += v[j] * v[j]; }
    s = wave_sum(s);
    const float rstd = rsqrtf(s * (1.f / D) + EPS);
#pragma unroll
    for (int j = 0; j < 16; ++j) { const int k = lane + 64 * j; out[(size_t)tok * D + k] = v[j] * rstd * g[k]; }
}

#define GAS __attribute__((address_space(1)))
#define LAS __attribute__((address_space(3)))
typedef short bf16x8 __attribute__((ext_vector_type(8)));
typedef float f32x4 __attribute__((ext_vector_type(4)));
typedef float f32x2 __attribute__((ext_vector_type(2)));
typedef unsigned u32x4 __attribute__((ext_vector_type(4)));
typedef unsigned u32x2 __attribute__((ext_vector_type(2)));
#define LDS_WAIT() asm volatile("s_waitcnt lgkmcnt(0)" ::: "memory")
#define VM_WAIT() asm volatile("s_waitcnt vmcnt(0)" ::: "memory")
__device__ __forceinline__ unsigned pk2(float lo, float hi) { return (unsigned)f2bf(lo) | ((unsigned)f2bf(hi) << 16); }
__device__ __forceinline__ unsigned cvt_pk_bf16(float lo, float hi) { unsigned r; asm volatile("v_cvt_pk_bf16_f32 %0, %1, %2" : "=v"(r) : "v"(lo), "v"(hi)); return r; }
__device__ __forceinline__ float u2f(unsigned u) { return __builtin_bit_cast(float, u); }
__device__ __forceinline__ float bflo(unsigned w) { return __builtin_bit_cast(float, w << 16); }
__device__ __forceinline__ float bfhi(unsigned w) { return __builtin_bit_cast(float, w & 0xffff0000u); }
constexpr float SW8 = 512.f, SX8 = 16.f, SH8 = 8.f;
__device__ __forceinline__ unsigned pk4_fp8(float a, float b, float c, float d) {
    a = __builtin_amdgcn_fmed3f(a, -448.f, 448.f); b = __builtin_amdgcn_fmed3f(b, -448.f, 448.f); c = __builtin_amdgcn_fmed3f(c, -448.f, 448.f); d = __builtin_amdgcn_fmed3f(d, -448.f, 448.f);
    unsigned w = 0u; w = __builtin_amdgcn_cvt_pk_fp8_f32(a, b, w, false); w = __builtin_amdgcn_cvt_pk_fp8_f32(c, d, w, true); return w; }
__device__ __forceinline__ float fast_exp(float x) { return __builtin_amdgcn_exp2f(x * 1.4426950408889634f); }
__device__ __forceinline__ float fast_rcp(float x) { return __builtin_amdgcn_rcpf(x); }
__device__ __forceinline__ float fsigmoid(float x) { return fast_rcp(1.f + fast_exp(-x)); }

#define XB_TMO      128
#define XB_XCNT(j)  (256  + 64 * (j))
#define XB_XSUB(j)  (1280 + 64 * (j))
#define XB_XGEN(j)  (2304 + 64 * (j))
#define XB_TOP      3328
#define XB_TOPGEN   3392
#define XCD_BAR_WORDS 3456
#define XB_SPIN_CAP (1u << 18)
__device__ __forceinline__ unsigned xb_ld(unsigned* p)              { return __hip_atomic_load(p, __ATOMIC_RELAXED, __HIP_MEMORY_SCOPE_AGENT); }
__device__ __forceinline__ unsigned xb_add(unsigned* p, unsigned v) { return __hip_atomic_fetch_add(p, v, __ATOMIC_RELAXED, __HIP_MEMORY_SCOPE_AGENT); }
__device__ __forceinline__ unsigned xb_xcc_id() { return (unsigned)__builtin_amdgcn_s_getreg((3 << 11) | 20) & 0xFu; }
#define XB_SPIN(cond, bar) do { unsigned _sp = 0; while (cond) { __builtin_amdgcn_s_sleep(1); \
    if ((++_sp & 255u) == 0u) { if (xb_ld(&(bar)[XB_TMO])) break; if (_sp > XB_SPIN_CAP) { atomicAdd(&(bar)[XB_TMO], 1u); break; } } } } while (0)
struct XcdBarrier { unsigned* bar; unsigned x; volatile LAS unsigned* st; };
__device__ __forceinline__ XcdBarrier xcd_barrier_post(unsigned* bar, volatile LAS unsigned* st) {
    XcdBarrier b; b.bar = bar; b.x = xb_xcc_id(); b.st = st;
    if (threadIdx.x == 0) (void)xb_add(&bar[XB_XCNT(b.x)], 1u);
    return b;
}
__device__ __forceinline__ void xcd_barrier_complete(unsigned* bar, unsigned x, unsigned& nloc, unsigned& nx) {
    const unsigned G = gridDim.x * gridDim.y * gridDim.z;
    unsigned sum, cnt, mine, sp = 0u;
    for (;;) {
        sum = 0u; cnt = 0u; mine = 0u;
#pragma unroll
        for (unsigned j = 0; j < 16; ++j) { const unsigned c = xb_ld(&bar[XB_XCNT(j)]); sum += c; cnt += (c > 0u) ? 1u : 0u; mine = (j == x) ? c : mine; }
        if (sum == G) break;
        __builtin_amdgcn_s_sleep(1);
        if ((++sp & 255u) == 0u) { if (xb_ld(&bar[XB_TMO])) break; if (sp > XB_SPIN_CAP) { atomicAdd(&bar[XB_TMO], 1u); break; } }
    }
    nloc = mine > 0u ? mine : 1u; nx = cnt > 0u ? cnt : 1u;
}
__device__ __forceinline__ void xcd_barrier(const XcdBarrier& b) {
    asm volatile("s_waitcnt vmcnt(0)" ::: "memory");
    __syncthreads();
    if (threadIdx.x == 0) {
        unsigned* bar = b.bar;
        __builtin_amdgcn_s_waitcnt(0);
        unsigned nloc = b.st[0], nx = b.st[1];
        if (nloc == 0u) { xcd_barrier_complete(bar, b.x, nloc, nx); b.st[0] = nloc; b.st[1] = nx; }
        const unsigned old = xb_add(&bar[XB_XSUB(b.x)], 1u);
        const unsigned gen = old / nloc;
        if (old + 1u == (gen + 1u) * nloc) {
            __builtin_amdgcn_fence(__ATOMIC_RELEASE, "agent");
            asm volatile("s_waitcnt vmcnt(0)" ::: "memory");
            const unsigned og = xb_add(&bar[XB_TOP], 1u);
            const unsigned tg = og / nx;
            if (og + 1u == (tg + 1u) * nx) xb_add(&bar[XB_TOPGEN], 1u);
            else XB_SPIN(xb_ld(&bar[XB_TOPGEN]) == tg, bar);
            __builtin_amdgcn_fence(__ATOMIC_ACQUIRE, "agent");
            xb_add(&bar[XB_XGEN(b.x)], 1u);
            asm volatile("s_waitcnt vmcnt(0)" ::: "memory");
        } else {
            XB_SPIN(xb_ld(&bar[XB_XGEN(b.x)]) == gen, bar);
            __builtin_amdgcn_fence(__ATOMIC_ACQUIRE, "agent");
            asm volatile("s_waitcnt vmcnt(0)" ::: "memory");
        }
    }
    __syncthreads();
}

namespace pg8 {
constexpr int BM = 256, BK = 64, HALF = 128, HTB = HALF * BK * 2, STAGE_BYTES = 8 * HTB, NXCD = 8, WGM = 8;
__host__ __device__ __forceinline__ int lds_byte(int r, int c) { const int st = (r >> 4) * 2 + (c >> 5), rr = r & 15, cc = c & 31, ob = rr * 64 + cc * 2; return st * 1024 + (ob ^ (((ob >> 9) & 1) << 5)); }
__host__ __device__ __forceinline__ void stage_rc(int b, int& R, int& C) { const int st = b / 1024, sb = b % 1024, swz = sb ^ (((sb >> 9) & 1) << 5); R = (st >> 1) * 16 + swz / 64; C = (st & 1) * 32 + (swz % 64) / 2; }
__host__ __device__ __forceinline__ int perm32(int rho) { const int n = rho >> 4, i = rho & 15; return 8 * (i >> 2) + 4 * n + (i & 3); }

struct Unit { const char* A; const char* B; const int* rows; int pm, pn, ex, cnt; };
struct Cfg { int K; unsigned lda, ldb; };
__device__ __forceinline__ void tile_of(int L, int nM, int nN, int& pm, int& pn) {
    const int nwg = nM * nN; int wgid = L; { const int q = nwg / NXCD, r = nwg % NXCD, xcd = wgid % NXCD, off = wgid / NXCD; wgid = (xcd < r ? xcd * (q + 1) : r * (q + 1) + (xcd - r) * q) + off; }
    const int nig = WGM * nN, gid = wgid / nig, fm = gid * WGM, gsz = (nM - fm) < WGM ? (nM - fm) : WGM;
    pm = fm + ((wgid % nig) % gsz); pn = (wgid % nig) / gsz;
}

template <class Epi, class Sched, bool GATHER>
__device__ __forceinline__ void gemm_phase(LAS unsigned char* lds, const Cfg g, const Sched& S, const Epi& E) {
    const int tid = threadIdx.x, wid = __builtin_amdgcn_readfirstlane(tid >> 6), lane = tid & 63, wr = wid >> 2, wc = wid & 3, fr = lane & 15, fq = lane >> 4;
    const int nt = g.K / BK;
    unsigned voffB[2], vA[2][2], vN[2][2]; int Rr[2]; unsigned Cb[2];
#pragma unroll
    for (int i = 0; i < 2; ++i) { int R, C; stage_rc(tid * 16 + i * 8192, R, C); const int Rb = Epi::PERM ? ((R & ~31) + perm32(R & 31)) : R;
        Rr[i] = R; Cb[i] = (unsigned)C * 2u; voffB[i] = (unsigned)Rb * g.ldb + (unsigned)C * 2u;
        vA[0][i] = (unsigned)R * g.lda + (unsigned)C * 2u; vA[1][i] = (unsigned)(R + HALF) * g.lda + (unsigned)C * 2u; vN[0][i] = vA[0][i]; vN[1][i] = vA[1][i]; }
    const size_t kstep = (size_t)(BK * 2);
    const size_t hstepB = (size_t)HALF * g.ldb;
    const unsigned ldsw = (unsigned)wid * 1024u;
    const int aoff = lds_byte(wr * 64 + fr, fq * 8), boff = lds_byte(wc * 32 + fr, fq * 8);
#define PG8_SA(b, h) (((b) * 2 + (h)) * HTB)
#define PG8_SB(b, h) ((4 + (b) * 2 + (h)) * HTB)
#define PG8_STAGE(bufoff, gbase, voff) do { _Pragma("unroll") for (int _i = 0; _i < 2; ++_i) \
        __builtin_amdgcn_global_load_lds((const unsigned*)((const char*)(gbase) + (voff)[_i]), (LAS unsigned*)(lds + (bufoff) + ldsw + _i * 8192), 16, 0, 0); } while (0)
#define PG8_STAGE_AX(bufoff, gbase, h, usenext) do { unsigned _vo[2]; _vo[0] = (usenext) ? vN[h][0] : vA[h][0]; _vo[1] = (usenext) ? vN[h][1] : vA[h][1]; PG8_STAGE(bufoff, gbase, _vo); } while (0)
#define PG8_LDA(dst, b, h) do { _Pragma("unroll") for (int m = 0; m < 4; ++m) _Pragma("unroll") for (int k = 0; k < 2; ++k) dst[m][k] = *(const LAS bf16x8*)(lds + PG8_SA(b, h) + aoff + m * 2048 + k * 1024); } while (0)
#define PG8_LDB(dst, b, h) do { _Pragma("unroll") for (int n = 0; n < 2; ++n) _Pragma("unroll") for (int k = 0; k < 2; ++k) dst[n][k] = *(const LAS bf16x8*)(lds + PG8_SB(b, h) + boff + n * 2048 + k * 1024); } while (0)
#define PG8_MMA(ai, bj, At, Bt) do { __builtin_amdgcn_s_setprio(1); _Pragma("unroll") for (int m = 0; m < 4; ++m) _Pragma("unroll") for (int n = 0; n < 2; ++n) _Pragma("unroll") for (int k = 0; k < 2; ++k) \
        acc[ai][bj][m][n] = __builtin_amdgcn_mfma_f32_16x16x32_bf16(Bt[n][k], At[m][k], acc[ai][bj][m][n], 0, 0, 0); __builtin_amdgcn_s_setprio(0); } while (0)
#define PG8_WAIT_V(n) asm volatile("s_waitcnt vmcnt(" #n ")" ::: "memory")
#define PG8_WAIT_L(n) asm volatile("s_waitcnt lgkmcnt(" #n ")" ::: "memory")
#define PG8_BAR __builtin_amdgcn_s_barrier()
#define PG8_SCHED __builtin_amdgcn_sched_barrier(0)
#define PG8_GATHER_LOAD(dst, u) do { _Pragma("unroll") for (int _h = 0; _h < 2; ++_h) _Pragma("unroll") for (int _i = 0; _i < 2; ++_i) { const int _r = _h * HALF + Rr[_i]; \
        const int _a = (_r < (u).cnt) ? ((u).rows[_r] >> 1) : 0; dst[_h][_i] = (unsigned)_a * g.lda + Cb[_i]; } } while (0)
    Unit cur, nxt; int ui = 0;
    if (!S.next(0, cur)) return;
    f32x4 acc[2][2][4][2];
#pragma unroll
    for (int a = 0; a < 2; ++a)
#pragma unroll
        for (int b = 0; b < 2; ++b)
#pragma unroll
            for (int m = 0; m < 4; ++m)
#pragma unroll
                for (int n = 0; n < 2; ++n) acc[a][b][m][n] = (f32x4){0.f, 0.f, 0.f, 0.f};
    bf16x8 At[4][2], B0[2][2], B1[2][2];
    const char* cA = cur.A; const char* cB = cur.B;
    if constexpr (GATHER) { PG8_GATHER_LOAD(vA, cur); __builtin_amdgcn_s_waitcnt(0x0F70); }
    PG8_STAGE(PG8_SB(0, 0), cB, voffB); PG8_STAGE(PG8_SB(0, 1), cB + hstepB, voffB); PG8_STAGE(PG8_SA(0, 0), cA, vA[0]); PG8_STAGE(PG8_SA(0, 1), cA, vA[1]);
    if (wr == 1) PG8_BAR;
    PG8_WAIT_V(2); PG8_BAR;
    PG8_STAGE(PG8_SB(1, 0), cB + kstep, voffB); PG8_STAGE(PG8_SA(1, 0), cA + kstep, vA[0]); PG8_STAGE(PG8_SB(1, 1), cB + hstepB + kstep, voffB);
    PG8_WAIT_V(6); PG8_BAR;
    for (;;) {
        const bool has_next = S.next(ui + 1, nxt);
        const char* nA = has_next ? nxt.A : cA; const char* nB = has_next ? nxt.B : cB;
        if constexpr (GATHER) {
            if (has_next) { PG8_GATHER_LOAD(vN, nxt); __builtin_amdgcn_s_waitcnt(0x0F70); }
            else {
#pragma unroll
                for (int h = 0; h < 2; ++h)
#pragma unroll
                    for (int i = 0; i < 2; ++i) vN[h][i] = vA[h][i]; }
        }
        for (int t = 0; t < nt; t += 2) {
            const bool last = (t == nt - 2);
            const char* a1 = cA + (size_t)(t + 1) * kstep;
            const char* a2 = last ? nA : cA + (size_t)(t + 2) * kstep; const char* b2 = last ? nB : cB + (size_t)(t + 2) * kstep;
            const char* a3 = a2 + kstep; const char* b3 = b2 + kstep;
            const bool un = GATHER && last;
            PG8_LDB(B0, 0, 0); PG8_LDB(B1, 0, 1); PG8_SCHED; PG8_LDA(At, 0, 0); PG8_STAGE(PG8_SA(1, 1), a1, vA[1]);
            PG8_WAIT_V(8); PG8_WAIT_L(0); PG8_BAR; PG8_MMA(0, 0, At, B0); PG8_MMA(0, 1, At, B1); PG8_BAR; PG8_SCHED;
            PG8_LDA(At, 0, 1); PG8_STAGE(PG8_SB(0, 0), b2, voffB); PG8_STAGE(PG8_SB(0, 1), b2 + hstepB, voffB); PG8_STAGE_AX(PG8_SA(0, 0), a2, 0, un);
            PG8_WAIT_V(8); PG8_WAIT_L(0); PG8_BAR; PG8_MMA(1, 0, At, B0); PG8_MMA(1, 1, At, B1); PG8_BAR; PG8_SCHED;
            PG8_LDB(B0, 1, 0); PG8_LDB(B1, 1, 1); PG8_SCHED; PG8_LDA(At, 1, 0); PG8_STAGE_AX(PG8_SA(0, 1), a2, 1, un);
            PG8_WAIT_V(8); PG8_WAIT_L(0); PG8_BAR; PG8_MMA(0, 0, At, B0); PG8_MMA(0, 1, At, B1); PG8_BAR; PG8_SCHED;
            PG8_LDA(At, 1, 1); PG8_STAGE(PG8_SB(1, 0), b3, voffB); PG8_STAGE(PG8_SB(1, 1), b3 + hstepB, voffB); PG8_STAGE_AX(PG8_SA(1, 0), a3, 0, un);
            PG8_WAIT_V(8); PG8_WAIT_L(0); PG8_BAR; PG8_MMA(1, 0, At, B0); PG8_MMA(1, 1, At, B1); PG8_BAR; PG8_SCHED;
        }
        if (wr == 0) PG8_BAR;
        const bool keep = E(acc, cur, wr, wc, fr, fq);
        if (!has_next) break;
        if (!keep) {
#pragma unroll
        for (int a = 0; a < 2; ++a)
#pragma unroll
            for (int b = 0; b < 2; ++b)
#pragma unroll
                for (int m = 0; m < 4; ++m)
#pragma unroll
                    for (int n = 0; n < 2; ++n) acc[a][b][m][n] = (f32x4){0.f, 0.f, 0.f, 0.f};
        }
        cur = nxt; cA = nA; cB = nB; ++ui;
        if constexpr (GATHER) {
#pragma unroll
            for (int h = 0; h < 2; ++h)
#pragma unroll
                for (int i = 0; i < 2; ++i) vA[h][i] = vN[h][i]; }
        if (wr == 1) PG8_BAR;
    }
    PG8_WAIT_V(0);
    PG8_BAR;
#undef PG8_SA
#undef PG8_SB
#undef PG8_STAGE
#undef PG8_STAGE_AX
#undef PG8_LDA
#undef PG8_LDB
#undef PG8_MMA
#undef PG8_WAIT_V
#undef PG8_WAIT_L
#undef PG8_BAR
#undef PG8_SCHED
#undef PG8_GATHER_LOAD
}
}


typedef int v8i_t __attribute__((ext_vector_type(8)));
typedef int v4i_t __attribute__((ext_vector_type(4)));
namespace pg8 {
struct UnitM { const char* A; const char* B; const int* rows; int blk, pn, ex, cnt, type; };
template <class Sched, class Epi0, class Epi1>
__device__ __forceinline__ void gemm_phase_moe(LAS unsigned char* lds, LAS unsigned char* meta, const Sched& S, const Epi0& E0, const Epi1& E1) {
    const int tid = threadIdx.x, wid = __builtin_amdgcn_readfirstlane(tid >> 6), lane = tid & 63, wr = wid >> 2, wc = wid & 3, fr = lane & 15, fq = lane >> 4;
    unsigned vA[2][2], vN[2][2], vB[2];
    const size_t kstep = (size_t)(BK * 2);
    const unsigned ldsw = (unsigned)wid * 1024u;
    const int aoff = lds_byte(wr * 64 + fr, fq * 8), boff = lds_byte(wc * 32 + fr, fq * 8);
#define PG8_SA(b, h) (((b) * 2 + (h)) * HTB)
#define PG8_SB(b, h) ((4 + (b) * 2 + (h)) * HTB)
#define PG8_STAGE_A(bufoff, gbase, voff) do { _Pragma("unroll") for (int _i = 0; _i < 2; ++_i) \
        __builtin_amdgcn_global_load_lds((const unsigned*)((const char*)(gbase) + (voff)[_i]), (LAS unsigned*)(lds + (bufoff) + ldsw + _i * 8192), 16, 0, 16); } while (0)
#define PG8_STAGE_B(bufoff, gbase, voff) do { _Pragma("unroll") for (int _i = 0; _i < 2; ++_i) \
        __builtin_amdgcn_global_load_lds((const unsigned*)((const char*)(gbase) + (voff)[_i]), (LAS unsigned*)(lds + (bufoff) + ldsw + _i * 8192), 16, 0, 0); } while (0)
#define PG8_STAGE_AX(bufoff, gbase, h, usenext) do { unsigned _vo[2]; _vo[0] = (usenext) ? vN[h][0] : vA[h][0]; _vo[1] = (usenext) ? vN[h][1] : vA[h][1]; PG8_STAGE_A(bufoff, gbase, _vo); } while (0)
#define PG8_STAGE_BX(bufoff, gbase, usenext) do { unsigned _vo[2]; _vo[0] = (usenext) ? vBn[0] : vB[0]; _vo[1] = (usenext) ? vBn[1] : vB[1]; PG8_STAGE_B(bufoff, gbase, _vo); } while (0)
#define PG8_LD32(p) __builtin_shufflevector(*(const LAS v4i_t*)(p), *(const LAS v4i_t*)((p) + 1024), 0, 1, 2, 3, 4, 5, 6, 7)
#define PG8_LDA(dst, b, h) do { _Pragma("unroll") for (int m = 0; m < 4; ++m) dst[m] = PG8_LD32(lds + PG8_SA(b, h) + aoff + m * 2048); } while (0)
#define PG8_LDB(dst, b, h) do { _Pragma("unroll") for (int n = 0; n < 2; ++n) dst[n] = PG8_LD32(lds + PG8_SB(b, h) + boff + n * 2048); } while (0)
#define PG8_MMA(ai, bj, At, Bt) do { __builtin_amdgcn_s_setprio(1); _Pragma("unroll") for (int m = 0; m < 4; ++m) _Pragma("unroll") for (int n = 0; n < 2; ++n) { \
        acc[ai][bj][m][n] = __builtin_amdgcn_mfma_scale_f32_16x16x128_f8f6f4(Bt[n], At[m], acc[ai][bj][m][n], 0, 0, 0, 0x7F7F7F7F, 0, 0x7F7F7F7F); asm volatile("" : "+v"(acc[ai][bj][m][n])); }     \
        __builtin_amdgcn_s_setprio(0); } while (0)
#define PG8_WAIT_V(n) asm volatile("s_waitcnt vmcnt(" #n ")" ::: "memory")
#define PG8_WAIT_L(n) asm volatile("s_waitcnt lgkmcnt(" #n ")" ::: "memory")
#define PG8_BAR __builtin_amdgcn_s_barrier()
#define PG8_SCHED __builtin_amdgcn_sched_barrier(0)
#define PG8_SETUP(u, vAx, vBx) do { const unsigned _ld = (u).type ? 512u : 1024u; \
        _Pragma("unroll") for (int _i = 0; _i < 2; ++_i) { int _R, _C; stage_rc(tid * 16 + _i * 8192, _R, _C); asm volatile("" : "+v"(_R), "+v"(_C)); const unsigned _cb = (unsigned)_C * 2u; \
            _Pragma("unroll") for (int _h = 0; _h < 2; ++_h) { const int _r = _h * HALF + _R; \
                const int _a = (u).type ? _r : ((_r < (u).cnt) ? ((u).rows[_r] >> 1) : 0); vAx[_h][_i] = (unsigned)_a * _ld + _cb; } \
            vBx[_i] = (unsigned)((_R & ~31) + perm32(_R & 31)) * _ld + _cb; } } while (0)
#define PG8_META(u, n) do { if (tid < 256) { u32x4 _mv = (u32x4){0xFFFFFFFFu, 0u, 0u, 0u}; \
        if (tid < (u).cnt) { const u32x2 _w2 = ((const u32x2*)S.rwlist)[((u).rows - S.alist) + tid]; _mv.x = (unsigned)(u).rows[tid]; _mv.y = _w2.x; _mv.z = _w2.y; } \
        *(LAS u32x4*)(meta + (((n) & 1) * 256 + tid) * 16) = _mv; } } while (0)
#define PG8_PUBLISH() do { if (pend >= 0) { if (lane == 0) __hip_atomic_fetch_add(S.ready + pend, 1u, __ATOMIC_RELAXED, __HIP_MEMORY_SCOPE_AGENT); pend = -1; } } while (0)
    int pend = -1;
    UnitM cur, nxt; int ui = 0;
    bool have = S.next(0, cur);
    f32x4 acc[2][2][4][2];
    v8i_t At[4], B0[2], B1[2];
    while (have) {
#pragma unroll
        for (int a = 0; a < 2; ++a)
#pragma unroll
            for (int b = 0; b < 2; ++b)
#pragma unroll
                for (int m = 0; m < 4; ++m)
#pragma unroll
                    for (int n = 0; n < 2; ++n) acc[a][b][m][n] = (f32x4){0.f, 0.f, 0.f, 0.f};
        const char* cA = cur.A; const char* cB = cur.B; size_t hB = cur.type ? (size_t)HALF * 512 : (size_t)HALF * 1024;
        PG8_SETUP(cur, vA, vB); PG8_META(cur, ui); __builtin_amdgcn_s_waitcnt(0x0F70); asm volatile("s_waitcnt vmcnt(0)" ::: "memory"); PG8_PUBLISH();
        if (cur.type) S.wait_ready(cur);
        PG8_STAGE_B(PG8_SB(0, 0), cB, vB); PG8_STAGE_B(PG8_SB(0, 1), cB + hB, vB); PG8_STAGE_A(PG8_SA(0, 0), cA, vA[0]); PG8_STAGE_A(PG8_SA(0, 1), cA, vA[1]);
        if (wr == 1) PG8_BAR;
        PG8_WAIT_V(2); PG8_BAR;
        PG8_STAGE_B(PG8_SB(1, 0), cB + kstep, vB); PG8_STAGE_A(PG8_SA(1, 0), cA + kstep, vA[0]); PG8_STAGE_B(PG8_SB(1, 1), cB + hB + kstep, vB);
        PG8_WAIT_V(6); PG8_BAR;
        bool has_next;
        for (;;) {
            has_next = S.next(ui + 1, nxt);
            const bool chain = has_next && nxt.type == cur.type;
            const char* nA = chain ? nxt.A : cA; const char* nB = chain ? nxt.B : cB;
            if (chain) { unsigned vBn[2]; PG8_SETUP(nxt, vN, vBn); PG8_META(nxt, ui + 1); __builtin_amdgcn_s_waitcnt(0x0F70); asm volatile("s_waitcnt vmcnt(0)" ::: "memory"); PG8_PUBLISH(); }
            else {
                if (pend >= 0) { asm volatile("s_waitcnt vmcnt(0)" ::: "memory"); PG8_PUBLISH(); }
#pragma unroll
                for (int h = 0; h < 2; ++h)
#pragma unroll
                    for (int i = 0; i < 2; ++i) vN[h][i] = vA[h][i]; }
            const int nt = cur.type ? 4 : 8;
            for (int t = 0; t < nt; t += 2) {
                const bool last = (t == nt - 2);
                if (last && chain && nxt.type) S.wait_ready(nxt);
                const char* a1 = cA + (size_t)(t + 1) * kstep;
                const char* a2 = last ? nA : cA + (size_t)(t + 2) * kstep; const char* b2 = last ? nB : cB + (size_t)(t + 2) * kstep; const size_t hB2 = hB;
                const char* a3 = a2 + kstep; const char* b3 = b2 + kstep;
                PG8_LDB(B0, 0, 0); PG8_LDB(B1, 0, 1); PG8_SCHED; PG8_LDA(At, 0, 0); PG8_STAGE_A(PG8_SA(1, 1), a1, vA[1]);
                PG8_WAIT_V(8); PG8_WAIT_L(0); PG8_BAR; PG8_MMA(0, 0, At, B0); PG8_MMA(0, 1, At, B1); PG8_BAR; PG8_SCHED;
                PG8_LDA(At, 0, 1); PG8_STAGE_B(PG8_SB(0, 0), b2, vB); PG8_STAGE_B(PG8_SB(0, 1), b2 + hB2, vB); PG8_STAGE_AX(PG8_SA(0, 0), a2, 0, last);
                PG8_WAIT_V(8); PG8_WAIT_L(0); PG8_BAR; PG8_MMA(1, 0, At, B0); PG8_MMA(1, 1, At, B1); PG8_BAR; PG8_SCHED;
                PG8_LDB(B0, 1, 0); PG8_LDB(B1, 1, 1); PG8_SCHED; PG8_LDA(At, 1, 0); PG8_STAGE_AX(PG8_SA(0, 1), a2, 1, last);
                PG8_WAIT_V(8); PG8_WAIT_L(0); PG8_BAR; PG8_MMA(0, 0, At, B0); PG8_MMA(0, 1, At, B1); PG8_BAR; PG8_SCHED;
                PG8_LDA(At, 1, 1); PG8_STAGE_B(PG8_SB(1, 0), b3, vB); PG8_STAGE_B(PG8_SB(1, 1), b3 + hB2, vB); PG8_STAGE_AX(PG8_SA(1, 0), a3, 0, last);
                PG8_WAIT_V(8); PG8_WAIT_L(0); PG8_BAR; PG8_MMA(1, 0, At, B0); PG8_MMA(1, 1, At, B1); PG8_BAR; PG8_SCHED;
            }
            if (wr == 0) PG8_BAR;
            if (cur.type == 0) { E0(acc, cur, wr, wc, fr, fq, meta + (ui & 1) * 4096); pend = cur.blk; } else E1(acc, cur, wr, wc, fr, fq, meta + (ui & 1) * 4096);
            if (!chain) break;
#pragma unroll
            for (int a = 0; a < 2; ++a)
#pragma unroll
                for (int b = 0; b < 2; ++b)
#pragma unroll
                    for (int m = 0; m < 4; ++m)
#pragma unroll
                        for (int n = 0; n < 2; ++n) acc[a][b][m][n] = (f32x4){0.f, 0.f, 0.f, 0.f};
            cur = nxt; cA = nA; cB = nB; ++ui;
#pragma unroll
            for (int h = 0; h < 2; ++h)
#pragma unroll
                for (int i = 0; i < 2; ++i) vA[h][i] = vN[h][i];
            if (wr == 1) PG8_BAR;
        }
        PG8_WAIT_V(0); PG8_PUBLISH();
        PG8_BAR;
        have = has_next; cur = nxt; ++ui;
    }
#undef PG8_SA
#undef PG8_SB
#undef PG8_STAGE_A
#undef PG8_STAGE_B
#undef PG8_STAGE_AX
#undef PG8_STAGE_BX
#undef PG8_LDA
#undef PG8_LD32
#undef PG8_LDB
#undef PG8_MMA
#undef PG8_WAIT_V
#undef PG8_WAIT_L
#undef PG8_BAR
#undef PG8_SCHED
#undef PG8_SETUP
#undef PG8_PUBLISH
}

struct UnitX { const char* A; const char* B; int pm, pn, ld, fp8; };
template <bool FP8, class Sched, class Epi>
__device__ __forceinline__ bool mix_segment(LAS unsigned char* lds, const Sched& S, const Epi& E, UnitX& cur, int& ui) {
    const int tid = threadIdx.x, wid = __builtin_amdgcn_readfirstlane(tid >> 6), lane = tid & 63, wr = wid >> 2, wc = wid & 3, fr = lane & 15, fq = lane >> 4;
    unsigned vA[2][2], vB[2];
    const size_t kstep = (size_t)(BK * 2);
    const unsigned ldsw = (unsigned)wid * 1024u;
    const int aoff = lds_byte(wr * 64 + fr, fq * 8), boff = lds_byte(wc * 32 + fr, fq * 8);
#define PG8_SA(b, h) (((b) * 2 + (h)) * HTB)
#define PG8_SB(b, h) ((4 + (b) * 2 + (h)) * HTB)
#define PG8_STAGE(bufoff, gbase, voff) do { _Pragma("unroll") for (int _i = 0; _i < 2; ++_i) \
        __builtin_amdgcn_global_load_lds((const unsigned*)((const char*)(gbase) + (voff)[_i]), (LAS unsigned*)(lds + (bufoff) + ldsw + _i * 8192), 16, 0, 0); } while (0)
#define PG8_LD32(p) __builtin_shufflevector(*(const LAS v4i_t*)(p), *(const LAS v4i_t*)((p) + 1024), 0, 1, 2, 3, 4, 5, 6, 7)
#define PG8_LDA(dst, b, h) do { _Pragma("unroll") for (int m = 0; m < 4; ++m) dst[m] = PG8_LD32(lds + PG8_SA(b, h) + aoff + m * 2048); } while (0)
#define PG8_LDB(dst, b, h) do { _Pragma("unroll") for (int n = 0; n < 2; ++n) dst[n] = PG8_LD32(lds + PG8_SB(b, h) + boff + n * 2048); } while (0)
#define PG8_H0(v) __builtin_bit_cast(bf16x8, __builtin_shufflevector(v, v, 0, 1, 2, 3))
#define PG8_H1(v) __builtin_bit_cast(bf16x8, __builtin_shufflevector(v, v, 4, 5, 6, 7))
#define PG8_MMA(ai, bj, At, Bt) do { __builtin_amdgcn_s_setprio(1); \
        if (FP8) { _Pragma("unroll") for (int m = 0; m < 4; ++m) _Pragma("unroll") for (int n = 0; n < 2; ++n) { \
            acc[ai][bj][m][n] = __builtin_amdgcn_mfma_scale_f32_16x16x128_f8f6f4(Bt[n], At[m], acc[ai][bj][m][n], 0, 0, 0, 0x7F7F7F7F, 0, 0x7F7F7F7F); asm volatile("" : "+v"(acc[ai][bj][m][n])); } } \
        else { _Pragma("unroll") for (int m = 0; m < 4; ++m) _Pragma("unroll") for (int n = 0; n < 2; ++n) { \
            acc[ai][bj][m][n] = __builtin_amdgcn_mfma_f32_16x16x32_bf16(PG8_H0(Bt[n]), PG8_H0(At[m]), acc[ai][bj][m][n], 0, 0, 0); \
            acc[ai][bj][m][n] = __builtin_amdgcn_mfma_f32_16x16x32_bf16(PG8_H1(Bt[n]), PG8_H1(At[m]), acc[ai][bj][m][n], 0, 0, 0); asm volatile("" : "+v"(acc[ai][bj][m][n])); } } \
        __builtin_amdgcn_s_setprio(0); } while (0)
#define PG8_WAIT_V(n) asm volatile("s_waitcnt vmcnt(" #n ")" ::: "memory")
#define PG8_WAIT_L(n) asm volatile("s_waitcnt lgkmcnt(" #n ")" ::: "memory")
#define PG8_BAR __builtin_amdgcn_s_barrier()
#define PG8_SCHED __builtin_amdgcn_sched_barrier(0)
    {
        const unsigned ld = (unsigned)cur.ld;
#pragma unroll
        for (int i = 0; i < 2; ++i) { int R, C; stage_rc(tid * 16 + i * 8192, R, C); const unsigned cb = (unsigned)C * 2u;
            vA[0][i] = (unsigned)R * ld + cb; vA[1][i] = (unsigned)(HALF + R) * ld + cb; vB[i] = (unsigned)((R & ~31) + perm32(R & 31)) * ld + cb; }
    }
    UnitX nxt; bool has_next = false;
    f32x4 acc[2][2][4][2];
    v8i_t At[4], B0[2], B1[2];
#pragma unroll
    for (int a = 0; a < 2; ++a)
#pragma unroll
        for (int b = 0; b < 2; ++b)
#pragma unroll
            for (int m = 0; m < 4; ++m)
#pragma unroll
                for (int n = 0; n < 2; ++n) acc[a][b][m][n] = (f32x4){0.f, 0.f, 0.f, 0.f};
    const char* cA = cur.A; const char* cB = cur.B; const size_t hB = (size_t)HALF * cur.ld;
    const int nt = cur.ld >> 7;
    PG8_STAGE(PG8_SB(0, 0), cB, vB); PG8_STAGE(PG8_SB(0, 1), cB + hB, vB); PG8_STAGE(PG8_SA(0, 0), cA, vA[0]); PG8_STAGE(PG8_SA(0, 1), cA, vA[1]);
    if (wr == 1) PG8_BAR;
    PG8_WAIT_V(2); PG8_BAR;
    PG8_STAGE(PG8_SB(1, 0), cB + kstep, vB); PG8_STAGE(PG8_SA(1, 0), cA + kstep, vA[0]); PG8_STAGE(PG8_SB(1, 1), cB + hB + kstep, vB);
    PG8_WAIT_V(6); PG8_BAR;
    for (;;) {
        has_next = S.next(ui + 1, nxt);
        const bool chain = has_next && nxt.ld == cur.ld && nxt.fp8 == cur.fp8;
        const char* nA = chain ? nxt.A : cA; const char* nB = chain ? nxt.B : cB;
        for (int t = 0; t < nt; t += 2) {
            const bool last = (t == nt - 2);
            const char* a1 = cA + (size_t)(t + 1) * kstep;
            const char* a2 = last ? nA : cA + (size_t)(t + 2) * kstep; const char* b2 = last ? nB : cB + (size_t)(t + 2) * kstep;
            const char* a3 = a2 + kstep; const char* b3 = b2 + kstep;
            PG8_LDB(B0, 0, 0); PG8_LDB(B1, 0, 1); PG8_SCHED; PG8_LDA(At, 0, 0); PG8_STAGE(PG8_SA(1, 1), a1, vA[1]);
            PG8_WAIT_V(8); PG8_WAIT_L(0); PG8_BAR; PG8_MMA(0, 0, At, B0); PG8_MMA(0, 1, At, B1); PG8_BAR; PG8_SCHED;
            PG8_LDA(At, 0, 1); PG8_STAGE(PG8_SB(0, 0), b2, vB); PG8_STAGE(PG8_SB(0, 1), b2 + hB, vB); PG8_STAGE(PG8_SA(0, 0), a2, vA[0]);
            PG8_WAIT_V(8); PG8_WAIT_L(0); PG8_BAR; PG8_MMA(1, 0, At, B0); PG8_MMA(1, 1, At, B1); PG8_BAR; PG8_SCHED;
            PG8_LDB(B0, 1, 0); PG8_LDB(B1, 1, 1); PG8_SCHED; PG8_LDA(At, 1, 0); PG8_STAGE(PG8_SA(0, 1), a2, vA[1]);
            PG8_WAIT_V(8); PG8_WAIT_L(0); PG8_BAR; PG8_MMA(0, 0, At, B0); PG8_MMA(0, 1, At, B1); PG8_BAR; PG8_SCHED;
            PG8_LDA(At, 1, 1); PG8_STAGE(PG8_SB(1, 0), b3, vB); PG8_STAGE(PG8_SB(1, 1), b3 + hB, vB); PG8_STAGE(PG8_SA(1, 0), a3, vA[0]);
            PG8_WAIT_V(8); PG8_WAIT_L(0); PG8_BAR; PG8_MMA(1, 0, At, B0); PG8_MMA(1, 1, At, B1); PG8_BAR; PG8_SCHED;
        }
        if (wr == 0) PG8_BAR;
        E(acc, cur, wr, wc, fr, fq);
        if (!chain) break;
#pragma unroll
        for (int a = 0; a < 2; ++a)
#pragma unroll
            for (int b = 0; b < 2; ++b)
#pragma unroll
                for (int m = 0; m < 4; ++m)
#pragma unroll
                    for (int n = 0; n < 2; ++n) acc[a][b][m][n] = (f32x4){0.f, 0.f, 0.f, 0.f};
        cur = nxt; cA = nA; cB = nB; ++ui;
        if (wr == 1) PG8_BAR;
    }
    PG8_WAIT_V(0);
    PG8_BAR;
    cur = nxt; ++ui;
    return has_next;
#undef PG8_SA
#undef PG8_SB
#undef PG8_STAGE
#undef PG8_LD32
#undef PG8_LDA
#undef PG8_LDB
#undef PG8_H0
#undef PG8_H1
#undef PG8_MMA
#undef PG8_WAIT_V
#undef PG8_WAIT_L
#undef PG8_BAR
#undef PG8_SCHED
}
template <class Sched, class Epi>
__device__ __forceinline__ void gemm_phase_mix(LAS unsigned char* lds, const Sched& S, const Epi& E) {
    UnitX cur; int ui = 0;
    bool have = S.next(0, cur);
    while (have) have = cur.fp8 ? mix_segment<true>(lds, S, E, cur, ui) : mix_segment<false>(lds, S, E, cur, ui);
}
}

#ifndef MOE_DYN
#define MOE_DYN 1
#endif
#ifndef PROBE_PHASE
#define PROBE_PHASE -1
#endif
#define REP(k) _Pragma("nounroll") for (int _r = 0; _r < ((PROBE_PHASE == (k)) ? 2 : 1); ++_r)
constexpr int NWAVES = 8;
constexpr size_t WS_CTL = 0, CTL_ZERO_BYTES = 64 * 1024;
constexpr size_t WS_GIF = 1 * MiB;
constexpr size_t WS_NLOC = 1 * MiB + 512 * 1024;
constexpr size_t WS_SCAL = 2 * MiB;
constexpr size_t WS_GW = 2 * MiB + 256 * 1024;
constexpr size_t WS_ALIST = 4 * MiB;
constexpr size_t WS_RWLIST = 6 * MiB;
constexpr size_t WS_WR = 3 * MiB + 512 * 1024;
constexpr size_t WS_RSTD2 = 3 * MiB, WS_SEL = 3 * MiB + 256 * 1024;
constexpr size_t WS_WZ = 10 * MiB, WS_W2T = 19 * MiB, WS_WBT = 20 * MiB, WS_WOT = 21 * MiB, WS_WUP = 23 * MiB, WS_WDN = 87 * MiB;
constexpr size_t WS_Z = 119 * MiB;
constexpr size_t WS_KACT = 263 * MiB;
constexpr size_t WS_END = 279 * MiB;
constexpr size_t WS_GATES = WS_Z + 80 * MiB;
constexpr size_t WS_X1Q = WS_Z;
constexpr size_t WS_X1 = WS_Z, WS_X1B = WS_Z + 64 * MiB, WS_HID = WS_Z + 96 * MiB;
constexpr size_t OB_H8 = 32 * MiB;
constexpr size_t WS_WZ8 = WS_WZ + (size_t)2560 * D * 2;
constexpr size_t OB_H = 0, OB_C = 0, OB_DA = 32 * MiB, OB_HM = 48 * MiB, OB_MERGED = 0;
constexpr int CW_CNT = 64;
constexpr int CW_Q = 1024;
constexpr int CW_READY = 2048;
constexpr int CW_TMO = 8;
constexpr int CW_BAR = 4096;
constexpr int META_OFF = 131072 + 320 + 2048;
constexpr int TAB_CNT = 16, TAB_CUM = 48, TAB_HIST = 96, TAB_BASE = 128, TAB_Q = 160, TAB_XS = 164, TAB_BLK = 176;
constexpr int RING_OFF = 0, RING_BYTES = 131072, LDSCTL_OFF = RING_BYTES, MISC_OFF = LDSCTL_OFF + 320, LDS_BYTES = 147456;

struct Args { const float* in[21]; float* out; unsigned char* ws; int ph_lo, ph_hi, li, flags; };

struct SchedDense {
    const char* A; const char* B; size_t astep, bstep; int nM, nN, G, c, rep;
    __device__ __forceinline__ bool next(int i, pg8::Unit& u) const {
        long L = (long)i * G + c; if (L >= (long)nM * nN * rep) return false; L %= (long)nM * nN;
        int pm, pn; pg8::tile_of((int)L, nM, nN, pm, pn);
        u.pm = pm; u.pn = pn; u.ex = 0; u.cnt = 256; u.rows = nullptr; u.A = A + (size_t)pm * astep; u.B = B + (size_t)pn * bstep; return true; }
};
struct EpiZ {
    static constexpr bool PERM = true;
    bf16_t* z; unsigned char* gates;
    __device__ __forceinline__ bool operator()(f32x4 (&acc)[2][2][4][2], const pg8::Unit& u, int wr, int wc, int fr, int fq) const {
        const int row0 = u.pm * 256 + wr * 64 + fr, col0 = u.pn * 256 + wc * 32 + 8 * fq;
        if (u.pn >= 10) {
            const int gc0 = col0 - 2560; const float lo = (gc0 >= 1024) ? 1.f : 0.f;
#pragma unroll
            for (int ai = 0; ai < 2; ++ai)
#pragma unroll
                for (int m = 0; m < 4; ++m) { const size_t row = (size_t)(row0 + ai * 128 + m * 16);
#pragma unroll
                    for (int bj = 0; bj < 2; ++bj) { const f32x4 v0 = acc[ai][bj][m][0], v1 = acc[ai][bj][m][1]; unsigned w0 = 0u, w1 = 0u;
#pragma unroll
                        for (int q = 0; q < 4; ++q) { w0 = __builtin_amdgcn_cvt_pk_u8_f32(fmaxf(fsigmoid(v0[q]) * 255.f, lo), q, w0); w1 = __builtin_amdgcn_cvt_pk_u8_f32(fmaxf(fsigmoid(v1[q]) * 255.f, lo), q, w1); }
                        *(u32x2*)(gates + row * 2048 + gc0 + bj * 128) = (u32x2){w0, w1}; } }
            return false;
        }
#pragma unroll
        for (int ai = 0; ai < 2; ++ai)
#pragma unroll
            for (int m = 0; m < 4; ++m) { const size_t row = (size_t)(row0 + ai * 128 + m * 16);
#pragma unroll
                for (int bj = 0; bj < 2; ++bj) { const f32x4 v0 = acc[ai][bj][m][0], v1 = acc[ai][bj][m][1]; u32x4 w;
                    w.x = cvt_pk_bf16(v0[0], v0[1]); w.y = cvt_pk_bf16(v0[2], v0[3]); w.z = cvt_pk_bf16(v1[0], v1[1]); w.w = cvt_pk_bf16(v1[2], v1[3]);
                    *(u32x4*)(z + zoff(row, col0 + bj * 128)) = w; } }
        return false;
    }
};


struct SchedP1X {
    const char* h; const char* h8; const char* wz; const char* wz8; int nM, nN, G, c;
    __device__ __forceinline__ bool next(int i, pg8::UnitX& u) const {
        const long L = (long)i * G + c; if (L >= (long)nM * nN) return false;
        int pm, pn; pg8::tile_of((int)L, nM, nN, pm, pn);
        u.pm = pm; u.pn = pn; u.fp8 = pn >= 10;
        if (u.fp8) { u.ld = D; u.A = h8 + (size_t)pm * 256 * D; u.B = wz8 + (size_t)(pn - 10) * 256 * D; }
        else { u.ld = D * 2; u.A = h + (size_t)pm * 256 * D * 2; u.B = wz + (size_t)pn * 256 * D * 2; }
        return true; }
};
struct EpiZX {
    bf16_t* z; unsigned char* gates;
    __device__ __forceinline__ void operator()(f32x4 (&acc)[2][2][4][2], const pg8::UnitX& u, int wr, int wc, int fr, int fq) const {
        asm volatile("" : "+v"(fr), "+v"(fq));
        const int row0 = u.pm * 256 + wr * 64 + fr, col0 = u.pn * 256 + wc * 32 + 8 * fq;
        if (u.pn >= 10) {
            const int gc0 = col0 - 2560; const float lo = (gc0 >= 1024) ? 1.f : 0.f; constexpr float ds = 1.f / (SX8 * SW8);
#pragma unroll
            for (int ai = 0; ai < 2; ++ai)
#pragma unroll
                for (int m = 0; m < 4; ++m) { const size_t row = (size_t)(row0 + ai * 128 + m * 16);
#pragma unroll
                    for (int bj = 0; bj < 2; ++bj) { const f32x4 v0 = acc[ai][bj][m][0] * ds, v1 = acc[ai][bj][m][1] * ds; unsigned w0 = 0u, w1 = 0u;
#pragma unroll
                        for (int q = 0; q < 4; ++q) { w0 = __builtin_amdgcn_cvt_pk_u8_f32(fmaxf(fsigmoid(v0[q]) * 255.f, lo), q, w0); w1 = __builtin_amdgcn_cvt_pk_u8_f32(fmaxf(fsigmoid(v1[q]) * 255.f, lo), q, w1); }
                        *(u32x2*)(gates + row * 2048 + gc0 + bj * 128) = (u32x2){w0, w1}; } }
            return;
        }
#pragma unroll
        for (int ai = 0; ai < 2; ++ai)
#pragma unroll
            for (int m = 0; m < 4; ++m) { const size_t row = (size_t)(row0 + ai * 128 + m * 16);
#pragma unroll
                for (int bj = 0; bj < 2; ++bj) { const f32x4 v0 = acc[ai][bj][m][0], v1 = acc[ai][bj][m][1]; u32x4 w;
                    w.x = cvt_pk_bf16(v0[0], v0[1]); w.y = cvt_pk_bf16(v0[2], v0[3]); w.z = cvt_pk_bf16(v1[0], v1[1]); w.w = cvt_pk_bf16(v1[2], v1[3]);
                    *(u32x4*)(z + zoff(row, col0 + bj * 128)) = w; } }
    }
};
struct SchedMerge {
    const char* A0; const char* A1; const char* B0; const char* B1; int nM, nN, G, c;
    __device__ __forceinline__ bool next(int i, pg8::Unit& u) const {
        const long L = (long)(i >> 1) * G + c; if (L >= (long)nM * nN) return false;
        int pm, pn; pg8::tile_of((int)L, nM, nN, pm, pn); const int part = i & 1;
        u.pm = pm; u.pn = pn; u.ex = part; u.cnt = 256; u.rows = nullptr;
        u.A = (part ? A1 : A0) + (size_t)pm * 256 * DP * 2; u.B = (part ? B1 : B0) + (size_t)pn * 256 * DP * 2; return true; }
};
struct EpiMerge {
    static constexpr bool PERM = true;
    const unsigned char* gates; bf16_t* mg;
    __device__ __forceinline__ bool operator()(f32x4 (&acc)[2][2][4][2], const pg8::Unit& u, int wr, int wc, int fr, int fq) const {
        const int row0 = u.pm * 256 + wr * 64 + fr, col0 = u.pn * 256 + wc * 32 + 8 * fq;
        if (u.ex == 0) {
#pragma unroll
            for (int ai = 0; ai < 2; ++ai)
#pragma unroll
                for (int m = 0; m < 4; ++m) { const unsigned char* gr = gates + (size_t)(row0 + ai * 128 + m * 16) * 2048 + col0;
#pragma unroll
                    for (int bj = 0; bj < 2; ++bj) { const u32x2 ga = *(const u32x2*)(gr + bj * 128), gb = *(const u32x2*)(gr + 1024 + bj * 128);
                        const unsigned a0 = ga.x, a1 = ga.y, b0 = gb.x, b1 = gb.y;
#pragma unroll
                        for (int q = 0; q < 4; ++q) { acc[ai][bj][m][0][q] *= (float)((a0 >> (8 * q)) & 255u) * fast_rcp((float)((b0 >> (8 * q)) & 255u));
                                                      acc[ai][bj][m][1][q] *= (float)((a1 >> (8 * q)) & 255u) * fast_rcp((float)((b1 >> (8 * q)) & 255u)); } } }
            return true;
        }
#pragma unroll
        for (int ai = 0; ai < 2; ++ai)
#pragma unroll
            for (int m = 0; m < 4; ++m) { const size_t row = (size_t)(row0 + ai * 128 + m * 16); const unsigned char* gr = gates + row * 2048 + 1024 + col0; bf16_t* mr = mg + row * D + col0;
#pragma unroll
                for (int bj = 0; bj < 2; ++bj) { const u32x2 gb = *(const u32x2*)(gr + bj * 128); const unsigned b0 = gb.x, b1 = gb.y;
                    f32x4 v0 = acc[ai][bj][m][0], v1 = acc[ai][bj][m][1];
#pragma unroll
                    for (int q = 0; q < 4; ++q) { v0[q] *= (float)((b0 >> (8 * q)) & 255u) * (1.f / 255.f); v1[q] *= (float)((b1 >> (8 * q)) & 255u) * (1.f / 255.f); }
                    u32x4 w; w.x = cvt_pk_bf16(v0[0], v0[1]); w.y = cvt_pk_bf16(v0[2], v0[3]); w.z = cvt_pk_bf16(v1[0], v1[1]); w.w = cvt_pk_bf16(v1[2], v1[3]);
                    *(u32x4*)(mr + bj * 128) = w; } }
        return false;
    }
};
struct EpiX1 {
    static constexpr bool PERM = true;
    const float* x; bf16_t* x1b; unsigned char* x1q;
    __device__ __forceinline__ bool operator()(f32x4 (&acc)[2][2][4][2], const pg8::Unit& u, int wr, int wc, int fr, int fq) const {
        const int row0 = u.pm * 256 + wr * 64 + fr, col0 = u.pn * 256 + wc * 32 + 8 * fq;
#pragma unroll
        for (int ai = 0; ai < 2; ++ai)
#pragma unroll
            for (int m = 0; m < 4; ++m) { const size_t off = (size_t)(row0 + ai * 128 + m * 16) * D + col0;
#pragma unroll
                for (int bj = 0; bj < 2; ++bj) { const f32x4 x0 = __builtin_nontemporal_load((const f32x4*)(x + off + bj * 128)), x1v = __builtin_nontemporal_load((const f32x4*)(x + off + bj * 128 + 4));
                    const f32x4 v0 = acc[ai][bj][m][0] + x0, v1 = acc[ai][bj][m][1] + x1v; u32x4 w;
                    w.x = cvt_pk_bf16(v0[0], v0[1]); w.y = cvt_pk_bf16(v0[2], v0[3]); w.z = cvt_pk_bf16(v1[0], v1[1]); w.w = cvt_pk_bf16(v1[2], v1[3]);
                    *(u32x4*)(x1b + off + bj * 128) = w;
                    u32x2 q8; q8.x = pk4_fp8(v0[0] * SX8, v0[1] * SX8, v0[2] * SX8, v0[3] * SX8); q8.y = pk4_fp8(v1[0] * SX8, v1[1] * SX8, v1[2] * SX8, v1[3] * SX8);
                    *(u32x2*)(x1q + off + bj * 128) = q8; } }
        return false;
    }
};

struct SchedMoE {
    volatile LAS unsigned* M; const char* A; const char* Bw; const int* alist; size_t bstepE, bstepN, astepBlk; int G, c, gather, rep;
    __device__ __forceinline__ bool next(int i, pg8::Unit& u) const {
        int L = i * G + c; const int tot = (int)M[TAB_CUM + 32];
        if (L >= 4 * tot * rep) return false; L %= 4 * tot;
        int e = 0;
        while (e < 31 && L >= 4 * (int)M[TAB_CUM + e + 1]) ++e;
        const int cb = (int)M[TAB_CUM + e], nb = (int)M[TAB_CUM + e + 1] - cb, r = L - 4 * cb;
        int pn = r / nb, rb = r - pn * nb; int cnt = (int)M[TAB_CNT + e] - rb * 256; cnt = cnt > 256 ? 256 : cnt;
        e = __builtin_amdgcn_readfirstlane(e); pn = __builtin_amdgcn_readfirstlane(pn); rb = __builtin_amdgcn_readfirstlane(rb); cnt = __builtin_amdgcn_readfirstlane(cnt);
        const int blk = __builtin_amdgcn_readfirstlane(cb) + rb;
        u.pm = blk; u.pn = pn; u.ex = e; u.cnt = cnt; u.rows = alist + (size_t)e * T + rb * 256;
        u.A = gather ? A : A + (size_t)blk * astepBlk; u.B = Bw + (size_t)e * bstepE + (size_t)pn * bstepN; return true; }
};
struct EpiUp {
    static constexpr bool PERM = true;
    const int* alist; const f32x2* rwlist; bf16_t* hid;
    __device__ __forceinline__ bool operator()(f32x4 (&acc)[2][2][4][2], const pg8::Unit& u, int wr, int wc, int fr, int fq) const {
        const f32x2* rw = rwlist + (u.rows - alist);
        const int col0 = u.pn * 128 + wc * 32 + 8 * fq;
#pragma unroll
        for (int ai = 0; ai < 2; ++ai)
#pragma unroll
            for (int m = 0; m < 4; ++m) { const int r = ai * 128 + wr * 64 + m * 16 + fr; const float rs = (r < u.cnt) ? rw[r].x : 0.f;
                const f32x4 g0 = acc[ai][0][m][0] * rs, g1 = acc[ai][0][m][1] * rs, u0 = acc[ai][1][m][0] * rs, u1 = acc[ai][1][m][1] * rs;
                float o[8];
#pragma unroll
                for (int q = 0; q < 4; ++q) { o[q] = g0[q] * fsigmoid(g0[q]) * u0[q]; o[4 + q] = g1[q] * fsigmoid(g1[q]) * u1[q]; }
                u32x4 w; w.x = cvt_pk_bf16(o[0], o[1]); w.y = cvt_pk_bf16(o[2], o[3]); w.z = cvt_pk_bf16(o[4], o[5]); w.w = cvt_pk_bf16(o[6], o[7]);
                *(u32x4*)(hid + (size_t)(u.pm * 256 + r) * DE + col0) = w; }
        return false;
    }
};
struct EpiDown {
    static constexpr bool PERM = true;
    const int* alist; const f32x2* rwlist; bf16_t* yb;
    __device__ __forceinline__ bool operator()(f32x4 (&acc)[2][2][4][2], const pg8::Unit& u, int wr, int wc, int fr, int fq) const {
        const f32x2* rw = rwlist + (u.rows - alist);
        const int col0 = u.pn * 256 + wc * 32 + 8 * fq;
#pragma unroll
        for (int ai = 0; ai < 2; ++ai)
#pragma unroll
            for (int m = 0; m < 4; ++m) { const int r = ai * 128 + wr * 64 + m * 16 + fr;
                if (r < u.cnt) { const int a = u.rows[r]; const float w8 = rw[r].y; bf16_t* yr = yb + (size_t)a * D + col0;
#pragma unroll
                    for (int bj = 0; bj < 2; ++bj) { const f32x4 v0 = acc[ai][bj][m][0] * w8, v1 = acc[ai][bj][m][1] * w8; u32x4 w;
                        w.x = cvt_pk_bf16(v0[0], v0[1]); w.y = cvt_pk_bf16(v0[2], v0[3]); w.z = cvt_pk_bf16(v1[0], v1[1]); w.w = cvt_pk_bf16(v1[2], v1[3]);
                        *(u32x4*)(yr + bj * 128) = w; } } }
        return false;
    }
};

struct SchedMoEQ {
    volatile LAS unsigned* M; unsigned* ctl; const char* x1b; const char* hid; const char* wup; const char* wdn; const int* alist; const f32x2* rwlist; unsigned* ready; int xcc, wave, lane;
    __device__ __forceinline__ bool next(int i, pg8::UnitM& u) const {
        if (wave == 0) {
            if (lane == 0) {
                unsigned code = 0xFFFFFFFFu; int sft = (int)M[TAB_XS]; const int tot = (int)M[TAB_CUM + 32];
                while (sft < 8) { const int x = (xcc + sft) & 7; const int b0 = x * tot / 8, b1 = (x + 1) * tot / 8; const unsigned nq = (unsigned)(b1 - b0) * 4u;
                    const unsigned p = nq ? __hip_atomic_fetch_add(ctl + CW_Q + 64 * x, 1u, __ATOMIC_RELAXED, __HIP_MEMORY_SCOPE_AGENT) : 0xFFFFFFFFu;
                    if (p < 2u * nq) { code = (p < nq) ? ((unsigned)b0 * 4u + p) : (0x80000000u | ((unsigned)b0 * 4u + (p - nq))); break; }
                    ++sft; }
                M[TAB_XS] = (unsigned)sft; M[TAB_Q + (i & 1)] = code;
            }
            asm volatile("s_waitcnt lgkmcnt(0)" ::: "memory");
        }
        asm volatile("" ::: "memory"); __builtin_amdgcn_s_barrier(); asm volatile("" ::: "memory");
        const unsigned code = (unsigned)__builtin_amdgcn_readfirstlane((int)M[TAB_Q + (i & 1)]);
        if (code == 0xFFFFFFFFu) return false;
        const int type = (int)(code >> 31), L = (int)(code & 0x7FFFFFFFu), blk = L >> 2, pn = L & 3;
        const int e = __builtin_amdgcn_readfirstlane((int)M[TAB_BLK + blk]);
        const int rb = blk - __builtin_amdgcn_readfirstlane((int)M[TAB_CUM + e]); int cnt = __builtin_amdgcn_readfirstlane((int)M[TAB_CNT + e]) - rb * 256; cnt = cnt > 256 ? 256 : cnt;
        u.blk = blk; u.pn = pn; u.ex = e; u.cnt = cnt; u.type = type; u.rows = alist + (size_t)e * T + rb * 256;
        if (type == 0) { u.A = x1b; u.B = wup + ((size_t)e * 1024 + pn * 256) * D; }
        else { u.A = hid + (size_t)blk * 256 * DE; u.B = wdn + ((size_t)e * 1024 + pn * 256) * DE; }
        return true;
    }
    __device__ __forceinline__ void wait_ready(const pg8::UnitM& u) const {
        unsigned spins = 0;
        while ((unsigned)__builtin_amdgcn_readfirstlane((int)__hip_atomic_load(ctl + CW_READY + u.blk, __ATOMIC_RELAXED, __HIP_MEMORY_SCOPE_AGENT)) < 32u) {
            __builtin_amdgcn_s_sleep(2);
            if (++spins > (1u << 22)) { if (lane == 0) __hip_atomic_store(ctl + CW_TMO, 1u, __ATOMIC_RELAXED, __HIP_MEMORY_SCOPE_AGENT); break; } }
    }
};
struct EpiUpQ {
    bf16_t* hid;
    __device__ __forceinline__ void operator()(f32x4 (&acc)[2][2][4][2], const pg8::UnitM& u, int wr, int wc, int fr, int fq, const LAS unsigned char* meta) const {
        asm volatile("" : "+v"(fr), "+v"(fq));
        const __amdgpu_buffer_rsrc_t rs = __builtin_amdgcn_make_buffer_rsrc(hid, 0, 40960 * DE, 0x00020000);
        const int col0 = u.pn * 128 + wc * 32 + 8 * fq;
#pragma unroll
        for (int ai = 0; ai < 2; ++ai)
#pragma unroll
            for (int m = 0; m < 4; ++m) { const int r = ai * 128 + wr * 64 + m * 16 + fr; const unsigned rbits = ((const LAS unsigned*)meta)[4 * r + 1]; const float rsd = u2f(rbits) * (1.f / (SX8 * SW8));
                const f32x4 g0 = acc[ai][0][m][0] * rsd, g1 = acc[ai][0][m][1] * rsd, u0 = acc[ai][1][m][0] * rsd, u1 = acc[ai][1][m][1] * rsd;
                float o[8];
#pragma unroll
                for (int q = 0; q < 4; ++q) { o[q] = g0[q] * fsigmoid(g0[q]) * u0[q]; o[4 + q] = g1[q] * fsigmoid(g1[q]) * u1[q]; }
                u32x2 w; w.x = pk4_fp8(o[0] * SH8, o[1] * SH8, o[2] * SH8, o[3] * SH8); w.y = pk4_fp8(o[4] * SH8, o[5] * SH8, o[6] * SH8, o[7] * SH8);
                __builtin_amdgcn_raw_buffer_store_b64(w, rs, (int)((unsigned)(u.blk * 256 + r) * DE + col0), 0, 16);
                if (m & 1) asm volatile("" ::: "memory"); }
    }
};
struct EpiDownQ {
    bf16_t* yb;
    __device__ __forceinline__ void operator()(f32x4 (&acc)[2][2][4][2], const pg8::UnitM& u, int wr, int wc, int fr, int fq, const LAS unsigned char* meta) const {
        asm volatile("" : "+v"(fr), "+v"(fq));
        const int col0 = u.pn * 256 + wc * 32 + 8 * fq;
#pragma unroll
        for (int ai = 0; ai < 2; ++ai)
#pragma unroll
            for (int m = 0; m < 4; ++m) { const int r = ai * 128 + wr * 64 + m * 16 + fr; const unsigned abits = ((const LAS unsigned*)meta)[4 * r], wbits = ((const LAS unsigned*)meta)[4 * r + 2];
                if ((int)abits >= 0) { const float w8 = u2f(wbits) * (1.f / (SH8 * SW8)); bf16_t* yr = yb + (size_t)abits * D + col0;
#pragma unroll
                    for (int bj = 0; bj < 2; ++bj) { const f32x4 v0 = acc[ai][bj][m][0] * w8, v1 = acc[ai][bj][m][1] * w8; u32x4 w;
                        w.x = cvt_pk_bf16(v0[0], v0[1]); w.y = cvt_pk_bf16(v0[2], v0[3]); w.z = cvt_pk_bf16(v1[0], v1[1]); w.w = cvt_pk_bf16(v1[2], v1[3]);
                        *(u32x4*)(yr + bj * 128) = w; } } }
    }
};

__device__ __forceinline__ void p7_route(const Args& a, LAS unsigned char* lds, volatile LAS unsigned* MISC, int tid, int lane, int wave, int vcu, int G) {
    const float* b_rg = a.in[14]; const float* b_re = a.in[16];
    unsigned char* ws = a.ws;
    const bf16_t* x1b = (const bf16_t*)(ws + WS_X1B);
    int* alist = (int*)(ws + WS_ALIST); f32x2* rwlist = (f32x2*)(ws + WS_RWLIST); unsigned* counts = (unsigned*)(ws + WS_CTL) + CW_CNT;
    float* rstd2 = (float*)(ws + WS_RSTD2); float* gwd = (float*)(ws + WS_GW);
    { u32x4 t[12];
#pragma unroll
      for (int i = 0; i < 12; ++i) t[i] = *(const u32x4*)(ws + WS_WR + (size_t)(tid + i * 512) * 16);
#pragma unroll
      for (int i = 0; i < 12; ++i) *(LAS u32x4*)(lds + (tid + i * 512) * 16) = t[i]; }
    if (tid < 32) MISC[TAB_HIST + tid] = 0u;
    __syncthreads();
    LAS float* lgs = (LAS float*)(lds + 98304 + wave * 4096);
    for (int tile = vcu; tile < T / 64; tile += G) {
        int e1 = 0, e2 = 0, lp1 = 0, lp2 = 0; float gw1 = 0.f, gw2 = 0.f, rstd_t = 0.f;
        const int tok0 = tile * 64 + wave * 16;
        if (wave < 4) {
            const int row = lane & 15, kg = lane >> 4;
            const bf16_t* xbp = x1b + (size_t)(tok0 + row) * D + 8 * kg;
            f32x4 acc[3]; acc[0] = (f32x4){0.f, 0.f, 0.f, 0.f}; acc[1] = acc[0]; acc[2] = acc[0];
            float ss = 0.f;
#pragma unroll 8
            for (int s = 0; s < 32; ++s) {
                const u32x4 w = *(const u32x4*)(xbp + 32 * s);
#pragma unroll
                for (int q = 0; q < 4; ++q) { const float lo = bflo(w[q]), hi = bfhi(w[q]); ss += lo * lo + hi * hi; }
                const bf16x8 af = __builtin_bit_cast(bf16x8, w);
#pragma unroll
                for (int j = 0; j < 3; ++j) { const bf16x8 bfr = *(const LAS bf16x8*)(lds + (16 * j + row) * 2048 + (((4 * s + kg) ^ row) << 4));
                    acc[j] = __builtin_amdgcn_mfma_f32_16x16x32_bf16(af, bfr, acc[j], 0, 0, 0); }
            }
            ss += __shfl_xor(ss, 16); ss += __shfl_xor(ss, 32);
            const float rstd = rsqrtf(ss * (1.f / D) + EPS);
#pragma unroll
            for (int j = 0; j < 3; ++j)
#pragma unroll
                for (int q = 0; q < 4; ++q) lgs[(4 * kg + q) * 48 + 16 * j + row] = acc[j][q];
            if (lane < 16) lgs[768 + lane] = rstd;
            LDS_WAIT(); asm volatile("" ::: "memory");
            if (lane < 16) {
                rstd_t = lgs[768 + lane];
                const LAS float* lr = lgs + lane * 48;
                float lg[4];
#pragma unroll
                for (int o = 0; o < 4; ++o) lg[o] = lr[o] * rstd_t + b_rg[o];
                int gs = 0; float gm = lg[0];
#pragma unroll
                for (int o = 1; o < 4; ++o) if (lg[o] > gm) { gm = lg[o]; gs = o; }
                float den = 0.f;
#pragma unroll
                for (int o = 0; o < 4; ++o) den += __expf(lg[o] - gm);
                const float pg = 1.f / den;
                float le[8];
#pragma unroll
                for (int o = 0; o < 8; ++o) le[o] = lr[4 + gs * 8 + o] * rstd_t + b_re[gs * 8 + o];
                int i1 = 0; float m1 = le[0];
#pragma unroll
                for (int o = 1; o < 8; ++o) if (le[o] > m1) { m1 = le[o]; i1 = o; }
                int i2 = 0; float m2 = -3.0e38f;
#pragma unroll
                for (int o = 0; o < 8; ++o) if (o != i1 && le[o] > m2) { m2 = le[o]; i2 = o; }
                const float ex2 = __expf(m2 - m1), inv = 1.f / (1.f + ex2);
                e1 = gs * 8 + i1; e2 = gs * 8 + i2; gw1 = pg * inv; gw2 = pg * ex2 * inv;
                lp1 = (int)__hip_atomic_fetch_add((LAS unsigned*)&MISC[TAB_HIST + e1], 1u, __ATOMIC_RELAXED, __HIP_MEMORY_SCOPE_WORKGROUP);
                lp2 = (int)__hip_atomic_fetch_add((LAS unsigned*)&MISC[TAB_HIST + e2], 1u, __ATOMIC_RELAXED, __HIP_MEMORY_SCOPE_WORKGROUP);
            }
        }
        __syncthreads();
        if (tid < 32) { const unsigned hc = MISC[TAB_HIST + tid]; MISC[TAB_BASE + tid] = hc ? __hip_atomic_fetch_add(counts + tid, hc, __ATOMIC_RELAXED, __HIP_MEMORY_SCOPE_AGENT) : 0u; MISC[TAB_HIST + tid] = 0u; }
        __syncthreads();
        if (wave < 4 && lane < 16) {
            const int tok = tok0 + lane;
            const int p1 = (int)MISC[TAB_BASE + e1] + lp1, p2 = (int)MISC[TAB_BASE + e2] + lp2;
            alist[(size_t)e1 * T + p1] = tok * 2; rwlist[(size_t)e1 * T + p1] = (f32x2){rstd_t, gw1};
            alist[(size_t)e2 * T + p2] = tok * 2 + 1; rwlist[(size_t)e2 * T + p2] = (f32x2){rstd_t, gw2};
            rstd2[tok] = rstd_t; gwd[tok * 2] = gw1; gwd[tok * 2 + 1] = gw2;
        }
        __syncthreads();
    }
}
__device__ __forceinline__ void moe_tables(unsigned* counts, volatile LAS unsigned* MISC, int tid) {
    if (tid == 0) { unsigned cum = 0;
        for (int e = 0; e < 32; ++e) { const unsigned c = __hip_atomic_load(counts + e, __ATOMIC_RELAXED, __HIP_MEMORY_SCOPE_AGENT); MISC[TAB_CNT + e] = c; MISC[TAB_CUM + e] = cum; const unsigned nb = (c + 255u) >> 8;
            for (unsigned b = 0; b < nb; ++b) MISC[TAB_BLK + cum + b] = (unsigned)e; cum += nb; }
        MISC[TAB_CUM + 32] = cum; MISC[TAB_XS] = 0u; }
    __syncthreads();
}
__device__ __forceinline__ void p10_final(const Args& a, int lane, int wave, int vcu, int G) {
    const bf16_t* x1b = (const bf16_t*)(a.ws + WS_X1B); const float* gf = a.in[20];
    const int gw = vcu * NWAVES + wave, NGW = G * NWAVES;
    f32x4 gv[4];
#pragma unroll
    for (int j = 0; j < 4; ++j) gv[j] = *(const f32x4*)(gf + 4 * lane + 256 * j);
    u32x2 xn[4], pn[4], qn[4];
    if (gw < T) {
#pragma unroll
        for (int j = 0; j < 4; ++j) { xn[j] = __builtin_nontemporal_load((const u32x2*)(x1b + (size_t)gw * D) + lane + 64 * j); pn[j] = __builtin_nontemporal_load((const u32x2*)(a.out + (size_t)gw * D) + lane + 64 * j); qn[j] = __builtin_nontemporal_load((const u32x2*)(a.out + (size_t)gw * D + 512) + lane + 64 * j); } }
    for (int t = gw; t < T; t += NGW) {
        float* orow = a.out + (size_t)t * D;
        f32x4 v[4]; float s = 0.f;
#pragma unroll
        for (int j = 0; j < 4; ++j) { const u32x2 xv = xn[j], p = pn[j], q = qn[j];
            v[j].x = bflo(xv.x) + bflo(p.x) + bflo(q.x); v[j].y = bfhi(xv.x) + bfhi(p.x) + bfhi(q.x); v[j].z = bflo(xv.y) + bflo(p.y) + bflo(q.y); v[j].w = bfhi(xv.y) + bfhi(p.y) + bfhi(q.y);
            s += (v[j].x * v[j].x + v[j].y * v[j].y) + (v[j].z * v[j].z + v[j].w * v[j].w); }
        if (t + NGW < T) { const size_t tn = (size_t)(t + NGW);
#pragma unroll
            for (int j = 0; j < 4; ++j) { xn[j] = __builtin_nontemporal_load((const u32x2*)(x1b + tn * D) + lane + 64 * j); pn[j] = __builtin_nontemporal_load((const u32x2*)(a.out + tn * D) + lane + 64 * j); qn[j] = __builtin_nontemporal_load((const u32x2*)(a.out + tn * D + 512) + lane + 64 * j); } }
        s = wave_sum(s);
        const float rstd = rsqrtf(s * (1.f / D) + EPS);
#pragma unroll
        for (int j = 0; j < 4; ++j) __builtin_nontemporal_store(v[j] * rstd * gv[j], (f32x4*)orow + lane + 64 * j);
    }
}

typedef short v4i16_t __attribute__((ext_vector_type(4)));
__device__ __forceinline__ int img_off(int row, int ch) { return 2048 * (row >> 3) + 512 * (ch >> 2) + 64 * (row & 7) + 16 * ((ch & 3) ^ ((row >> 2) & 3)); }
__device__ __forceinline__ v4i16_t tr_read(LAS unsigned char* p) { return __builtin_amdgcn_ds_read_tr16_b64_v4i16((LAS v4i16_t*)p); }
__device__ __forceinline__ bf16x8 tr_frag(LAS unsigned char* img, int r0, int r1, int c0, int lane) {
    const int li = lane & 15, q = li >> 2, p = li & 3;
    const v4i16_t lo = tr_read(img + img_off(r0 + q, c0 + (p >> 1)) + 8 * (p & 1)), hi = tr_read(img + img_off(r1 + q, c0 + (p >> 1)) + 8 * (p & 1));
    return (bf16x8){lo[0], lo[1], lo[2], lo[3], hi[0], hi[1], hi[2], hi[3]};
}
__device__ __forceinline__ float wave_prefix_sum(float v, int lane) {
#pragma unroll
    for (int d = 1; d < 64; d <<= 1) { const float o = __shfl_up(v, d); if (lane >= d) v += o; }
    return v;
}
__device__ __forceinline__ float wave_prefix_max(float v, int lane) {
#pragma unroll
    for (int d = 1; d < 64; d <<= 1) { const float o = __shfl_up(v, d); if (lane >= d) v = fmaxf(v, o); }
    return v;
}
__device__ __forceinline__ float wave_max(float v) {
#pragma unroll
    for (int o = 1; o < 64; o <<= 1) v = fmaxf(v, __shfl_xor(v, o));
    return v;
}
constexpr int HALF_LDS = 50176;
__device__ __forceinline__ void conv4_silu(const u32x4 (&raw)[7], const float (&cw)[4][8], float scale, float (&out)[4][8]) {
#pragma unroll
    for (int i = 0; i < 4; ++i)
#pragma unroll
        for (int q = 0; q < 4; ++q) { float a0 = 0.f, a1 = 0.f;
#pragma unroll
            for (int j = 0; j < 4; ++j) { const unsigned w = raw[i + j][q]; a0 += bflo(w) * cw[j][2 * q]; a1 += bfhi(w) * cw[j][2 * q + 1]; }
            out[i][2 * q] = a0 * fsigmoid(a0) * scale; out[i][2 * q + 1] = a1 * fsigmoid(a1) * scale; }
}
__device__ __forceinline__ void b1_item(const Args& a, LAS unsigned char* hl, int item, int tl, int wv, int lane) {
    unsigned char* ws = a.ws; const bf16_t* z = (const bf16_t*)(ws + WS_Z); const float* gif = (const float*)(ws + WS_GIF); const float* conv_k = a.in[5];
    bf16_t* kact = (bf16_t*)(ws + WS_KACT); float* nloc = (float*)(ws + WS_NLOC); float* scal = (float*)(ws + WS_SCAL);
    unsigned char* Cb = (unsigned char*)a.out + OB_C + (size_t)item * 32768;
    const int bh = item >> 5, c = item & 31, b = bh >> 2, hh = bh & 3;
    const size_t tok_base = (size_t)b * SEQ + c * 64;
    const int cc = tl & 15, tg = tl >> 4, t0 = 4 * tg;
    u32x4 kr[7], vr[4];
#pragma unroll
    for (int j = 0; j < 7; ++j) { const int t = t0 - 3 + j; kr[j] = (c * 64 + t >= 0) ? __builtin_nontemporal_load((const u32x4*)(z + zoff(tok_base + t, 1024 + hh * 128 + cc * 8))) : (u32x4){0u, 0u, 0u, 0u}; }
#pragma unroll
    for (int i = 0; i < 4; ++i) vr[i] = __builtin_nontemporal_load((const u32x4*)(z + zoff(tok_base + t0 + i, 1536 + hh * 128 + cc * 8)));
    float cw[4][8];
#pragma unroll
    for (int j = 0; j < 4; ++j) { const f32x4 w0 = *(const f32x4*)(conv_k + j * DM + hh * 128 + cc * 8), w1 = *(const f32x4*)(conv_k + j * DM + hh * 128 + cc * 8 + 4);
        cw[j][0] = w0.x; cw[j][1] = w0.y; cw[j][2] = w0.z; cw[j][3] = w0.w; cw[j][4] = w1.x; cw[j][5] = w1.y; cw[j][6] = w1.z; cw[j][7] = w1.w; }
    LAS float* sc = (LAS float*)(hl + 49152);
    if (wv == 0) {
        const size_t tok = tok_base + lane;
        const float ig = gif[tok * 8 + hh], fp = gif[tok * 8 + 4 + hh];
        const float bb = wave_prefix_sum(logsigmoidf_(fp), lane);
        const float blast = __shfl(bb, 63);
        const float alog = blast - bb + ig;
        const float amax = wave_max(alog);
        sc[lane] = __expf(alog - amax);
        if (lane == 0) { scal[item] = amax; scal[1024 + item] = blast; }
    }
#pragma unroll
    for (int i = 0; i < 4; ++i) *(LAS u32x4*)(hl + 16384 + img_off(t0 + i, cc)) = vr[i];
    __syncthreads();
    {
        float ka[4][8]; conv4_silu(kr, cw, 0.08838834764831845f, ka);
#pragma unroll
        for (int i = 0; i < 4; ++i) { const float wl = sc[t0 + i];
            u32x4 w; w.x = pk2(ka[i][0], ka[i][1]); w.y = pk2(ka[i][2], ka[i][3]); w.z = pk2(ka[i][4], ka[i][5]); w.w = pk2(ka[i][6], ka[i][7]);
            *(u32x4*)(kact + ((size_t)hh * T + tok_base + t0 + i) * 128 + cc * 8) = w;
            u32x4 x; x.x = pk2(ka[i][0] * wl, ka[i][1] * wl); x.y = pk2(ka[i][2] * wl, ka[i][3] * wl); x.z = pk2(ka[i][4] * wl, ka[i][5] * wl); x.w = pk2(ka[i][6] * wl, ka[i][7] * wl);
            *(LAS u32x4*)(hl + img_off(t0 + i, cc)) = x; }
    }
    __syncthreads();
    {
        const int g = lane >> 4;
        bf16x8 af[2][2];
#pragma unroll
        for (int ii = 0; ii < 2; ++ii)
#pragma unroll
            for (int ks = 0; ks < 2; ++ks) af[ii][ks] = tr_frag(hl, 32 * ks + 8 * g, 32 * ks + 8 * g + 4, 2 * (2 * wv + ii), lane);
        const bf16x8 ones = (bf16x8){0x3F80, 0x3F80, 0x3F80, 0x3F80, 0x3F80, 0x3F80, 0x3F80, 0x3F80};
        f32x4 accn[2];
#pragma unroll
        for (int ii = 0; ii < 2; ++ii) { accn[ii] = (f32x4){0.f, 0.f, 0.f, 0.f};
#pragma unroll
            for (int ks = 0; ks < 2; ++ks) accn[ii] = __builtin_amdgcn_mfma_f32_16x16x32_bf16(af[ii][ks], ones, accn[ii], 0, 0, 0); }
#pragma unroll
        for (int j = 0; j < 8; ++j) {
            f32x4 acc0 = (f32x4){0.f, 0.f, 0.f, 0.f}, acc1 = acc0;
#pragma unroll
            for (int ks = 0; ks < 2; ++ks) { const bf16x8 bfv = tr_frag(hl + 16384, 32 * ks + 8 * g, 32 * ks + 8 * g + 4, 2 * j, lane);
                acc0 = __builtin_amdgcn_mfma_f32_16x16x32_bf16(af[0][ks], bfv, acc0, 0, 0, 0); acc1 = __builtin_amdgcn_mfma_f32_16x16x32_bf16(af[1][ks], bfv, acc1, 0, 0, 0); }
            u32x4 w; w.x = pk2(acc0[0], acc0[1]); w.y = pk2(acc0[2], acc0[3]); w.z = pk2(acc1[0], acc1[1]); w.w = pk2(acc1[2], acc1[3]);
            *(u32x4*)(Cb + ((size_t)((wv * 8 + j) * 64 + lane) << 4)) = w;
        }
        if ((lane & 15) == 0) {
#pragma unroll
            for (int ii = 0; ii < 2; ++ii) *(f32x4*)(nloc + (size_t)item * 128 + 16 * (2 * wv + ii) + 4 * g) = accn[ii]; }
    }
    __syncthreads();
}
__device__ __forceinline__ void pool_pass(const Args& a, int tid, int vcu, int G) {
    const bf16_t* z = (const bf16_t*)(a.ws + WS_Z); bf16_t* dA = (bf16_t*)((unsigned char*)a.out + OB_DA);
    for (int w = vcu * (NWAVES * 64) + tid; w < (T / 8) * 64; w += G * NWAVES * 64) {
        const int cc = w & 63, run = w >> 6, tokA = run * 8, s0 = tokA % SEQ, grp = cc >> 4, win = 2 << grp;
        const bf16_t* zp = z + zoff((size_t)tokA, cc * 8);
        float S[8];
#pragma unroll
        for (int q = 0; q < 8; ++q) S[q] = 0.f;
        for (int j = 1; j <= win; ++j) if (s0 - j >= 0) { const u32x4 r = *(const u32x4*)(zp - (size_t)j * 128);
#pragma unroll
            for (int q = 0; q < 4; ++q) { S[2 * q] += bflo(r[q]); S[2 * q + 1] += bfhi(r[q]); } }
#pragma unroll
        for (int i = 0; i < 8; ++i) {
            const int s = s0 + i; const u32x4 r = *(const u32x4*)(zp + (size_t)i * 128);
            float cur[8];
#pragma unroll
            for (int q = 0; q < 4; ++q) { cur[2 * q] = bflo(r[q]); cur[2 * q + 1] = bfhi(r[q]); S[2 * q] += cur[2 * q]; S[2 * q + 1] += cur[2 * q + 1]; }
            if (s - win >= 0) { const u32x4 o = *(const u32x4*)(zp + (size_t)(i - win) * 128);
#pragma unroll
                for (int q = 0; q < 4; ++q) { S[2 * q] -= bflo(o[q]); S[2 * q + 1] -= bfhi(o[q]); } }
            const float inv = 1.f / (float)(s + 1 < win ? s + 1 : win);
            u32x4 w4;
#pragma unroll
            for (int q = 0; q < 4; ++q) w4[q] = pk2(S[2 * q] * inv - cur[2 * q], S[2 * q + 1] * inv - cur[2 * q + 1]);
            *(u32x4*)(dA + (size_t)(tokA + i) * DP + cc * 8) = w4;
        }
    }
}
__device__ __forceinline__ void p3_scan(const Args& a, int tid, int vcu, int G) {
    float* scal = (float*)(a.ws + WS_SCAL); float* nloc = (float*)(a.ws + WS_NLOC);
    for (int w = vcu; w < 256; w += G) {
        const int bh = w >> 3, part = w & 7;
        unsigned char* Cp = (unsigned char*)a.out + OB_C + (size_t)bh * 32 * 32768 + (size_t)(part * 512 + tid) * 8;
        u32x2 ld[32];
#pragma unroll
        for (int c = 0; c < 32; ++c) ld[c] = __builtin_nontemporal_load((const u32x2*)(Cp + (size_t)c * 32768));
        const bool do_n = (part == 0 && tid < 128);
        float nl[32];
        if (do_n) {
#pragma unroll
            for (int c = 0; c < 32; ++c) nl[c] = nloc[(size_t)(bh * 32 + c) * 128 + tid]; }
        float st[4] = {0.f, 0.f, 0.f, 0.f}; float m = 0.f, nst = 0.f;
#pragma unroll
        for (int c = 0; c < 32; ++c) {
            const float am = scal[bh * 32 + c], bl = scal[1024 + bh * 32 + c];
            const float mn = fmaxf(bl + m, am), sp = __expf(bl + m - mn), sl = __expf(am - mn);
            u32x2 o; o.x = pk2(st[0], st[1]); o.y = pk2(st[2], st[3]); *(u32x2*)(Cp + (size_t)c * 32768) = o;
            st[0] = sp * st[0] + sl * bflo(ld[c].x); st[1] = sp * st[1] + sl * bfhi(ld[c].x); st[2] = sp * st[2] + sl * bflo(ld[c].y); st[3] = sp * st[3] + sl * bfhi(ld[c].y);
            if (do_n) { nloc[(size_t)(bh * 32 + c) * 128 + tid] = nst; nst = sp * nst + sl * nl[c]; }
            if (part == 0 && tid == 0) scal[2048 + bh * 32 + c] = m;
            m = mn;
        }
    }
}
__device__ __forceinline__ void b3_item(const Args& a, LAS unsigned char* hl, const LAS float* ghl, int item, int tl, int wv, int lane) {
    unsigned char* ws = a.ws; const bf16_t* z = (const bf16_t*)(ws + WS_Z); const float* gif = (const float*)(ws + WS_GIF); const float* conv_q = a.in[4]; const float* g_head = a.in[6];
    const bf16_t* kact = (const bf16_t*)(ws + WS_KACT); const float* nprev = (const float*)(ws + WS_NLOC) + (size_t)item * 128; const float* scal = (const float*)(ws + WS_SCAL);
    const unsigned char* Cb = (const unsigned char*)a.out + OB_C + (size_t)item * 32768; bf16_t* hm = (bf16_t*)((unsigned char*)a.out + OB_HM);
    const int bh = item >> 5, c = item & 31, b = bh >> 2, hh = bh & 3;
    const size_t tok_base = (size_t)b * SEQ + c * 64;
    const int cc = tl & 15, tg = tl >> 4, t0 = 4 * tg;
    LAS unsigned char* qi = hl; LAS unsigned char* ki = hl + 16384; LAS unsigned char* vi = hl + 32768; LAS float* sc = (LAS float*)(hl + 49152);
    const float mprev = scal[2048 + item];
    u32x4 cpre[8]; u32x2 opre[8];
#pragma unroll
    for (int i = 0; i < 8; ++i) cpre[i] = __builtin_nontemporal_load((const u32x4*)(Cb + ((size_t)((wv * 8 + i) * 64 + lane) << 4)));
#pragma unroll
    for (int jd = 0; jd < 8; ++jd) opre[jd] = __builtin_nontemporal_load((const u32x2*)(z + zoff(tok_base + 16 * wv + (lane & 15), 2048 + hh * 128 + 16 * jd + 4 * (lane >> 4))));
    {
        u32x4 qr[7], kv[4], vr[4];
#pragma unroll
        for (int j = 0; j < 7; ++j) { const int t = t0 - 3 + j; qr[j] = (c * 64 + t >= 0) ? __builtin_nontemporal_load((const u32x4*)(z + zoff(tok_base + t, 512 + hh * 128 + cc * 8))) : (u32x4){0u, 0u, 0u, 0u}; }
#pragma unroll
        for (int i = 0; i < 4; ++i) { kv[i] = __builtin_nontemporal_load((const u32x4*)(kact + ((size_t)hh * T + tok_base + t0 + i) * 128 + cc * 8)); vr[i] = __builtin_nontemporal_load((const u32x4*)(z + zoff(tok_base + t0 + i, 1536 + hh * 128 + cc * 8))); }
        float cw[4][8];
#pragma unroll
        for (int j = 0; j < 4; ++j) { const f32x4 w0 = *(const f32x4*)(conv_q + j * DM + hh * 128 + cc * 8), w1 = *(const f32x4*)(conv_q + j * DM + hh * 128 + cc * 8 + 4);
            cw[j][0] = w0.x; cw[j][1] = w0.y; cw[j][2] = w0.z; cw[j][3] = w0.w; cw[j][4] = w1.x; cw[j][5] = w1.y; cw[j][6] = w1.z; cw[j][7] = w1.w; }
        if (wv == 0) {
            const size_t tok = tok_base + lane;
            const float ig = gif[tok * 8 + hh], fp = gif[tok * 8 + 4 + hh];
            const float bb = wave_prefix_sum(logsigmoidf_(fp), lane);
            const float gg = ig - bb;
            const float M = fmaxf(mprev, wave_prefix_max(gg, lane));
            sc[lane] = gg; sc[64 + lane] = M; sc[128 + lane] = bb;
        }
        float qa[4][8]; conv4_silu(qr, cw, 1.f, qa);
#pragma unroll
        for (int i = 0; i < 4; ++i) { u32x4 w; w.x = pk2(qa[i][0], qa[i][1]); w.y = pk2(qa[i][2], qa[i][3]); w.z = pk2(qa[i][4], qa[i][5]); w.w = pk2(qa[i][6], qa[i][7]);
            *(LAS u32x4*)(qi + img_off(t0 + i, cc)) = w; *(LAS u32x4*)(ki + img_off(t0 + i, cc)) = kv[i]; *(LAS u32x4*)(vi + img_off(t0 + i, cc)) = vr[i]; }
    }
    __syncthreads();
    {
        const int jt = wv, li = lane & 15, g = lane >> 4, trow = 16 * jt + li;
        bf16x8 qn[4];
#pragma unroll
        for (int ks = 0; ks < 4; ++ks) qn[ks] = *(const LAS bf16x8*)(qi + img_off(trow, 4 * ks + g));
        f32x4 accs[4];
#pragma unroll
        for (int i = 0; i < 4; ++i) { accs[i] = (f32x4){0.f, 0.f, 0.f, 0.f};
            if (i <= jt) {
#pragma unroll
                for (int ks = 0; ks < 4; ++ks) { const bf16x8 kf = *(const LAS bf16x8*)(ki + img_off(16 * i + li, 4 * ks + g)); accs[i] = __builtin_amdgcn_mfma_f32_16x16x32_bf16(kf, qn[ks], accs[i], 0, 0, 0); } } }
        const float Mt = sc[64 + trow], bt = sc[128 + trow];
        float rsum = 0.f;
#pragma unroll
        for (int i = 0; i < 4; ++i) { if (i <= jt) { const f32x4 gsv = *(const LAS f32x4*)(sc + 16 * i + 4 * g);
#pragma unroll
                for (int q = 0; q < 4; ++q) { float p = accs[i][q] * __expf(gsv[q] - Mt); if (i == jt && 4 * g + q > li) p = 0.f; accs[i][q] = p; rsum += p; } } }
        rsum += __shfl_xor(rsum, 16); rsum += __shfl_xor(rsum, 32);
        bf16x8 pf[2];
#pragma unroll
        for (int u = 0; u < 2; ++u) { u32x4 w; w.x = pk2(accs[2 * u][0], accs[2 * u][1]); w.y = pk2(accs[2 * u][2], accs[2 * u][3]); w.z = pk2(accs[2 * u + 1][0], accs[2 * u + 1][1]); w.w = pk2(accs[2 * u + 1][2], accs[2 * u + 1][3]); pf[u] = __builtin_bit_cast(bf16x8, w); }
        bf16x8 qp[4];
#pragma unroll
        for (int s4 = 0; s4 < 4; ++s4) { const u32x2 lo = *(const LAS u32x2*)(qi + img_off(trow, 4 * s4 + (g >> 1)) + 8 * (g & 1)), hi = *(const LAS u32x2*)(qi + img_off(trow, 4 * s4 + 2 + (g >> 1)) + 8 * (g & 1));
            qp[s4] = __builtin_bit_cast(bf16x8, (u32x4){lo.x, lo.y, hi.x, hi.y}); }
        f32x4 acco[8]; f32x4 accn = (f32x4){0.f, 0.f, 0.f, 0.f};
#pragma unroll
        for (int s4 = 0; s4 < 4; ++s4) { const f32x4 n0 = *(const f32x4*)(nprev + 32 * s4 + 4 * g), n1 = *(const f32x4*)(nprev + 32 * s4 + 16 + 4 * g);
            u32x4 w; w.x = pk2(n0.x, n0.y); w.y = pk2(n0.z, n0.w); w.z = pk2(n1.x, n1.y); w.w = pk2(n1.z, n1.w);
            accn = __builtin_amdgcn_mfma_f32_16x16x32_bf16(__builtin_bit_cast(bf16x8, w), qp[s4], accn, 0, 0, 0); }
        LDS_WAIT(); __syncthreads();
#pragma unroll
        for (int i = 0; i < 8; ++i) *(LAS u32x4*)(hl + (((wv * 8 + i) * 64 + lane) << 4)) = cpre[i];
        LDS_WAIT(); __syncthreads();
#pragma unroll
        for (int jd = 0; jd < 8; ++jd) { acco[jd] = (f32x4){0.f, 0.f, 0.f, 0.f};
#pragma unroll
            for (int s4 = 0; s4 < 4; ++s4) { const bf16x8 cf = *(const LAS bf16x8*)(hl + (((s4 * 8 + jd) * 64 + lane) << 4)); acco[jd] = __builtin_amdgcn_mfma_f32_16x16x32_bf16(cf, qp[s4], acco[jd], 0, 0, 0); } }
        const float winter = __expf(mprev - Mt);
#pragma unroll
        for (int jd = 0; jd < 8; ++jd) acco[jd] = acco[jd] * winter;
#pragma unroll
        for (int u = 0; u < 2; ++u) { if (2 * u <= jt) {
#pragma unroll
                for (int jd = 0; jd < 8; ++jd) { const bf16x8 vf = tr_frag(vi, 32 * u + 4 * g, 32 * u + 16 + 4 * g, 2 * jd, lane); acco[jd] = __builtin_amdgcn_mfma_f32_16x16x32_bf16(vf, pf[u], acco[jd], 0, 0, 0); } } }
        const float nq = winter * accn[0] + rsum;
        const float inv = 1.f / fmaxf(fabsf(nq), __expf(-bt - Mt));
        float s1 = 0.f;
#pragma unroll
        for (int jd = 0; jd < 8; ++jd) { acco[jd] = acco[jd] * inv; s1 += (acco[jd][0] + acco[jd][1]) + (acco[jd][2] + acco[jd][3]); }
        s1 += __shfl_xor(s1, 16); s1 += __shfl_xor(s1, 32);
        const float mu = s1 * (1.f / HD);
        float s2 = 0.f;
#pragma unroll
        for (int jd = 0; jd < 8; ++jd) { const f32x4 d = acco[jd] - mu; s2 += (d[0] * d[0] + d[1] * d[1]) + (d[2] * d[2] + d[3] * d[3]); }
        s2 += __shfl_xor(s2, 16); s2 += __shfl_xor(s2, 32);
        const float rstd = rsqrtf(s2 * (1.f / HD) + EPS);
        const size_t tok = tok_base + trow;
#pragma unroll
        for (int jd = 0; jd < 8; ++jd) { const int dv0 = hh * 128 + 16 * jd + 4 * g;
            const f32x4 gh = *(const LAS f32x4*)(ghl + dv0); const u32x2 ov = opre[jd];
            const f32x4 hn = (acco[jd] - mu) * rstd * gh;
            u32x2 w; w.x = pk2(hn[0] * fsigmoid(bflo(ov.x)), hn[1] * fsigmoid(bfhi(ov.x))); w.y = pk2(hn[2] * fsigmoid(bflo(ov.y)), hn[3] * fsigmoid(bfhi(ov.y)));
            *(u32x2*)(hm + tok * DM + dv0) = w; }
    }
    __syncthreads();
}

constexpr int TR_PITCH = 144, TR_SCR = 64 * TR_PITCH;
struct TrDesc { const float* src; bf16_t* dst; const float* ksc; int ld, k0, n0s, dstK, fp8; };
__device__ __forceinline__ void tr64_load(const TrDesc& d, f32x4 (&v)[16], int lane) {
    const int lr = lane >> 4, lc = (lane & 15) * 4;
#pragma unroll
    for (int i = 0; i < 16; ++i) v[i] = __builtin_nontemporal_load((const f32x4*)(d.src + (size_t)(d.k0 + 4 * i + lr) * d.ld + d.n0s + lc));
}
__device__ __forceinline__ void tr64_store(const TrDesc& d, const f32x4 (&v)[16], LAS unsigned char* scr, int lane) {
    const int lr = lane >> 4, lc = (lane & 15) * 4;
#pragma unroll
    for (int i = 0; i < 16; ++i) { f32x4 x = v[i]; if (d.ksc) x = x * d.ksc[d.k0 + 4 * i + lr];
        u32x2 w; w.x = pk2(x.x, x.y); w.y = pk2(x.z, x.w); *(LAS u32x2*)(scr + (4 * i + lr) * TR_PITCH + lc * 2) = w; }
    LDS_WAIT(); asm volatile("" ::: "memory");
    const int li = lane & 15, g = lane >> 4, q = li >> 2, p = li & 3;
#pragma unroll
    for (int nb = 0; nb < 4; ++nb)
#pragma unroll
        for (int kh = 0; kh < 2; ++kh) { const int kc = 4 * kh + g;
            LAS unsigned char* ap = scr + (8 * kc + q) * TR_PITCH + (nb * 16 + 4 * p) * 2;
            const v4i16_t lo = tr_read(ap), hi = tr_read(ap + 4 * TR_PITCH);
            if (d.fp8) { const u32x2 l2 = __builtin_bit_cast(u32x2, lo), h2 = __builtin_bit_cast(u32x2, hi); const unsigned l0 = l2.x, l1 = l2.y, h0 = h2.x, h1 = h2.y;
                u32x2 o8; o8.x = pk4_fp8(bflo(l0) * SW8, bfhi(l0) * SW8, bflo(l1) * SW8, bfhi(l1) * SW8); o8.y = pk4_fp8(bflo(h0) * SW8, bfhi(h0) * SW8, bflo(h1) * SW8, bfhi(h1) * SW8);
                *(u32x2*)((unsigned char*)d.dst + (size_t)(nb * 16 + li) * d.dstK + d.k0 + 8 * kc) = o8; }
            else { const bf16x8 o = (bf16x8){lo[0], lo[1], lo[2], lo[3], hi[0], hi[1], hi[2], hi[3]};
                *(bf16x8*)(d.dst + (size_t)(nb * 16 + li) * d.dstK + d.k0 + 8 * kc) = o; } }
    LDS_WAIT(); asm volatile("" ::: "memory");
}
template <class Dec>
__device__ __forceinline__ void tr64_stream(const Dec& dec, int it0, int stride, int n, LAS unsigned char* scr, int lane) {
    if (it0 >= n) return;
    TrDesc dc = dec(it0); f32x4 vc[16]; tr64_load(dc, vc, lane);
    for (int it = it0; it < n; it += stride) {
        const bool more = it + stride < n;
        TrDesc dn = dc; f32x4 vn[16];
        if (more) { dn = dec(it + stride); tr64_load(dn, vn, lane); }
        tr64_store(dc, vc, scr, lane);
        if (more) { dc = dn;
#pragma unroll
            for (int i = 0; i < 16; ++i) vc[i] = vn[i]; }
    }
}
struct DecP0 { const float *w_in, *w_br_b, *w_out, *w_eg, *w_eu, *g_ffn; unsigned char* ws;
    __device__ __forceinline__ TrDesc operator()(int r) const {
        constexpr int I_WZ = 16 * 72, I_WB = 8 * 16, I_WO = 16 * 16, I_EG = 32 * 16 * 8;
        TrDesc d; d.ksc = nullptr; d.fp8 = 0;
        if (r < I_WZ) { const int kb = r / 72, nb = r % 72, n0 = nb * 64; d.src = w_in; d.ld = NIN; d.k0 = kb * 64; d.n0s = zcol2orig(n0); d.dst = (bf16_t*)(ws + WS_WZ) + (size_t)n0 * D; d.dstK = D;
            if (n0 >= 2560) { d.dst = (bf16_t*)(ws + WS_WZ8 + (size_t)(n0 - 2560) * D); d.fp8 = 1; } return d; } r -= I_WZ;
        if (r < I_WB) { const int kb = r >> 4, nb = r & 15; d.src = w_br_b; d.ld = D; d.k0 = kb * 64; d.n0s = nb * 64; d.dst = (bf16_t*)(ws + WS_WBT) + (size_t)(nb * 64) * DM; d.dstK = DM; return d; } r -= I_WB;
        if (r < I_WO) { const int kb = r >> 4, nb = r & 15; d.src = w_out; d.ld = D; d.k0 = kb * 64; d.n0s = nb * 64; d.dst = (bf16_t*)(ws + WS_WOT) + (size_t)(nb * 64) * D; d.dstK = D; return d; } r -= I_WO;
        const int up = r >= I_EG; if (up) r -= I_EG; const int e = r >> 7, kb = (r >> 3) & 15, nb = r & 7, j0 = nb * 64;
        const int drow = (j0 >> 7) * 256 + up * 128 + (j0 & 127);
        d.src = (up ? w_eu : w_eg) + (size_t)e * D * DE; d.ld = DE; d.k0 = kb * 64; d.n0s = j0; d.dst = (bf16_t*)(ws + WS_WUP + ((size_t)e * 1024 + drow) * D); d.dstK = D; d.ksc = g_ffn; d.fp8 = 1; return d; }
};
struct DecWd { const float* w_ed; unsigned char* ws;
    __device__ __forceinline__ TrDesc operator()(int r) const { const int e = r >> 7, kb = (r >> 4) & 7, nb = r & 15;
        TrDesc d; d.src = w_ed + (size_t)e * DE * D; d.ld = D; d.k0 = kb * 64; d.n0s = nb * 64; d.dst = (bf16_t*)(ws + WS_WDN + ((size_t)e * 1024 + nb * 64) * DE); d.dstK = DE; d.ksc = nullptr; d.fp8 = 1; return d; }
};

__device__ __forceinline__ void p0_prologue(const Args& a, LAS unsigned char* lds, int tid, int lane, int wave, int vcu, int G) {
    const float* x = a.in[0]; const float* g_mix = a.in[1]; const float* w_in = a.in[2]; const float* b_if = a.in[3];
    const float* w_pool = a.in[7]; const float* pool_scale = a.in[8]; const float* w_br_a = a.in[9]; const float* w_br_b = a.in[10]; const float* w_out = a.in[11];
    const float* g_ffn = a.in[12]; const float* w_eg = a.in[17]; const float* w_eu = a.in[18];
    unsigned char* ws = a.ws;
    bf16_t* h = (bf16_t*)((unsigned char*)a.out + OB_H); float* gif = (float*)(ws + WS_GIF); unsigned char* h8 = (unsigned char*)a.out + OB_H8;
    const int gw = vcu * NWAVES + wave, NGW = G * NWAVES;
    LAS float* gwl = (LAS float*)(lds + 81920);
    for (int idx = tid; idx < 8192; idx += NWAVES * 64) { const int k = idx >> 3, o = idx & 7; gwl[o * 1024 + k] = w_in[(size_t)k * NIN + 2560 + o] * g_mix[k]; }
    __syncthreads();
    REP(20) {
        f32x4 gm[4];
#pragma unroll
        for (int j = 0; j < 4; ++j) gm[j] = *(const f32x4*)(g_mix + 4 * lane + 256 * j);
        f32x4 vn[4], vm[4];
        if (gw < T) {
#pragma unroll
            for (int j = 0; j < 4; ++j) vn[j] = __builtin_nontemporal_load((const f32x4*)(x + (size_t)gw * D) + lane + 64 * j); }
        if (gw + NGW < T) {
#pragma unroll
            for (int j = 0; j < 4; ++j) vm[j] = __builtin_nontemporal_load((const f32x4*)(x + (size_t)(gw + NGW) * D) + lane + 64 * j); }
        for (int m = gw; m < T; m += NGW) {
            f32x4 v[4];
#pragma unroll
            for (int j = 0; j < 4; ++j) { v[j] = vn[j]; vn[j] = vm[j]; }
            if (m + 2 * NGW < T) {
#pragma unroll
                for (int j = 0; j < 4; ++j) vm[j] = __builtin_nontemporal_load((const f32x4*)(x + (size_t)(m + 2 * NGW) * D) + lane + 64 * j); }
            float s = 0.f;
#pragma unroll
            for (int j = 0; j < 4; ++j) s += (v[j].x * v[j].x + v[j].y * v[j].y) + (v[j].z * v[j].z + v[j].w * v[j].w);
            float acc[8];
#pragma unroll
            for (int o = 0; o < 8; ++o) { float t = 0.f;
#pragma unroll
                for (int j = 0; j < 4; ++j) { const f32x4 w = *(const LAS f32x4*)(gwl + o * 1024 + 4 * lane + 256 * j); t += (v[j].x * w.x + v[j].y * w.y) + (v[j].z * w.z + v[j].w * w.w); }
                acc[o] = t; }
            s = wave_sum(s);
#pragma unroll
            for (int o = 0; o < 8; ++o) acc[o] = wave_sum(acc[o]);
            const float rstd = rsqrtf(s * (1.f / D) + EPS);
            u32x2* o8 = (u32x2*)(h + (size_t)m * D) + lane;
#pragma unroll
            for (int j = 0; j < 4; ++j) { const f32x4 hv = v[j] * rstd * gm[j]; u32x2 w; w.x = pk2(hv.x, hv.y); w.y = pk2(hv.z, hv.w); o8[64 * j] = w;
                ((unsigned*)(h8 + (size_t)m * D))[lane + 64 * j] = pk4_fp8(hv.x * SX8, hv.y * SX8, hv.z * SX8, hv.w * SX8); }
            if (lane < 8) { float r = acc[0];
#pragma unroll
                for (int o = 1; o < 8; ++o) r = (lane == o) ? acc[o] : r;
                gif[(size_t)m * 8 + lane] = r * rstd + b_if[lane]; }
        }
    }
    REP(21) {
        bf16_t* W2T = (bf16_t*)(ws + WS_W2T);
        const int li = lane & 15, g = lane >> 4;
        for (int tile = gw; tile < 32 * 64; tile += NGW) {
            const int k0 = (tile >> 6) * 16, n0 = (tile & 63) * 16, gq = k0 >> 7;
            const float* wp = w_pool + (size_t)(k0 + li) * 128 + 8 * g; const float* sc = pool_scale + gq * 128 + 8 * g; const float* wa = w_br_a + (size_t)(gq * 128 + 8 * g) * D + n0 + li;
            f32x4 a0[4], a1[4], s0[4], s1[4]; float bv[4][8];
#pragma unroll
            for (int st = 0; st < 4; ++st) { a0[st] = *(const f32x4*)(wp + 32 * st); a1[st] = *(const f32x4*)(wp + 32 * st + 4); s0[st] = *(const f32x4*)(sc + 32 * st); s1[st] = *(const f32x4*)(sc + 32 * st + 4);
#pragma unroll
                for (int j = 0; j < 8; ++j) bv[st][j] = wa[(size_t)(32 * st + j) * D]; }
            f32x4 acc = (f32x4){0.f, 0.f, 0.f, 0.f};
#pragma unroll
            for (int st = 0; st < 4; ++st) { const f32x4 p0 = a0[st] * s0[st], p1 = a1[st] * s1[st];
                u32x4 aw; aw.x = pk2(p0.x, p0.y); aw.y = pk2(p0.z, p0.w); aw.z = pk2(p1.x, p1.y); aw.w = pk2(p1.z, p1.w);
                u32x4 bw; bw.x = pk2(bv[st][0], bv[st][1]); bw.y = pk2(bv[st][2], bv[st][3]); bw.z = pk2(bv[st][4], bv[st][5]); bw.w = pk2(bv[st][6], bv[st][7]);
                acc = __builtin_amdgcn_mfma_f32_16x16x32_bf16(__builtin_bit_cast(bf16x8, aw), __builtin_bit_cast(bf16x8, bw), acc, 0, 0, 0); }
            u32x2 o; o.x = pk2(acc[0], acc[1]); o.y = pk2(acc[2], acc[3]);
            *(u32x2*)(W2T + (size_t)(n0 + li) * DP + k0 + 4 * g) = o;
        }
    }
    LAS unsigned char* scr = lds + wave * TR_SCR;
    constexpr int NITEMS = 16 * 72 + 8 * 16 + 16 * 16 + 2 * 32 * 16 * 8;
    REP(22) tr64_stream(DecP0{w_in, w_br_b, w_out, w_eg, w_eu, g_ffn, ws}, gw, NGW, NITEMS, scr, lane);
    {
        const float* w_rg = a.in[13]; const float* w_re = a.in[15];
        const int gt = gw * 64 + lane;
        if (gt < 48 * 128) { const int col = gt >> 7, ch = gt & 127; float v[8];
#pragma unroll
            for (int q = 0; q < 8; ++q) { const int k = 8 * ch + q; v[q] = (col < 4 ? w_rg[k * NG + col] : col < 36 ? w_re[k * NE + col - 4] : 0.f) * g_ffn[k]; }
            u32x4 w; w.x = pk2(v[0], v[1]); w.y = pk2(v[2], v[3]); w.z = pk2(v[4], v[5]); w.w = pk2(v[6], v[7]);
            *(u32x4*)(ws + WS_WR + col * 2048 + ((ch ^ (col & 15)) << 4)) = w; }
    }
}

__device__ __forceinline__ void convert_wdown(const Args& a, LAS unsigned char* lds, int lane, int wave, int gi, int ngrp) {
    tr64_stream(DecWd{a.in[19], a.ws}, gi * NWAVES + wave, ngrp * NWAVES, 32 * 8 * 16, lds + wave * TR_SCR, lane);
}

__global__ void __launch_bounds__(NWAVES * 64, 2) mk_fwd(Args args) {
    extern __shared__ __attribute__((aligned(16))) unsigned char lds_raw[];
    LAS unsigned char* lds = (LAS unsigned char*)lds_raw;
    volatile LAS unsigned* MISC = (volatile LAS unsigned*)(lds + MISC_OFF);
    const int tid = threadIdx.x, lane = tid & 63, wave = __builtin_amdgcn_readfirstlane(tid >> 6);
    const int G = gridDim.x; const int bx = blockIdx.x; const int vcu = (G % 8 == 0) ? (bx % 8) * (G / 8) + bx / 8 : bx;
    unsigned char* ws = args.ws; unsigned* ctl = (unsigned*)(ws + WS_CTL);
    for (int u = tid; u < (LDS_BYTES - LDSCTL_OFF) / 4; u += NWAVES * 64) ((LAS unsigned*)(lds + LDSCTL_OFF))[u] = 0u;
    __syncthreads();
    XcdBarrier bar = xcd_barrier_post(ctl + CW_BAR + args.li * XCD_BAR_WORDS, MISC + 8);
    const int lo = args.ph_lo, hi = args.ph_hi;
#define IN(k) (lo <= (k) && (k) < hi)
#define BOTH(k) (IN(k) && IN((k) + 1))
#define GRID_BAR() xcd_barrier(bar)
#define STAMP(k) do { if (PROBE_PHASE >= 100 && bx == 0 && tid == 0) { const unsigned long long _t = __builtin_amdgcn_s_memrealtime(); if ((k) == PROBE_PHASE - 100) tstart = _t; if ((k) == PROBE_PHASE - 99) tend = _t; } } while (0)
    unsigned long long tstart = 0, tend = 0;
    STAMP(0);
    if (IN(0)) { REP(0) { p0_prologue(args, lds, tid, lane, wave, vcu, G); __syncthreads(); } if (BOTH(0)) GRID_BAR(); STAMP(1); }
    if (IN(1)) {
        SchedP1X S{(const char*)args.out + OB_H, (const char*)args.out + OB_H8, (const char*)(ws + WS_WZ), (const char*)(ws + WS_WZ8), T / 256, NZ / 256, G, bx};
        EpiZX E{(bf16_t*)(ws + WS_Z), ws + WS_GATES};
        pg8::gemm_phase_mix<SchedP1X, EpiZX>(lds + RING_OFF, S, E);
        { const int nwg = (T / 256) * (NZ / 256), full = nwg % G;
          if (full == 0) convert_wdown(args, lds, lane, wave, bx, G); else if (bx >= full) convert_wdown(args, lds, lane, wave, bx - full, G - full); }
        if (BOTH(1)) GRID_BAR(); STAMP(2);
    }
    if (IN(2)) {
        REP(2) for (int pr = vcu; pr < 512; pr += G) b1_item(args, lds + (wave >> 2) * HALF_LDS, 2 * pr + (wave >> 2), tid & 255, wave & 3, lane);
        pool_pass(args, tid, vcu, G);
        if (BOTH(2)) GRID_BAR(); STAMP(3);
    }
    if (IN(3)) { p3_scan(args, tid, vcu, G); if (BOTH(3)) GRID_BAR(); STAMP(4); }
    if (IN(4)) {
        { LAS float* ghl = (LAS float*)(lds + META_OFF); ghl[tid] = args.in[6][tid]; __syncthreads();
          REP(4) for (int pr = vcu; pr < 512; pr += G) b3_item(args, lds + (wave >> 2) * HALF_LDS, ghl, 2 * pr + (wave >> 2), tid & 255, wave & 3, lane); }
        if (BOTH(4)) GRID_BAR(); STAMP(5);
    }
    if (IN(5)) {
        SchedMerge S{(const char*)args.out + OB_DA, (const char*)args.out + OB_HM, (const char*)(ws + WS_W2T), (const char*)(ws + WS_WBT), T / 256, D / 256, G, bx};
        EpiMerge E{ws + WS_GATES, (bf16_t*)((unsigned char*)args.out + OB_MERGED)};
        pg8::gemm_phase<EpiMerge, SchedMerge, false>(lds + RING_OFF, pg8::Cfg{DP, DP * 2, DP * 2}, S, E);
        if (BOTH(5)) GRID_BAR(); STAMP(6);
    }
    if (IN(6)) {
        SchedDense S{(const char*)args.out + OB_MERGED, (const char*)(ws + WS_WOT), (size_t)256 * D * 2, (size_t)256 * D * 2, T / 256, D / 256, G, bx, (PROBE_PHASE == 6) ? 2 : 1};
        EpiX1 E{args.in[0], (bf16_t*)(ws + WS_X1B), ws + WS_X1Q};
        pg8::gemm_phase<EpiX1, SchedDense, false>(lds + RING_OFF, pg8::Cfg{D, D * 2, D * 2}, S, E);
        if (BOTH(6)) GRID_BAR(); STAMP(7);
    }
    if (IN(7)) { p7_route(args, lds, MISC, tid, lane, wave, vcu, G); if (BOTH(7)) GRID_BAR(); STAMP(8); }
#if MOE_DYN
    if (IN(8)) {
        moe_tables(ctl + CW_CNT, MISC, tid);
        SchedMoEQ S{MISC, ctl, (const char*)(ws + WS_X1Q), (const char*)(ws + WS_HID), (const char*)(ws + WS_WUP), (const char*)(ws + WS_WDN), (const int*)(ws + WS_ALIST), (const f32x2*)(ws + WS_RWLIST), ctl + CW_READY, (int)(bar.x & 7u), wave, lane};
        EpiUpQ E0{(bf16_t*)(ws + WS_HID)};
        EpiDownQ E1{(bf16_t*)args.out};
        pg8::gemm_phase_moe<SchedMoEQ, EpiUpQ, EpiDownQ>(lds + RING_OFF, lds + META_OFF, S, E0, E1);
        if (IN(10)) GRID_BAR(); STAMP(9); STAMP(10);
    }
#else
    if (IN(8)) {
        moe_tables(ctl + CW_CNT, MISC, tid);
        SchedMoE S{MISC, (const char*)(ws + WS_X1B), (const char*)(ws + WS_WUP), (const int*)(ws + WS_ALIST), (size_t)1024 * D * 2, (size_t)256 * D * 2, 0, G, vcu, 1, (PROBE_PHASE == 8) ? 2 : 1};
        EpiUp E{(const int*)(ws + WS_ALIST), (const f32x2*)(ws + WS_RWLIST), (bf16_t*)(ws + WS_HID)};
        pg8::gemm_phase<EpiUp, SchedMoE, true>(lds + RING_OFF, pg8::Cfg{D, D * 2, D * 2}, S, E);
        if (BOTH(8)) GRID_BAR(); STAMP(9);
    }
    if (IN(9)) {
        moe_tables(ctl + CW_CNT, MISC, tid);
        SchedMoE S{MISC, (const char*)(ws + WS_HID), (const char*)(ws + WS_WDN), (const int*)(ws + WS_ALIST), (size_t)1024 * DE * 2, (size_t)256 * DE * 2, (size_t)256 * DE * 2, G, vcu, 0, (PROBE_PHASE == 9) ? 2 : 1};
        EpiDown E{(const int*)(ws + WS_ALIST), (const f32x2*)(ws + WS_RWLIST), (bf16_t*)args.out};
        pg8::gemm_phase<EpiDown, SchedMoE, false>(lds + RING_OFF, pg8::Cfg{DE, DE * 2, DE * 2}, S, E);
        if (BOTH(9)) GRID_BAR(); STAMP(10);
    }
#endif
    if (IN(10)) p10_final(args, lane, wave, vcu, G);
    STAMP(11);
    if (PROBE_PHASE >= 100 && bx == 0 && tid == 0) { const unsigned long long d = (tend - tstart) * 8ull, t0 = __builtin_amdgcn_s_memrealtime(); while (__builtin_amdgcn_s_memrealtime() - t0 < d) __builtin_amdgcn_s_sleep(16); }
#undef IN
#undef BOTH
#undef GRID_BAR
}

}

extern "C" void kernel_launch(void* const* d_in, const int* in_sizes, int n_in, void* d_out, int out_size, void* d_ws, size_t ws_size, hipStream_t stream) {
    const float* x = (const float*)d_in[0];
    const float* conv_q = (const float*)d_in[4]; const float* conv_k = (const float*)d_in[5]; const float* g_head = (const float*)d_in[6]; const float* w_pool = (const float*)d_in[7];
    const float* pool_scale = (const float*)d_in[8]; const float* w_br_a = (const float*)d_in[9]; const float* w_br_b = (const float*)d_in[10]; const float* w_out = (const float*)d_in[11];
    const float* g_ffn = (const float*)d_in[12]; const float* w_rg = (const float*)d_in[13]; const float* b_rg = (const float*)d_in[14]; const float* w_re = (const float*)d_in[15];
    const float* b_re = (const float*)d_in[16]; const float* w_eg = (const float*)d_in[17]; const float* w_eu = (const float*)d_in[18]; const float* w_ed = (const float*)d_in[19];
    const float* g_final = (const float*)d_in[20];
    static int grid = 0;
    if (grid == 0) {
        if (n_in != 21 || out_size != T * D || ws_size < WS_END) { fprintf(stderr, "kernel_launch: unexpected shapes/ws (%d inputs, out %d, ws %zu)\n", n_in, out_size, ws_size); grid = -1; return; }
        int dev = 0, cus = 0, per_cu = 0;
        if (hipGetDevice(&dev) != hipSuccess || hipDeviceGetAttribute(&cus, hipDeviceAttributeMultiprocessorCount, dev) != hipSuccess) { grid = -1; return; }
        if (hipFuncSetAttribute((const void*)mk_fwd, hipFuncAttributeMaxDynamicSharedMemorySize, LDS_BYTES) != hipSuccess) { fprintf(stderr, "kernel_launch: hipFuncSetAttribute failed\n"); grid = -1; return; }
        if (hipOccupancyMaxActiveBlocksPerMultiprocessor(&per_cu, (const void*)mk_fwd, NWAVES * 64, LDS_BYTES) != hipSuccess || per_cu < 1) { fprintf(stderr, "kernel_launch: occupancy query says %d blocks per CU\n", per_cu); grid = -1; return; }
        (void)hipGetLastError();
        grid = cus;
    }
    if (grid < 0) return;
    unsigned char* ws = (unsigned char*)d_ws; unsigned char* ob = (unsigned char*)d_out;
    (void)hipMemsetAsync(ws + WS_CTL, 0, CTL_ZERO_BYTES, stream);
    Args a{};
    for (int i = 0; i < 21; ++i) a.in[i] = (const float*)d_in[i];
    a.out = (float*)d_out; a.ws = ws; a.flags = 0;
    a.ph_lo = 0; a.ph_hi = 11; a.li = 0;
    hipLaunchKernelGGL(mk_fwd, dim3(grid), dim3(NWAVES * 64), LDS_BYTES, stream, a);
}
```
